# Optimizing an MI355X kernel written in HIP

```python
import math
import jax, jax.numpy as jnp
from jax import lax
import numpy as np

D_MODEL = 1024
BATCH = 16
SEQ = 2048
DEPTH = 1

MEM_LEN = 256

SSM_WIDTH = 512
SSM_GROUP = 16
SSM_GROUPS = SSM_WIDTH // SSM_GROUP
SSM_STATE = 64
SSM_DT_MIN = 1e-3
SSM_DT_MAX = 1e-1
SSM_EIG_CLIP = -1e-4

N_HEADS = 16
N_KV_HEADS = 4
HEAD_DIM = 64
GQA_GROUP = N_HEADS // N_KV_HEADS
CMP_BLOCK = 32
CMP_STRIDE = 16
CMP_HIDDEN = 256
SLC_BLOCK = 64
SLC_TOP_N = 8
WINDOW = 512
Q_BLOCK = 64
SEL_BIG = 1e9

X_HEADS = 4
X_HEAD_DIM = D_MODEL // X_HEADS

D_FF = 256 * ((8 * D_MODEL + 3 * 256 - 1) // (3 * 256))

DEEPNORM_ALPHA = (2.0 * DEPTH) ** 0.25
DEEPNORM_BETA = (8.0 * DEPTH) ** -0.25
LN_EPS = 1e-5

Q_WIDTH = N_HEADS * HEAD_DIM
KV_WIDTH = 2 * N_KV_HEADS * HEAD_DIM
IN_SPLITS = (SSM_WIDTH, Q_WIDTH, KV_WIDTH, KV_WIDTH, KV_WIDTH, 3 * N_HEADS, 2 * D_MODEL)
IN_WIDTH = sum(IN_SPLITS)

kernel_name = "hybrid_s5_nsa_deepnorm_layer"


def _layer_norm(x, g, b):
    xf = x.astype(jnp.float32)
    mu = jnp.mean(xf, axis=-1, keepdims=True)
    var = jnp.mean(jnp.square(xf - mu), axis=-1, keepdims=True)
    return ((xf - mu) * lax.rsqrt(var + LN_EPS) * g + b).astype(x.dtype)


def _masked_softmax(s, mask):
    s = jnp.where(mask, s, -jnp.inf)
    m = jnp.max(s, axis=-1, keepdims=True)
    m = jnp.where(jnp.isfinite(m), m, 0.0)
    p = jnp.exp(s - m)
    return p / jnp.maximum(jnp.sum(p, axis=-1, keepdims=True), 1e-30)


def _alibi_slopes():
    h = jnp.arange(1, N_HEADS + 1, dtype=jnp.float32)
    return jnp.exp2(-8.0 * h / N_HEADS)


def _s5_branch(u, a_re, a_im, b_re, b_im, c_re, c_im, d_skip, log_dt, w_glu, b_glu, w_o):
    bsz, L, _ = u.shape
    uf = u.astype(jnp.float32)
    ug = uf.reshape(bsz, L, SSM_GROUPS, SSM_GROUP)
    lam_re = jnp.minimum(a_re.astype(jnp.float32), SSM_EIG_CLIP)
    lam_im = a_im.astype(jnp.float32)
    dt = jnp.exp(log_dt.astype(jnp.float32))[:, None]
    mag = jnp.exp(lam_re * dt)
    lb_re = mag * jnp.cos(lam_im * dt)
    lb_im = mag * jnp.sin(lam_im * dt)
    den = jnp.square(lam_re) + jnp.square(lam_im)
    nr = lb_re - 1.0
    f_re = (nr * lam_re + lb_im * lam_im) / den
    f_im = (lb_im * lam_re - nr * lam_im) / den
    br = b_re.astype(jnp.float32)
    bi = b_im.astype(jnp.float32)
    bb_re = f_re[..., None] * br - f_im[..., None] * bi
    bb_im = f_re[..., None] * bi + f_im[..., None] * br
    bu_re = jnp.einsum('blgc,gnc->blgn', ug, bb_re)
    bu_im = jnp.einsum('blgc,gnc->blgn', ug, bb_im)
    shape_a = (1, L, SSM_GROUPS, SSM_STATE)
    a_seq_re = jnp.broadcast_to(lb_re[None, None], shape_a)
    a_seq_im = jnp.broadcast_to(lb_im[None, None], shape_a)

    def combine(e1, e2):
        a1r, a1i, b1r, b1i = e1
        a2r, a2i, b2r, b2i = e2
        return (a1r * a2r - a1i * a2i,
                a1r * a2i + a1i * a2r,
                a2r * b1r - a2i * b1i + b2r,
                a2r * b1i + a2i * b1r + b2i)

    _, _, h_re, h_im = lax.associative_scan(combine, (a_seq_re, a_seq_im, bu_re, bu_im), axis=1)
    y = (jnp.einsum('blgn,gcn->blgc', h_re, c_re.astype(jnp.float32))
         - jnp.einsum('blgn,gcn->blgc', h_im, c_im.astype(jnp.float32)))
    y = y.reshape(bsz, L, SSM_WIDTH) + d_skip.astype(jnp.float32) * uf
    g = jax.nn.gelu(y)
    y = g * jax.nn.sigmoid(g @ w_glu.astype(jnp.float32) + b_glu.astype(jnp.float32))
    return y.astype(u.dtype) @ w_o


def _nsa_branch(q, kv_cmp, kv_slc, kv_win, gate_logits, cmp_pos, cmp_w1, cmp_b1, cmp_w2, w_o):
    bsz, L = q.shape[0], q.shape[1]
    n_cmp = L // CMP_STRIDE - CMP_BLOCK // CMP_STRIDE + 1
    n_slc = L // SLC_BLOCK
    n_sel = min(SLC_TOP_N, n_slc)
    scale = HEAD_DIM ** -0.5
    slopes = _alibi_slopes().reshape(N_KV_HEADS, GQA_GROUP)

    kv = jnp.moveaxis(kv_cmp, 2, 0)
    chunks = kv.reshape(2, bsz, L // CMP_STRIDE, CMP_STRIDE, N_KV_HEADS, HEAD_DIM)
    blocks = jnp.concatenate([chunks[:, :, r:r + n_cmp] for r in range(CMP_BLOCK // CMP_STRIDE)], axis=3)
    blocks = blocks + cmp_pos[:, None, None, :, None, :]
    flat = jnp.moveaxis(blocks, 3, 4).reshape(2, bsz, n_cmp, N_KV_HEADS, CMP_BLOCK * HEAD_DIM)
    hid = jax.nn.gelu(jnp.einsum('zbnhf,zfe->zbnhe', flat, cmp_w1) + cmp_b1[:, None, None, None, :])
    comp = jnp.einsum('zbnhe,zed->zbnhd', hid, cmp_w2)
    k_c, v_c = comp[0], comp[1]
    cmp_start = jnp.arange(n_cmp) * CMP_STRIDE
    cmp_end = cmp_start + CMP_BLOCK - 1
    slc_start = jnp.arange(n_slc) * SLC_BLOCK
    overlap = ((cmp_start[:, None] < slc_start[None, :] + SLC_BLOCK)
               & (cmp_end[:, None] >= slc_start[None, :])).astype(jnp.float32)

    k_s = kv_slc[:, :, 0].reshape(bsz, n_slc, SLC_BLOCK, N_KV_HEADS, HEAD_DIM).transpose(0, 3, 1, 2, 4)
    v_s = kv_slc[:, :, 1].reshape(bsz, n_slc, SLC_BLOCK, N_KV_HEADS, HEAD_DIM).transpose(0, 3, 1, 2, 4)

    pad = ((0, 0), (WINDOW, 0), (0, 0), (0, 0))
    k_w = jnp.pad(kv_win[:, :, 0], pad)
    v_w = jnp.pad(kv_win[:, :, 1], pad)

    qg = q.reshape(bsz, L, N_KV_HEADS, GQA_GROUP, HEAD_DIM)
    b_idx = jnp.arange(bsz)[:, None, None, None]
    h_idx = jnp.arange(N_KV_HEADS)[None, :, None, None]
    blk = jnp.arange(n_slc)
    in_blk = jnp.arange(SLC_BLOCK)
    win_off = jnp.arange(WINDOW + Q_BLOCK) - WINDOW

    def query_block(c):
        t0 = c * Q_BLOCK
        t = t0 + jnp.arange(Q_BLOCK)
        qc = lax.dynamic_slice_in_dim(qg, t0, Q_BLOCK, axis=1)

        s = jnp.einsum('bqhgd,bnhd->bhgqn', qc, k_c, preferred_element_type=jnp.float32) * scale
        dist = t[:, None] - cmp_end[None, :]
        s = s - slopes[:, :, None, None] * dist
        p_cmp = _masked_softmax(s, dist >= 0)
        o_cmp = jnp.einsum('bhgqn,bnhd->bqhgd', p_cmp, v_c)

        imp = jnp.einsum('bhgqn,nj->bhqj', p_cmp, overlap)
        cur = t // SLC_BLOCK
        forced = (blk[None, :] == 0) | (blk[None, :] == cur[:, None]) | (blk[None, :] == cur[:, None] - 1)
        future = blk[None, :] * SLC_BLOCK > t[:, None]
        imp = jnp.where(forced, SEL_BIG, jnp.where(future, -SEL_BIG, imp))
        _, idx = lax.top_k(imp, n_sel)
        k_sel = k_s[b_idx, h_idx, idx].reshape(bsz, N_KV_HEADS, Q_BLOCK, n_sel * SLC_BLOCK, HEAD_DIM)
        v_sel = v_s[b_idx, h_idx, idx].reshape(bsz, N_KV_HEADS, Q_BLOCK, n_sel * SLC_BLOCK, HEAD_DIM)
        s_pos = (idx[..., None] * SLC_BLOCK + in_blk).reshape(bsz, N_KV_HEADS, Q_BLOCK, n_sel * SLC_BLOCK)
        dist = t[:, None] - s_pos
        s = jnp.einsum('bqhgd,bhqsd->bhgqs', qc, k_sel, preferred_element_type=jnp.float32) * scale
        s = s - slopes[:, :, None, None] * dist[:, :, None]
        p = _masked_softmax(s, (dist >= 0)[:, :, None])
        o_slc = jnp.einsum('bhgqs,bhqsd->bqhgd', p, v_sel)

        k_wc = lax.dynamic_slice_in_dim(k_w, t0, WINDOW + Q_BLOCK, axis=1)
        v_wc = lax.dynamic_slice_in_dim(v_w, t0, WINDOW + Q_BLOCK, axis=1)
        w_pos = t0 + win_off
        dist = t[:, None] - w_pos[None, :]
        mask = (dist >= 0) & (dist < WINDOW) & (w_pos[None, :] >= 0)
        s = jnp.einsum('bqhgd,bkhd->bhgqk', qc, k_wc, preferred_element_type=jnp.float32) * scale
        s = s - slopes[:, :, None, None] * dist
        p = _masked_softmax(s, mask)
        o_win = jnp.einsum('bhgqk,bkhd->bqhgd', p, v_wc)
        return jnp.stack([o_cmp, o_slc, o_win], axis=0).astype(q.dtype)

    o = lax.map(query_block, jnp.arange(L // Q_BLOCK))
    o = jnp.moveaxis(o, 0, 2).reshape(3, bsz, L, N_HEADS, HEAD_DIM)
    g = jax.nn.sigmoid(gate_logits.astype(jnp.float32)).reshape(bsz, L, N_HEADS, 3)
    o = jnp.einsum('zblhd,blhz->blhd', o, g)
    return o.reshape(bsz, L, Q_WIDTH).astype(q.dtype) @ w_o


def _memory_cross_attention(h, mem, w_q, w_kv, w_o):
    bsz, L, _ = h.shape
    m = mem.shape[1]
    q = (h @ w_q).reshape(bsz, L, X_HEADS, X_HEAD_DIM)
    kv = (mem @ w_kv).reshape(bsz, m, 2, X_HEADS, X_HEAD_DIM)
    s = jnp.einsum('blhd,bmhd->bhlm', q, kv[:, :, 0], preferred_element_type=jnp.float32) * (X_HEAD_DIM ** -0.5)
    p = jax.nn.softmax(s, axis=-1)
    o = jnp.einsum('bhlm,bmhd->blhd', p, kv[:, :, 1]).astype(h.dtype)
    return o.reshape(bsz, L, D_MODEL) @ w_o


def _swiglu(h, w_in, w_out):
    gate, up = jnp.split(h @ w_in, 2, axis=-1)
    return (jax.nn.silu(gate) * up) @ w_out


def setup_inputs(seed: int = 0) -> dict:
    key = jax.random.key(seed)
    keys = iter(jax.random.split(key, 40))

    def nrm(shape, std):
        return std * jax.random.normal(next(keys), shape, jnp.float32)

    G, N = SSM_GROUPS, SSM_STATE
    n_idx = jnp.arange(N, dtype=jnp.float32)
    return {
        "x": nrm((BATCH, SEQ, D_MODEL), 1.0),
        "mem": nrm((BATCH, MEM_LEN, D_MODEL), 1.0),
        "ln_emb_g": 1.0 + nrm((D_MODEL,), 0.02),
        "ln_emb_b": nrm((D_MODEL,), 0.02),
        "w_in": nrm((DEPTH, D_MODEL, IN_WIDTH), D_MODEL ** -0.5),
        "ssm_a_re": -0.5 + nrm((DEPTH, G, N), 0.01),
        "ssm_a_im": jnp.pi * n_idx + nrm((DEPTH, G, N), 0.01),
        "ssm_b_re": nrm((DEPTH, G, N, SSM_GROUP), (2.0 * SSM_GROUP) ** -0.5),
        "ssm_b_im": nrm((DEPTH, G, N, SSM_GROUP), (2.0 * SSM_GROUP) ** -0.5),
        "ssm_c_re": nrm((DEPTH, G, SSM_GROUP, N), (2.0 * N) ** -0.5),
        "ssm_c_im": nrm((DEPTH, G, SSM_GROUP, N), (2.0 * N) ** -0.5),
        "ssm_d": nrm((DEPTH, SSM_WIDTH), 1.0),
        "ssm_log_dt": jax.random.uniform(next(keys), (DEPTH, G), jnp.float32,
                                         minval=math.log(SSM_DT_MIN), maxval=math.log(SSM_DT_MAX)),
        "ssm_w_glu": nrm((DEPTH, SSM_WIDTH, SSM_WIDTH), SSM_WIDTH ** -0.5),
        "ssm_b_glu": nrm((DEPTH, SSM_WIDTH), 0.01),
        "ssm_w_out": nrm((DEPTH, SSM_WIDTH, D_MODEL), SSM_WIDTH ** -0.5),
        "cmp_pos": nrm((DEPTH, 2, CMP_BLOCK, HEAD_DIM), 0.02),
        "cmp_w1": nrm((DEPTH, 2, CMP_BLOCK * HEAD_DIM, CMP_HIDDEN), (CMP_BLOCK * HEAD_DIM) ** -0.5),
        "cmp_b1": nrm((DEPTH, 2, CMP_HIDDEN), 0.01),
        "cmp_w2": nrm((DEPTH, 2, CMP_HIDDEN, HEAD_DIM), CMP_HIDDEN ** -0.5),
        "nsa_w_out": nrm((DEPTH, Q_WIDTH, D_MODEL), Q_WIDTH ** -0.5),
        "w_out": nrm((DEPTH, D_MODEL, D_MODEL), DEEPNORM_BETA * D_MODEL ** -0.5),
        "ln1_g": 1.0 + nrm((DEPTH, D_MODEL), 0.02),
        "ln1_b": nrm((DEPTH, D_MODEL), 0.02),
        "xattn_w_q": nrm((DEPTH, D_MODEL, D_MODEL), D_MODEL ** -0.5),
        "xattn_w_kv": nrm((DEPTH, D_MODEL, 2 * D_MODEL), D_MODEL ** -0.5),
        "xattn_w_o": nrm((DEPTH, D_MODEL, D_MODEL), DEEPNORM_BETA * D_MODEL ** -0.5),
        "ln2_g": 1.0 + nrm((DEPTH, D_MODEL), 0.02),
        "ln2_b": nrm((DEPTH, D_MODEL), 0.02),
        "ffn_w_in": nrm((DEPTH, D_MODEL, 2 * D_FF), D_MODEL ** -0.5),
        "ffn_w_out": nrm((DEPTH, D_FF, D_MODEL), DEEPNORM_BETA * D_FF ** -0.5),
        "ln3_g": 1.0 + nrm((DEPTH, D_MODEL), 0.02),
        "ln3_b": nrm((DEPTH, D_MODEL), 0.02),
    }


def reference(x, mem, ln_emb_g, ln_emb_b, w_in, ssm_a_re, ssm_a_im, ssm_b_re, ssm_b_im,
              ssm_c_re, ssm_c_im, ssm_d, ssm_log_dt, ssm_w_glu, ssm_b_glu, ssm_w_out,
              cmp_pos, cmp_w1, cmp_b1, cmp_w2, nsa_w_out, w_out, ln1_g, ln1_b,
              xattn_w_q, xattn_w_kv, xattn_w_o, ln2_g, ln2_b,
              ffn_w_in, ffn_w_out, ln3_g, ln3_b):
    bsz, L, _ = x.shape
    cuts = np.cumsum(IN_SPLITS)[:-1].tolist()
    h = _layer_norm(x, ln_emb_g, ln_emb_b)
    for l in range(DEPTH):
        z = h @ w_in[l]
        u, q, kv_c, kv_s, kv_w, g_nsa, g_mix = jnp.split(z, cuts, axis=-1)
        y_ssm = _s5_branch(u, ssm_a_re[l], ssm_a_im[l], ssm_b_re[l], ssm_b_im[l],
                           ssm_c_re[l], ssm_c_im[l], ssm_d[l], ssm_log_dt[l],
                           ssm_w_glu[l], ssm_b_glu[l], ssm_w_out[l])
        kv_shape = (bsz, L, 2, N_KV_HEADS, HEAD_DIM)
        y_nsa = _nsa_branch(q.reshape(bsz, L, N_HEADS, HEAD_DIM), kv_c.reshape(kv_shape),
                            kv_s.reshape(kv_shape), kv_w.reshape(kv_shape), g_nsa,
                            cmp_pos[l], cmp_w1[l], cmp_b1[l], cmp_w2[l], nsa_w_out[l])
        gate_ssm, gate_nsa = jnp.split(jax.nn.sigmoid(g_mix), 2, axis=-1)
        mixed = (gate_ssm * y_ssm + gate_nsa * y_nsa) @ w_out[l]
        h = _layer_norm(DEEPNORM_ALPHA * h + mixed, ln1_g[l], ln1_b[l])
        h = _layer_norm(DEEPNORM_ALPHA * h + _memory_cross_attention(h, mem, xattn_w_q[l], xattn_w_kv[l], xattn_w_o[l]),
                        ln2_g[l], ln2_b[l])
        h = _layer_norm(DEEPNORM_ALPHA * h + _swiglu(h, ffn_w_in[l], ffn_w_out[l]), ln3_g[l], ln3_b[l])
    return h
```

```cpp
#include <hip/hip_runtime.h>
#include <hip/hip_cooperative_groups.h>
#include <cstdio>
#include <cstdint>
namespace cg = cooperative_groups;

typedef unsigned short bf16_t;
typedef short bf16x8 __attribute__((ext_vector_type(8)));
typedef float f32x4 __attribute__((ext_vector_type(4)));
typedef unsigned u32x4 __attribute__((ext_vector_type(4)));
typedef unsigned u32x2 __attribute__((ext_vector_type(2)));
#define DEV __device__ __forceinline__

constexpr int T_ = 32768, L_ = 2048;
constexpr float LOG2E = 1.4426950408889634f;
constexpr float ALPHA = 1.189207115002721f;
constexpr float LN_EPS = 1e-5f;
constexpr float NEG = -1e30f;
constexpr int LDS_BYTES = 81920;
constexpr size_t MiB = 1048576;

constexpr size_t O_WIN_T = 0;
constexpr size_t O_WGLU_T = O_WIN_T + 5376ull * 1024 * 2;
constexpr size_t O_WSOUT_T = O_WGLU_T + 512ull * 512 * 2;
constexpr size_t O_W1_T = O_WSOUT_T + 1024ull * 512 * 2;
constexpr size_t O_W2_T = O_W1_T + 2ull * 256 * 2048 * 2;
constexpr size_t O_WNOUT_T = O_W2_T + 2ull * 128 * 256 * 2;
constexpr size_t O_WOUT_T = O_WNOUT_T + 2 * MiB;
constexpr size_t O_WXQ_T = O_WOUT_T + 2 * MiB;
constexpr size_t O_WXKV_T = O_WXQ_T + 2 * MiB;
constexpr size_t O_WXO_T = O_WXKV_T + 4 * MiB;
constexpr size_t O_WFIN_T = O_WXO_T + 2 * MiB;
constexpr size_t O_WFOUT_T = O_WFIN_T + 5632ull * 1024 * 2;
constexpr size_t O_BT1 = O_WFOUT_T + 1024ull * 2816 * 2;
constexpr size_t O_MTW = O_BT1 + 4 * MiB;
constexpr size_t O_KC = O_MTW + 20 * MiB;
constexpr size_t O_VCT = O_KC + 1 * MiB;
constexpr size_t O_GN = O_VCT + 1 * MiB;
constexpr size_t O_ST0 = O_GN + 6 * MiB;
constexpr size_t O_ST1 = O_ST0 + 262144;
constexpr size_t O_ST2 = O_ST1 + 262144;
constexpr size_t O_BIAS2 = O_ST2 + 262144;
constexpr size_t O_A = 76 * MiB;
constexpr size_t O_KVC = O_A;
constexpr size_t O_KS = O_A + 32 * MiB;
constexpr size_t O_VST = O_A + 48 * MiB;
constexpr size_t O_KW = O_A + 64 * MiB;
constexpr size_t O_VWT = O_A + 80 * MiB;
constexpr size_t O_GB = O_A + 96 * MiB;
constexpr size_t O_MIXIN = O_A;
constexpr size_t O_MEMB = O_A + 64 * MiB;
constexpr size_t O_XK = O_A + 72 * MiB;
constexpr size_t O_XVT = O_A + 80 * MiB;
constexpr size_t O_V2 = O_A;
constexpr size_t O_B = O_A + 128 * MiB;
constexpr size_t O_SS = O_B;
constexpr size_t O_HID = O_B + 16 * MiB;
constexpr size_t O_Y = O_B + 64 * MiB;
constexpr size_t O_GM = O_Y;
constexpr size_t O_V1 = O_Y;
constexpr size_t O_X = O_Y + 128 * MiB;
constexpr size_t O_QB = O_X;
constexpr size_t O_UH = O_X + 64 * MiB;
constexpr size_t O_YS = O_X + 64 * MiB;
constexpr size_t O_FB = O_Y;
constexpr size_t WS_NEED = O_X + 104 * MiB;
static_assert(O_BIAS2 + 4096 <= O_A, "F region overflow");

struct P {
    const float* in[33];
    float* out;
    unsigned char* ws;
    int ph_lo, ph_hi, coop, pad;
};

DEV int get_tid() { int t = threadIdx.x; asm volatile("" : "+v"(t)); return t; }
DEV int get_bid() { int t = blockIdx.x; asm volatile("" : "+s"(t)); return t; }
typedef __bf16 bf2_t __attribute__((ext_vector_type(2)));
typedef float f32x2_t __attribute__((ext_vector_type(2)));
DEV unsigned cvt_pk_bf16(float lo, float hi) { const f32x2_t f = {lo, hi}; const bf2_t r = __builtin_convertvector(f, bf2_t); return __builtin_bit_cast(unsigned, r); }
DEV bf16_t f2bf(float v) { return (bf16_t)(cvt_pk_bf16(v, 0.f) & 0xffffu); }
DEV float bf2f(unsigned v) { return __uint_as_float(v << 16); }
DEV float bflo(unsigned w) { return __uint_as_float(w << 16); }
DEV float bfhi(unsigned w) { return __uint_as_float(w & 0xffff0000u); }
DEV float fexp2(float x) { return __builtin_amdgcn_exp2f(x); }
DEV float frcp(float x) { return __builtin_amdgcn_rcpf(x); }
DEV float sigmoidf_(float x) { return frcp(1.f + fexp2(-x * LOG2E)); }
DEV float gelu_tanh(float x) { const float u = 0.7978845608028654f * (x + 0.044715f * x * x * x); return x * frcp(1.f + fexp2(-2.f * LOG2E * u)); }
DEV void st_bf4(bf16_t* p, float a, float b, float c, float d) { u32x2 w; w.x = cvt_pk_bf16(a, b); w.y = cvt_pk_bf16(c, d); *(u32x2*)p = w; }
DEV f32x4 ld_bf4(const bf16_t* p) { const u32x2 w = *(const u32x2*)p; return (f32x4){bflo(w.x), bfhi(w.x), bflo(w.y), bfhi(w.y)}; }
DEV float wred_sum(float v) {
#pragma unroll
    for (int o = 32; o >= 1; o >>= 1) v += __shfl_xor(v, o);
    return v;
}

DEV void ln_pass(const float* src, const float* g, const float* b, bf16_t* dstb, float* stats, float* dstf) {
    const int lane = get_tid() & 63, wid = get_tid() >> 6;
    const int nw = gridDim.x * 4;
    for (int row = get_bid() * 4 + wid; row < T_; row += nw) {
        const f32x4* p = (const f32x4*)(src + (size_t)row * 1024);
        f32x4 v[4];
#pragma unroll
        for (int i = 0; i < 4; ++i) v[i] = p[lane + 64 * i];
        float s = 0.f;
#pragma unroll
        for (int i = 0; i < 4; ++i) s += (v[i][0] + v[i][1]) + (v[i][2] + v[i][3]);
        s = wred_sum(s);
        const float mu = s * (1.f / 1024.f);
        float q = 0.f;
#pragma unroll
        for (int i = 0; i < 4; ++i) { const f32x4 d = v[i] - mu; q += (d[0] * d[0] + d[1] * d[1]) + (d[2] * d[2] + d[3] * d[3]); }
        q = wred_sum(q);
        const float rstd = 1.0f / sqrtf(q * (1.f / 1024.f) + LN_EPS);
        if (stats && lane == 0) { stats[row * 2] = mu; stats[row * 2 + 1] = rstd; }
#pragma unroll
        for (int i = 0; i < 4; ++i) {
            const int col = (lane + 64 * i) * 4;
            const f32x4 gg = *(const f32x4*)(g + col), bb = *(const f32x4*)(b + col);
            const f32x4 y = (v[i] - mu) * rstd * gg + bb;
            if (dstb) st_bf4(dstb + (size_t)row * 1024 + col, y[0], y[1], y[2], y[3]);
            if (dstf) *(f32x4*)(dstf + (size_t)row * 1024 + col) = y;
        }
    }
}

DEV int colmap(int mode, int n) {
    if (mode == 0) return n;
    if (mode == 1) return n < 3072 ? n : (n < 5120 ? n + 48 : (n < 5168 ? n - 5120 + 3072 : -1));
    if (mode == 2) { const int blk = n >> 5, r = n & 31; return r < 16 ? blk * 16 + r : 2816 + blk * 16 + (r - 16); }
    return n < 64 ? n : -1;
}
DEV void conv_job(const float* src, int ldsrc, int K, int N, bf16_t* dst, int mode, unsigned char* lds, int& cursor) {
    float* tile = (float*)lds;
    const int tk = K / 64, tn = N / 64, ntile = tk * tn;
    const int tx = get_tid() & 63, ty = get_tid() >> 6;
    for (int t = (int)((get_bid() + gridDim.x - (cursor % gridDim.x)) % gridDim.x); t < ntile; t += gridDim.x) {
        const int k0 = (t % tk) * 64, n0 = (t / tk) * 64;
        const int sc = colmap(mode, n0 + tx);
#pragma unroll 4
        for (int kk = ty; kk < 64; kk += 4) tile[kk * 65 + tx] = sc >= 0 ? src[(size_t)(k0 + kk) * ldsrc + sc] : 0.f;
        __syncthreads();
#pragma unroll 4
        for (int nn = ty; nn < 64; nn += 4) dst[(size_t)(n0 + nn) * K + k0 + tx] = f2bf(tile[tx * 65 + nn]);
        __syncthreads();
    }
    cursor += ntile;
}

struct SsmIn { const float *a_re, *a_im, *b_re, *b_im, *c_re, *c_im, *log_dt; };
DEV void lb_pow(const SsmIn& s, int g, int n, float p, float& re, float& im) {
    const float lre = fminf(s.a_re[g * 64 + n], -1e-4f), lim = s.a_im[g * 64 + n], dt = expf(s.log_dt[g]);
    const float mag = expf(lre * dt * p); float sn, cs; sincosf(lim * dt * p, &sn, &cs);
    re = mag * cs; im = mag * sn;
}
DEV void bbar(const SsmIn& s, int g, int n, int c, float& re, float& im) {
    const float lre = fminf(s.a_re[g * 64 + n], -1e-4f), lim = s.a_im[g * 64 + n], dt = expf(s.log_dt[g]);
    const float mag = expf(lre * dt); float sn, cs; sincosf(lim * dt, &sn, &cs);
    const float sh = sinf(0.5f * lim * dt);
    const float nr = expm1f(lre * dt) - mag * 2.f * sh * sh, lbi = mag * sn;
    const float den = lre * lre + lim * lim;
    const float fre = (nr * lre + lbi * lim) / den, fim = (lbi * lre - nr * lim) / den;
    const float br = s.b_re[(g * 64 + n) * 16 + c], bi = s.b_im[(g * 64 + n) * 16 + c];
    re = fre * br - fim * bi; im = fre * bi + fim * br;
}
DEV void ssm_prep(const SsmIn& s, bf16_t* BT1, bf16_t* MTW, unsigned char* lds) {
    const int tid = get_tid();
    const size_t gt = (size_t)get_bid() * 256 + tid, gs = (size_t)gridDim.x * 256;
    for (size_t i = gt; i < 32ull * 128 * 512; i += gs) {
        const int kk = (int)(i & 511), nn = (int)((i >> 9) & 127), g = (int)(i >> 16);
        const int n = nn & 63, sidx = kk >> 4, c = kk & 15;
        float pr, pi, br, bi; lb_pow(s, g, n, (float)(31 - sidx), pr, pi); bbar(s, g, n, c, br, bi);
        BT1[i] = f2bf((nn >> 6) ? (pr * bi + pi * br) : (pr * br - pi * bi));
    }
    for (size_t i = gt; i < 32ull * 512 * 128; i += gs) {
        const int nn = (int)(i & 127), r = (int)((i >> 7) & 511), g = (int)(i >> 16);
        const int n = nn & 63, tau = r >> 4, c = r & 15;
        float pr, pi; lb_pow(s, g, n, (float)(tau + 1), pr, pi);
        const float cr = s.c_re[(g * 16 + c) * 64 + n], ci = s.c_im[(g * 16 + c) * 64 + n];
        MTW[((size_t)g * 512 + r) * 640 + 512 + nn] = f2bf((nn >> 6) ? -(cr * pi + ci * pr) : (cr * pr - ci * pi));
    }
    for (size_t i = gt; i < 32ull * 512 * 512; i += gs) {
        const int kk = (int)(i & 511), r = (int)((i >> 9) & 511), g = (int)(i >> 18);
        if ((kk >> 4) > (r >> 4)) MTW[((size_t)g * 512 + r) * 640 + kk] = 0;
    }
    float* cpw = (float*)lds;
    float* bb = cpw + 2048;
    for (int it = get_bid(); it < 1024; it += gridDim.x) {
        const int g = it >> 5, d = it & 31;
        __syncthreads();
        for (int e = tid; e < 1024; e += 256) {
            const int c = e >> 6, n = e & 63;
            float pr, pi; lb_pow(s, g, n, (float)d, pr, pi);
            const float cr = s.c_re[(g * 16 + c) * 64 + n], ci = s.c_im[(g * 16 + c) * 64 + n];
            cpw[e * 2] = cr * pr - ci * pi; cpw[e * 2 + 1] = cr * pi + ci * pr;
            const int n2 = e >> 4, c2 = e & 15;
            float br, bi; bbar(s, g, n2, c2, br, bi);
            bb[e * 2] = br; bb[e * 2 + 1] = bi;
        }
        __syncthreads();
        const int c = tid >> 4, c2 = tid & 15;
        float acc = 0.f;
        for (int n = 0; n < 64; ++n) acc += cpw[(c * 64 + n) * 2] * bb[(n * 16 + c2) * 2] - cpw[(c * 64 + n) * 2 + 1] * bb[(n * 16 + c2) * 2 + 1];
        const bf16_t v = f2bf(acc);
        for (int sidx = 0; sidx + d < 32; ++sidx) MTW[((size_t)g * 512 + (sidx + d) * 16 + c) * 640 + sidx * 16 + c2] = v;
    }
}
DEV void ssm_scan(const SsmIn& s, const float* SS, bf16_t* UH) {
    for (int idx = get_bid() * 256 + get_tid(); idx < 32768; idx += gridDim.x * 256) {
        const int n = idx & 63, b = (idx >> 6) & 15, g = idx >> 10;
        float ar, ai; lb_pow(s, g, n, 32.f, ar, ai);
        float hr = 0.f, hi = 0.f;
        const size_t row0 = (size_t)(g * 16 + b) * 64;
#pragma unroll 8
        for (int k = 0; k < 64; ++k) {
            UH[(row0 + k) * 640 + 512 + n] = f2bf(hr); UH[(row0 + k) * 640 + 576 + n] = f2bf(hi);
            const float sr = SS[(row0 + k) * 128 + n], si = SS[(row0 + k) * 128 + 64 + n];
            const float nr = ar * hr - ai * hi + sr, ni = ar * hi + ai * hr + si;
            hr = nr; hi = ni;
        }
    }
}

struct GemmP { const bf16_t* A; const bf16_t* Bt; int lda, ldb, MT, NT, KT, nbatch; };
template <class Addr, class Epi>
DEV void gemm_run(const GemmP p, const Addr ad, const Epi epi, unsigned char* lds) {
    const int tid = get_tid(), lane = tid & 63, wid = tid >> 6, wr = wid >> 1, wc = wid & 1, l15 = lane & 15, quad = lane >> 4;
    const int G = gridDim.x;
    const int nx = (G % 8 == 0) ? 8 : 1, x = get_bid() % nx, jx = get_bid() / nx, stride = G / nx;
    const int SRtot = (p.nbatch * p.MT) / 8, per = 8 * p.NT;
    const int prow = tid >> 3, pc16 = tid & 7;
    const int aoff = (wr * 64 + l15) * 144 + quad * 16, boff = 36864 / 2 + (wc * 64 + l15) * 144 + quad * 16;
    for (int s = jx;; s += stride) {
        const int q = s / per, rem = s % per;
        const int sr = x + nx * q;
        if (sr >= SRtot) break;
        const int nt = rem >> 3, R = sr * 8 + (rem & 7), batch = R / p.MT, mt = R % p.MT;
        const bf16_t* Ab = p.A + ad.a_off(batch) + (size_t)(mt * 128 + prow) * p.lda + pc16 * 8;
        const bf16_t* Bb = p.Bt + ad.b_off(batch) + (size_t)(nt * 128 + prow) * p.ldb + pc16 * 8;
        f32x4 acc[4][4];
#pragma unroll
        for (int i = 0; i < 4; ++i)
#pragma unroll
            for (int j = 0; j < 4; ++j) acc[i][j] = (f32x4){0.f, 0.f, 0.f, 0.f};
        u32x4 ra[4], rb[4];
#pragma unroll
        for (int i = 0; i < 4; ++i) { ra[i] = *(const u32x4*)(Ab + (size_t)(32 * i) * p.lda); rb[i] = *(const u32x4*)(Bb + (size_t)(32 * i) * p.ldb); }
#pragma unroll
        for (int i = 0; i < 4; ++i) { *(u32x4*)(lds + (prow + 32 * i) * 144 + pc16 * 16) = ra[i]; *(u32x4*)(lds + 18432 + (prow + 32 * i) * 144 + pc16 * 16) = rb[i]; }
        __syncthreads();
        for (int kt = 0; kt < p.KT; ++kt) {
            const bool more = kt + 1 < p.KT;
            if (more) {
#pragma unroll
                for (int i = 0; i < 4; ++i) { ra[i] = *(const u32x4*)(Ab + (size_t)(32 * i) * p.lda + (kt + 1) * 64); rb[i] = *(const u32x4*)(Bb + (size_t)(32 * i) * p.ldb + (kt + 1) * 64); }
            }
            const unsigned char* st = lds + (kt & 1) * 36864;
#pragma unroll
            for (int ks = 0; ks < 2; ++ks) {
                bf16x8 af[4], bfr[4];
#pragma unroll
                for (int i = 0; i < 4; ++i) { af[i] = *(const bf16x8*)(st + aoff + i * 16 * 144 + ks * 64); bfr[i] = *(const bf16x8*)(st + boff + i * 16 * 144 + ks * 64); }
#pragma unroll
                for (int mi = 0; mi < 4; ++mi)
#pragma unroll
                    for (int ni = 0; ni < 4; ++ni) acc[mi][ni] = __builtin_amdgcn_mfma_f32_16x16x32_bf16(bfr[ni], af[mi], acc[mi][ni], 0, 0, 0);
            }
            if (more) {
                unsigned char* sn = lds + ((kt + 1) & 1) * 36864;
#pragma unroll
                for (int i = 0; i < 4; ++i) { *(u32x4*)(sn + (prow + 32 * i) * 144 + pc16 * 16) = ra[i]; *(u32x4*)(sn + 18432 + (prow + 32 * i) * 144 + pc16 * 16) = rb[i]; }
            }
            __syncthreads();
        }
        epi(acc, batch, mt * 128 + wr * 64, nt * 128 + wc * 64, l15, quad);
    }
}
struct AddrNone { DEV size_t a_off(int) const { return 0; } DEV size_t b_off(int) const { return 0; } };
struct AddrStride { size_t as, bs; DEV size_t a_off(int b) const { return as * b; } DEV size_t b_off(int b) const { return bs * b; } };
struct AddrCmp1 { DEV size_t a_off(int b) const { return (size_t)b * 2048 * 64; } DEV size_t b_off(int b) const { return (size_t)((b >> 2) & 1) * 256 * 2048; } };
struct AddrCmp2 { DEV size_t a_off(int b) const { return (size_t)b * 128 * 256; } DEV size_t b_off(int b) const { return (size_t)((b >> 2) & 1) * 128 * 256; } };

#define EPI_ARGS const f32x4 (&acc)[4][4], int batch, int m0, int n0, int l15, int quad
struct EpiIn {
    bf16_t *UH, *Qb, *KVC, *KS, *VST, *KW, *VWT, *GM; float* GN;
    DEV void operator()(EPI_ARGS) const {
#pragma unroll
        for (int mi = 0; mi < 4; ++mi) {
            const int t = m0 + mi * 16 + l15, b = t >> 11, tt = t & 2047;
#pragma unroll
            for (int ni = 0; ni < 4; ++ni) {
                const f32x4 v = acc[mi][ni];
                const int c = n0 + ni * 16 + quad * 4;
                if (n0 < 512) {
                    const int g = c >> 4;
                    st_bf4(UH + ((size_t)((g * 16 + b) * 64 + (tt >> 5))) * 640 + (tt & 31) * 16 + (c & 15), v[0], v[1], v[2], v[3]);
                } else if (n0 < 1536) {
                    const float sc = 0.125f * LOG2E;
                    st_bf4(Qb + (size_t)t * 1024 + (c - 512), v[0] * sc, v[1] * sc, v[2] * sc, v[3] * sc);
                } else if (n0 < 2048) {
                    const int cc = c - 1536, z = cc >> 8, h = (cc >> 6) & 3, d = cc & 63;
                    st_bf4(KVC + ((size_t)(((b * 2 + z) * 4 + h) * 2048 + tt)) * 64 + d, v[0], v[1], v[2], v[3]);
                } else if (n0 < 3072) {
                    const int cc = (c - 2048) & 511, isw = (c - 2048) >> 9, h = (cc >> 6) & 3, d = cc & 63;
                    if (cc < 256) st_bf4((isw ? KW : KS) + ((size_t)((b * 4 + h) * 2048 + tt)) * 64 + d, v[0], v[1], v[2], v[3]);
                    else { bf16_t* o = (isw ? VWT : VST) + ((size_t)((b * 4 + h) * 64 + d)) * 2048 + tt;
#pragma unroll
                        for (int i = 0; i < 4; ++i) o[(size_t)i * 2048] = f2bf(v[i]); }
                } else if (n0 < 5120) {
                    st_bf4(GM + (size_t)t * 2048 + (c - 3072), sigmoidf_(v[0]), sigmoidf_(v[1]), sigmoidf_(v[2]), sigmoidf_(v[3]));
                } else {
                    const int cc = c - 5120;
                    if (cc < 48) *(f32x4*)(GN + (size_t)t * 48 + cc) = (f32x4){sigmoidf_(v[0]), sigmoidf_(v[1]), sigmoidf_(v[2]), sigmoidf_(v[3])};
                }
            }
        }
    }
};
struct EpiXkv {
    bf16_t *XK, *XVT;
    DEV void operator()(EPI_ARGS) const {
#pragma unroll
        for (int mi = 0; mi < 4; ++mi) {
            const int r = m0 + mi * 16 + l15, b = r >> 8, m = r & 255;
#pragma unroll
            for (int ni = 0; ni < 4; ++ni) {
                const f32x4 v = acc[mi][ni]; const int c = n0 + ni * 16 + quad * 4;
                if (n0 < 1024) st_bf4(XK + (size_t)r * 1024 + c, v[0], v[1], v[2], v[3]);
                else { const int cc = c - 1024, h = cc >> 8, d = cc & 255; bf16_t* o = XVT + ((size_t)((b * 4 + h) * 256 + d)) * 256 + m;
#pragma unroll
                    for (int i = 0; i < 4; ++i) o[i * 256] = f2bf(v[i]); }
            }
        }
    }
};
struct EpiSsmA { float* SS;
    DEV void operator()(EPI_ARGS) const {
#pragma unroll
        for (int mi = 0; mi < 4; ++mi)
#pragma unroll
            for (int ni = 0; ni < 4; ++ni) *(f32x4*)(SS + ((size_t)batch * 1024 + m0 + mi * 16 + l15) * 128 + n0 + ni * 16 + quad * 4) = acc[mi][ni];
    }
};
struct EpiCmp1 { bf16_t* HID; const float* bias2;
    DEV void operator()(EPI_ARGS) const {
        const int z = (batch >> 2) & 1;
#pragma unroll
        for (int ni = 0; ni < 4; ++ni) {
            const int c = n0 + ni * 16 + quad * 4; const f32x4 bv = *(const f32x4*)(bias2 + z * 256 + c);
#pragma unroll
            for (int mi = 0; mi < 4; ++mi) { const f32x4 v = acc[mi][ni] + bv;
                st_bf4(HID + ((size_t)batch * 128 + m0 + mi * 16 + l15) * 256 + c, gelu_tanh(v[0]), gelu_tanh(v[1]), gelu_tanh(v[2]), gelu_tanh(v[3])); }
        }
    }
};
struct EpiCmp2 { bf16_t *KC, *VCT;
    DEV void operator()(EPI_ARGS) const {
        if (n0 >= 64) return;
        const int z = (batch >> 2) & 1, bh = (batch >> 3) * 4 + (batch & 3);
#pragma unroll
        for (int mi = 0; mi < 4; ++mi) { const int r = m0 + mi * 16 + l15;
#pragma unroll
            for (int ni = 0; ni < 4; ++ni) { const f32x4 v = acc[mi][ni]; const int c = n0 + ni * 16 + quad * 4;
                if (z == 0) st_bf4(KC + ((size_t)bh * 128 + r) * 64 + c, v[0], v[1], v[2], v[3]);
                else {
#pragma unroll
                    for (int i = 0; i < 4; ++i) VCT[((size_t)bh * 64 + c + i) * 128 + r] = f2bf(v[i]); } } }
    }
};
struct EpiSsmB { const bf16_t* UH; const float* dskip; bf16_t* GB;
    DEV void operator()(EPI_ARGS) const {
#pragma unroll
        for (int mi = 0; mi < 4; ++mi) { const int r = m0 + mi * 16 + l15, b = r >> 6, k = r & 63;
#pragma unroll
            for (int ni = 0; ni < 4; ++ni) { const int col = n0 + ni * 16 + quad * 4, tau = col >> 4, c = col & 15;
                const f32x4 u = ld_bf4(UH + ((size_t)batch * 1024 + r) * 640 + col);
                const f32x4 dv = *(const f32x4*)(dskip + batch * 16 + c);
                const f32x4 y = acc[mi][ni] + dv * u;
                st_bf4(GB + ((size_t)(b * 2048 + k * 32 + tau)) * 512 + batch * 16 + c, gelu_tanh(y[0]), gelu_tanh(y[1]), gelu_tanh(y[2]), gelu_tanh(y[3])); } }
    }
};
struct EpiGlu { const bf16_t* GB; const float* bglu; bf16_t* YS;
    DEV void operator()(EPI_ARGS) const {
#pragma unroll
        for (int ni = 0; ni < 4; ++ni) { const int c = n0 + ni * 16 + quad * 4; const f32x4 bv = *(const f32x4*)(bglu + c);
#pragma unroll
            for (int mi = 0; mi < 4; ++mi) { const size_t o = (size_t)(m0 + mi * 16 + l15) * 512 + c; const f32x4 g = ld_bf4(GB + o); const f32x4 v = acc[mi][ni] + bv;
                st_bf4(YS + o, g[0] * sigmoidf_(v[0]), g[1] * sigmoidf_(v[1]), g[2] * sigmoidf_(v[2]), g[3] * sigmoidf_(v[3])); } }
    }
};
struct EpiSout { const bf16_t* GM; bf16_t* P1;
    DEV void operator()(EPI_ARGS) const {
#pragma unroll
        for (int mi = 0; mi < 4; ++mi) { const size_t t = m0 + mi * 16 + l15;
#pragma unroll
            for (int ni = 0; ni < 4; ++ni) { const int c = n0 + ni * 16 + quad * 4; const f32x4 g = ld_bf4(GM + t * 2048 + c); const f32x4 v = acc[mi][ni] * g;
                st_bf4(P1 + t * 1024 + c, v[0], v[1], v[2], v[3]); } }
    }
};
struct EpiNout { const bf16_t* GM; const bf16_t* P1; bf16_t* MIX;
    DEV void operator()(EPI_ARGS) const {
#pragma unroll
        for (int mi = 0; mi < 4; ++mi) { const size_t t = m0 + mi * 16 + l15;
#pragma unroll
            for (int ni = 0; ni < 4; ++ni) { const int c = n0 + ni * 16 + quad * 4; const f32x4 g = ld_bf4(GM + t * 2048 + 1024 + c); const f32x4 v = acc[mi][ni] * g + ld_bf4(P1 + t * 1024 + c);
                st_bf4(MIX + t * 1024 + c, v[0], v[1], v[2], v[3]); } }
    }
};
struct EpiRes { const float* src; const float* stats; const float* g; const float* b; float* dst;
    DEV void operator()(EPI_ARGS) const {
#pragma unroll
        for (int mi = 0; mi < 4; ++mi) { const size_t t = m0 + mi * 16 + l15; const float mu = stats[t * 2], rs = stats[t * 2 + 1];
#pragma unroll
            for (int ni = 0; ni < 4; ++ni) { const int c = n0 + ni * 16 + quad * 4;
                const f32x4 xv = *(const f32x4*)(src + t * 1024 + c), gg = *(const f32x4*)(g + c), bb = *(const f32x4*)(b + c);
                *(f32x4*)(dst + t * 1024 + c) = ((xv - mu) * rs * gg + bb) * ALPHA + acc[mi][ni]; } }
    }
};
struct EpiScaleBf { bf16_t* O; int ldc; float sc;
    DEV void operator()(EPI_ARGS) const {
#pragma unroll
        for (int mi = 0; mi < 4; ++mi)
#pragma unroll
            for (int ni = 0; ni < 4; ++ni) { const f32x4 v = acc[mi][ni] * sc; st_bf4(O + (size_t)(m0 + mi * 16 + l15) * ldc + n0 + ni * 16 + quad * 4, v[0], v[1], v[2], v[3]); }
    }
};
struct EpiFfnIn { bf16_t* FB;
    DEV void operator()(EPI_ARGS) const {
#pragma unroll
        for (int mi = 0; mi < 4; ++mi) { const size_t t = m0 + mi * 16 + l15;
#pragma unroll
            for (int pp = 0; pp < 2; ++pp) { const f32x4 ga = acc[mi][2 * pp], up = acc[mi][2 * pp + 1]; const int j = (n0 + pp * 32) / 2 + quad * 4;
                st_bf4(FB + t * 2816 + j, ga[0] * sigmoidf_(ga[0]) * up[0], ga[1] * sigmoidf_(ga[1]) * up[1], ga[2] * sigmoidf_(ga[2]) * up[2], ga[3] * sigmoidf_(ga[3]) * up[3]); } }
    }
};

DEV float qmax(float v) { v = fmaxf(v, __shfl_xor(v, 16)); return fmaxf(v, __shfl_xor(v, 32)); }
DEV float qsum(float v) { v += __shfl_xor(v, 16); return v + __shfl_xor(v, 32); }
DEV bf16x8 pack_p(const f32x4& a, const f32x4& b) { u32x4 w; w.x = cvt_pk_bf16(a[0], a[1]); w.y = cvt_pk_bf16(a[2], a[3]); w.z = cvt_pk_bf16(b[0], b[1]); w.w = cvt_pk_bf16(b[2], b[3]); return __builtin_bit_cast(bf16x8, w); }
DEV void st_vt(unsigned char* rowbase, int e, const u32x4& v) {
    const int grp = e >> 2, ep = e & 3, a = ep >> 1, qp = (ep & 1) * 2;
    unsigned char* o = rowbase + grp * 64 + (qp * 8 + a * 4) * 2;
    *(u32x2*)o = (u32x2){v.x, v.y}; *(u32x2*)(o + 16) = (u32x2){v.z, v.w};
}

struct NsaCtx { const bf16_t *Qb, *KC, *VCT, *KS, *VST, *KW, *VWT; const float* GN; bf16_t* ON; };
constexpr float MINIT = -1e20f;

template <int MODE, bool BOUND>
DEV void nsa_tile(const unsigned char* Kl, const unsigned char* Vl, const bf16x8 (&Qf)[2][2], f32x4 (&O)[2][4], float (&m)[2], float (&l)[2],
                  const float (&slope)[2], int dist0, bool sel, int l15, int quad) {
    const float d0f = (float)dist0;
#pragma unroll
    for (int g = 0; g < 2; ++g) {
        f32x4 S[4];
#pragma unroll
        for (int kt = 0; kt < 4; ++kt) { S[kt] = (f32x4){0.f, 0.f, 0.f, 0.f};
#pragma unroll
            for (int ks = 0; ks < 2; ++ks) { const bf16x8 kf = *(const bf16x8*)(Kl + (kt * 16 + l15) * 144 + ks * 64 + quad * 16); S[kt] = __builtin_amdgcn_mfma_f32_16x16x32_bf16(kf, Qf[g][ks], S[kt], 0, 0, 0); } }
        float base = -slope[g] * d0f;
        if (MODE == 0) base = sel ? base : NEG;
        float tmax = NEG;
#pragma unroll
        for (int kt = 0; kt < 4; ++kt)
#pragma unroll
            for (int i = 0; i < 4; ++i) { const int cc = 16 * kt + i;
                float s = fmaf(slope[g], (float)cc, S[kt][i] + base);
                if (BOUND) { bool v = cc <= dist0; if (MODE == 1) v = v && (cc > dist0 - 512); s = v ? s : NEG; }
                S[kt][i] = s; tmax = fmaxf(tmax, s); }
        tmax = qmax(tmax);
        const float mnew = fmaxf(m[g], tmax), alpha = fexp2(m[g] - mnew);
        float rs = 0.f;
#pragma unroll
        for (int kt = 0; kt < 4; ++kt)
#pragma unroll
            for (int i = 0; i < 4; ++i) { const float pv = fexp2(S[kt][i] - mnew); S[kt][i] = pv; rs += pv; }
        rs = qsum(rs);
        l[g] = l[g] * alpha + rs; m[g] = mnew;
        const bf16x8 P0 = pack_p(S[0], S[1]), P1 = pack_p(S[2], S[3]);
#pragma unroll
        for (int dt = 0; dt < 4; ++dt) { O[g][dt] = O[g][dt] * alpha;
            const bf16x8 v0 = *(const bf16x8*)(Vl + (dt * 16 + l15) * 144 + quad * 16), v1 = *(const bf16x8*)(Vl + (dt * 16 + l15) * 144 + 64 + quad * 16);
            O[g][dt] = __builtin_amdgcn_mfma_f32_16x16x32_bf16(v0, P0, O[g][dt], 0, 0, 0);
            O[g][dt] = __builtin_amdgcn_mfma_f32_16x16x32_bf16(v1, P1, O[g][dt], 0, 0, 0); }
    }
}

template <int MODE>
DEV void nsa_tiles(unsigned char* lds, const bf16_t* Kg, const bf16_t* VTg, unsigned tilemask, unsigned wmask, unsigned qmask, int jb0, int jb1,
                   const bf16x8 (&Qf)[2][2], f32x4 (&O)[2][4], float (&m)[2], float (&l)[2], const float (&slope)[2], int tq, int l15, int quad) {
    const int tid = get_tid();
    const int prow = tid >> 3, pe = tid & 7;
    unsigned rem = tilemask;
    int j = __builtin_ctz(rem); rem &= rem - 1;
    u32x4 rk[2], rv[2];
#pragma unroll
    for (int i = 0; i < 2; ++i) { rk[i] = *(const u32x4*)(Kg + (size_t)(64 * j + prow + 32 * i) * 64 + pe * 8); rv[i] = *(const u32x4*)(VTg + (size_t)(prow + 32 * i) * 2048 + 64 * j + pe * 8); }
    int cur = 0;
#pragma unroll
    for (int i = 0; i < 2; ++i) { *(u32x4*)(lds + (prow + 32 * i) * 144 + pe * 16) = rk[i]; st_vt(lds + 9216 + (prow + 32 * i) * 144, pe, rv[i]); }
    __syncthreads();
    for (;;) {
        int jn = -1;
        if (rem) { jn = __builtin_ctz(rem); rem &= rem - 1;
#pragma unroll
            for (int i = 0; i < 2; ++i) { rk[i] = *(const u32x4*)(Kg + (size_t)(64 * jn + prow + 32 * i) * 64 + pe * 8); rv[i] = *(const u32x4*)(VTg + (size_t)(prow + 32 * i) * 2048 + 64 * jn + pe * 8); } }
        const unsigned char* st = lds + cur * 18432;
        if (MODE == 1 || ((wmask >> j) & 1u)) {
            const int dist0 = tq - 64 * j - 4 * quad; const bool sel = (qmask >> j) & 1u;
            if (j == jb0 || j == jb1) nsa_tile<MODE, true>(st, st + 9216, Qf, O, m, l, slope, dist0, sel, l15, quad);
            else nsa_tile<MODE, false>(st, st + 9216, Qf, O, m, l, slope, dist0, sel, l15, quad);
        }
        if (jn >= 0) { unsigned char* sn = lds + (cur ^ 1) * 18432;
#pragma unroll
            for (int i = 0; i < 2; ++i) { *(u32x4*)(sn + (prow + 32 * i) * 144 + pe * 16) = rk[i]; st_vt(sn + 9216 + (prow + 32 * i) * 144, pe, rv[i]); } }
        __syncthreads();
        if (jn < 0) break;
        j = jn; cur ^= 1;
    }
}

DEV void nsa_unit(const NsaCtx& c, int b, int hkv, int qb32, unsigned char* lds) {
    const int tid = get_tid(), lane = tid & 63, wid = tid >> 6, l15 = lane & 15, quad = lane >> 4;
    const int qs = wid & 1, hp = wid >> 1;
    const int tq = qb32 * 32 + qs * 16 + l15, cur = qb32 >> 1;
    const size_t trow = (size_t)b * 2048 + tq;
    const int head0 = hkv * 4 + hp * 2;
    const float* gnp = c.GN + trow * 48 + head0 * 3;
    unsigned char* stash = lds + 36864 + wid * 4096;
    float* xch = (float*)(lds + 53248);
    unsigned* smask = (unsigned*)(lds + 69632);
    const int bh = b * 4 + hkv;
    {
        const bf16_t* Kg = c.KC + (size_t)bh * 128 * 64; const bf16_t* Vg = c.VCT + (size_t)bh * 64 * 128;
#pragma unroll
        for (int i = 0; i < 4; ++i) { const int pc = tid + 256 * i;
            *(u32x4*)(lds + (pc >> 3) * 144 + (pc & 7) * 16) = *(const u32x4*)(Kg + pc * 8);
            st_vt(lds + 18432 + (pc >> 4) * 272, pc & 15, *(const u32x4*)(Vg + pc * 8)); }
    }
    __syncthreads();
    const int nkt = (2 * qb32) / 16 + 1;
    float Mx[8], Sm[8];
#pragma unroll
    for (int kt = 0; kt < 8; ++kt) { Mx[kt] = NEG; Sm[kt] = 0.f; }
#ifdef NSA_NO_CMP
    for (int g = 0; g < 0; ++g) {
#else
#pragma unroll 1
    for (int g = 0; g < 2; ++g) {
#endif
        bf16x8 Qg[2];
#pragma unroll
        for (int ks = 0; ks < 2; ++ks) Qg[ks] = *(const bf16x8*)(c.Qb + trow * 1024 + (head0 + g) * 64 + ks * 32 + quad * 8);
        const float slope_g = exp2f(-0.5f * (float)(head0 + g + 1)) * LOG2E;
        f32x4 S[8];
#pragma unroll
        for (int kt = 0; kt < 8; ++kt) { S[kt] = (f32x4){0.f, 0.f, 0.f, 0.f};
            if (kt < nkt) {
#pragma unroll
                for (int ks = 0; ks < 2; ++ks) { const bf16x8 kf = *(const bf16x8*)(lds + (kt * 16 + l15) * 144 + ks * 64 + quad * 16); S[kt] = __builtin_amdgcn_mfma_f32_16x16x32_bf16(kf, Qg[ks], S[kt], 0, 0, 0); } } }
        float mx = NEG;
        const int d0 = tq - 31 - 64 * quad; const float base = -slope_g * (float)d0;
#pragma unroll
        for (int kt = 0; kt < 8; ++kt)
#pragma unroll
            for (int i = 0; i < 4; ++i) { const int cc = 256 * kt + 16 * i; const float s = (kt < nkt && cc <= d0) ? fmaf(slope_g, (float)cc, S[kt][i] + base) : NEG; S[kt][i] = s; mx = fmaxf(mx, s); }
        mx = qmax(mx);
        float ls = 0.f;
#pragma unroll
        for (int kt = 0; kt < 8; ++kt)
#pragma unroll
            for (int i = 0; i < 4; ++i) ls += S[kt][i] > -1e29f ? fexp2(S[kt][i] - mx) : 0.f;
        ls = qsum(ls);
        const float lcl = fmaxf(ls, 1e-30f), lg = __log2f(lcl) + mx;
        float x3[8];
#pragma unroll
        for (int kt = 0; kt < 8; ++kt) {
#pragma unroll
            for (int i = 0; i < 4; ++i) S[kt][i] = S[kt][i] > -1e29f ? S[kt][i] - lg : NEG;
            x3[kt] = __shfl(S[kt][3], (lane + 48) & 63);
        }
#pragma unroll
        for (int kt = 0; kt < 8; ++kt) {
            const float nb = quad >= 1 ? x3[kt] : (kt >= 1 ? x3[kt >= 1 ? kt - 1 : 0] : NEG);
            const float tm = fmaxf(fmaxf(fmaxf(S[kt][0], S[kt][1]), fmaxf(S[kt][2], S[kt][3])), nb);
            const float nm = fmaxf(Mx[kt], tm);
            Sm[kt] = Sm[kt] * fexp2(Mx[kt] - nm) + fexp2(S[kt][0] - nm) + fexp2(S[kt][1] - nm) + fexp2(S[kt][2] - nm) + fexp2(S[kt][3] - nm) + fexp2(nb - nm);
            Mx[kt] = nm;
        }
        const float gate0 = gnp[g * 3];
        f32x4 Oc[4];
#pragma unroll
        for (int dt = 0; dt < 4; ++dt) Oc[dt] = (f32x4){0.f, 0.f, 0.f, 0.f};
#pragma unroll
        for (int k2 = 0; k2 < 4; ++k2) {
            if (2 * k2 < nkt) {
                f32x4 pa, pb;
#pragma unroll
                for (int i = 0; i < 4; ++i) { pa[i] = fexp2(S[2 * k2][i]); pb[i] = fexp2(S[2 * k2 + 1][i]); }
                const bf16x8 pf = pack_p(pa, pb);
#pragma unroll
                for (int dt = 0; dt < 4; ++dt) { const bf16x8 vf = *(const bf16x8*)(lds + 18432 + (dt * 16 + l15) * 272 + k2 * 64 + quad * 16); Oc[dt] = __builtin_amdgcn_mfma_f32_16x16x32_bf16(vf, pf, Oc[dt], 0, 0, 0); }
            }
        }
#pragma unroll
        for (int dt = 0; dt < 4; ++dt) { const f32x4 v = Oc[dt] * gate0; u32x2 w; w.x = cvt_pk_bf16(v[0], v[1]); w.y = cvt_pk_bf16(v[2], v[3]); *(u32x2*)(stash + ((g * 4 + dt) * 64 + lane) * 8) = w; }
    }
    unsigned qmask;
    if (cur < 8) qmask = (2u << cur) - 1u;
    if (cur >= 8) {
#pragma unroll
        for (int kt = 0; kt < 8; ++kt) { xch[(wid * 16 + kt) * 64 + lane] = Mx[kt]; xch[(wid * 16 + 8 + kt) * 64 + lane] = Sm[kt]; }
    }
    __syncthreads();
    if (cur >= 8) {
        float v[8];
#pragma unroll
        for (int kt = 0; kt < 8; ++kt) {
            const float m2 = xch[((wid ^ 2) * 16 + kt) * 64 + lane], s2 = xch[((wid ^ 2) * 16 + 8 + kt) * 64 + lane];
            const float mm = fmaxf(Mx[kt], m2), ss = Sm[kt] * fexp2(Mx[kt] - mm) + s2 * fexp2(m2 - mm);
            const int jb = 4 * kt + quad; v[kt] = (jb >= 1 && jb <= cur - 2) ? mm + __log2f(ss) : -3e38f; }
        qmask = 1u | (1u << cur) | (1u << (cur - 1));
        for (int r = 0; r < 5; ++r) {
            float bv = v[0]; int bj = quad;
#pragma unroll
            for (int kt = 1; kt < 8; ++kt) if (v[kt] > bv) { bv = v[kt]; bj = 4 * kt + quad; }
#pragma unroll
            for (int o = 16; o <= 32; o <<= 1) { const float ov = __shfl_xor(bv, o); const int oj = __shfl_xor(bj, o); if (ov > bv || (ov == bv && oj < bj)) { bv = ov; bj = oj; } }
            qmask |= 1u << bj;
#pragma unroll
            for (int kt = 0; kt < 8; ++kt) if (4 * kt + quad == bj) v[kt] = -3.2e38f;
        }
    }
    unsigned wmask = qmask;
#pragma unroll
    for (int o = 1; o <= 8; o <<= 1) wmask |= __shfl_xor(wmask, o);
    if (lane == 0) smask[wid] = wmask;
    __syncthreads();
    const unsigned umask = smask[0] | smask[1] | smask[2] | smask[3];
    bf16x8 Qf[2][2]; float slope[2];
#pragma unroll
    for (int g = 0; g < 2; ++g) {
#pragma unroll
        for (int ks = 0; ks < 2; ++ks) Qf[g][ks] = *(const bf16x8*)(c.Qb + trow * 1024 + (head0 + g) * 64 + ks * 32 + quad * 8);
        slope[g] = exp2f(-0.5f * (float)(head0 + g + 1)) * LOG2E;
    }
    f32x4 O[2][4]; float m[2], l[2];
#pragma unroll
    for (int g = 0; g < 2; ++g) { m[g] = MINIT; l[g] = 0.f;
#pragma unroll
        for (int dt = 0; dt < 4; ++dt) O[g][dt] = (f32x4){0.f, 0.f, 0.f, 0.f}; }
#ifndef NSA_NO_SLC
    nsa_tiles<0>(lds, c.KS + (size_t)bh * 2048 * 64, c.VST + (size_t)bh * 64 * 2048, umask, wmask, qmask, cur, cur, Qf, O, m, l, slope, tq, l15, quad);
#endif
#pragma unroll
    for (int g = 0; g < 2; ++g) { const float sc = gnp[g * 3 + 1] / fmaxf(l[g], 1e-30f);
#pragma unroll
        for (int dt = 0; dt < 4; ++dt) { u32x2* sp = (u32x2*)(stash + ((g * 4 + dt) * 64 + lane) * 8); const u32x2 w = *sp;
            const f32x4 v = O[g][dt] * sc + (f32x4){bflo(w.x), bfhi(w.x), bflo(w.y), bfhi(w.y)};
            u32x2 w2; w2.x = cvt_pk_bf16(v[0], v[1]); w2.y = cvt_pk_bf16(v[2], v[3]); *sp = w2;
            O[g][dt] = (f32x4){0.f, 0.f, 0.f, 0.f}; }
        m[g] = MINIT; l[g] = 0.f; }
    const int t0 = qb32 * 32;
    const int jlo = t0 >= 511 ? (t0 - 511) >> 6 : 0;
    const unsigned winmask = ((2u << cur) - 1u) & ~((1u << jlo) - 1u);
#ifndef NSA_NO_WIN
    nsa_tiles<1>(lds, c.KW + (size_t)bh * 2048 * 64, c.VWT + (size_t)bh * 64 * 2048, winmask, 0u, 0u, cur, jlo, Qf, O, m, l, slope, tq, l15, quad);
#endif
#pragma unroll
    for (int g = 0; g < 2; ++g) { const float sc = gnp[g * 3 + 2] / fmaxf(l[g], 1e-30f);
#pragma unroll
        for (int dt = 0; dt < 4; ++dt) { const u32x2 w = *(const u32x2*)(stash + ((g * 4 + dt) * 64 + lane) * 8);
            const f32x4 v = O[g][dt] * sc + (f32x4){bflo(w.x), bfhi(w.x), bflo(w.y), bfhi(w.y)};
            st_bf4(c.ON + trow * 1024 + (head0 + g) * 64 + dt * 16 + quad * 4, v[0], v[1], v[2], v[3]); } }
}

DEV void xattn_unit(const bf16_t* Qx, const bf16_t* XK, const bf16_t* XVT, bf16_t* OX, int b, int h, int qblk, unsigned char* lds) {
    const int tid = get_tid(), lane = tid & 63, wid = tid >> 6, l15 = lane & 15, quad = lane >> 4;
    const size_t trow = (size_t)b * 2048 + qblk * 64 + wid * 16 + l15;
    bf16x8 Qf[8];
#pragma unroll
    for (int ks = 0; ks < 8; ++ks) Qf[ks] = *(const bf16x8*)(Qx + trow * 1024 + h * 256 + ks * 32 + quad * 8);
    f32x4 O[16];
#pragma unroll
    for (int dt = 0; dt < 16; ++dt) O[dt] = (f32x4){0.f, 0.f, 0.f, 0.f};
    float m = NEG, l = 0.f;
    const bf16_t* Kg = XK + (size_t)b * 256 * 1024 + h * 256;
    const bf16_t* Vg = XVT + (size_t)(b * 4 + h) * 256 * 256;
    u32x4 rk[4], rv[4];
#pragma unroll
    for (int i = 0; i < 4; ++i) { const int pc = tid + 256 * i; rk[i] = *(const u32x4*)(Kg + (size_t)(pc >> 5) * 1024 + (pc & 31) * 8); rv[i] = *(const u32x4*)(Vg + (size_t)(pc >> 2) * 256 + (pc & 3) * 8); }
#pragma unroll
    for (int i = 0; i < 4; ++i) { const int pc = tid + 256 * i; *(u32x4*)(lds + (pc >> 5) * 528 + (pc & 31) * 16) = rk[i]; st_vt(lds + 16896 + (pc >> 2) * 80, pc & 3, rv[i]); }
    __syncthreads();
    for (int j = 0; j < 8; ++j) {
        const bool more = j + 1 < 8;
        if (more) {
#pragma unroll
            for (int i = 0; i < 4; ++i) { const int pc = tid + 256 * i; rk[i] = *(const u32x4*)(Kg + (size_t)(32 * (j + 1) + (pc >> 5)) * 1024 + (pc & 31) * 8); rv[i] = *(const u32x4*)(Vg + (size_t)(pc >> 2) * 256 + 32 * (j + 1) + (pc & 3) * 8); } }
        const unsigned char* st = lds + (j & 1) * 37376;
        f32x4 S[2];
#pragma unroll
        for (int kt = 0; kt < 2; ++kt) { S[kt] = (f32x4){0.f, 0.f, 0.f, 0.f};
#pragma unroll
            for (int ks = 0; ks < 8; ++ks) { const bf16x8 kf = *(const bf16x8*)(st + (kt * 16 + l15) * 528 + ks * 64 + quad * 16); S[kt] = __builtin_amdgcn_mfma_f32_16x16x32_bf16(kf, Qf[ks], S[kt], 0, 0, 0); } }
        float tmax = fmaxf(fmaxf(fmaxf(S[0][0], S[0][1]), fmaxf(S[0][2], S[0][3])), fmaxf(fmaxf(S[1][0], S[1][1]), fmaxf(S[1][2], S[1][3])));
        tmax = qmax(tmax);
        const float mnew = fmaxf(m, tmax), alpha = fexp2(m - mnew);
        float rs = 0.f;
#pragma unroll
        for (int kt = 0; kt < 2; ++kt)
#pragma unroll
            for (int i = 0; i < 4; ++i) { const float pv = fexp2(S[kt][i] - mnew); S[kt][i] = pv; rs += pv; }
        rs = qsum(rs); l = l * alpha + rs; m = mnew;
        const bf16x8 pf = pack_p(S[0], S[1]);
#pragma unroll
        for (int dt = 0; dt < 16; ++dt) { O[dt] = O[dt] * alpha; const bf16x8 vf = *(const bf16x8*)(st + 16896 + (dt * 16 + l15) * 80 + quad * 16); O[dt] = __builtin_amdgcn_mfma_f32_16x16x32_bf16(vf, pf, O[dt], 0, 0, 0); }
        if (more) { unsigned char* sn = lds + ((j + 1) & 1) * 37376;
#pragma unroll
            for (int i = 0; i < 4; ++i) { const int pc = tid + 256 * i; *(u32x4*)(sn + (pc >> 5) * 528 + (pc & 31) * 16) = rk[i]; st_vt(sn + 16896 + (pc >> 2) * 80, pc & 3, rv[i]); } }
        __syncthreads();
    }
    const float inv = 1.0f / l;
#pragma unroll
    for (int dt = 0; dt < 16; ++dt) { const f32x4 v = O[dt] * inv; st_bf4(OX + trow * 1024 + h * 256 + dt * 16 + quad * 4, v[0], v[1], v[2], v[3]); }
}

constexpr int NPHASE = 17;
__global__ void __launch_bounds__(256, 2) fwd_kernel(P p) {
    extern __shared__ __attribute__((aligned(16))) unsigned char lds[];
#define WSB(off) ((bf16_t*)(ws + (off)))
#define WSF(off) ((float*)(ws + (off)))
    const SsmIn sin_{p.in[5], p.in[6], p.in[7], p.in[8], p.in[9], p.in[10], p.in[12]};
    for (int ph = p.ph_lo; ph < p.ph_hi; ++ph) {
        size_t zoff = 0; asm volatile("" : "+s"(zoff)); unsigned char* ws = p.ws + zoff;
        switch (ph) {
#ifdef ONLY_PHASE
        default: break;
#define CASE(k) case (k): if ((k) != ONLY_PHASE) break; else
#else
#define CASE(k) case (k):
#endif
        CASE(0) {
            const int tid = get_tid();
            ln_pass(p.in[0], p.in[2], p.in[3], WSB(O_B), WSF(O_ST0), nullptr);
            int cur = 0;
            conv_job(p.in[4], 5168, 1024, 5376, WSB(O_WIN_T), 1, lds, cur);
            conv_job(p.in[13], 512, 512, 512, WSB(O_WGLU_T), 0, lds, cur);
            conv_job(p.in[15], 1024, 512, 1024, WSB(O_WSOUT_T), 0, lds, cur);
            conv_job(p.in[17], 256, 2048, 256, WSB(O_W1_T), 0, lds, cur);
            conv_job(p.in[17] + 2048 * 256, 256, 2048, 256, WSB(O_W1_T) + 256 * 2048, 0, lds, cur);
            conv_job(p.in[19], 64, 256, 128, WSB(O_W2_T), 3, lds, cur);
            conv_job(p.in[19] + 256 * 64, 64, 256, 128, WSB(O_W2_T) + 128 * 256, 3, lds, cur);
            conv_job(p.in[20], 1024, 1024, 1024, WSB(O_WNOUT_T), 0, lds, cur);
            conv_job(p.in[21], 1024, 1024, 1024, WSB(O_WOUT_T), 0, lds, cur);
            conv_job(p.in[24], 1024, 1024, 1024, WSB(O_WXQ_T), 0, lds, cur);
            conv_job(p.in[25], 2048, 1024, 2048, WSB(O_WXKV_T), 0, lds, cur);
            conv_job(p.in[26], 1024, 1024, 1024, WSB(O_WXO_T), 0, lds, cur);
            conv_job(p.in[29], 5632, 1024, 5632, WSB(O_WFIN_T), 2, lds, cur);
            conv_job(p.in[30], 1024, 2816, 1024, WSB(O_WFOUT_T), 0, lds, cur);
            for (int it = get_bid(); it < 8; it += gridDim.x) {
                const int z = it >> 2, e = (it & 3) * 64 + (tid & 63), fg = tid >> 6;
                float a = 0.f;
                for (int f = fg * 512; f < fg * 512 + 512; ++f) a += p.in[16][z * 2048 + f] * p.in[17][((size_t)z * 2048 + f) * 256 + e];
                float* red = (float*)lds;
                __syncthreads(); red[tid] = a; __syncthreads();
                if (tid < 64) WSF(O_BIAS2)[z * 256 + e] = red[tid] + red[tid + 64] + red[tid + 128] + red[tid + 192] + p.in[18][z * 256 + e];
                __syncthreads();
            }
            ssm_prep(sin_, WSB(O_BT1), WSB(O_MTW), lds);
        } break;
        CASE(1) {
            { const GemmP g{WSB(O_B), WSB(O_WIN_T), 1024, 1024, 256, 42, 16, 1};
              const EpiIn e{WSB(O_UH), WSB(O_QB), WSB(O_KVC), WSB(O_KS), WSB(O_VST), WSB(O_KW), WSB(O_VWT), WSB(O_GM), WSF(O_GN)};
              gemm_run(g, AddrNone{}, e, lds); }
        } break;
        CASE(2) {
            { const GemmP g{WSB(O_KVC), WSB(O_W1_T), 1024, 2048, 1, 2, 32, 128};
              const EpiCmp1 e{WSB(O_HID), WSF(O_BIAS2)};
              gemm_run(g, AddrCmp1{}, e, lds); }
            { const GemmP g{WSB(O_UH), WSB(O_BT1), 640, 512, 8, 1, 8, 32};
              const EpiSsmA e{WSF(O_SS)};
              gemm_run(g, AddrStride{1024ull * 640, 128ull * 512}, e, lds); }
        } break;
        CASE(3) {
            ssm_scan(sin_, WSF(O_SS), WSB(O_UH));
            { const GemmP g{WSB(O_HID), WSB(O_W2_T), 256, 256, 1, 1, 4, 128};
              const EpiCmp2 e{WSB(O_KC), WSB(O_VCT)};
              gemm_run(g, AddrCmp2{}, e, lds); }
        } break;
        CASE(4) {
            const NsaCtx c{WSB(O_QB), WSB(O_KC), WSB(O_VCT), WSB(O_KS), WSB(O_VST), WSB(O_KW), WSB(O_VWT), WSF(O_GN), WSB(O_B)};
            const int G = gridDim.x;
            for (int i = 0;; ++i) {
                const int u = (i & 1) ? i * G + (G - 1 - get_bid()) : i * G + get_bid();
                if (i * G >= 4096) break;
                if (u < 4096) { const int qb32 = 63 - (u >> 6), bh = u & 63; nsa_unit(c, bh >> 2, bh & 3, qb32, lds); }
                __syncthreads();
            }
            { const GemmP g{WSB(O_UH), WSB(O_MTW), 640, 640, 8, 4, 10, 32};
              const EpiSsmB e{WSB(O_UH), p.in[11], WSB(O_GB)};
              gemm_run(g, AddrStride{1024ull * 640, 512ull * 640}, e, lds); }
        } break;
        CASE(5) { const GemmP g{WSB(O_GB), WSB(O_WGLU_T), 512, 512, 256, 4, 8, 1}; const EpiGlu e{WSB(O_GB), p.in[14], WSB(O_YS)}; gemm_run(g, AddrNone{}, e, lds); } break;
        CASE(6) { const GemmP g{WSB(O_YS), WSB(O_WSOUT_T), 512, 512, 256, 8, 8, 1}; const EpiSout e{WSB(O_GM), WSB(O_QB)}; gemm_run(g, AddrNone{}, e, lds); } break;
        CASE(7) { const GemmP g{WSB(O_B), WSB(O_WNOUT_T), 1024, 1024, 256, 8, 16, 1}; const EpiNout e{WSB(O_GM), WSB(O_QB), WSB(O_MIXIN)}; gemm_run(g, AddrNone{}, e, lds); } break;
        CASE(8) { const GemmP g{WSB(O_MIXIN), WSB(O_WOUT_T), 1024, 1024, 256, 8, 16, 1}; const EpiRes e{p.in[0], WSF(O_ST0), p.in[2], p.in[3], WSF(O_V1)}; gemm_run(g, AddrNone{}, e, lds); } break;
        CASE(9) { ln_pass(WSF(O_V1), p.in[22], p.in[23], WSB(O_B), WSF(O_ST1), nullptr);
            for (size_t i = (size_t)get_bid() * 256 + get_tid(); i < 4096ull * 1024 / 4; i += (size_t)gridDim.x * 256) { const f32x4 v = ((const f32x4*)p.in[1])[i]; st_bf4(WSB(O_MEMB) + i * 4, v[0], v[1], v[2], v[3]); }
        } break;
        CASE(10) { { const GemmP g{WSB(O_B), WSB(O_WXQ_T), 1024, 1024, 256, 8, 16, 1}; const EpiScaleBf e{WSB(O_QB), 1024, 0.0625f * LOG2E}; gemm_run(g, AddrNone{}, e, lds); }
            { const GemmP g{WSB(O_MEMB), WSB(O_WXKV_T), 1024, 1024, 32, 16, 16, 1};
              const EpiXkv e{WSB(O_XK), WSB(O_XVT)};
              gemm_run(g, AddrNone{}, e, lds); }
        } break;
        CASE(11) {
            for (int u = get_bid(); u < 2048; u += gridDim.x) { const int qblk = u >> 6, bh = u & 63; xattn_unit(WSB(O_QB), WSB(O_XK), WSB(O_XVT), WSB(O_B), bh >> 2, bh & 3, qblk, lds); }
        } break;
        CASE(12) { const GemmP g{WSB(O_B), WSB(O_WXO_T), 1024, 1024, 256, 8, 16, 1}; const EpiRes e{WSF(O_V1), WSF(O_ST1), p.in[22], p.in[23], WSF(O_V2)}; gemm_run(g, AddrNone{}, e, lds); } break;
        CASE(13) ln_pass(WSF(O_V2), p.in[27], p.in[28], WSB(O_B), WSF(O_ST2), nullptr); break;
        CASE(14) { const GemmP g{WSB(O_B), WSB(O_WFIN_T), 1024, 1024, 256, 44, 16, 1}; const EpiFfnIn e{WSB(O_FB)}; gemm_run(g, AddrNone{}, e, lds); } break;
        CASE(15) { const GemmP g{WSB(O_FB), WSB(O_WFOUT_T), 2816, 2816, 256, 8, 44, 1}; const EpiRes e{WSF(O_V2), WSF(O_ST2), p.in[27], p.in[28], WSF(O_V2)}; gemm_run(g, AddrNone{}, e, lds); } break;
        CASE(16) ln_pass(WSF(O_V2), p.in[31], p.in[32], nullptr, nullptr, p.out); break;
        }
        if (ph + 1 < p.ph_hi) { if (p.coop) cg::this_grid().sync(); }
    }
}

#ifndef ONE_LAUNCH
#define ONE_LAUNCH 1
#endif
extern "C" void kernel_launch(void* const* d_in, const int* in_sizes, int n_in, void* d_out, int out_size, void* d_ws, size_t ws_size, hipStream_t stream) {
    static int grid = 0;
    if (grid == 0) {
        if (n_in != 33 || out_size != T_ * 1024 || ws_size < WS_NEED) { fprintf(stderr, "kernel_launch: unexpected shapes (n_in %d out %d ws %zu need %zu)\n", n_in, out_size, ws_size, (size_t)WS_NEED); grid = -1; return; }
        int dev = 0, cus = 0, per_cu = 0;
        hipGetDevice(&dev);
        hipDeviceGetAttribute(&cus, hipDeviceAttributeMultiprocessorCount, dev);
        if (hipFuncSetAttribute((const void*)fwd_kernel, hipFuncAttributeMaxDynamicSharedMemorySize, LDS_BYTES) != hipSuccess) { fprintf(stderr, "kernel_launch: hipFuncSetAttribute failed\n"); grid = -1; return; }
        if (hipOccupancyMaxActiveBlocksPerMultiprocessor(&per_cu, (const void*)fwd_kernel, 256, LDS_BYTES) != hipSuccess || per_cu < 1) { fprintf(stderr, "kernel_launch: occupancy query failed (%d)\n", per_cu); per_cu = 1; (void)hipGetLastError(); }
        if (per_cu > 2) per_cu = 2;
        grid = cus * per_cu;
    }
    if (grid < 0) return;
    P p{};
    for (int i = 0; i < 33; ++i) p.in[i] = (const float*)d_in[i];
    p.out = (float*)d_out; p.ws = (unsigned char*)d_ws;
#if ONE_LAUNCH
    p.ph_lo = 0; p.ph_hi = NPHASE; p.coop = 1;
    void* args[] = {&p};
    hipError_t e = hipLaunchCooperativeKernel((const void*)fwd_kernel, dim3(grid), dim3(256), args, LDS_BYTES, stream);
    if (e != hipSuccess) fprintf(stderr, "cooperative launch failed: %s (grid %d)\n", hipGetErrorString(e), grid);
#else
#ifdef STOP_AFTER
    const int nrun = STOP_AFTER + 1;
#else
    const int nrun = NPHASE;
#endif
    for (int ph = 0; ph < nrun; ++ph) {
        p.ph_lo = ph; p.ph_hi = ph + 1; p.coop = 0;
        hipLaunchKernelGGL(fwd_kernel, dim3(grid), dim3(256), LDS_BYTES, stream, p);
    }
#endif
}
```

```cpp
#include <hip/hip_runtime.h>
#include <hip/hip_cooperative_groups.h>
#include <cstdio>
#include <cstdint>
namespace cg = cooperative_groups;

typedef unsigned short bf16_t;
typedef short bf16x8 __attribute__((ext_vector_type(8)));
typedef float f32x4 __attribute__((ext_vector_type(4)));
typedef unsigned u32x4 __attribute__((ext_vector_type(4)));
typedef unsigned u32x2 __attribute__((ext_vector_type(2)));
#define DEV __device__ __forceinline__

constexpr int T_ = 32768, L_ = 2048;
constexpr float LOG2E = 1.4426950408889634f;
constexpr float ALPHA = 1.189207115002721f;
constexpr float LN_EPS = 1e-5f;
constexpr float NEG = -1e30f;
constexpr int LDS_BYTES = 81920;
constexpr size_t MiB = 1048576;

constexpr size_t O_WIN_T = 0;
constexpr size_t O_WGLU_T = O_WIN_T + 5376ull * 1024 * 2;
constexpr size_t O_WSOUT_T = O_WGLU_T + 512ull * 512 * 2;
constexpr size_t O_W1_T = O_WSOUT_T + 1024ull * 512 * 2;
constexpr size_t O_W2_T = O_W1_T + 2ull * 256 * 2048 * 2;
constexpr size_t O_WNOUT_T = O_W2_T + 2ull * 128 * 256 * 2;
constexpr size_t O_WOUT_T = O_WNOUT_T + 2 * MiB;
constexpr size_t O_WXQ_T = O_WOUT_T + 2 * MiB;
constexpr size_t O_WXKV_T = O_WXQ_T + 2 * MiB;
constexpr size_t O_WXO_T = O_WXKV_T + 4 * MiB;
constexpr size_t O_WFIN_T = O_WXO_T + 2 * MiB;
constexpr size_t O_WFOUT_T = O_WFIN_T + 5632ull * 1024 * 2;
constexpr size_t O_BT1 = O_WFOUT_T + 1024ull * 2816 * 2;
constexpr size_t O_MTW = O_BT1 + 4 * MiB;
constexpr size_t O_KC = O_MTW + 20 * MiB;
constexpr size_t O_VCT = O_KC + 1 * MiB;
constexpr size_t O_GN = O_VCT + 1 * MiB;
constexpr size_t O_ST0 = O_GN + 6 * MiB;
constexpr size_t O_ST1 = O_ST0 + 262144;
constexpr size_t O_ST2 = O_ST1 + 262144;
constexpr size_t O_BIAS2 = O_ST2 + 262144;
constexpr size_t O_BAR = O_BIAS2 + 4096;
constexpr size_t O_A = 76 * MiB;
constexpr size_t O_KVC = O_A;
constexpr size_t O_KS = O_A + 32 * MiB;
constexpr size_t O_VST = O_A + 48 * MiB;
constexpr size_t O_KW = O_A + 64 * MiB;
constexpr size_t O_VWT = O_A + 80 * MiB;
constexpr size_t O_GB = O_A + 96 * MiB;
constexpr size_t O_MIXIN = O_A;
constexpr size_t O_MEMB = O_A + 64 * MiB;
constexpr size_t O_XK = O_A + 72 * MiB;
constexpr size_t O_XVT = O_A + 80 * MiB;
constexpr size_t O_V2 = O_A;
constexpr size_t O_B = O_A + 128 * MiB;
constexpr size_t O_SS = O_B;
constexpr size_t O_HID = O_B + 16 * MiB;
constexpr size_t O_Y = O_B + 64 * MiB;
constexpr size_t O_GM = O_Y;
constexpr size_t O_V1 = O_Y;
constexpr size_t O_X = O_Y + 128 * MiB;
constexpr size_t O_QB = O_X;
constexpr size_t O_UH = O_X + 64 * MiB;
constexpr size_t O_YS = O_X + 64 * MiB;
constexpr size_t O_FB = O_Y;
constexpr size_t WS_NEED = O_X + 104 * MiB;
static_assert(O_BAR + 16384 <= O_A, "F region overflow");

struct P {
    const float* in[33];
    float* out;
    unsigned char* ws;
    int ph_lo, ph_hi, coop, pad;
};

DEV int get_tid() { int t = threadIdx.x; asm volatile("" : "+v"(t)); return t; }
DEV int get_bid() { int t = blockIdx.x; asm volatile("" : "+s"(t)); return t; }
typedef __bf16 bf2_t __attribute__((ext_vector_type(2)));
typedef float f32x2_t __attribute__((ext_vector_type(2)));
DEV unsigned cvt_pk_bf16(float lo, float hi) { const f32x2_t f = {lo, hi}; const bf2_t r = __builtin_convertvector(f, bf2_t); return __builtin_bit_cast(unsigned, r); }
DEV bf16_t f2bf(float v) { return (bf16_t)(cvt_pk_bf16(v, 0.f) & 0xffffu); }
DEV float bf2f(unsigned v) { return __uint_as_float(v << 16); }
DEV float bflo(unsigned w) { return __uint_as_float(w << 16); }
DEV float bfhi(unsigned w) { return __uint_as_float(w & 0xffff0000u); }
DEV float fexp2(float x) { return __builtin_amdgcn_exp2f(x); }
DEV float frcp(float x) { return __builtin_amdgcn_rcpf(x); }
DEV float sigmoidf_(float x) { return frcp(1.f + fexp2(-x * LOG2E)); }
DEV float gelu_tanh(float x) { const float u = 0.7978845608028654f * (x + 0.044715f * x * x * x); return x * frcp(1.f + fexp2(-2.f * LOG2E * u)); }
DEV void st_bf4(bf16_t* p, float a, float b, float c, float d) { u32x2 w; w.x = cvt_pk_bf16(a, b); w.y = cvt_pk_bf16(c, d); *(u32x2*)p = w; }
DEV f32x4 ld_bf4(const bf16_t* p) { const u32x2 w = *(const u32x2*)p; return (f32x4){bflo(w.x), bfhi(w.x), bflo(w.y), bfhi(w.y)}; }
DEV float wred_sum(float v) {
#pragma unroll
    for (int o = 32; o >= 1; o >>= 1) v += __shfl_xor(v, o);
    return v;
}

DEV void ln_pass(const float* src, const float* g, const float* b, bf16_t* dstb, float* stats, float* dstf) {
    const int lane = get_tid() & 63, wid = get_tid() >> 6;
    const int nw = gridDim.x * 4;
    for (int row = get_bid() * 4 + wid; row < T_; row += nw) {
        const f32x4* p = (const f32x4*)(src + (size_t)row * 1024);
        f32x4 v[4];
#pragma unroll
        for (int i = 0; i < 4; ++i) v[i] = p[lane + 64 * i];
        float s = 0.f;
#pragma unroll
        for (int i = 0; i < 4; ++i) s += (v[i][0] + v[i][1]) + (v[i][2] + v[i][3]);
        s = wred_sum(s);
        const float mu = s * (1.f / 1024.f);
        float q = 0.f;
#pragma unroll
        for (int i = 0; i < 4; ++i) { const f32x4 d = v[i] - mu; q += (d[0] * d[0] + d[1] * d[1]) + (d[2] * d[2] + d[3] * d[3]); }
        q = wred_sum(q);
        const float rstd = 1.0f / sqrtf(q * (1.f / 1024.f) + LN_EPS);
        if (stats && lane == 0) { stats[row * 2] = mu; stats[row * 2 + 1] = rstd; }
#pragma unroll
        for (int i = 0; i < 4; ++i) {
            const int col = (lane + 64 * i) * 4;
            const f32x4 gg = *(const f32x4*)(g + col), bb = *(const f32x4*)(b + col);
            const f32x4 y = (v[i] - mu) * rstd * gg + bb;
            if (dstb) st_bf4(dstb + (size_t)row * 1024 + col, y[0], y[1], y[2], y[3]);
            if (dstf) *(f32x4*)(dstf + (size_t)row * 1024 + col) = y;
        }
    }
}

DEV int colmap(int mode, int n) {
    if (mode == 0) return n;
    if (mode == 1) return n < 3072 ? n : (n < 5120 ? n + 48 : (n < 5168 ? n - 5120 + 3072 : -1));
    if (mode == 2) { const int blk = n >> 5, r = n & 31; return r < 16 ? blk * 16 + r : 2816 + blk * 16 + (r - 16); }
    return n < 64 ? n : -1;
}
DEV void conv_job(const float* src, int ldsrc, int K, int N, bf16_t* dst, int mode, unsigned char* lds, int& cursor) {
    float* tile = (float*)lds;
    const int tk = K / 64, tn = N / 64, ntile = tk * tn;
    const int tx = get_tid() & 63, ty = get_tid() >> 6;
    for (int t = (int)((get_bid() + gridDim.x - (cursor % gridDim.x)) % gridDim.x); t < ntile; t += gridDim.x) {
        const int k0 = (t % tk) * 64, n0 = (t / tk) * 64;
        const int sc = colmap(mode, n0 + tx);
#pragma unroll 4
        for (int kk = ty; kk < 64; kk += 4) tile[kk * 65 + tx] = sc >= 0 ? src[(size_t)(k0 + kk) * ldsrc + sc] : 0.f;
        __syncthreads();
#pragma unroll 4
        for (int nn = ty; nn < 64; nn += 4) dst[(size_t)(n0 + nn) * K + k0 + tx] = f2bf(tile[tx * 65 + nn]);
        __syncthreads();
    }
    cursor += ntile;
}

struct SsmIn { const float *a_re, *a_im, *b_re, *b_im, *c_re, *c_im, *log_dt; };
DEV void lb_pow(const SsmIn& s, int g, int n, float p, float& re, float& im) {
    const float lre = fminf(s.a_re[g * 64 + n], -1e-4f), lim = s.a_im[g * 64 + n], dt = expf(s.log_dt[g]);
    const float mag = expf(lre * dt * p); float sn, cs; sincosf(lim * dt * p, &sn, &cs);
    re = mag * cs; im = mag * sn;
}
DEV void bbar(const SsmIn& s, int g, int n, int c, float& re, float& im) {
    const float lre = fminf(s.a_re[g * 64 + n], -1e-4f), lim = s.a_im[g * 64 + n], dt = expf(s.log_dt[g]);
    const float mag = expf(lre * dt); float sn, cs; sincosf(lim * dt, &sn, &cs);
    const float sh = sinf(0.5f * lim * dt);
    const float nr = expm1f(lre * dt) - mag * 2.f * sh * sh, lbi = mag * sn;
    const float den = lre * lre + lim * lim;
    const float fre = (nr * lre + lbi * lim) / den, fim = (lbi * lre - nr * lim) / den;
    const float br = s.b_re[(g * 64 + n) * 16 + c], bi = s.b_im[(g * 64 + n) * 16 + c];
    re = fre * br - fim * bi; im = fre * bi + fim * br;
}
DEV void ssm_prep(const SsmIn& s, bf16_t* BT1, bf16_t* MTW, unsigned char* lds) {
    const int tid = get_tid();
    const size_t gt = (size_t)get_bid() * 256 + tid, gs = (size_t)gridDim.x * 256;
    for (size_t i = gt; i < 32ull * 128 * 512; i += gs) {
        const int kk = (int)(i & 511), nn = (int)((i >> 9) & 127), g = (int)(i >> 16);
        const int n = nn & 63, sidx = kk >> 4, c = kk & 15;
        float pr, pi, br, bi; lb_pow(s, g, n, (float)(31 - sidx), pr, pi); bbar(s, g, n, c, br, bi);
        BT1[i] = f2bf((nn >> 6) ? (pr * bi + pi * br) : (pr * br - pi * bi));
    }
    for (size_t i = gt; i < 32ull * 512 * 128; i += gs) {
        const int nn = (int)(i & 127), r = (int)((i >> 7) & 511), g = (int)(i >> 16);
        const int n = nn & 63, tau = r >> 4, c = r & 15;
        float pr, pi; lb_pow(s, g, n, (float)(tau + 1), pr, pi);
        const float cr = s.c_re[(g * 16 + c) * 64 + n], ci = s.c_im[(g * 16 + c) * 64 + n];
        MTW[((size_t)g * 512 + r) * 640 + 512 + nn] = f2bf((nn >> 6) ? -(cr * pi + ci * pr) : (cr * pr - ci * pi));
    }
    for (size_t i = gt; i < 32ull * 512 * 512; i += gs) {
        const int kk = (int)(i & 511), r = (int)((i >> 9) & 511), g = (int)(i >> 18);
        if ((kk >> 4) > (r >> 4)) MTW[((size_t)g * 512 + r) * 640 + kk] = 0;
    }
    float* cpw = (float*)lds;
    float* bb = cpw + 2048;
    for (int it = get_bid(); it < 1024; it += gridDim.x) {
        const int g = it >> 5, d = it & 31;
        __syncthreads();
        for (int e = tid; e < 1024; e += 256) {
            const int c = e >> 6, n = e & 63;
            float pr, pi; lb_pow(s, g, n, (float)d, pr, pi);
            const float cr = s.c_re[(g * 16 + c) * 64 + n], ci = s.c_im[(g * 16 + c) * 64 + n];
            cpw[e * 2] = cr * pr - ci * pi; cpw[e * 2 + 1] = cr * pi + ci * pr;
            const int n2 = e >> 4, c2 = e & 15;
            float br, bi; bbar(s, g, n2, c2, br, bi);
            bb[e * 2] = br; bb[e * 2 + 1] = bi;
        }
        __syncthreads();
        const int c = tid >> 4, c2 = tid & 15;
        float acc = 0.f;
        for (int n = 0; n < 64; ++n) acc += cpw[(c * 64 + n) * 2] * bb[(n * 16 + c2) * 2] - cpw[(c * 64 + n) * 2 + 1] * bb[(n * 16 + c2) * 2 + 1];
        const bf16_t v = f2bf(acc);
        for (int sidx = 0; sidx + d < 32; ++sidx) MTW[((size_t)g * 512 + (sidx + d) * 16 + c) * 640 + sidx * 16 + c2] = v;
    }
}
DEV void ssm_scan(const SsmIn& s, const float* SS, bf16_t* UH) {
    for (int idx = get_bid() * 256 + get_tid(); idx < 32768; idx += gridDim.x * 256) {
        const int n = idx & 63, b = (idx >> 6) & 15, g = idx >> 10;
        float ar, ai; lb_pow(s, g, n, 32.f, ar, ai);
        float hr = 0.f, hi = 0.f;
        const size_t row0 = (size_t)(g * 16 + b) * 64;
#pragma unroll 8
        for (int k = 0; k < 64; ++k) {
            UH[(row0 + k) * 640 + 512 + n] = f2bf(hr); UH[(row0 + k) * 640 + 576 + n] = f2bf(hi);
            const float sr = SS[(row0 + k) * 128 + n], si = SS[(row0 + k) * 128 + 64 + n];
            const float nr = ar * hr - ai * hi + sr, ni = ar * hi + ai * hr + si;
            hr = nr; hi = ni;
        }
    }
}

struct GemmP { const bf16_t* A; const bf16_t* Bt; int lda, ldb, MT, NT, KT, nbatch; };
template <class Addr, class Epi>
DEV void gemm_run(const GemmP p, const Addr ad, const Epi epi, unsigned char* lds) {
    const int tid = get_tid(), lane = tid & 63, wid = tid >> 6, wr = wid >> 1, wc = wid & 1, l15 = lane & 15, quad = lane >> 4;
    const int G = gridDim.x;
    const int nx = (G % 8 == 0) ? 8 : 1, x = get_bid() % nx, jx = get_bid() / nx, stride = G / nx;
    const int SRtot = (p.nbatch * p.MT) / 8, per = 8 * p.NT;
    const int prow = tid >> 3, pc16 = tid & 7;
    const int aoff = (wr * 64 + l15) * 144 + quad * 16, boff = 36864 / 2 + (wc * 64 + l15) * 144 + quad * 16;
    for (int s = jx;; s += stride) {
        const int q = s / per, rem = s % per;
        const int sr = x + nx * q;
        if (sr >= SRtot) break;
        const int nt = rem >> 3, R = sr * 8 + (rem & 7), batch = R / p.MT, mt = R % p.MT;
        const bf16_t* Ab = p.A + ad.a_off(batch) + (size_t)(mt * 128 + prow) * p.lda + pc16 * 8;
        const bf16_t* Bb = p.Bt + ad.b_off(batch) + (size_t)(nt * 128 + prow) * p.ldb + pc16 * 8;
        f32x4 acc[4][4];
#pragma unroll
        for (int i = 0; i < 4; ++i)
#pragma unroll
            for (int j = 0; j < 4; ++j) acc[i][j] = (f32x4){0.f, 0.f, 0.f, 0.f};
        u32x4 ra[4], rb[4];
#pragma unroll
        for (int i = 0; i < 4; ++i) { ra[i] = *(const u32x4*)(Ab + (size_t)(32 * i) * p.lda); rb[i] = *(const u32x4*)(Bb + (size_t)(32 * i) * p.ldb); }
#pragma unroll
        for (int i = 0; i < 4; ++i) { *(u32x4*)(lds + (prow + 32 * i) * 144 + pc16 * 16) = ra[i]; *(u32x4*)(lds + 18432 + (prow + 32 * i) * 144 + pc16 * 16) = rb[i]; }
        __syncthreads();
        for (int kt = 0; kt < p.KT; ++kt) {
            const bool more = kt + 1 < p.KT;
            if (more) {
#pragma unroll
                for (int i = 0; i < 4; ++i) { ra[i] = *(const u32x4*)(Ab + (size_t)(32 * i) * p.lda + (kt + 1) * 64); rb[i] = *(const u32x4*)(Bb + (size_t)(32 * i) * p.ldb + (kt + 1) * 64); }
            }
            const unsigned char* st = lds + (kt & 1) * 36864;
#pragma unroll
            for (int ks = 0; ks < 2; ++ks) {
                bf16x8 af[4], bfr[4];
#pragma unroll
                for (int i = 0; i < 4; ++i) { af[i] = *(const bf16x8*)(st + aoff + i * 16 * 144 + ks * 64); bfr[i] = *(const bf16x8*)(st + boff + i * 16 * 144 + ks * 64); }
#pragma unroll
                for (int mi = 0; mi < 4; ++mi)
#pragma unroll
                    for (int ni = 0; ni < 4; ++ni) acc[mi][ni] = __builtin_amdgcn_mfma_f32_16x16x32_bf16(bfr[ni], af[mi], acc[mi][ni], 0, 0, 0);
            }
            if (more) {
                unsigned char* sn = lds + ((kt + 1) & 1) * 36864;
#pragma unroll
                for (int i = 0; i < 4; ++i) { *(u32x4*)(sn + (prow + 32 * i) * 144 + pc16 * 16) = ra[i]; *(u32x4*)(sn + 18432 + (prow + 32 * i) * 144 + pc16 * 16) = rb[i]; }
            }
            __syncthreads();
        }
        epi(acc, batch, mt * 128 + wr * 64, nt * 128 + wc * 64, l15, quad);
    }
}
struct AddrNone { DEV size_t a_off(int) const { return 0; } DEV size_t b_off(int) const { return 0; } };
struct AddrStride { size_t as, bs; DEV size_t a_off(int b) const { return as * b; } DEV size_t b_off(int b) const { return bs * b; } };
struct AddrCmp1 { DEV size_t a_off(int b) const { return (size_t)b * 2048 * 64; } DEV size_t b_off(int b) const { return (size_t)((b >> 2) & 1) * 256 * 2048; } };
struct AddrCmp2 { DEV size_t a_off(int b) const { return (size_t)b * 128 * 256; } DEV size_t b_off(int b) const { return (size_t)((b >> 2) & 1) * 128 * 256; } };

#define EPI_ARGS const f32x4 (&acc)[4][4], int batch, int m0, int n0, int l15, int quad
struct EpiIn {
    bf16_t *UH, *Qb, *KVC, *KS, *VST, *KW, *VWT, *GM; float* GN;
    DEV void operator()(EPI_ARGS) const {
#pragma unroll
        for (int mi = 0; mi < 4; ++mi) {
            const int t = m0 + mi * 16 + l15, b = t >> 11, tt = t & 2047;
#pragma unroll
            for (int ni = 0; ni < 4; ++ni) {
                const f32x4 v = acc[mi][ni];
                const int c = n0 + ni * 16 + quad * 4;
                if (n0 < 512) {
                    const int g = c >> 4;
                    st_bf4(UH + ((size_t)((g * 16 + b) * 64 + (tt >> 5))) * 640 + (tt & 31) * 16 + (c & 15), v[0], v[1], v[2], v[3]);
                } else if (n0 < 1536) {
                    const float sc = 0.125f * LOG2E;
                    st_bf4(Qb + (size_t)t * 1024 + (c - 512), v[0] * sc, v[1] * sc, v[2] * sc, v[3] * sc);
                } else if (n0 < 2048) {
                    const int cc = c - 1536, z = cc >> 8, h = (cc >> 6) & 3, d = cc & 63;
                    st_bf4(KVC + ((size_t)(((b * 2 + z) * 4 + h) * 2048 + tt)) * 64 + d, v[0], v[1], v[2], v[3]);
                } else if (n0 < 3072) {
                    const int cc = (c - 2048) & 511, isw = (c - 2048) >> 9, h = (cc >> 6) & 3, d = cc & 63;
                    if (cc < 256) st_bf4((isw ? KW : KS) + ((size_t)((b * 4 + h) * 2048 + tt)) * 64 + d, v[0], v[1], v[2], v[3]);
                    else { bf16_t* o = (isw ? VWT : VST) + ((size_t)((b * 4 + h) * 64 + d)) * 2048 + tt;
#pragma unroll
                        for (int i = 0; i < 4; ++i) o[(size_t)i * 2048] = f2bf(v[i]); }
                } else if (n0 < 5120) {
                    st_bf4(GM + (size_t)t * 2048 + (c - 3072), sigmoidf_(v[0]), sigmoidf_(v[1]), sigmoidf_(v[2]), sigmoidf_(v[3]));
                } else {
                    const int cc = c - 5120;
                    if (cc < 48) *(f32x4*)(GN + (size_t)t * 48 + cc) = (f32x4){sigmoidf_(v[0]), sigmoidf_(v[1]), sigmoidf_(v[2]), sigmoidf_(v[3])};
                }
            }
        }
    }
};
struct EpiXkv {
    bf16_t *XK, *XVT;
    DEV void operator()(EPI_ARGS) const {
#pragma unroll
        for (int mi = 0; mi < 4; ++mi) {
            const int r = m0 + mi * 16 + l15, b = r >> 8, m = r & 255;
#pragma unroll
            for (int ni = 0; ni < 4; ++ni) {
                const f32x4 v = acc[mi][ni]; const int c = n0 + ni * 16 + quad * 4;
                if (n0 < 1024) st_bf4(XK + (size_t)r * 1024 + c, v[0], v[1], v[2], v[3]);
                else { const int cc = c - 1024, h = cc >> 8, d = cc & 255; bf16_t* o = XVT + ((size_t)((b * 4 + h) * 256 + d)) * 256 + m;
#pragma unroll
                    for (int i = 0; i < 4; ++i) o[i * 256] = f2bf(v[i]); }
            }
        }
    }
};
struct EpiSsmA { float* SS;
    DEV void operator()(EPI_ARGS) const {
#pragma unroll
        for (int mi = 0; mi < 4; ++mi)
#pragma unroll
            for (int ni = 0; ni < 4; ++ni) *(f32x4*)(SS + ((size_t)batch * 1024 + m0 + mi * 16 + l15) * 128 + n0 + ni * 16 + quad * 4) = acc[mi][ni];
    }
};
struct EpiCmp1 { bf16_t* HID; const float* bias2;
    DEV void operator()(EPI_ARGS) const {
        const int z = (batch >> 2) & 1;
#pragma unroll
        for (int ni = 0; ni < 4; ++ni) {
            const int c = n0 + ni * 16 + quad * 4; const f32x4 bv = *(const f32x4*)(bias2 + z * 256 + c);
#pragma unroll
            for (int mi = 0; mi < 4; ++mi) { const f32x4 v = acc[mi][ni] + bv;
                st_bf4(HID + ((size_t)batch * 128 + m0 + mi * 16 + l15) * 256 + c, gelu_tanh(v[0]), gelu_tanh(v[1]), gelu_tanh(v[2]), gelu_tanh(v[3])); }
        }
    }
};
struct EpiCmp2 { bf16_t *KC, *VCT;
    DEV void operator()(EPI_ARGS) const {
        if (n0 >= 64) return;
        const int z = (batch >> 2) & 1, bh = (batch >> 3) * 4 + (batch & 3);
#pragma unroll
        for (int mi = 0; mi < 4; ++mi) { const int r = m0 + mi * 16 + l15;
#pragma unroll
            for (int ni = 0; ni < 4; ++ni) { const f32x4 v = acc[mi][ni]; const int c = n0 + ni * 16 + quad * 4;
                if (z == 0) st_bf4(KC + ((size_t)bh * 128 + r) * 64 + c, v[0], v[1], v[2], v[3]);
                else {
#pragma unroll
                    for (int i = 0; i < 4; ++i) VCT[((size_t)bh * 64 + c + i) * 128 + r] = f2bf(v[i]); } } }
    }
};
struct EpiSsmB { const bf16_t* UH; const float* dskip; bf16_t* GB;
    DEV void operator()(EPI_ARGS) const {
#pragma unroll
        for (int mi = 0; mi < 4; ++mi) { const int r = m0 + mi * 16 + l15, b = r >> 6, k = r & 63;
#pragma unroll
            for (int ni = 0; ni < 4; ++ni) { const int col = n0 + ni * 16 + quad * 4, tau = col >> 4, c = col & 15;
                const f32x4 u = ld_bf4(UH + ((size_t)batch * 1024 + r) * 640 + col);
                const f32x4 dv = *(const f32x4*)(dskip + batch * 16 + c);
                const f32x4 y = acc[mi][ni] + dv * u;
                st_bf4(GB + ((size_t)(b * 2048 + k * 32 + tau)) * 512 + batch * 16 + c, gelu_tanh(y[0]), gelu_tanh(y[1]), gelu_tanh(y[2]), gelu_tanh(y[3])); } }
    }
};
struct EpiGlu { const bf16_t* GB; const float* bglu; bf16_t* YS;
    DEV void operator()(EPI_ARGS) const {
#pragma unroll
        for (int ni = 0; ni < 4; ++ni) { const int c = n0 + ni * 16 + quad * 4; const f32x4 bv = *(const f32x4*)(bglu + c);
#pragma unroll
            for (int mi = 0; mi < 4; ++mi) { const size_t o = (size_t)(m0 + mi * 16 + l15) * 512 + c; const f32x4 g = ld_bf4(GB + o); const f32x4 v = acc[mi][ni] + bv;
                st_bf4(YS + o, g[0] * sigmoidf_(v[0]), g[1] * sigmoidf_(v[1]), g[2] * sigmoidf_(v[2]), g[3] * sigmoidf_(v[3])); } }
    }
};
struct EpiSout { const bf16_t* GM; bf16_t* P1;
    DEV void operator()(EPI_ARGS) const {
#pragma unroll
        for (int mi = 0; mi < 4; ++mi) { const size_t t = m0 + mi * 16 + l15;
#pragma unroll
            for (int ni = 0; ni < 4; ++ni) { const int c = n0 + ni * 16 + quad * 4; const f32x4 g = ld_bf4(GM + t * 2048 + c); const f32x4 v = acc[mi][ni] * g;
                st_bf4(P1 + t * 1024 + c, v[0], v[1], v[2], v[3]); } }
    }
};
struct EpiNout { const bf16_t* GM; const bf16_t* P1; bf16_t* MIX;
    DEV void operator()(EPI_ARGS) const {
#pragma unroll
        for (int mi = 0; mi < 4; ++mi) { const size_t t = m0 + mi * 16 + l15;
#pragma unroll
            for (int ni = 0; ni < 4; ++ni) { const int c = n0 + ni * 16 + quad * 4; const f32x4 g = ld_bf4(GM + t * 2048 + 1024 + c); const f32x4 v = acc[mi][ni] * g + ld_bf4(P1 + t * 1024 + c);
                st_bf4(MIX + t * 1024 + c, v[0], v[1], v[2], v[3]); } }
    }
};
struct EpiRes { const float* src; const float* stats; const float* g; const float* b; float* dst;
    DEV void operator()(EPI_ARGS) const {
#pragma unroll
        for (int mi = 0; mi < 4; ++mi) { const size_t t = m0 + mi * 16 + l15; const float mu = stats[t * 2], rs = stats[t * 2 + 1];
#pragma unroll
            for (int ni = 0; ni < 4; ++ni) { const int c = n0 + ni * 16 + quad * 4;
                const f32x4 xv = *(const f32x4*)(src + t * 1024 + c), gg = *(const f32x4*)(g + c), bb = *(const f32x4*)(b + c);
                *(f32x4*)(dst + t * 1024 + c) = ((xv - mu) * rs * gg + bb) * ALPHA + acc[mi][ni]; } }
    }
};
struct EpiScaleBf { bf16_t* O; int ldc; float sc;
    DEV void operator()(EPI_ARGS) const {
#pragma unroll
        for (int mi = 0; mi < 4; ++mi)
#pragma unroll
            for (int ni = 0; ni < 4; ++ni) { const f32x4 v = acc[mi][ni] * sc; st_bf4(O + (size_t)(m0 + mi * 16 + l15) * ldc + n0 + ni * 16 + quad * 4, v[0], v[1], v[2], v[3]); }
    }
};
struct EpiFfnIn { bf16_t* FB;
    DEV void operator()(EPI_ARGS) const {
#pragma unroll
        for (int mi = 0; mi < 4; ++mi) { const size_t t = m0 + mi * 16 + l15;
#pragma unroll
            for (int pp = 0; pp < 2; ++pp) { const f32x4 ga = acc[mi][2 * pp], up = acc[mi][2 * pp + 1]; const int j = (n0 + pp * 32) / 2 + quad * 4;
                st_bf4(FB + t * 2816 + j, ga[0] * sigmoidf_(ga[0]) * up[0], ga[1] * sigmoidf_(ga[1]) * up[1], ga[2] * sigmoidf_(ga[2]) * up[2], ga[3] * sigmoidf_(ga[3]) * up[3]); } }
    }
};

DEV float qmax(float v) { v = fmaxf(v, __shfl_xor(v, 16)); return fmaxf(v, __shfl_xor(v, 32)); }
DEV float qsum(float v) { v += __shfl_xor(v, 16); return v + __shfl_xor(v, 32); }
DEV bf16x8 pack_p(const f32x4& a, const f32x4& b) { u32x4 w; w.x = cvt_pk_bf16(a[0], a[1]); w.y = cvt_pk_bf16(a[2], a[3]); w.z = cvt_pk_bf16(b[0], b[1]); w.w = cvt_pk_bf16(b[2], b[3]); return __builtin_bit_cast(bf16x8, w); }
DEV void st_vt(unsigned char* rowbase, int e, const u32x4& v) {
    const int grp = e >> 2, ep = e & 3, a = ep >> 1, qp = (ep & 1) * 2;
    unsigned char* o = rowbase + grp * 64 + (qp * 8 + a * 4) * 2;
    *(u32x2*)o = (u32x2){v.x, v.y}; *(u32x2*)(o + 16) = (u32x2){v.z, v.w};
}

struct NsaCtx { const bf16_t *Qb, *KC, *VCT, *KS, *VST, *KW, *VWT; const float* GN; bf16_t* ON; };
constexpr float MINIT = -1e20f;

template <int MODE, bool BOUND>
DEV void nsa_tile(const unsigned char* Kl, const unsigned char* Vl, const bf16x8 (&Qf)[2][2], f32x4 (&O)[2][4], float (&m)[2], float (&l)[2],
                  const float (&slope)[2], int dist0, bool sel, int l15, int quad) {
    const float d0f = (float)dist0;
#pragma unroll
    for (int g = 0; g < 2; ++g) {
        f32x4 S[4];
#pragma unroll
        for (int kt = 0; kt < 4; ++kt) { S[kt] = (f32x4){0.f, 0.f, 0.f, 0.f};
#pragma unroll
            for (int ks = 0; ks < 2; ++ks) { const bf16x8 kf = *(const bf16x8*)(Kl + (kt * 16 + l15) * 144 + ks * 64 + quad * 16); S[kt] = __builtin_amdgcn_mfma_f32_16x16x32_bf16(kf, Qf[g][ks], S[kt], 0, 0, 0); } }
        float base = -slope[g] * d0f;
        if (MODE == 0) base = sel ? base : NEG;
        float tmax = NEG;
#pragma unroll
        for (int kt = 0; kt < 4; ++kt)
#pragma unroll
            for (int i = 0; i < 4; ++i) { const int cc = 16 * kt + i;
                float s = fmaf(slope[g], (float)cc, S[kt][i] + base);
                if (BOUND) { bool v = cc <= dist0; if (MODE == 1) v = v && (cc > dist0 - 512); s = v ? s : NEG; }
                S[kt][i] = s; tmax = fmaxf(tmax, s); }
        tmax = qmax(tmax);
        const float mnew = fmaxf(m[g], tmax), alpha = fexp2(m[g] - mnew);
        float rs = 0.f;
#pragma unroll
        for (int kt = 0; kt < 4; ++kt)
#pragma unroll
            for (int i = 0; i < 4; ++i) { const float pv = fexp2(S[kt][i] - mnew); S[kt][i] = pv; rs += pv; }
        rs = qsum(rs);
        l[g] = l[g] * alpha + rs; m[g] = mnew;
        const bf16x8 P0 = pack_p(S[0], S[1]), P1 = pack_p(S[2], S[3]);
#pragma unroll
        for (int dt = 0; dt < 4; ++dt) { O[g][dt] = O[g][dt] * alpha;
            const bf16x8 v0 = *(const bf16x8*)(Vl + (dt * 16 + l15) * 144 + quad * 16), v1 = *(const bf16x8*)(Vl + (dt * 16 + l15) * 144 + 64 + quad * 16);
            O[g][dt] = __builtin_amdgcn_mfma_f32_16x16x32_bf16(v0, P0, O[g][dt], 0, 0, 0);
            O[g][dt] = __builtin_amdgcn_mfma_f32_16x16x32_bf16(v1, P1, O[g][dt], 0, 0, 0); }
    }
}

template <int MODE>
DEV void nsa_tiles(unsigned char* lds, const bf16_t* Kg, const bf16_t* VTg, unsigned tilemask, unsigned wmask, unsigned qmask, int jb0, int jb1,
                   const bf16x8 (&Qf)[2][2], f32x4 (&O)[2][4], float (&m)[2], float (&l)[2], const float (&slope)[2], int tq, int l15, int quad) {
    const int tid = get_tid();
    const int prow = tid >> 3, pe = tid & 7;
    unsigned rem = tilemask;
    int j = __builtin_ctz(rem); rem &= rem - 1;
    u32x4 rk[2], rv[2];
#pragma unroll
    for (int i = 0; i < 2; ++i) { rk[i] = *(const u32x4*)(Kg + (size_t)(64 * j + prow + 32 * i) * 64 + pe * 8); rv[i] = *(const u32x4*)(VTg + (size_t)(prow + 32 * i) * 2048 + 64 * j + pe * 8); }
    int cur = 0;
#pragma unroll
    for (int i = 0; i < 2; ++i) { *(u32x4*)(lds + (prow + 32 * i) * 144 + pe * 16) = rk[i]; st_vt(lds + 9216 + (prow + 32 * i) * 144, pe, rv[i]); }
    __syncthreads();
    for (;;) {
        int jn = -1;
        if (rem) { jn = __builtin_ctz(rem); rem &= rem - 1;
#pragma unroll
            for (int i = 0; i < 2; ++i) { rk[i] = *(const u32x4*)(Kg + (size_t)(64 * jn + prow + 32 * i) * 64 + pe * 8); rv[i] = *(const u32x4*)(VTg + (size_t)(prow + 32 * i) * 2048 + 64 * jn + pe * 8); } }
        const unsigned char* st = lds + cur * 18432;
        if (MODE == 1 || ((wmask >> j) & 1u)) {
            const int dist0 = tq - 64 * j - 4 * quad; const bool sel = (qmask >> j) & 1u;
            if (j == jb0 || j == jb1) nsa_tile<MODE, true>(st, st + 9216, Qf, O, m, l, slope, dist0, sel, l15, quad);
            else nsa_tile<MODE, false>(st, st + 9216, Qf, O, m, l, slope, dist0, sel, l15, quad);
        }
        if (jn >= 0) { unsigned char* sn = lds + (cur ^ 1) * 18432;
#pragma unroll
            for (int i = 0; i < 2; ++i) { *(u32x4*)(sn + (prow + 32 * i) * 144 + pe * 16) = rk[i]; st_vt(sn + 9216 + (prow + 32 * i) * 144, pe, rv[i]); } }
        __syncthreads();
        if (jn < 0) break;
        j = jn; cur ^= 1;
    }
}

DEV void nsa_unit(const NsaCtx& c, int b, int hkv, int qb32, unsigned char* lds) {
    const int tid = get_tid(), lane = tid & 63, wid = tid >> 6, l15 = lane & 15, quad = lane >> 4;
    const int qs = wid & 1, hp = wid >> 1;
    const int tq = qb32 * 32 + qs * 16 + l15, cur = qb32 >> 1;
    const size_t trow = (size_t)b * 2048 + tq;
    const int head0 = hkv * 4 + hp * 2;
    const float* gnp = c.GN + trow * 48 + head0 * 3;
    unsigned char* stash = lds + 36864 + wid * 4096;
    float* xch = (float*)(lds + 53248);
    unsigned* smask = (unsigned*)(lds + 69632);
    const int bh = b * 4 + hkv;
    {
        const bf16_t* Kg = c.KC + (size_t)bh * 128 * 64; const bf16_t* Vg = c.VCT + (size_t)bh * 64 * 128;
#pragma unroll
        for (int i = 0; i < 4; ++i) { const int pc = tid + 256 * i;
            *(u32x4*)(lds + (pc >> 3) * 144 + (pc & 7) * 16) = *(const u32x4*)(Kg + pc * 8);
            st_vt(lds + 18432 + (pc >> 4) * 272, pc & 15, *(const u32x4*)(Vg + pc * 8)); }
    }
    __syncthreads();
    const int nkt = (2 * qb32) / 16 + 1;
    float Mx[8], Sm[8];
#pragma unroll
    for (int kt = 0; kt < 8; ++kt) { Mx[kt] = NEG; Sm[kt] = 0.f; }
#ifdef NSA_NO_CMP
    for (int g = 0; g < 0; ++g) {
#else
#pragma unroll 1
    for (int g = 0; g < 2; ++g) {
#endif
        bf16x8 Qg[2];
#pragma unroll
        for (int ks = 0; ks < 2; ++ks) Qg[ks] = *(const bf16x8*)(c.Qb + trow * 1024 + (head0 + g) * 64 + ks * 32 + quad * 8);
        const float slope_g = exp2f(-0.5f * (float)(head0 + g + 1)) * LOG2E;
        f32x4 S[8];
#pragma unroll
        for (int kt = 0; kt < 8; ++kt) { S[kt] = (f32x4){0.f, 0.f, 0.f, 0.f};
            if (kt < nkt) {
#pragma unroll
                for (int ks = 0; ks < 2; ++ks) { const bf16x8 kf = *(const bf16x8*)(lds + (kt * 16 + l15) * 144 + ks * 64 + quad * 16); S[kt] = __builtin_amdgcn_mfma_f32_16x16x32_bf16(kf, Qg[ks], S[kt], 0, 0, 0); } } }
        float mx = NEG;
        const int d0 = tq - 31 - 64 * quad; const float base = -slope_g * (float)d0;
#pragma unroll
        for (int kt = 0; kt < 8; ++kt)
#pragma unroll
            for (int i = 0; i < 4; ++i) { const int cc = 256 * kt + 16 * i; const float s = (kt < nkt && cc <= d0) ? fmaf(slope_g, (float)cc, S[kt][i] + base) : NEG; S[kt][i] = s; mx = fmaxf(mx, s); }
        mx = qmax(mx);
        float ls = 0.f;
#pragma unroll
        for (int kt = 0; kt < 8; ++kt)
#pragma unroll
            for (int i = 0; i < 4; ++i) ls += S[kt][i] > -1e29f ? fexp2(S[kt][i] - mx) : 0.f;
        ls = qsum(ls);
        const float lcl = fmaxf(ls, 1e-30f), lg = __log2f(lcl) + mx;
        float x3[8];
#pragma unroll
        for (int kt = 0; kt < 8; ++kt) {
#pragma unroll
            for (int i = 0; i < 4; ++i) S[kt][i] = S[kt][i] > -1e29f ? S[kt][i] - lg : NEG;
            x3[kt] = __shfl(S[kt][3], (lane + 48) & 63);
        }
#pragma unroll
        for (int kt = 0; kt < 8; ++kt) {
            const float nb = quad >= 1 ? x3[kt] : (kt >= 1 ? x3[kt >= 1 ? kt - 1 : 0] : NEG);
            const float tm = fmaxf(fmaxf(fmaxf(S[kt][0], S[kt][1]), fmaxf(S[kt][2], S[kt][3])), nb);
            const float nm = fmaxf(Mx[kt], tm);
            Sm[kt] = Sm[kt] * fexp2(Mx[kt] - nm) + fexp2(S[kt][0] - nm) + fexp2(S[kt][1] - nm) + fexp2(S[kt][2] - nm) + fexp2(S[kt][3] - nm) + fexp2(nb - nm);
            Mx[kt] = nm;
        }
        const float gate0 = gnp[g * 3];
        f32x4 Oc[4];
#pragma unroll
        for (int dt = 0; dt < 4; ++dt) Oc[dt] = (f32x4){0.f, 0.f, 0.f, 0.f};
#pragma unroll
        for (int k2 = 0; k2 < 4; ++k2) {
            if (2 * k2 < nkt) {
                f32x4 pa, pb;
#pragma unroll
                for (int i = 0; i < 4; ++i) { pa[i] = fexp2(S[2 * k2][i]); pb[i] = fexp2(S[2 * k2 + 1][i]); }
                const bf16x8 pf = pack_p(pa, pb);
#pragma unroll
                for (int dt = 0; dt < 4; ++dt) { const bf16x8 vf = *(const bf16x8*)(lds + 18432 + (dt * 16 + l15) * 272 + k2 * 64 + quad * 16); Oc[dt] = __builtin_amdgcn_mfma_f32_16x16x32_bf16(vf, pf, Oc[dt], 0, 0, 0); }
            }
        }
#pragma unroll
        for (int dt = 0; dt < 4; ++dt) { const f32x4 v = Oc[dt] * gate0; u32x2 w; w.x = cvt_pk_bf16(v[0], v[1]); w.y = cvt_pk_bf16(v[2], v[3]); *(u32x2*)(stash + ((g * 4 + dt) * 64 + lane) * 8) = w; }
    }
    unsigned qmask;
    if (cur < 8) qmask = (2u << cur) - 1u;
    if (cur >= 8) {
#pragma unroll
        for (int kt = 0; kt < 8; ++kt) { xch[(wid * 16 + kt) * 64 + lane] = Mx[kt]; xch[(wid * 16 + 8 + kt) * 64 + lane] = Sm[kt]; }
    }
    __syncthreads();
    if (cur >= 8) {
        float v[8];
#pragma unroll
        for (int kt = 0; kt < 8; ++kt) {
            const float m2 = xch[((wid ^ 2) * 16 + kt) * 64 + lane], s2 = xch[((wid ^ 2) * 16 + 8 + kt) * 64 + lane];
            const float mm = fmaxf(Mx[kt], m2), ss = Sm[kt] * fexp2(Mx[kt] - mm) + s2 * fexp2(m2 - mm);
            const int jb = 4 * kt + quad; v[kt] = (jb >= 1 && jb <= cur - 2) ? mm + __log2f(ss) : -3e38f; }
        qmask = 1u | (1u << cur) | (1u << (cur - 1));
        for (int r = 0; r < 5; ++r) {
            float bv = v[0]; int bj = quad;
#pragma unroll
            for (int kt = 1; kt < 8; ++kt) if (v[kt] > bv) { bv = v[kt]; bj = 4 * kt + quad; }
#pragma unroll
            for (int o = 16; o <= 32; o <<= 1) { const float ov = __shfl_xor(bv, o); const int oj = __shfl_xor(bj, o); if (ov > bv || (ov == bv && oj < bj)) { bv = ov; bj = oj; } }
            qmask |= 1u << bj;
#pragma unroll
            for (int kt = 0; kt < 8; ++kt) if (4 * kt + quad == bj) v[kt] = -3.2e38f;
        }
    }
    unsigned wmask = qmask;
#pragma unroll
    for (int o = 1; o <= 8; o <<= 1) wmask |= __shfl_xor(wmask, o);
    if (lane == 0) smask[wid] = wmask;
    __syncthreads();
    const unsigned umask = smask[0] | smask[1] | smask[2] | smask[3];
    bf16x8 Qf[2][2]; float slope[2];
#pragma unroll
    for (int g = 0; g < 2; ++g) {
#pragma unroll
        for (int ks = 0; ks < 2; ++ks) Qf[g][ks] = *(const bf16x8*)(c.Qb + trow * 1024 + (head0 + g) * 64 + ks * 32 + quad * 8);
        slope[g] = exp2f(-0.5f * (float)(head0 + g + 1)) * LOG2E;
    }
    f32x4 O[2][4]; float m[2], l[2];
#pragma unroll
    for (int g = 0; g < 2; ++g) { m[g] = MINIT; l[g] = 0.f;
#pragma unroll
        for (int dt = 0; dt < 4; ++dt) O[g][dt] = (f32x4){0.f, 0.f, 0.f, 0.f}; }
#ifndef NSA_NO_SLC
    nsa_tiles<0>(lds, c.KS + (size_t)bh * 2048 * 64, c.VST + (size_t)bh * 64 * 2048, umask, wmask, qmask, cur, cur, Qf, O, m, l, slope, tq, l15, quad);
#endif
#pragma unroll
    for (int g = 0; g < 2; ++g) { const float sc = gnp[g * 3 + 1] / fmaxf(l[g], 1e-30f);
#pragma unroll
        for (int dt = 0; dt < 4; ++dt) { u32x2* sp = (u32x2*)(stash + ((g * 4 + dt) * 64 + lane) * 8); const u32x2 w = *sp;
            const f32x4 v = O[g][dt] * sc + (f32x4){bflo(w.x), bfhi(w.x), bflo(w.y), bfhi(w.y)};
            u32x2 w2; w2.x = cvt_pk_bf16(v[0], v[1]); w2.y = cvt_pk_bf16(v[2], v[3]); *sp = w2;
            O[g][dt] = (f32x4){0.f, 0.f, 0.f, 0.f}; }
        m[g] = MINIT; l[g] = 0.f; }
    const int t0 = qb32 * 32;
    const int jlo = t0 >= 511 ? (t0 - 511) >> 6 : 0;
    const unsigned winmask = ((2u << cur) - 1u) & ~((1u << jlo) - 1u);
#ifndef NSA_NO_WIN
    nsa_tiles<1>(lds, c.KW + (size_t)bh * 2048 * 64, c.VWT + (size_t)bh * 64 * 2048, winmask, 0u, 0u, cur, jlo, Qf, O, m, l, slope, tq, l15, quad);
#endif
#pragma unroll
    for (int g = 0; g < 2; ++g) { const float sc = gnp[g * 3 + 2] / fmaxf(l[g], 1e-30f);
#pragma unroll
        for (int dt = 0; dt < 4; ++dt) { const u32x2 w = *(const u32x2*)(stash + ((g * 4 + dt) * 64 + lane) * 8);
            const f32x4 v = O[g][dt] * sc + (f32x4){bflo(w.x), bfhi(w.x), bflo(w.y), bfhi(w.y)};
            st_bf4(c.ON + trow * 1024 + (head0 + g) * 64 + dt * 16 + quad * 4, v[0], v[1], v[2], v[3]); } }
}

DEV void xattn_unit(const bf16_t* Qx, const bf16_t* XK, const bf16_t* XVT, bf16_t* OX, int b, int h, int qblk, unsigned char* lds) {
    const int tid = get_tid(), lane = tid & 63, wid = tid >> 6, l15 = lane & 15, quad = lane >> 4;
    const size_t trow = (size_t)b * 2048 + qblk * 64 + wid * 16 + l15;
    bf16x8 Qf[8];
#pragma unroll
    for (int ks = 0; ks < 8; ++ks) Qf[ks] = *(const bf16x8*)(Qx + trow * 1024 + h * 256 + ks * 32 + quad * 8);
    f32x4 O[16];
#pragma unroll
    for (int dt = 0; dt < 16; ++dt) O[dt] = (f32x4){0.f, 0.f, 0.f, 0.f};
    float m = NEG, l = 0.f;
    const bf16_t* Kg = XK + (size_t)b * 256 * 1024 + h * 256;
    const bf16_t* Vg = XVT + (size_t)(b * 4 + h) * 256 * 256;
    u32x4 rk[4], rv[4];
#pragma unroll
    for (int i = 0; i < 4; ++i) { const int pc = tid + 256 * i; rk[i] = *(const u32x4*)(Kg + (size_t)(pc >> 5) * 1024 + (pc & 31) * 8); rv[i] = *(const u32x4*)(Vg + (size_t)(pc >> 2) * 256 + (pc & 3) * 8); }
#pragma unroll
    for (int i = 0; i < 4; ++i) { const int pc = tid + 256 * i; *(u32x4*)(lds + (pc >> 5) * 528 + (pc & 31) * 16) = rk[i]; st_vt(lds + 16896 + (pc >> 2) * 80, pc & 3, rv[i]); }
    __syncthreads();
    for (int j = 0; j < 8; ++j) {
        const bool more = j + 1 < 8;
        if (more) {
#pragma unroll
            for (int i = 0; i < 4; ++i) { const int pc = tid + 256 * i; rk[i] = *(const u32x4*)(Kg + (size_t)(32 * (j + 1) + (pc >> 5)) * 1024 + (pc & 31) * 8); rv[i] = *(const u32x4*)(Vg + (size_t)(pc >> 2) * 256 + 32 * (j + 1) + (pc & 3) * 8); } }
        const unsigned char* st = lds + (j & 1) * 37376;
        f32x4 S[2];
#pragma unroll
        for (int kt = 0; kt < 2; ++kt) { S[kt] = (f32x4){0.f, 0.f, 0.f, 0.f};
#pragma unroll
            for (int ks = 0; ks < 8; ++ks) { const bf16x8 kf = *(const bf16x8*)(st + (kt * 16 + l15) * 528 + ks * 64 + quad * 16); S[kt] = __builtin_amdgcn_mfma_f32_16x16x32_bf16(kf, Qf[ks], S[kt], 0, 0, 0); } }
        float tmax = fmaxf(fmaxf(fmaxf(S[0][0], S[0][1]), fmaxf(S[0][2], S[0][3])), fmaxf(fmaxf(S[1][0], S[1][1]), fmaxf(S[1][2], S[1][3])));
        tmax = qmax(tmax);
        const float mnew = fmaxf(m, tmax), alpha = fexp2(m - mnew);
        float rs = 0.f;
#pragma unroll
        for (int kt = 0; kt < 2; ++kt)
#pragma unroll
            for (int i = 0; i < 4; ++i) { const float pv = fexp2(S[kt][i] - mnew); S[kt][i] = pv; rs += pv; }
        rs = qsum(rs); l = l * alpha + rs; m = mnew;
        const bf16x8 pf = pack_p(S[0], S[1]);
#pragma unroll
        for (int dt = 0; dt < 16; ++dt) { O[dt] = O[dt] * alpha; const bf16x8 vf = *(const bf16x8*)(st + 16896 + (dt * 16 + l15) * 80 + quad * 16); O[dt] = __builtin_amdgcn_mfma_f32_16x16x32_bf16(vf, pf, O[dt], 0, 0, 0); }
        if (more) { unsigned char* sn = lds + ((j + 1) & 1) * 37376;
#pragma unroll
            for (int i = 0; i < 4; ++i) { const int pc = tid + 256 * i; *(u32x4*)(sn + (pc >> 5) * 528 + (pc & 31) * 16) = rk[i]; st_vt(sn + 16896 + (pc >> 2) * 80, pc & 3, rv[i]); } }
        __syncthreads();
    }
    const float inv = 1.0f / l;
#pragma unroll
    for (int dt = 0; dt < 16; ++dt) { const f32x4 v = O[dt] * inv; st_bf4(OX + trow * 1024 + h * 256 + dt * 16 + quad * 4, v[0], v[1], v[2], v[3]); }
}


#define XB_TMO      128
#define XB_XCNT(j)  (256  + 64 * (j))
#define XB_XSUB(j)  (1280 + 64 * (j))
#define XB_XGEN(j)  (2304 + 64 * (j))
#define XB_TOP      3328
#define XB_TOPGEN   3392
#define XCD_BAR_WORDS 3456
#define XB_SPIN_CAP (1u << 18)
#define LAS __attribute__((address_space(3)))
DEV unsigned xb_ld(unsigned* p)              { return __hip_atomic_load(p, __ATOMIC_RELAXED, __HIP_MEMORY_SCOPE_AGENT); }
DEV unsigned xb_add(unsigned* p, unsigned v) { return __hip_atomic_fetch_add(p, v, __ATOMIC_RELAXED, __HIP_MEMORY_SCOPE_AGENT); }
DEV unsigned xb_xcc_id() { return (unsigned)__builtin_amdgcn_s_getreg((3 << 11) | 20) & 0xFu; }
#define XB_SPIN(cond, bar) do { unsigned _sp = 0; while (cond) { __builtin_amdgcn_s_sleep(1); \
    if ((++_sp & 255u) == 0u) { if (xb_ld(&(bar)[XB_TMO])) break; if (_sp > XB_SPIN_CAP) { atomicAdd(&(bar)[XB_TMO], 1u); break; } } } } while (0)
struct XcdBarrier { unsigned* bar; unsigned x; volatile LAS unsigned* st; };
DEV XcdBarrier xcd_barrier_post(unsigned* bar, volatile LAS unsigned* st) {
    XcdBarrier b; b.bar = bar; b.x = xb_xcc_id(); b.st = st;
    if (threadIdx.x == 0) (void)xb_add(&bar[XB_XCNT(b.x)], 1u);
    return b;
}
DEV void xcd_barrier_complete(unsigned* bar, unsigned x, unsigned& nloc, unsigned& nx) {
    const unsigned G = gridDim.x * gridDim.y * gridDim.z;
    unsigned sum, cnt, mine, sp = 0u;
    for (;;) {
        sum = 0u; cnt = 0u; mine = 0u;
#pragma unroll
        for (unsigned j = 0; j < 16; ++j) { const unsigned c = xb_ld(&bar[XB_XCNT(j)]); sum += c; cnt += (c > 0u) ? 1u : 0u; mine = (j == x) ? c : mine; }
        if (sum == G) break;
        __builtin_amdgcn_s_sleep(1);
        if ((++sp & 255u) == 0u) { if (xb_ld(&bar[XB_TMO])) break; if (sp > XB_SPIN_CAP) { atomicAdd(&bar[XB_TMO], 1u); break; } }
    }
    nloc = mine > 0u ? mine : 1u; nx = cnt > 0u ? cnt : 1u;
}
DEV void xcd_barrier(const XcdBarrier& b) {
    asm volatile("s_waitcnt vmcnt(0)" ::: "memory");
    __syncthreads();
    if (threadIdx.x == 0) {
        unsigned* bar = b.bar;
        __builtin_amdgcn_s_waitcnt(0);
        unsigned nloc = b.st[0], nx = b.st[1];
        if (nloc == 0u) { xcd_barrier_complete(bar, b.x, nloc, nx); b.st[0] = nloc; b.st[1] = nx; }
        const unsigned old = xb_add(&bar[XB_XSUB(b.x)], 1u);
        const unsigned gen = old / nloc;
        if (old + 1u == (gen + 1u) * nloc) {
            __builtin_amdgcn_fence(__ATOMIC_RELEASE, "agent");
            asm volatile("s_waitcnt vmcnt(0)" ::: "memory");
            const unsigned og = xb_add(&bar[XB_TOP], 1u);
            const unsigned tg = og / nx;
            if (og + 1u == (tg + 1u) * nx) xb_add(&bar[XB_TOPGEN], 1u);
            else XB_SPIN(xb_ld(&bar[XB_TOPGEN]) == tg, bar);
            __builtin_amdgcn_fence(__ATOMIC_ACQUIRE, "agent");
            xb_add(&bar[XB_XGEN(b.x)], 1u);
            asm volatile("s_waitcnt vmcnt(0)" ::: "memory");
        } else {
            XB_SPIN(xb_ld(&bar[XB_XGEN(b.x)]) == gen, bar);
            __builtin_amdgcn_fence(__ATOMIC_ACQUIRE, "agent");
            asm volatile("s_waitcnt vmcnt(0)" ::: "memory");
        }
    }
    __syncthreads();
}

constexpr int NPHASE = 17;
__global__ void __launch_bounds__(256, 2) fwd_kernel(P p) {
    extern __shared__ __attribute__((aligned(16))) unsigned char lds[];
#define WSB(off) ((bf16_t*)(ws + (off)))
#define WSF(off) ((float*)(ws + (off)))
    volatile LAS unsigned* bst = (volatile LAS unsigned*)(LAS unsigned char*)(lds + LDS_BYTES - 16);
    if (threadIdx.x == 0) { bst[0] = 0u; bst[1] = 0u; }
    __syncthreads();
    XcdBarrier gbar; gbar.bar = (unsigned*)(p.ws + O_BAR); gbar.x = 0; gbar.st = bst;
    if (p.coop) gbar = xcd_barrier_post((unsigned*)(p.ws + O_BAR), bst);
    const SsmIn sin_{p.in[5], p.in[6], p.in[7], p.in[8], p.in[9], p.in[10], p.in[12]};
    for (int ph = p.ph_lo; ph < p.ph_hi; ++ph) {
        size_t zoff = 0; asm volatile("" : "+s"(zoff)); unsigned char* ws = p.ws + zoff;
        switch (ph) {
#ifdef ONLY_PHASE
        default: break;
#define CASE(k) case (k): if ((k) != ONLY_PHASE) break; else
#else
#define CASE(k) case (k):
#endif
        CASE(0) {
            const int tid = get_tid();
            ln_pass(p.in[0], p.in[2], p.in[3], WSB(O_B), WSF(O_ST0), nullptr);
            int cur = 0;
            conv_job(p.in[4], 5168, 1024, 5376, WSB(O_WIN_T), 1, lds, cur);
            conv_job(p.in[13], 512, 512, 512, WSB(O_WGLU_T), 0, lds, cur);
            conv_job(p.in[15], 1024, 512, 1024, WSB(O_WSOUT_T), 0, lds, cur);
            conv_job(p.in[17], 256, 2048, 256, WSB(O_W1_T), 0, lds, cur);
            conv_job(p.in[17] + 2048 * 256, 256, 2048, 256, WSB(O_W1_T) + 256 * 2048, 0, lds, cur);
            conv_job(p.in[19], 64, 256, 128, WSB(O_W2_T), 3, lds, cur);
            conv_job(p.in[19] + 256 * 64, 64, 256, 128, WSB(O_W2_T) + 128 * 256, 3, lds, cur);
            conv_job(p.in[20], 1024, 1024, 1024, WSB(O_WNOUT_T), 0, lds, cur);
            conv_job(p.in[21], 1024, 1024, 1024, WSB(O_WOUT_T), 0, lds, cur);
            conv_job(p.in[24], 1024, 1024, 1024, WSB(O_WXQ_T), 0, lds, cur);
            conv_job(p.in[25], 2048, 1024, 2048, WSB(O_WXKV_T), 0, lds, cur);
            conv_job(p.in[26], 1024, 1024, 1024, WSB(O_WXO_T), 0, lds, cur);
            conv_job(p.in[29], 5632, 1024, 5632, WSB(O_WFIN_T), 2, lds, cur);
            conv_job(p.in[30], 1024, 2816, 1024, WSB(O_WFOUT_T), 0, lds, cur);
            for (int it = get_bid(); it < 8; it += gridDim.x) {
                const int z = it >> 2, e = (it & 3) * 64 + (tid & 63), fg = tid >> 6;
                float a = 0.f;
                for (int f = fg * 512; f < fg * 512 + 512; ++f) a += p.in[16][z * 2048 + f] * p.in[17][((size_t)z * 2048 + f) * 256 + e];
                float* red = (float*)lds;
                __syncthreads(); red[tid] = a; __syncthreads();
                if (tid < 64) WSF(O_BIAS2)[z * 256 + e] = red[tid] + red[tid + 64] + red[tid + 128] + red[tid + 192] + p.in[18][z * 256 + e];
                __syncthreads();
            }
            ssm_prep(sin_, WSB(O_BT1), WSB(O_MTW), lds);
        } break;
        CASE(1) {
            { const GemmP g{WSB(O_B), WSB(O_WIN_T), 1024, 1024, 256, 42, 16, 1};
              const EpiIn e{WSB(O_UH), WSB(O_QB), WSB(O_KVC), WSB(O_KS), WSB(O_VST), WSB(O_KW), WSB(O_VWT), WSB(O_GM), WSF(O_GN)};
              gemm_run(g, AddrNone{}, e, lds); }
        } break;
        CASE(2) {
            { const GemmP g{WSB(O_KVC), WSB(O_W1_T), 1024, 2048, 1, 2, 32, 128};
              const EpiCmp1 e{WSB(O_HID), WSF(O_BIAS2)};
              gemm_run(g, AddrCmp1{}, e, lds); }
            { const GemmP g{WSB(O_UH), WSB(O_BT1), 640, 512, 8, 1, 8, 32};
              const EpiSsmA e{WSF(O_SS)};
              gemm_run(g, AddrStride{1024ull * 640, 128ull * 512}, e, lds); }
        } break;
        CASE(3) {
            ssm_scan(sin_, WSF(O_SS), WSB(O_UH));
            { const GemmP g{WSB(O_HID), WSB(O_W2_T), 256, 256, 1, 1, 4, 128};
              const EpiCmp2 e{WSB(O_KC), WSB(O_VCT)};
              gemm_run(g, AddrCmp2{}, e, lds); }
        } break;
        CASE(4) {
            const NsaCtx c{WSB(O_QB), WSB(O_KC), WSB(O_VCT), WSB(O_KS), WSB(O_VST), WSB(O_KW), WSB(O_VWT), WSF(O_GN), WSB(O_B)};
            const int G = gridDim.x;
            for (int i = 0;; ++i) {
                const int u = (i & 1) ? i * G + (G - 1 - get_bid()) : i * G + get_bid();
                if (i * G >= 4096) break;
                if (u < 4096) { const int qb32 = 63 - (u >> 6), bh = u & 63; nsa_unit(c, bh >> 2, bh & 3, qb32, lds); }
                __syncthreads();
            }
            { const GemmP g{WSB(O_UH), WSB(O_MTW), 640, 640, 8, 4, 10, 32};
              const EpiSsmB e{WSB(O_UH), p.in[11], WSB(O_GB)};
              gemm_run(g, AddrStride{1024ull * 640, 512ull * 640}, e, lds); }
        } break;
        CASE(5) { const GemmP g{WSB(O_GB), WSB(O_WGLU_T), 512, 512, 256, 4, 8, 1}; const EpiGlu e{WSB(O_GB), p.in[14], WSB(O_YS)}; gemm_run(g, AddrNone{}, e, lds); } break;
        CASE(6) { const GemmP g{WSB(O_YS), WSB(O_WSOUT_T), 512, 512, 256, 8, 8, 1}; const EpiSout e{WSB(O_GM), WSB(O_QB)}; gemm_run(g, AddrNone{}, e, lds); } break;
        CASE(7) { const GemmP g{WSB(O_B), WSB(O_WNOUT_T), 1024, 1024, 256, 8, 16, 1}; const EpiNout e{WSB(O_GM), WSB(O_QB), WSB(O_MIXIN)}; gemm_run(g, AddrNone{}, e, lds); } break;
        CASE(8) { const GemmP g{WSB(O_MIXIN), WSB(O_WOUT_T), 1024, 1024, 256, 8, 16, 1}; const EpiRes e{p.in[0], WSF(O_ST0), p.in[2], p.in[3], WSF(O_V1)}; gemm_run(g, AddrNone{}, e, lds); } break;
        CASE(9) { ln_pass(WSF(O_V1), p.in[22], p.in[23], WSB(O_B), WSF(O_ST1), nullptr);
            for (size_t i = (size_t)get_bid() * 256 + get_tid(); i < 4096ull * 1024 / 4; i += (size_t)gridDim.x * 256) { const f32x4 v = ((const f32x4*)p.in[1])[i]; st_bf4(WSB(O_MEMB) + i * 4, v[0], v[1], v[2], v[3]); }
        } break;
        CASE(10) { { const GemmP g{WSB(O_B), WSB(O_WXQ_T), 1024, 1024, 256, 8, 16, 1}; const EpiScaleBf e{WSB(O_QB), 1024, 0.0625f * LOG2E}; gemm_run(g, AddrNone{}, e, lds); }
            { const GemmP g{WSB(O_MEMB), WSB(O_WXKV_T), 1024, 1024, 32, 16, 16, 1};
              const EpiXkv e{WSB(O_XK), WSB(O_XVT)};
              gemm_run(g, AddrNone{}, e, lds); }
        } break;
        CASE(11) {
            for (int u = get_bid(); u < 2048; u += gridDim.x) { const int qblk = u >> 6, bh = u & 63; xattn_unit(WSB(O_QB), WSB(O_XK), WSB(O_XVT), WSB(O_B), bh >> 2, bh & 3, qblk, lds); }
        } break;
        CASE(12) { const GemmP g{WSB(O_B), WSB(O_WXO_T), 1024, 1024, 256, 8, 16, 1}; const EpiRes e{WSF(O_V1), WSF(O_ST1), p.in[22], p.in[23], WSF(O_V2)}; gemm_run(g, AddrNone{}, e, lds); } break;
        CASE(13) ln_pass(WSF(O_V2), p.in[27], p.in[28], WSB(O_B), WSF(O_ST2), nullptr); break;
        CASE(14) { const GemmP g{WSB(O_B), WSB(O_WFIN_T), 1024, 1024, 256, 44, 16, 1}; const EpiFfnIn e{WSB(O_FB)}; gemm_run(g, AddrNone{}, e, lds); } break;
        CASE(15) { const GemmP g{WSB(O_FB), WSB(O_WFOUT_T), 2816, 2816, 256, 8, 44, 1}; const EpiRes e{WSF(O_V2), WSF(O_ST2), p.in[27], p.in[28], WSF(O_V2)}; gemm_run(g, AddrNone{}, e, lds); } break;
        CASE(16) ln_pass(WSF(O_V2), p.in[31], p.in[32], nullptr, nullptr, p.out); break;
        }
        if (ph + 1 < p.ph_hi) { if (p.coop) xcd_barrier(gbar); if (p.pad == 0x5eed) cg::this_grid().sync(); }
    }
}

#ifndef ONE_LAUNCH
#define ONE_LAUNCH 1
#endif
extern "C" void kernel_launch(void* const* d_in, const int* in_sizes, int n_in, void* d_out, int out_size, void* d_ws, size_t ws_size, hipStream_t stream) {
    static int grid = 0;
    if (grid == 0) {
        if (n_in != 33 || out_size != T_ * 1024 || ws_size < WS_NEED) { fprintf(stderr, "kernel_launch: unexpected shapes (n_in %d out %d ws %zu need %zu)\n", n_in, out_size, ws_size, (size_t)WS_NEED); grid = -1; return; }
        int dev = 0, cus = 0, per_cu = 0;
        hipGetDevice(&dev);
        hipDeviceGetAttribute(&cus, hipDeviceAttributeMultiprocessorCount, dev);
        if (hipFuncSetAttribute((const void*)fwd_kernel, hipFuncAttributeMaxDynamicSharedMemorySize, LDS_BYTES) != hipSuccess) { fprintf(stderr, "kernel_launch: hipFuncSetAttribute failed\n"); grid = -1; return; }
        if (hipOccupancyMaxActiveBlocksPerMultiprocessor(&per_cu, (const void*)fwd_kernel, 256, LDS_BYTES) != hipSuccess || per_cu < 1) { fprintf(stderr, "kernel_launch: occupancy query failed (%d)\n", per_cu); per_cu = 1; (void)hipGetLastError(); }
        if (per_cu > 2) per_cu = 2;
        grid = cus * per_cu;
    }
    if (grid < 0) return;
    P p{};
    for (int i = 0; i < 33; ++i) p.in[i] = (const float*)d_in[i];
    p.out = (float*)d_out; p.ws = (unsigned char*)d_ws;
#if ONE_LAUNCH
    p.ph_lo = 0; p.ph_hi = NPHASE; p.coop = 1;
    if (hipMemsetAsync((unsigned char*)d_ws + O_BAR, 0, XCD_BAR_WORDS * 4, stream) != hipSuccess) { fprintf(stderr, "kernel_launch: memset of barrier words failed\n"); return; }
    void* args[] = {&p};
    hipError_t e = hipLaunchCooperativeKernel((const void*)fwd_kernel, dim3(grid), dim3(256), args, LDS_BYTES, stream);
    if (e != hipSuccess) fprintf(stderr, "cooperative launch failed: %s (grid %d)\n", hipGetErrorString(e), grid);
#else
#ifdef STOP_AFTER
    const int nrun = STOP_AFTER + 1;
#else
    const int nrun = NPHASE;
#endif
    for (int ph = 0; ph < nrun; ++ph) {
        p.ph_lo = ph; p.ph_hi = ph + 1; p.coop = 0;
        hipLaunchKernelGGL(fwd_kernel, dim3(grid), dim3(256), LDS_BYTES, stream, p);
    }
#endif
}
```

```cpp
#include <hip/hip_runtime.h>
#include <hip/hip_cooperative_groups.h>
#include <cstdio>
#include <cstdint>
namespace cg = cooperative_groups;

typedef unsigned short bf16_t;
typedef short bf16x8 __attribute__((ext_vector_type(8)));
typedef float f32x4 __attribute__((ext_vector_type(4)));
typedef unsigned u32x4 __attribute__((ext_vector_type(4)));
typedef unsigned u32x2 __attribute__((ext_vector_type(2)));
#define DEV __device__ __forceinline__

constexpr int T_ = 32768, L_ = 2048;
constexpr float LOG2E = 1.4426950408889634f;
constexpr float ALPHA = 1.189207115002721f;
constexpr float LN_EPS = 1e-5f;
constexpr float NEG = -1e30f;
constexpr int LDS_BYTES = 81920;
constexpr size_t MiB = 1048576;

constexpr size_t O_WIN_T = 0;
constexpr size_t O_WGLU_T = O_WIN_T + 5376ull * 1024 * 2;
constexpr size_t O_WSOUT_T = O_WGLU_T + 512ull * 512 * 2;
constexpr size_t O_W1_T = O_WSOUT_T + 1024ull * 512 * 2;
constexpr size_t O_W2_T = O_W1_T + 2ull * 256 * 2048 * 2;
constexpr size_t O_WNOUT_T = O_W2_T + 2ull * 128 * 256 * 2;
constexpr size_t O_WOUT_T = O_WNOUT_T + 2 * MiB;
constexpr size_t O_WXQ_T = O_WOUT_T + 2 * MiB;
constexpr size_t O_WXKV_T = O_WXQ_T + 2 * MiB;
constexpr size_t O_WXO_T = O_WXKV_T + 4 * MiB;
constexpr size_t O_WFIN_T = O_WXO_T + 2 * MiB;
constexpr size_t O_WFOUT_T = O_WFIN_T + 5632ull * 1024 * 2;
constexpr size_t O_BT1 = O_WFOUT_T + 1024ull * 2816 * 2;
constexpr size_t O_MTW = O_BT1 + 4 * MiB;
constexpr size_t O_KC = O_MTW + 20 * MiB;
constexpr size_t O_VCT = O_KC + 1 * MiB;
constexpr size_t O_GN = O_VCT + 1 * MiB;
constexpr size_t O_ST0 = O_GN + 6 * MiB;
constexpr size_t O_ST1 = O_ST0 + 262144;
constexpr size_t O_ST2 = O_ST1 + 262144;
constexpr size_t O_BIAS2 = O_ST2 + 262144;
constexpr size_t O_BPART = O_BIAS2 + 4096;
constexpr size_t O_BAR = O_BPART + 32768;
constexpr size_t O_A = 76 * MiB;
constexpr size_t O_KVC = O_A;
constexpr size_t O_KS = O_A + 32 * MiB;
constexpr size_t O_VST = O_A + 48 * MiB;
constexpr size_t O_KW = O_A + 64 * MiB;
constexpr size_t O_VWT = O_A + 80 * MiB;
constexpr size_t O_GB = O_A + 96 * MiB;
constexpr size_t O_MIXIN = O_A;
constexpr size_t O_MEMB = O_A + 64 * MiB;
constexpr size_t O_XK = O_A + 72 * MiB;
constexpr size_t O_XVT = O_A + 80 * MiB;
constexpr size_t O_V2 = O_A;
constexpr size_t O_B = O_A + 128 * MiB;
constexpr size_t O_SS = O_B;
constexpr size_t O_HID = O_B + 16 * MiB;
constexpr size_t O_Y = O_B + 64 * MiB;
constexpr size_t O_GM = O_Y;
constexpr size_t O_V1 = O_Y;
constexpr size_t O_X = O_Y + 128 * MiB;
constexpr size_t O_QB = O_X;
constexpr size_t O_UH = O_X + 64 * MiB;
constexpr size_t O_YS = O_X + 64 * MiB;
constexpr size_t O_FB = O_Y;
constexpr size_t WS_NEED = O_X + 104 * MiB;
static_assert(O_BAR + 16384 <= O_A, "F region overflow");

struct P {
    const float* in[33];
    float* out;
    unsigned char* ws;
    int ph_lo, ph_hi, coop, pad;
};

DEV int get_tid() { int t = threadIdx.x; asm volatile("" : "+v"(t)); return t; }
DEV int get_bid() { int t = blockIdx.x; asm volatile("" : "+s"(t)); return t; }
typedef __bf16 bf2_t __attribute__((ext_vector_type(2)));
typedef float f32x2_t __attribute__((ext_vector_type(2)));
DEV unsigned cvt_pk_bf16(float lo, float hi) { const f32x2_t f = {lo, hi}; const bf2_t r = __builtin_convertvector(f, bf2_t); return __builtin_bit_cast(unsigned, r); }
DEV bf16_t f2bf(float v) { return (bf16_t)(cvt_pk_bf16(v, 0.f) & 0xffffu); }
DEV float bf2f(unsigned v) { return __uint_as_float(v << 16); }
DEV float bflo(unsigned w) { return __uint_as_float(w << 16); }
DEV float bfhi(unsigned w) { return __uint_as_float(w & 0xffff0000u); }
DEV float fexp2(float x) { return __builtin_amdgcn_exp2f(x); }
DEV float frcp(float x) { return __builtin_amdgcn_rcpf(x); }
DEV float sigmoidf_(float x) { return frcp(1.f + fexp2(-x * LOG2E)); }
DEV float gelu_tanh(float x) { const float u = 0.7978845608028654f * (x + 0.044715f * x * x * x); return x * frcp(1.f + fexp2(-2.f * LOG2E * u)); }
DEV void st_bf4(bf16_t* p, float a, float b, float c, float d) { u32x2 w; w.x = cvt_pk_bf16(a, b); w.y = cvt_pk_bf16(c, d); *(u32x2*)p = w; }
DEV f32x4 ld_bf4(const bf16_t* p) { const u32x2 w = *(const u32x2*)p; return (f32x4){bflo(w.x), bfhi(w.x), bflo(w.y), bfhi(w.y)}; }
DEV float wred_sum(float v) {
#pragma unroll
    for (int o = 32; o >= 1; o >>= 1) v += __shfl_xor(v, o);
    return v;
}

DEV void ln_pass(const float* src, const float* g, const float* b, bf16_t* dstb, float* stats, float* dstf) {
    const int lane = get_tid() & 63, wid = get_tid() >> 6;
    const int nw = gridDim.x * 4;
    for (int row = get_bid() * 4 + wid; row < T_; row += nw) {
        const f32x4* p = (const f32x4*)(src + (size_t)row * 1024);
        f32x4 v[4];
#pragma unroll
        for (int i = 0; i < 4; ++i) v[i] = p[lane + 64 * i];
        float s = 0.f;
#pragma unroll
        for (int i = 0; i < 4; ++i) s += (v[i][0] + v[i][1]) + (v[i][2] + v[i][3]);
        s = wred_sum(s);
        const float mu = s * (1.f / 1024.f);
        float q = 0.f;
#pragma unroll
        for (int i = 0; i < 4; ++i) { const f32x4 d = v[i] - mu; q += (d[0] * d[0] + d[1] * d[1]) + (d[2] * d[2] + d[3] * d[3]); }
        q = wred_sum(q);
        const float rstd = 1.0f / sqrtf(q * (1.f / 1024.f) + LN_EPS);
        if (stats && lane == 0) { stats[row * 2] = mu; stats[row * 2 + 1] = rstd; }
#pragma unroll
        for (int i = 0; i < 4; ++i) {
            const int col = (lane + 64 * i) * 4;
            const f32x4 gg = *(const f32x4*)(g + col), bb = *(const f32x4*)(b + col);
            const f32x4 y = (v[i] - mu) * rstd * gg + bb;
            if (dstb) st_bf4(dstb + (size_t)row * 1024 + col, y[0], y[1], y[2], y[3]);
            if (dstf) *(f32x4*)(dstf + (size_t)row * 1024 + col) = y;
        }
    }
}

DEV int colmap(int mode, int n) {
    if (mode == 0) return n;
    if (mode == 1) return n < 3072 ? n : (n < 5120 ? n + 48 : (n < 5168 ? n - 5120 + 3072 : -1));
    if (mode == 2) { const int blk = n >> 5, r = n & 31; return r < 16 ? blk * 16 + r : 2816 + blk * 16 + (r - 16); }
    return n < 64 ? n : -1;
}
DEV void conv_job(const float* src, int ldsrc, int K, int N, bf16_t* dst, int mode, unsigned char* lds, int& cursor) {
    const int tid = get_tid(), lane = tid & 63, gw = get_bid() * 4 + (tid >> 6), nw = gridDim.x * 4;
    const int kb = K / 32, nitem = (N / 64) * kb;
    for (int t = (gw + nw - (cursor % nw)) % nw; t < nitem; t += nw) {
        const int k0 = (t % kb) * 32, n = (t / kb) * 64 + lane;
        const int sc = colmap(mode, n);
        float e[32];
#pragma unroll
        for (int r = 0; r < 32; ++r) e[r] = sc >= 0 ? src[(size_t)(k0 + r) * ldsrc + sc] : 0.f;
#pragma unroll
        for (int q = 0; q < 4; ++q) { u32x4 w; w.x = cvt_pk_bf16(e[8 * q], e[8 * q + 1]); w.y = cvt_pk_bf16(e[8 * q + 2], e[8 * q + 3]); w.z = cvt_pk_bf16(e[8 * q + 4], e[8 * q + 5]); w.w = cvt_pk_bf16(e[8 * q + 6], e[8 * q + 7]);
            *(u32x4*)(dst + (size_t)n * K + k0 + 8 * q) = w; }
    }
    cursor += nitem;
}

struct SsmIn { const float *a_re, *a_im, *b_re, *b_im, *c_re, *c_im, *log_dt; };
DEV void lb_pow(const SsmIn& s, int g, int n, float p, float& re, float& im) {
    const float lre = fminf(s.a_re[g * 64 + n], -1e-4f), lim = s.a_im[g * 64 + n], dt = expf(s.log_dt[g]);
    const float mag = expf(lre * dt * p); float sn, cs; sincosf(lim * dt * p, &sn, &cs);
    re = mag * cs; im = mag * sn;
}
DEV void bbar(const SsmIn& s, int g, int n, int c, float& re, float& im) {
    const float lre = fminf(s.a_re[g * 64 + n], -1e-4f), lim = s.a_im[g * 64 + n], dt = expf(s.log_dt[g]);
    const float mag = expf(lre * dt); float sn, cs; sincosf(lim * dt, &sn, &cs);
    const float sh = sinf(0.5f * lim * dt);
    const float nr = expm1f(lre * dt) - mag * 2.f * sh * sh, lbi = mag * sn;
    const float den = lre * lre + lim * lim;
    const float fre = (nr * lre + lbi * lim) / den, fim = (lbi * lre - nr * lim) / den;
    const float br = s.b_re[(g * 64 + n) * 16 + c], bi = s.b_im[(g * 64 + n) * 16 + c];
    re = fre * br - fim * bi; im = fre * bi + fim * br;
}
DEV void ssm_prep(const SsmIn& s, bf16_t* BT1, bf16_t* MTW, unsigned char* lds) {
    const int tid = get_tid();
    float* pw = (float*)lds;
    float* bb = pw + 33 * 128;
    float* cc = bb + 2048;
    float* fn = cc + 2048;
    float* km = fn + 128;
    for (int job = get_bid(); job < 512; job += gridDim.x) {
        const int g = job >> 4, pt = job & 15;
        __syncthreads();
        for (int e = tid; e < 33 * 64; e += 256) { float pr, pi; lb_pow(s, g, e & 63, (float)(e >> 6), pr, pi); pw[e * 2] = pr; pw[e * 2 + 1] = pi; }
        if (tid < 64) {
            const int n = tid;
            const float lre = fminf(s.a_re[g * 64 + n], -1e-4f), lim = s.a_im[g * 64 + n], dt = expf(s.log_dt[g]);
            const float mag = expf(lre * dt); float sn, cs; sincosf(lim * dt, &sn, &cs);
            const float sh = sinf(0.5f * lim * dt);
            const float nr = expm1f(lre * dt) - mag * 2.f * sh * sh, lbi = mag * sn;
            const float den = lre * lre + lim * lim;
            fn[n * 2] = (nr * lre + lbi * lim) / den; fn[n * 2 + 1] = (lbi * lre - nr * lim) / den;
        }
        for (int e = tid; e < 1024; e += 256) { const int c = e >> 6, n = e & 63; cc[e * 2] = s.c_re[(g * 16 + c) * 64 + n]; cc[e * 2 + 1] = s.c_im[(g * 16 + c) * 64 + n]; }
        __syncthreads();
        for (int e = tid; e < 1024; e += 256) { const int n = e >> 4; const float fre = fn[n * 2], fim = fn[n * 2 + 1];
            const float br = s.b_re[(g * 64) * 16 + e], bi = s.b_im[(g * 64) * 16 + e];
            bb[e * 2] = fre * br - fim * bi; bb[e * 2 + 1] = fre * bi + fim * br; }
        __syncthreads();
        for (int i = tid; i < 4096; i += 256) { const int e = pt * 4096 + i, nn = e >> 9, kk = e & 511, n = nn & 63, sidx = kk >> 4, c = kk & 15;
            const float pr = pw[((31 - sidx) * 64 + n) * 2], pi = pw[((31 - sidx) * 64 + n) * 2 + 1], br = bb[(n * 16 + c) * 2], bi = bb[(n * 16 + c) * 2 + 1];
            BT1[(size_t)g * 65536 + e] = f2bf((nn >> 6) ? (pr * bi + pi * br) : (pr * br - pi * bi)); }
        for (int i = tid; i < 4096; i += 256) { const int e = pt * 4096 + i, nn = e & 127, r = e >> 7, n = nn & 63, tau = r >> 4, c = r & 15;
            const float pr = pw[((tau + 1) * 64 + n) * 2], pi = pw[((tau + 1) * 64 + n) * 2 + 1], cr = cc[(c * 64 + n) * 2], ci = cc[(c * 64 + n) * 2 + 1];
            MTW[((size_t)g * 512 + r) * 640 + 512 + nn] = f2bf((nn >> 6) ? -(cr * pi + ci * pr) : (cr * pr - ci * pi)); }
        for (int i = tid; i < 32 * 512; i += 256) { const int r = pt * 32 + (i >> 9), kk = i & 511; if ((kk >> 4) > (r >> 4)) MTW[((size_t)g * 512 + r) * 640 + kk] = 0; }
        for (int dd = 0; dd < 2; ++dd) { const int d = 2 * pt + dd, c = tid >> 4, c2 = tid & 15; float acc = 0.f;
            for (int n = 0; n < 64; ++n) { const float cr = cc[(c * 64 + n) * 2], ci = cc[(c * 64 + n) * 2 + 1], pr = pw[(d * 64 + n) * 2], pi = pw[(d * 64 + n) * 2 + 1];
                const float xr = cr * pr - ci * pi, xi = cr * pi + ci * pr; acc += xr * bb[(n * 16 + c2) * 2] - xi * bb[(n * 16 + c2) * 2 + 1]; }
            km[dd * 256 + tid] = acc; }
        __syncthreads();
        for (int dd = 0; dd < 2; ++dd) { const int d = 2 * pt + dd; const bf16_t v = f2bf(km[dd * 256 + tid]); const int c = tid >> 4, c2 = tid & 15;
            for (int sidx = 0; sidx + d < 32; ++sidx) MTW[((size_t)g * 512 + (sidx + d) * 16 + c) * 640 + sidx * 16 + c2] = v; }
    }
    __syncthreads();
}
DEV void ssm_scan(const SsmIn& s, const float* SS, bf16_t* UH) {
    for (int idx = get_bid() * 256 + get_tid(); idx < 32768; idx += gridDim.x * 256) {
        const int n = idx & 63, b = (idx >> 6) & 15, g = idx >> 10;
        float ar, ai; lb_pow(s, g, n, 32.f, ar, ai);
        float hr = 0.f, hi = 0.f;
        const size_t row0 = (size_t)(g * 16 + b) * 64;
#pragma unroll 8
        for (int k = 0; k < 64; ++k) {
            UH[(row0 + k) * 640 + 512 + n] = f2bf(hr); UH[(row0 + k) * 640 + 576 + n] = f2bf(hi);
            const float sr = SS[(row0 + k) * 128 + n], si = SS[(row0 + k) * 128 + 64 + n];
            const float nr = ar * hr - ai * hi + sr, ni = ar * hi + ai * hr + si;
            hr = nr; hi = ni;
        }
    }
}

struct GemmP { const bf16_t* A; const bf16_t* Bt; int lda, ldb, MT, NT, KT, nbatch; };
#define GLAS __attribute__((address_space(3)))
template <class Addr, class Epi>
DEV void gemm_run(const GemmP p, const Addr ad, const Epi epi, unsigned char* lds_) {
    GLAS unsigned char* lds = (GLAS unsigned char*)lds_;
    const int tid = get_tid(), lane = tid & 63, wid = __builtin_amdgcn_readfirstlane(tid >> 6), wr = wid >> 1, wc = wid & 1, l15 = lane & 15, quad = lane >> 4;
    const int G = gridDim.x;
    const int nx = (G % 8 == 0) ? 8 : 1, x = get_bid() % nx, jx = get_bid() / nx, stride = G / nx;
    const int SRtot = (p.nbatch * p.MT) / 8, per = 8 * p.NT, KT = p.KT * 2;
    int offA[2], offB[2];
#pragma unroll
    for (int i = 0; i < 2; ++i) { const int slot = (wid + 4 * i) * 64 + lane, row = slot >> 2, c = (slot & 3) ^ ((row >> 2) & 3); offA[i] = row * p.lda + c * 8; offB[i] = row * p.ldb + c * 8; }
    const int swz = ((quad ^ (l15 >> 2)) & 3) * 16;
    const int aoff = (wr * 64 + l15) * 64 + swz, boff = 8192 + (wc * 64 + l15) * 64 + swz;
    int ls = jx, lkt = 0; const bf16_t* lA = nullptr; const bf16_t* lB = nullptr; bool lvalid;
#define GEMM_DECODE_L() do { const int q_ = ls / per, rem_ = ls % per, sr_ = x + nx * q_; lvalid = sr_ < SRtot; if (lvalid) { const int R_ = sr_ * 8 + (rem_ & 7), b_ = R_ / p.MT; \
        lA = p.A + ad.a_off(b_) + (size_t)((R_ % p.MT) * 128) * p.lda; lB = p.Bt + ad.b_off(b_) + (size_t)((rem_ >> 3) * 128) * p.ldb; } } while (0)
#define GEMM_ISSUE(stg) do { _Pragma("unroll") for (int i_ = 0; i_ < 2; ++i_) { \
        __builtin_amdgcn_global_load_lds((const unsigned*)(lA + offA[i_] + lkt * 32), (GLAS unsigned*)(lds + (stg) * 16384 + (wid + 4 * i_) * 1024), 16, 0, 0); \
        __builtin_amdgcn_global_load_lds((const unsigned*)(lB + offB[i_] + lkt * 32), (GLAS unsigned*)(lds + (stg) * 16384 + 8192 + (wid + 4 * i_) * 1024), 16, 0, 0); } \
        ++issued; if (++lkt == KT) { lkt = 0; ls += stride; GEMM_DECODE_L(); } } while (0)
    GEMM_DECODE_L();
    int issued = 0;
    asm volatile("s_waitcnt vmcnt(0)" ::: "memory");
    __syncthreads();
#pragma unroll 1
    for (int t = 0; t < 3; ++t) if (lvalid) GEMM_ISSUE(t);
    f32x4 acc[4][4];
#pragma unroll
    for (int i = 0; i < 4; ++i)
#pragma unroll
        for (int j = 0; j < 4; ++j) acc[i][j] = (f32x4){0.f, 0.f, 0.f, 0.f};
    int cs = jx, ckt = 0; bool drain = false;
#pragma unroll 1
    for (int it = 0; it < issued; ++it) {
        const int y = issued - it - 1;
        if (drain || y == 0) asm volatile("s_waitcnt vmcnt(0)" ::: "memory");
        else if (y == 1) asm volatile("s_waitcnt vmcnt(4)" ::: "memory");
        else asm volatile("s_waitcnt vmcnt(8)" ::: "memory");
        drain = false;
        __builtin_amdgcn_s_barrier();
        asm volatile("" ::: "memory");
        if (lvalid) GEMM_ISSUE((it + 3) & 3);
        asm volatile("" ::: "memory");
        const GLAS unsigned char* st = lds + (it & 3) * 16384;
        bf16x8 af[4], bfr[4];
#pragma unroll
        for (int i = 0; i < 4; ++i) { af[i] = *(const GLAS bf16x8*)(st + aoff + i * 1024); bfr[i] = *(const GLAS bf16x8*)(st + boff + i * 1024); }
#pragma unroll
        for (int mi = 0; mi < 4; ++mi)
#pragma unroll
            for (int ni = 0; ni < 4; ++ni) acc[mi][ni] = __builtin_amdgcn_mfma_f32_16x16x32_bf16(bfr[ni], af[mi], acc[mi][ni], 0, 0, 0);
        if (++ckt == KT) {
            const int q_ = cs / per, rem_ = cs % per, R_ = (x + nx * q_) * 8 + (rem_ & 7);
            epi(acc, R_ / p.MT, (R_ % p.MT) * 128 + wr * 64, (rem_ >> 3) * 128 + wc * 64, l15, quad);
#pragma unroll
            for (int i = 0; i < 4; ++i)
#pragma unroll
                for (int j = 0; j < 4; ++j) acc[i][j] = (f32x4){0.f, 0.f, 0.f, 0.f};
            ckt = 0; cs += stride; drain = true;
        }
    }
    asm volatile("s_waitcnt vmcnt(0) lgkmcnt(0)" ::: "memory");
    __syncthreads();
#undef GEMM_DECODE_L
#undef GEMM_ISSUE
}
struct AddrNone { DEV size_t a_off(int) const { return 0; } DEV size_t b_off(int) const { return 0; } };
struct AddrStride { size_t as, bs; DEV size_t a_off(int b) const { return as * b; } DEV size_t b_off(int b) const { return bs * b; } };
struct AddrCmp1 { DEV size_t a_off(int b) const { return (size_t)b * 2048 * 64; } DEV size_t b_off(int b) const { return (size_t)((b >> 2) & 1) * 256 * 2048; } };
struct AddrCmp2 { DEV size_t a_off(int b) const { return (size_t)b * 128 * 256; } DEV size_t b_off(int b) const { return (size_t)((b >> 2) & 1) * 128 * 256; } };

#define EPI_ARGS const f32x4 (&acc)[4][4], int batch, int m0, int n0, int l15, int quad
struct EpiIn {
    bf16_t *UH, *Qb, *KVC, *KS, *VST, *KW, *VWT, *GM; float* GN;
    DEV void operator()(EPI_ARGS) const {
#pragma unroll
        for (int mi = 0; mi < 4; ++mi) {
            const int t = m0 + mi * 16 + l15, b = t >> 11, tt = t & 2047;
#pragma unroll
            for (int ni = 0; ni < 4; ++ni) {
                const f32x4 v = acc[mi][ni];
                const int c = n0 + ni * 16 + quad * 4;
                if (n0 < 512) {
                    const int g = c >> 4;
                    st_bf4(UH + ((size_t)((g * 16 + b) * 64 + (tt >> 5))) * 640 + (tt & 31) * 16 + (c & 15), v[0], v[1], v[2], v[3]);
                } else if (n0 < 1536) {
                    const float sc = 0.125f * LOG2E;
                    st_bf4(Qb + (size_t)t * 1024 + (c - 512), v[0] * sc, v[1] * sc, v[2] * sc, v[3] * sc);
                } else if (n0 < 2048) {
                    const int cc = c - 1536, z = cc >> 8, h = (cc >> 6) & 3, d = cc & 63;
                    st_bf4(KVC + ((size_t)(((b * 2 + z) * 4 + h) * 2048 + tt)) * 64 + d, v[0], v[1], v[2], v[3]);
                } else if (n0 < 3072) {
                    const int cc = (c - 2048) & 511, isw = (c - 2048) >> 9, h = (cc >> 6) & 3, d = cc & 63;
                    if (cc < 256) st_bf4((isw ? KW : KS) + ((size_t)((b * 4 + h) * 2048 + tt)) * 64 + d, v[0], v[1], v[2], v[3]);
                    else { bf16_t* o = (isw ? VWT : VST) + ((size_t)((b * 4 + h) * 64 + d)) * 2048 + tt;
#pragma unroll
                        for (int i = 0; i < 4; ++i) o[(size_t)i * 2048] = f2bf(v[i]); }
                } else if (n0 < 5120) {
                    st_bf4(GM + (size_t)t * 2048 + (c - 3072), sigmoidf_(v[0]), sigmoidf_(v[1]), sigmoidf_(v[2]), sigmoidf_(v[3]));
                } else {
                    const int cc = c - 5120;
                    if (cc < 48) *(f32x4*)(GN + (size_t)t * 48 + cc) = (f32x4){sigmoidf_(v[0]), sigmoidf_(v[1]), sigmoidf_(v[2]), sigmoidf_(v[3])};
                }
            }
        }
    }
};
struct EpiXkv {
    bf16_t *XK, *XVT;
    DEV void operator()(EPI_ARGS) const {
#pragma unroll
        for (int mi = 0; mi < 4; ++mi) {
            const int r = m0 + mi * 16 + l15, b = r >> 8, m = r & 255;
#pragma unroll
            for (int ni = 0; ni < 4; ++ni) {
                const f32x4 v = acc[mi][ni]; const int c = n0 + ni * 16 + quad * 4;
                if (n0 < 1024) st_bf4(XK + (size_t)r * 1024 + c, v[0], v[1], v[2], v[3]);
                else { const int cc = c - 1024, h = cc >> 8, d = cc & 255; bf16_t* o = XVT + ((size_t)((b * 4 + h) * 256 + d)) * 256 + m;
#pragma unroll
                    for (int i = 0; i < 4; ++i) o[i * 256] = f2bf(v[i]); }
            }
        }
    }
};
struct EpiSsmA { float* SS;
    DEV void operator()(EPI_ARGS) const {
#pragma unroll
        for (int mi = 0; mi < 4; ++mi)
#pragma unroll
            for (int ni = 0; ni < 4; ++ni) *(f32x4*)(SS + ((size_t)batch * 1024 + m0 + mi * 16 + l15) * 128 + n0 + ni * 16 + quad * 4) = acc[mi][ni];
    }
};
struct EpiCmp1 { bf16_t* HID; const float* bias2;
    DEV void operator()(EPI_ARGS) const {
        const int z = (batch >> 2) & 1;
#pragma unroll
        for (int ni = 0; ni < 4; ++ni) {
            const int c = n0 + ni * 16 + quad * 4; const f32x4 bv = *(const f32x4*)(bias2 + z * 256 + c);
#pragma unroll
            for (int mi = 0; mi < 4; ++mi) { const f32x4 v = acc[mi][ni] + bv;
                st_bf4(HID + ((size_t)batch * 128 + m0 + mi * 16 + l15) * 256 + c, gelu_tanh(v[0]), gelu_tanh(v[1]), gelu_tanh(v[2]), gelu_tanh(v[3])); }
        }
    }
};
struct EpiCmp2 { bf16_t *KC, *VCT;
    DEV void operator()(EPI_ARGS) const {
        if (n0 >= 64) return;
        const int z = (batch >> 2) & 1, bh = (batch >> 3) * 4 + (batch & 3);
#pragma unroll
        for (int mi = 0; mi < 4; ++mi) { const int r = m0 + mi * 16 + l15;
#pragma unroll
            for (int ni = 0; ni < 4; ++ni) { const f32x4 v = acc[mi][ni]; const int c = n0 + ni * 16 + quad * 4;
                if (z == 0) st_bf4(KC + ((size_t)bh * 128 + r) * 64 + c, v[0], v[1], v[2], v[3]);
                else {
#pragma unroll
                    for (int i = 0; i < 4; ++i) VCT[((size_t)bh * 64 + c + i) * 128 + r] = f2bf(v[i]); } } }
    }
};
struct EpiSsmB { const bf16_t* UH; const float* dskip; bf16_t* GB;
    DEV void operator()(EPI_ARGS) const {
#pragma unroll
        for (int mi = 0; mi < 4; ++mi) { const int r = m0 + mi * 16 + l15, b = r >> 6, k = r & 63;
#pragma unroll
            for (int ni = 0; ni < 4; ++ni) { const int col = n0 + ni * 16 + quad * 4, tau = col >> 4, c = col & 15;
                const f32x4 u = ld_bf4(UH + ((size_t)batch * 1024 + r) * 640 + col);
                const f32x4 dv = *(const f32x4*)(dskip + batch * 16 + c);
                const f32x4 y = acc[mi][ni] + dv * u;
                st_bf4(GB + ((size_t)(b * 2048 + k * 32 + tau)) * 512 + batch * 16 + c, gelu_tanh(y[0]), gelu_tanh(y[1]), gelu_tanh(y[2]), gelu_tanh(y[3])); } }
    }
};
struct EpiGlu { const bf16_t* GB; const float* bglu; bf16_t* YS;
    DEV void operator()(EPI_ARGS) const {
#pragma unroll
        for (int ni = 0; ni < 4; ++ni) { const int c = n0 + ni * 16 + quad * 4; const f32x4 bv = *(const f32x4*)(bglu + c);
#pragma unroll
            for (int mi = 0; mi < 4; ++mi) { const size_t o = (size_t)(m0 + mi * 16 + l15) * 512 + c; const f32x4 g = ld_bf4(GB + o); const f32x4 v = acc[mi][ni] + bv;
                st_bf4(YS + o, g[0] * sigmoidf_(v[0]), g[1] * sigmoidf_(v[1]), g[2] * sigmoidf_(v[2]), g[3] * sigmoidf_(v[3])); } }
    }
};
struct EpiSout { const bf16_t* GM; bf16_t* P1;
    DEV void operator()(EPI_ARGS) const {
#pragma unroll
        for (int mi = 0; mi < 4; ++mi) { const size_t t = m0 + mi * 16 + l15;
#pragma unroll
            for (int ni = 0; ni < 4; ++ni) { const int c = n0 + ni * 16 + quad * 4; const f32x4 g = ld_bf4(GM + t * 2048 + c); const f32x4 v = acc[mi][ni] * g;
                st_bf4(P1 + t * 1024 + c, v[0], v[1], v[2], v[3]); } }
    }
};
struct EpiNout { const bf16_t* GM; const bf16_t* P1; bf16_t* MIX;
    DEV void operator()(EPI_ARGS) const {
#pragma unroll
        for (int mi = 0; mi < 4; ++mi) { const size_t t = m0 + mi * 16 + l15;
#pragma unroll
            for (int ni = 0; ni < 4; ++ni) { const int c = n0 + ni * 16 + quad * 4; const f32x4 g = ld_bf4(GM + t * 2048 + 1024 + c); const f32x4 v = acc[mi][ni] * g + ld_bf4(P1 + t * 1024 + c);
                st_bf4(MIX + t * 1024 + c, v[0], v[1], v[2], v[3]); } }
    }
};
struct EpiRes { const float* src; const float* stats; const float* g; const float* b; float* dst;
    DEV void operator()(EPI_ARGS) const {
#pragma unroll
        for (int mi = 0; mi < 4; ++mi) { const size_t t = m0 + mi * 16 + l15; const float mu = stats[t * 2], rs = stats[t * 2 + 1];
#pragma unroll
            for (int ni = 0; ni < 4; ++ni) { const int c = n0 + ni * 16 + quad * 4;
                const f32x4 xv = *(const f32x4*)(src + t * 1024 + c), gg = *(const f32x4*)(g + c), bb = *(const f32x4*)(b + c);
                *(f32x4*)(dst + t * 1024 + c) = ((xv - mu) * rs * gg + bb) * ALPHA + acc[mi][ni]; } }
    }
};
struct EpiScaleBf { bf16_t* O; int ldc; float sc;
    DEV void operator()(EPI_ARGS) const {
#pragma unroll
        for (int mi = 0; mi < 4; ++mi)
#pragma unroll
            for (int ni = 0; ni < 4; ++ni) { const f32x4 v = acc[mi][ni] * sc; st_bf4(O + (size_t)(m0 + mi * 16 + l15) * ldc + n0 + ni * 16 + quad * 4, v[0], v[1], v[2], v[3]); }
    }
};
struct EpiFfnIn { bf16_t* FB;
    DEV void operator()(EPI_ARGS) const {
#pragma unroll
        for (int mi = 0; mi < 4; ++mi) { const size_t t = m0 + mi * 16 + l15;
#pragma unroll
            for (int pp = 0; pp < 2; ++pp) { const f32x4 ga = acc[mi][2 * pp], up = acc[mi][2 * pp + 1]; const int j = (n0 + pp * 32) / 2 + quad * 4;
                st_bf4(FB + t * 2816 + j, ga[0] * sigmoidf_(ga[0]) * up[0], ga[1] * sigmoidf_(ga[1]) * up[1], ga[2] * sigmoidf_(ga[2]) * up[2], ga[3] * sigmoidf_(ga[3]) * up[3]); } }
    }
};

DEV float qmax(float v) { v = fmaxf(v, __shfl_xor(v, 16)); return fmaxf(v, __shfl_xor(v, 32)); }
DEV float qsum(float v) { v += __shfl_xor(v, 16); return v + __shfl_xor(v, 32); }
DEV bf16x8 pack_p(const f32x4& a, const f32x4& b) { u32x4 w; w.x = cvt_pk_bf16(a[0], a[1]); w.y = cvt_pk_bf16(a[2], a[3]); w.z = cvt_pk_bf16(b[0], b[1]); w.w = cvt_pk_bf16(b[2], b[3]); return __builtin_bit_cast(bf16x8, w); }
DEV void st_vt(unsigned char* rowbase, int e, const u32x4& v) {
    const int grp = e >> 2, ep = e & 3, a = ep >> 1, qp = (ep & 1) * 2;
    unsigned char* o = rowbase + grp * 64 + (qp * 8 + a * 4) * 2;
    *(u32x2*)o = (u32x2){v.x, v.y}; *(u32x2*)(o + 16) = (u32x2){v.z, v.w};
}

struct NsaCtx { const bf16_t *Qb, *KC, *VCT, *KS, *VST, *KW, *VWT; const float* GN; bf16_t* ON; };
constexpr float MINIT = -1e20f;

template <int MODE, bool BOUND>
DEV void nsa_tile(const unsigned char* Kl, const unsigned char* Vl, const bf16x8 (&Qf)[2][2], f32x4 (&O)[2][4], float (&m)[2], float (&l)[2],
                  const float (&slope)[2], int dist0, bool sel, int l15, int quad) {
    const float d0f = (float)dist0;
#pragma unroll
    for (int g = 0; g < 2; ++g) {
        f32x4 S[4];
#pragma unroll
        for (int kt = 0; kt < 4; ++kt) { S[kt] = (f32x4){0.f, 0.f, 0.f, 0.f};
#pragma unroll
            for (int ks = 0; ks < 2; ++ks) { const bf16x8 kf = *(const bf16x8*)(Kl + (kt * 16 + l15) * 144 + ks * 64 + quad * 16); S[kt] = __builtin_amdgcn_mfma_f32_16x16x32_bf16(kf, Qf[g][ks], S[kt], 0, 0, 0); } }
        float base = -slope[g] * d0f;
        if (MODE == 0) base = sel ? base : NEG;
        float tmax = NEG;
#pragma unroll
        for (int kt = 0; kt < 4; ++kt)
#pragma unroll
            for (int i = 0; i < 4; ++i) { const int cc = 16 * kt + i;
                float s = fmaf(slope[g], (float)cc, S[kt][i] + base);
                if (BOUND) { bool v = cc <= dist0; if (MODE == 1) v = v && (cc > dist0 - 512); s = v ? s : NEG; }
                S[kt][i] = s; tmax = fmaxf(tmax, s); }
        tmax = qmax(tmax);
        const float mnew = fmaxf(m[g], tmax), alpha = fexp2(m[g] - mnew);
        float rs = 0.f;
#pragma unroll
        for (int kt = 0; kt < 4; ++kt)
#pragma unroll
            for (int i = 0; i < 4; ++i) { const float pv = fexp2(S[kt][i] - mnew); S[kt][i] = pv; rs += pv; }
        rs = qsum(rs);
        l[g] = l[g] * alpha + rs; m[g] = mnew;
        const bf16x8 P0 = pack_p(S[0], S[1]), P1 = pack_p(S[2], S[3]);
#pragma unroll
        for (int dt = 0; dt < 4; ++dt) { O[g][dt] = O[g][dt] * alpha;
            const bf16x8 v0 = *(const bf16x8*)(Vl + (dt * 16 + l15) * 144 + quad * 16), v1 = *(const bf16x8*)(Vl + (dt * 16 + l15) * 144 + 64 + quad * 16);
            O[g][dt] = __builtin_amdgcn_mfma_f32_16x16x32_bf16(v0, P0, O[g][dt], 0, 0, 0);
            O[g][dt] = __builtin_amdgcn_mfma_f32_16x16x32_bf16(v1, P1, O[g][dt], 0, 0, 0); }
    }
}

template <int MODE>
DEV void nsa_tiles(unsigned char* lds, const bf16_t* Kg, const bf16_t* VTg, unsigned tilemask, unsigned wmask, unsigned qmask, int jb0, int jb1,
                   const bf16x8 (&Qf)[2][2], f32x4 (&O)[2][4], float (&m)[2], float (&l)[2], const float (&slope)[2], int tq, int l15, int quad) {
    const int tid = get_tid();
    const int prow = tid >> 3, pe = tid & 7;
    unsigned rem = tilemask;
    int j = __builtin_ctz(rem); rem &= rem - 1;
    u32x4 rk[2], rv[2];
#pragma unroll
    for (int i = 0; i < 2; ++i) { rk[i] = *(const u32x4*)(Kg + (size_t)(64 * j + prow + 32 * i) * 64 + pe * 8); rv[i] = *(const u32x4*)(VTg + (size_t)(prow + 32 * i) * 2048 + 64 * j + pe * 8); }
    int cur = 0;
#pragma unroll
    for (int i = 0; i < 2; ++i) { *(u32x4*)(lds + (prow + 32 * i) * 144 + pe * 16) = rk[i]; st_vt(lds + 9216 + (prow + 32 * i) * 144, pe, rv[i]); }
    __syncthreads();
    for (;;) {
        int jn = -1;
        if (rem) { jn = __builtin_ctz(rem); rem &= rem - 1;
#pragma unroll
            for (int i = 0; i < 2; ++i) { rk[i] = *(const u32x4*)(Kg + (size_t)(64 * jn + prow + 32 * i) * 64 + pe * 8); rv[i] = *(const u32x4*)(VTg + (size_t)(prow + 32 * i) * 2048 + 64 * jn + pe * 8); } }
        const unsigned char* st = lds + cur * 18432;
        if (MODE == 1 || ((wmask >> j) & 1u)) {
            const int dist0 = tq - 64 * j - 4 * quad; const bool sel = (qmask >> j) & 1u;
            if (j == jb0 || j == jb1) nsa_tile<MODE, true>(st, st + 9216, Qf, O, m, l, slope, dist0, sel, l15, quad);
            else nsa_tile<MODE, false>(st, st + 9216, Qf, O, m, l, slope, dist0, sel, l15, quad);
        }
        if (jn >= 0) { unsigned char* sn = lds + (cur ^ 1) * 18432;
#pragma unroll
            for (int i = 0; i < 2; ++i) { *(u32x4*)(sn + (prow + 32 * i) * 144 + pe * 16) = rk[i]; st_vt(sn + 9216 + (prow + 32 * i) * 144, pe, rv[i]); } }
        __syncthreads();
        if (jn < 0) break;
        j = jn; cur ^= 1;
    }
}

DEV void nsa_unit(const NsaCtx& c, int b, int hkv, int qb32, unsigned char* lds) {
    const int tid = get_tid(), lane = tid & 63, wid = tid >> 6, l15 = lane & 15, quad = lane >> 4;
    const int qs = wid & 1, hp = wid >> 1;
    const int tq = qb32 * 32 + qs * 16 + l15, cur = qb32 >> 1;
    const size_t trow = (size_t)b * 2048 + tq;
    const int head0 = hkv * 4 + hp * 2;
    const float* gnp = c.GN + trow * 48 + head0 * 3;
    unsigned char* stash = lds + 36864 + wid * 4096;
    float* xch = (float*)(lds + 53248);
    unsigned* smask = (unsigned*)(lds + 69632);
    const int bh = b * 4 + hkv;
    {
        const bf16_t* Kg = c.KC + (size_t)bh * 128 * 64; const bf16_t* Vg = c.VCT + (size_t)bh * 64 * 128;
#pragma unroll
        for (int i = 0; i < 4; ++i) { const int pc = tid + 256 * i;
            *(u32x4*)(lds + (pc >> 3) * 144 + (pc & 7) * 16) = *(const u32x4*)(Kg + pc * 8);
            st_vt(lds + 18432 + (pc >> 4) * 272, pc & 15, *(const u32x4*)(Vg + pc * 8)); }
    }
    __syncthreads();
    const int nkt = (2 * qb32) / 16 + 1;
    float Mx[8], Sm[8];
#pragma unroll
    for (int kt = 0; kt < 8; ++kt) { Mx[kt] = NEG; Sm[kt] = 0.f; }
#ifdef NSA_NO_CMP
    for (int g = 0; g < 0; ++g) {
#else
#pragma unroll 1
    for (int g = 0; g < 2; ++g) {
#endif
        bf16x8 Qg[2];
#pragma unroll
        for (int ks = 0; ks < 2; ++ks) Qg[ks] = *(const bf16x8*)(c.Qb + trow * 1024 + (head0 + g) * 64 + ks * 32 + quad * 8);
        const float slope_g = exp2f(-0.5f * (float)(head0 + g + 1)) * LOG2E;
        f32x4 S[8];
#pragma unroll
        for (int kt = 0; kt < 8; ++kt) { S[kt] = (f32x4){0.f, 0.f, 0.f, 0.f};
            if (kt < nkt) {
#pragma unroll
                for (int ks = 0; ks < 2; ++ks) { const bf16x8 kf = *(const bf16x8*)(lds + (kt * 16 + l15) * 144 + ks * 64 + quad * 16); S[kt] = __builtin_amdgcn_mfma_f32_16x16x32_bf16(kf, Qg[ks], S[kt], 0, 0, 0); } } }
        float mx = NEG;
        const int d0 = tq - 31 - 64 * quad; const float base = -slope_g * (float)d0;
#pragma unroll
        for (int kt = 0; kt < 8; ++kt)
#pragma unroll
            for (int i = 0; i < 4; ++i) { const int cc = 256 * kt + 16 * i; const float s = (kt < nkt && cc <= d0) ? fmaf(slope_g, (float)cc, S[kt][i] + base) : NEG; S[kt][i] = s; mx = fmaxf(mx, s); }
        mx = qmax(mx);
        float ls = 0.f;
#pragma unroll
        for (int kt = 0; kt < 8; ++kt)
#pragma unroll
            for (int i = 0; i < 4; ++i) ls += S[kt][i] > -1e29f ? fexp2(S[kt][i] - mx) : 0.f;
        ls = qsum(ls);
        const float lcl = fmaxf(ls, 1e-30f), lg = __log2f(lcl) + mx;
        float x3[8];
#pragma unroll
        for (int kt = 0; kt < 8; ++kt) {
#pragma unroll
            for (int i = 0; i < 4; ++i) S[kt][i] = S[kt][i] > -1e29f ? S[kt][i] - lg : NEG;
            x3[kt] = __shfl(S[kt][3], (lane + 48) & 63);
        }
#pragma unroll
        for (int kt = 0; kt < 8; ++kt) {
            const float nb = quad >= 1 ? x3[kt] : (kt >= 1 ? x3[kt >= 1 ? kt - 1 : 0] : NEG);
            const float tm = fmaxf(fmaxf(fmaxf(S[kt][0], S[kt][1]), fmaxf(S[kt][2], S[kt][3])), nb);
            const float nm = fmaxf(Mx[kt], tm);
            Sm[kt] = Sm[kt] * fexp2(Mx[kt] - nm) + fexp2(S[kt][0] - nm) + fexp2(S[kt][1] - nm) + fexp2(S[kt][2] - nm) + fexp2(S[kt][3] - nm) + fexp2(nb - nm);
            Mx[kt] = nm;
        }
        const float gate0 = gnp[g * 3];
        f32x4 Oc[4];
#pragma unroll
        for (int dt = 0; dt < 4; ++dt) Oc[dt] = (f32x4){0.f, 0.f, 0.f, 0.f};
#pragma unroll
        for (int k2 = 0; k2 < 4; ++k2) {
            if (2 * k2 < nkt) {
                f32x4 pa, pb;
#pragma unroll
                for (int i = 0; i < 4; ++i) { pa[i] = fexp2(S[2 * k2][i]); pb[i] = fexp2(S[2 * k2 + 1][i]); }
                const bf16x8 pf = pack_p(pa, pb);
#pragma unroll
                for (int dt = 0; dt < 4; ++dt) { const bf16x8 vf = *(const bf16x8*)(lds + 18432 + (dt * 16 + l15) * 272 + k2 * 64 + quad * 16); Oc[dt] = __builtin_amdgcn_mfma_f32_16x16x32_bf16(vf, pf, Oc[dt], 0, 0, 0); }
            }
        }
#pragma unroll
        for (int dt = 0; dt < 4; ++dt) { const f32x4 v = Oc[dt] * gate0; u32x2 w; w.x = cvt_pk_bf16(v[0], v[1]); w.y = cvt_pk_bf16(v[2], v[3]); *(u32x2*)(stash + ((g * 4 + dt) * 64 + lane) * 8) = w; }
    }
    unsigned qmask;
    if (cur < 8) qmask = (2u << cur) - 1u;
    if (cur >= 8) {
#pragma unroll
        for (int kt = 0; kt < 8; ++kt) { xch[(wid * 16 + kt) * 64 + lane] = Mx[kt]; xch[(wid * 16 + 8 + kt) * 64 + lane] = Sm[kt]; }
    }
    __syncthreads();
    if (cur >= 8) {
        float v[8];
#pragma unroll
        for (int kt = 0; kt < 8; ++kt) {
            const float m2 = xch[((wid ^ 2) * 16 + kt) * 64 + lane], s2 = xch[((wid ^ 2) * 16 + 8 + kt) * 64 + lane];
            const float mm = fmaxf(Mx[kt], m2), ss = Sm[kt] * fexp2(Mx[kt] - mm) + s2 * fexp2(m2 - mm);
            const int jb = 4 * kt + quad; v[kt] = (jb >= 1 && jb <= cur - 2) ? mm + __log2f(ss) : -3e38f; }
        qmask = 1u | (1u << cur) | (1u << (cur - 1));
        for (int r = 0; r < 5; ++r) {
            float bv = v[0]; int bj = quad;
#pragma unroll
            for (int kt = 1; kt < 8; ++kt) if (v[kt] > bv) { bv = v[kt]; bj = 4 * kt + quad; }
#pragma unroll
            for (int o = 16; o <= 32; o <<= 1) { const float ov = __shfl_xor(bv, o); const int oj = __shfl_xor(bj, o); if (ov > bv || (ov == bv && oj < bj)) { bv = ov; bj = oj; } }
            qmask |= 1u << bj;
#pragma unroll
            for (int kt = 0; kt < 8; ++kt) if (4 * kt + quad == bj) v[kt] = -3.2e38f;
        }
    }
    unsigned wmask = qmask;
#pragma unroll
    for (int o = 1; o <= 8; o <<= 1) wmask |= __shfl_xor(wmask, o);
    if (lane == 0) smask[wid] = wmask;
    __syncthreads();
    const unsigned umask = smask[0] | smask[1] | smask[2] | smask[3];
    bf16x8 Qf[2][2]; float slope[2];
#pragma unroll
    for (int g = 0; g < 2; ++g) {
#pragma unroll
        for (int ks = 0; ks < 2; ++ks) Qf[g][ks] = *(const bf16x8*)(c.Qb + trow * 1024 + (head0 + g) * 64 + ks * 32 + quad * 8);
        slope[g] = exp2f(-0.5f * (float)(head0 + g + 1)) * LOG2E;
    }
    f32x4 O[2][4]; float m[2], l[2];
#pragma unroll
    for (int g = 0; g < 2; ++g) { m[g] = MINIT; l[g] = 0.f;
#pragma unroll
        for (int dt = 0; dt < 4; ++dt) O[g][dt] = (f32x4){0.f, 0.f, 0.f, 0.f}; }
#ifndef NSA_NO_SLC
    nsa_tiles<0>(lds, c.KS + (size_t)bh * 2048 * 64, c.VST + (size_t)bh * 64 * 2048, umask, wmask, qmask, cur, cur, Qf, O, m, l, slope, tq, l15, quad);
#endif
#pragma unroll
    for (int g = 0; g < 2; ++g) { const float sc = gnp[g * 3 + 1] / fmaxf(l[g], 1e-30f);
#pragma unroll
        for (int dt = 0; dt < 4; ++dt) { u32x2* sp = (u32x2*)(stash + ((g * 4 + dt) * 64 + lane) * 8); const u32x2 w = *sp;
            const f32x4 v = O[g][dt] * sc + (f32x4){bflo(w.x), bfhi(w.x), bflo(w.y), bfhi(w.y)};
            u32x2 w2; w2.x = cvt_pk_bf16(v[0], v[1]); w2.y = cvt_pk_bf16(v[2], v[3]); *sp = w2;
            O[g][dt] = (f32x4){0.f, 0.f, 0.f, 0.f}; }
        m[g] = MINIT; l[g] = 0.f; }
    const int t0 = qb32 * 32;
    const int jlo = t0 >= 511 ? (t0 - 511) >> 6 : 0;
    const unsigned winmask = ((2u << cur) - 1u) & ~((1u << jlo) - 1u);
#ifndef NSA_NO_WIN
    nsa_tiles<1>(lds, c.KW + (size_t)bh * 2048 * 64, c.VWT + (size_t)bh * 64 * 2048, winmask, 0u, 0u, cur, jlo, Qf, O, m, l, slope, tq, l15, quad);
#endif
#pragma unroll
    for (int g = 0; g < 2; ++g) { const float sc = gnp[g * 3 + 2] / fmaxf(l[g], 1e-30f);
#pragma unroll
        for (int dt = 0; dt < 4; ++dt) { const u32x2 w = *(const u32x2*)(stash + ((g * 4 + dt) * 64 + lane) * 8);
            const f32x4 v = O[g][dt] * sc + (f32x4){bflo(w.x), bfhi(w.x), bflo(w.y), bfhi(w.y)};
            st_bf4(c.ON + trow * 1024 + (head0 + g) * 64 + dt * 16 + quad * 4, v[0], v[1], v[2], v[3]); } }
}

DEV void xattn_unit(const bf16_t* Qx, const bf16_t* XK, const bf16_t* XVT, bf16_t* OX, int b, int h, int qblk, unsigned char* lds) {
    const int tid = get_tid(), lane = tid & 63, wid = tid >> 6, l15 = lane & 15, quad = lane >> 4;
    const size_t trow = (size_t)b * 2048 + qblk * 64 + wid * 16 + l15;
    bf16x8 Qf[8];
#pragma unroll
    for (int ks = 0; ks < 8; ++ks) Qf[ks] = *(const bf16x8*)(Qx + trow * 1024 + h * 256 + ks * 32 + quad * 8);
    f32x4 O[16];
#pragma unroll
    for (int dt = 0; dt < 16; ++dt) O[dt] = (f32x4){0.f, 0.f, 0.f, 0.f};
    float m = NEG, l = 0.f;
    const bf16_t* Kg = XK + (size_t)b * 256 * 1024 + h * 256;
    const bf16_t* Vg = XVT + (size_t)(b * 4 + h) * 256 * 256;
    u32x4 rk[4], rv[4];
#pragma unroll
    for (int i = 0; i < 4; ++i) { const int pc = tid + 256 * i; rk[i] = *(const u32x4*)(Kg + (size_t)(pc >> 5) * 1024 + (pc & 31) * 8); rv[i] = *(const u32x4*)(Vg + (size_t)(pc >> 2) * 256 + (pc & 3) * 8); }
#pragma unroll
    for (int i = 0; i < 4; ++i) { const int pc = tid + 256 * i; *(u32x4*)(lds + (pc >> 5) * 528 + (pc & 31) * 16) = rk[i]; st_vt(lds + 16896 + (pc >> 2) * 80, pc & 3, rv[i]); }
    __syncthreads();
    for (int j = 0; j < 8; ++j) {
        const bool more = j + 1 < 8;
        if (more) {
#pragma unroll
            for (int i = 0; i < 4; ++i) { const int pc = tid + 256 * i; rk[i] = *(const u32x4*)(Kg + (size_t)(32 * (j + 1) + (pc >> 5)) * 1024 + (pc & 31) * 8); rv[i] = *(const u32x4*)(Vg + (size_t)(pc >> 2) * 256 + 32 * (j + 1) + (pc & 3) * 8); } }
        const unsigned char* st = lds + (j & 1) * 37376;
        f32x4 S[2];
#pragma unroll
        for (int kt = 0; kt < 2; ++kt) { S[kt] = (f32x4){0.f, 0.f, 0.f, 0.f};
#pragma unroll
            for (int ks = 0; ks < 8; ++ks) { const bf16x8 kf = *(const bf16x8*)(st + (kt * 16 + l15) * 528 + ks * 64 + quad * 16); S[kt] = __builtin_amdgcn_mfma_f32_16x16x32_bf16(kf, Qf[ks], S[kt], 0, 0, 0); } }
        float tmax = fmaxf(fmaxf(fmaxf(S[0][0], S[0][1]), fmaxf(S[0][2], S[0][3])), fmaxf(fmaxf(S[1][0], S[1][1]), fmaxf(S[1][2], S[1][3])));
        tmax = qmax(tmax);
        const float mnew = fmaxf(m, tmax), alpha = fexp2(m - mnew);
        float rs = 0.f;
#pragma unroll
        for (int kt = 0; kt < 2; ++kt)
#pragma unroll
            for (int i = 0; i < 4; ++i) { const float pv = fexp2(S[kt][i] - mnew); S[kt][i] = pv; rs += pv; }
        rs = qsum(rs); l = l * alpha + rs; m = mnew;
        const bf16x8 pf = pack_p(S[0], S[1]);
#pragma unroll
        for (int dt = 0; dt < 16; ++dt) { O[dt] = O[dt] * alpha; const bf16x8 vf = *(const bf16x8*)(st + 16896 + (dt * 16 + l15) * 80 + quad * 16); O[dt] = __builtin_amdgcn_mfma_f32_16x16x32_bf16(vf, pf, O[dt], 0, 0, 0); }
        if (more) { unsigned char* sn = lds + ((j + 1) & 1) * 37376;
#pragma unroll
            for (int i = 0; i < 4; ++i) { const int pc = tid + 256 * i; *(u32x4*)(sn + (pc >> 5) * 528 + (pc & 31) * 16) = rk[i]; st_vt(sn + 16896 + (pc >> 2) * 80, pc & 3, rv[i]); } }
        __syncthreads();
    }
    const float inv = 1.0f / l;
#pragma unroll
    for (int dt = 0; dt < 16; ++dt) { const f32x4 v = O[dt] * inv; st_bf4(OX + trow * 1024 + h * 256 + dt * 16 + quad * 4, v[0], v[1], v[2], v[3]); }
}


#define XB_TMO      128
#define XB_XCNT(j)  (256  + 64 * (j))
#define XB_XSUB(j)  (1280 + 64 * (j))
#define XB_XGEN(j)  (2304 + 64 * (j))
#define XB_TOP      3328
#define XB_TOPGEN   3392
#define XCD_BAR_WORDS 3456
#define XB_SPIN_CAP (1u << 18)
#define LAS __attribute__((address_space(3)))
DEV unsigned xb_ld(unsigned* p)              { return __hip_atomic_load(p, __ATOMIC_RELAXED, __HIP_MEMORY_SCOPE_AGENT); }
DEV unsigned xb_add(unsigned* p, unsigned v) { return __hip_atomic_fetch_add(p, v, __ATOMIC_RELAXED, __HIP_MEMORY_SCOPE_AGENT); }
DEV unsigned xb_xcc_id() { return (unsigned)__builtin_amdgcn_s_getreg((3 << 11) | 20) & 0xFu; }
#define XB_SPIN(cond, bar) do { unsigned _sp = 0; while (cond) { __builtin_amdgcn_s_sleep(1); \
    if ((++_sp & 255u) == 0u) { if (xb_ld(&(bar)[XB_TMO])) break; if (_sp > XB_SPIN_CAP) { atomicAdd(&(bar)[XB_TMO], 1u); break; } } } } while (0)
struct XcdBarrier { unsigned* bar; unsigned x; volatile LAS unsigned* st; };
DEV XcdBarrier xcd_barrier_post(unsigned* bar, volatile LAS unsigned* st) {
    XcdBarrier b; b.bar = bar; b.x = xb_xcc_id(); b.st = st;
    if (threadIdx.x == 0) (void)xb_add(&bar[XB_XCNT(b.x)], 1u);
    return b;
}
DEV void xcd_barrier_complete(unsigned* bar, unsigned x, unsigned& nloc, unsigned& nx) {
    const unsigned G = gridDim.x * gridDim.y * gridDim.z;
    unsigned sum, cnt, mine, sp = 0u;
    for (;;) {
        sum = 0u; cnt = 0u; mine = 0u;
#pragma unroll
        for (unsigned j = 0; j < 16; ++j) { const unsigned c = xb_ld(&bar[XB_XCNT(j)]); sum += c; cnt += (c > 0u) ? 1u : 0u; mine = (j == x) ? c : mine; }
        if (sum == G) break;
        __builtin_amdgcn_s_sleep(1);
        if ((++sp & 255u) == 0u) { if (xb_ld(&bar[XB_TMO])) break; if (sp > XB_SPIN_CAP) { atomicAdd(&bar[XB_TMO], 1u); break; } }
    }
    nloc = mine > 0u ? mine : 1u; nx = cnt > 0u ? cnt : 1u;
}
DEV void xcd_barrier(const XcdBarrier& b) {
    asm volatile("s_waitcnt vmcnt(0)" ::: "memory");
    __syncthreads();
    if (threadIdx.x == 0) {
        unsigned* bar = b.bar;
        __builtin_amdgcn_s_waitcnt(0);
        unsigned nloc = b.st[0], nx = b.st[1];
        if (nloc == 0u) { xcd_barrier_complete(bar, b.x, nloc, nx); b.st[0] = nloc; b.st[1] = nx; }
        const unsigned old = xb_add(&bar[XB_XSUB(b.x)], 1u);
        const unsigned gen = old / nloc;
        if (old + 1u == (gen + 1u) * nloc) {
            __builtin_amdgcn_fence(__ATOMIC_RELEASE, "agent");
            asm volatile("s_waitcnt vmcnt(0)" ::: "memory");
            const unsigned og = xb_add(&bar[XB_TOP], 1u);
            const unsigned tg = og / nx;
            if (og + 1u == (tg + 1u) * nx) xb_add(&bar[XB_TOPGEN], 1u);
            else XB_SPIN(xb_ld(&bar[XB_TOPGEN]) == tg, bar);
            __builtin_amdgcn_fence(__ATOMIC_ACQUIRE, "agent");
            xb_add(&bar[XB_XGEN(b.x)], 1u);
            asm volatile("s_waitcnt vmcnt(0)" ::: "memory");
        } else {
            XB_SPIN(xb_ld(&bar[XB_XGEN(b.x)]) == gen, bar);
            __builtin_amdgcn_fence(__ATOMIC_ACQUIRE, "agent");
            asm volatile("s_waitcnt vmcnt(0)" ::: "memory");
        }
    }
    __syncthreads();
}

constexpr int NPHASE = 17;
__global__ void __launch_bounds__(256, 2) fwd_kernel(P p) {
    extern __shared__ __attribute__((aligned(16))) unsigned char lds[];
#define WSB(off) ((bf16_t*)(ws + (off)))
#define WSF(off) ((float*)(ws + (off)))
    volatile LAS unsigned* bst = (volatile LAS unsigned*)(LAS unsigned char*)(lds + LDS_BYTES - 16);
    if (threadIdx.x == 0) { bst[0] = 0u; bst[1] = 0u; }
    __syncthreads();
    XcdBarrier gbar; gbar.bar = (unsigned*)(p.ws + O_BAR); gbar.x = 0; gbar.st = bst;
    if (p.coop) gbar = xcd_barrier_post((unsigned*)(p.ws + O_BAR), bst);
    const SsmIn sin_{p.in[5], p.in[6], p.in[7], p.in[8], p.in[9], p.in[10], p.in[12]};
    for (int ph = p.ph_lo; ph < p.ph_hi; ++ph) {
        size_t zoff = 0; asm volatile("" : "+s"(zoff)); unsigned char* ws = p.ws + zoff;
        switch (ph) {
#ifdef ONLY_PHASE
        default: break;
#define CASE(k) case (k): if ((k) != ONLY_PHASE) break; else
#else
#define CASE(k) case (k):
#endif
        CASE(0) {
            const int tid = get_tid();
            ln_pass(p.in[0], p.in[2], p.in[3], WSB(O_B), WSF(O_ST0), nullptr);
            int cur = 0;
            conv_job(p.in[4], 5168, 1024, 5376, WSB(O_WIN_T), 1, lds, cur);
            conv_job(p.in[13], 512, 512, 512, WSB(O_WGLU_T), 0, lds, cur);
            conv_job(p.in[15], 1024, 512, 1024, WSB(O_WSOUT_T), 0, lds, cur);
            conv_job(p.in[17], 256, 2048, 256, WSB(O_W1_T), 0, lds, cur);
            conv_job(p.in[17] + 2048 * 256, 256, 2048, 256, WSB(O_W1_T) + 256 * 2048, 0, lds, cur);
            conv_job(p.in[19], 64, 256, 128, WSB(O_W2_T), 3, lds, cur);
            conv_job(p.in[19] + 256 * 64, 64, 256, 128, WSB(O_W2_T) + 128 * 256, 3, lds, cur);
            conv_job(p.in[20], 1024, 1024, 1024, WSB(O_WNOUT_T), 0, lds, cur);
            conv_job(p.in[21], 1024, 1024, 1024, WSB(O_WOUT_T), 0, lds, cur);
            conv_job(p.in[24], 1024, 1024, 1024, WSB(O_WXQ_T), 0, lds, cur);
            conv_job(p.in[25], 2048, 1024, 2048, WSB(O_WXKV_T), 0, lds, cur);
            conv_job(p.in[26], 1024, 1024, 1024, WSB(O_WXO_T), 0, lds, cur);
            conv_job(p.in[29], 5632, 1024, 5632, WSB(O_WFIN_T), 2, lds, cur);
            conv_job(p.in[30], 1024, 2816, 1024, WSB(O_WFOUT_T), 0, lds, cur);
            for (int it = get_bid(); it < 128; it += gridDim.x) {
                const int z = it >> 6, ec = (it >> 4) & 3, fc = it & 15, e = ec * 64 + (tid & 63), fg = tid >> 6;
                float a = 0.f;
#pragma unroll 8
                for (int f = fc * 128 + fg * 32; f < fc * 128 + fg * 32 + 32; ++f) a += p.in[16][z * 2048 + f] * p.in[17][((size_t)z * 2048 + f) * 256 + e];
                float* red = (float*)lds;
                __syncthreads(); red[tid] = a; __syncthreads();
                if (tid < 64) WSF(O_BPART)[(z * 16 + fc) * 256 + e] = red[tid] + red[tid + 64] + red[tid + 128] + red[tid + 192];
                __syncthreads();
            }
            ssm_prep(sin_, WSB(O_BT1), WSB(O_MTW), lds);
        } break;
        CASE(1) {
            if (get_bid() == 0) { for (int e = get_tid(); e < 512; e += 256) { float a = p.in[18][e]; for (int fc = 0; fc < 16; ++fc) a += WSF(O_BPART)[((e >> 8) * 16 + fc) * 256 + (e & 255)]; WSF(O_BIAS2)[e] = a; } }
            { const GemmP g{WSB(O_B), WSB(O_WIN_T), 1024, 1024, 256, 42, 16, 1};
              const EpiIn e{WSB(O_UH), WSB(O_QB), WSB(O_KVC), WSB(O_KS), WSB(O_VST), WSB(O_KW), WSB(O_VWT), WSB(O_GM), WSF(O_GN)};
              gemm_run(g, AddrNone{}, e, lds); }
        } break;
        CASE(2) {
            { const GemmP g{WSB(O_KVC), WSB(O_W1_T), 1024, 2048, 1, 2, 32, 128};
              const EpiCmp1 e{WSB(O_HID), WSF(O_BIAS2)};
              gemm_run(g, AddrCmp1{}, e, lds); }
            { const GemmP g{WSB(O_UH), WSB(O_BT1), 640, 512, 8, 1, 8, 32};
              const EpiSsmA e{WSF(O_SS)};
              gemm_run(g, AddrStride{1024ull * 640, 128ull * 512}, e, lds); }
        } break;
        CASE(3) {
            ssm_scan(sin_, WSF(O_SS), WSB(O_UH));
            { const GemmP g{WSB(O_HID), WSB(O_W2_T), 256, 256, 1, 1, 4, 128};
              const EpiCmp2 e{WSB(O_KC), WSB(O_VCT)};
              gemm_run(g, AddrCmp2{}, e, lds); }
        } break;
        CASE(4) {
            const NsaCtx c{WSB(O_QB), WSB(O_KC), WSB(O_VCT), WSB(O_KS), WSB(O_VST), WSB(O_KW), WSB(O_VWT), WSF(O_GN), WSB(O_B)};
            const int G = gridDim.x;
            for (int i = 0;; ++i) {
                const int u = (i & 1) ? i * G + (G - 1 - get_bid()) : i * G + get_bid();
                if (i * G >= 4096) break;
                if (u < 4096) { const int qb32 = 63 - (u >> 6), bh = u & 63; nsa_unit(c, bh >> 2, bh & 3, qb32, lds); }
                __syncthreads();
            }
            { const GemmP g{WSB(O_UH), WSB(O_MTW), 640, 640, 8, 4, 10, 32};
              const EpiSsmB e{WSB(O_UH), p.in[11], WSB(O_GB)};
              gemm_run(g, AddrStride{1024ull * 640, 512ull * 640}, e, lds); }
        } break;
        CASE(5) { const GemmP g{WSB(O_GB), WSB(O_WGLU_T), 512, 512, 256, 4, 8, 1}; const EpiGlu e{WSB(O_GB), p.in[14], WSB(O_YS)}; gemm_run(g, AddrNone{}, e, lds); } break;
        CASE(6) { const GemmP g{WSB(O_YS), WSB(O_WSOUT_T), 512, 512, 256, 8, 8, 1}; const EpiSout e{WSB(O_GM), WSB(O_QB)}; gemm_run(g, AddrNone{}, e, lds); } break;
        CASE(7) { const GemmP g{WSB(O_B), WSB(O_WNOUT_T), 1024, 1024, 256, 8, 16, 1}; const EpiNout e{WSB(O_GM), WSB(O_QB), WSB(O_MIXIN)}; gemm_run(g, AddrNone{}, e, lds); } break;
        CASE(8) { const GemmP g{WSB(O_MIXIN), WSB(O_WOUT_T), 1024, 1024, 256, 8, 16, 1}; const EpiRes e{p.in[0], WSF(O_ST0), p.in[2], p.in[3], WSF(O_V1)}; gemm_run(g, AddrNone{}, e, lds); } break;
        CASE(9) { ln_pass(WSF(O_V1), p.in[22], p.in[23], WSB(O_B), WSF(O_ST1), nullptr);
            for (size_t i = (size_t)get_bid() * 256 + get_tid(); i < 4096ull * 1024 / 4; i += (size_t)gridDim.x * 256) { const f32x4 v = ((const f32x4*)p.in[1])[i]; st_bf4(WSB(O_MEMB) + i * 4, v[0], v[1], v[2], v[3]); }
        } break;
        CASE(10) { { const GemmP g{WSB(O_B), WSB(O_WXQ_T), 1024, 1024, 256, 8, 16, 1}; const EpiScaleBf e{WSB(O_QB), 1024, 0.0625f * LOG2E}; gemm_run(g, AddrNone{}, e, lds); }
            { const GemmP g{WSB(O_MEMB), WSB(O_WXKV_T), 1024, 1024, 32, 16, 16, 1};
              const EpiXkv e{WSB(O_XK), WSB(O_XVT)};
              gemm_run(g, AddrNone{}, e, lds); }
        } break;
        CASE(11) {
            for (int u = get_bid(); u < 2048; u += gridDim.x) { const int qblk = u >> 6, bh = u & 63; xattn_unit(WSB(O_QB), WSB(O_XK), WSB(O_XVT), WSB(O_B), bh >> 2, bh & 3, qblk, lds); }
        } break;
        CASE(12) { const GemmP g{WSB(O_B), WSB(O_WXO_T), 1024, 1024, 256, 8, 16, 1}; const EpiRes e{WSF(O_V1), WSF(O_ST1), p.in[22], p.in[23], WSF(O_V2)}; gemm_run(g, AddrNone{}, e, lds); } break;
        CASE(13) ln_pass(WSF(O_V2), p.in[27], p.in[28], WSB(O_B), WSF(O_ST2), nullptr); break;
        CASE(14) { const GemmP g{WSB(O_B), WSB(O_WFIN_T), 1024, 1024, 256, 44, 16, 1}; const EpiFfnIn e{WSB(O_FB)}; gemm_run(g, AddrNone{}, e, lds); } break;
        CASE(15) { const GemmP g{WSB(O_FB), WSB(O_WFOUT_T), 2816, 2816, 256, 8, 44, 1}; const EpiRes e{WSF(O_V2), WSF(O_ST2), p.in[27], p.in[28], WSF(O_V2)}; gemm_run(g, AddrNone{}, e, lds); } break;
        CASE(16) ln_pass(WSF(O_V2), p.in[31], p.in[32], nullptr, nullptr, p.out); break;
        }
        if (ph + 1 < p.ph_hi) { if (p.coop) xcd_barrier(gbar); if (p.pad == 0x5eed) cg::this_grid().sync(); }
    }
}

#ifndef ONE_LAUNCH
#define ONE_LAUNCH 1
#endif
extern "C" void kernel_launch(void* const* d_in, const int* in_sizes, int n_in, void* d_out, int out_size, void* d_ws, size_t ws_size, hipStream_t stream) {
    static int grid = 0;
    if (grid == 0) {
        if (n_in != 33 || out_size != T_ * 1024 || ws_size < WS_NEED) { fprintf(stderr, "kernel_launch: unexpected shapes (n_in %d out %d ws %zu need %zu)\n", n_in, out_size, ws_size, (size_t)WS_NEED); grid = -1; return; }
        int dev = 0, cus = 0, per_cu = 0;
        hipGetDevice(&dev);
        hipDeviceGetAttribute(&cus, hipDeviceAttributeMultiprocessorCount, dev);
        if (hipFuncSetAttribute((const void*)fwd_kernel, hipFuncAttributeMaxDynamicSharedMemorySize, LDS_BYTES) != hipSuccess) { fprintf(stderr, "kernel_launch: hipFuncSetAttribute failed\n"); grid = -1; return; }
        if (hipOccupancyMaxActiveBlocksPerMultiprocessor(&per_cu, (const void*)fwd_kernel, 256, LDS_BYTES) != hipSuccess || per_cu < 1) { fprintf(stderr, "kernel_launch: occupancy query failed (%d)\n", per_cu); per_cu = 1; (void)hipGetLastError(); }
        if (per_cu > 2) per_cu = 2;
        grid = cus * per_cu;
    }
    if (grid < 0) return;
    P p{};
    for (int i = 0; i < 33; ++i) p.in[i] = (const float*)d_in[i];
    p.out = (float*)d_out; p.ws = (unsigned char*)d_ws;
#if ONE_LAUNCH
    p.ph_lo = 0; p.ph_hi = NPHASE; p.coop = 1;
    if (hipMemsetAsync((unsigned char*)d_ws + O_BAR, 0, XCD_BAR_WORDS * 4, stream) != hipSuccess) { fprintf(stderr, "kernel_launch: memset of barrier words failed\n"); return; }
    void* args[] = {&p};
    hipError_t e = hipLaunchCooperativeKernel((const void*)fwd_kernel, dim3(grid), dim3(256), args, LDS_BYTES, stream);
    if (e != hipSuccess) fprintf(stderr, "cooperative launch failed: %s (grid %d)\n", hipGetErrorString(e), grid);
#else
#ifdef STOP_AFTER
    const int nrun = STOP_AFTER + 1;
#else
    const int nrun = NPHASE;
#endif
    for (int ph = 0; ph < nrun; ++ph) {
        p.ph_lo = ph; p.ph_hi = ph + 1; p.coop = 0;
        hipLaunchKernelGGL(fwd_kernel, dim3(grid), dim3(256), LDS_BYTES, stream, p);
    }
#endif
}
```

```cpp
#include <hip/hip_runtime.h>
#include <hip/hip_cooperative_groups.h>
#include <cstdio>
#include <cstdint>
namespace cg = cooperative_groups;

typedef unsigned short bf16_t;
typedef short bf16x8 __attribute__((ext_vector_type(8)));
typedef float f32x4 __attribute__((ext_vector_type(4)));
typedef unsigned u32x4 __attribute__((ext_vector_type(4)));
typedef unsigned u32x2 __attribute__((ext_vector_type(2)));
#define DEV __device__ __forceinline__

constexpr int T_ = 32768, L_ = 2048;
constexpr float LOG2E = 1.4426950408889634f;
constexpr float ALPHA = 1.189207115002721f;
constexpr float LN_EPS = 1e-5f;
constexpr float NEG = -1e30f;
constexpr int LDS_BYTES = 81920;
constexpr size_t MiB = 1048576;

constexpr size_t O_WIN_T = 0;
constexpr size_t O_WGLU_T = O_WIN_T + 5376ull * 1024 * 2;
constexpr size_t O_WSOUT_T = O_WGLU_T + 512ull * 512 * 2;
constexpr size_t O_W1_T = O_WSOUT_T + 1024ull * 512 * 2;
constexpr size_t O_W2_T = O_W1_T + 2ull * 256 * 2048 * 2;
constexpr size_t O_WNOUT_T = O_W2_T + 2ull * 128 * 256 * 2;
constexpr size_t O_WOUT_T = O_WNOUT_T + 2 * MiB;
constexpr size_t O_WXQ_T = O_WOUT_T + 2 * MiB;
constexpr size_t O_WXKV_T = O_WXQ_T + 2 * MiB;
constexpr size_t O_WXO_T = O_WXKV_T + 4 * MiB;
constexpr size_t O_WFIN_T = O_WXO_T + 2 * MiB;
constexpr size_t O_WFOUT_T = O_WFIN_T + 5632ull * 1024 * 2;
constexpr size_t O_BT1 = O_WFOUT_T + 1024ull * 2816 * 2;
constexpr size_t O_MTW = O_BT1 + 4 * MiB;
constexpr size_t O_KC = O_MTW + 20 * MiB;
constexpr size_t O_VCT = O_KC + 1 * MiB;
constexpr size_t O_GN = O_VCT + 1 * MiB;
constexpr size_t O_ST0 = O_GN + 6 * MiB;
constexpr size_t O_ST1 = O_ST0 + 262144;
constexpr size_t O_ST2 = O_ST1 + 262144;
constexpr size_t O_BIAS2 = O_ST2 + 262144;
constexpr size_t O_BPART = O_BIAS2 + 4096;
constexpr size_t O_BAR = O_BPART + 32768;
constexpr size_t O_A = 76 * MiB;
constexpr size_t O_KVC = O_A;
constexpr size_t O_KS = O_A + 32 * MiB;
constexpr size_t O_VST = O_A + 48 * MiB;
constexpr size_t O_KW = O_A + 64 * MiB;
constexpr size_t O_VWT = O_A + 80 * MiB;
constexpr size_t O_GB = O_A + 96 * MiB;
constexpr size_t O_MIXIN = O_A;
constexpr size_t O_MEMB = O_A + 64 * MiB;
constexpr size_t O_XK = O_A + 72 * MiB;
constexpr size_t O_XVT = O_A + 80 * MiB;
constexpr size_t O_V2 = O_A;
constexpr size_t O_B = O_A + 128 * MiB;
constexpr size_t O_SS = O_B;
constexpr size_t O_HID = O_B + 16 * MiB;
constexpr size_t O_Y = O_B + 64 * MiB;
constexpr size_t O_GM = O_Y;
constexpr size_t O_V1 = O_Y;
constexpr size_t O_X = O_Y + 128 * MiB;
constexpr size_t O_QB = O_X;
constexpr size_t O_UH = O_X + 64 * MiB;
constexpr size_t O_YS = O_X + 64 * MiB;
constexpr size_t O_FB = O_Y;
constexpr size_t WS_NEED = O_X + 104 * MiB;
static_assert(O_BAR + 16384 <= O_A, "F region overflow");

struct P {
    const float* in[33];
    float* out;
    unsigned char* ws;
    int ph_lo, ph_hi, coop, pad;
};

DEV int get_tid() { int t = threadIdx.x; asm volatile("" : "+v"(t)); return t; }
DEV int get_bid() { int t = blockIdx.x; asm volatile("" : "+s"(t)); return t; }
typedef __bf16 bf2_t __attribute__((ext_vector_type(2)));
typedef float f32x2_t __attribute__((ext_vector_type(2)));
DEV unsigned cvt_pk_bf16(float lo, float hi) { const f32x2_t f = {lo, hi}; const bf2_t r = __builtin_convertvector(f, bf2_t); return __builtin_bit_cast(unsigned, r); }
DEV bf16_t f2bf(float v) { return (bf16_t)(cvt_pk_bf16(v, 0.f) & 0xffffu); }
DEV float bf2f(unsigned v) { return __uint_as_float(v << 16); }
DEV float bflo(unsigned w) { return __uint_as_float(w << 16); }
DEV float bfhi(unsigned w) { return __uint_as_float(w & 0xffff0000u); }
DEV float fexp2(float x) { return __builtin_amdgcn_exp2f(x); }
DEV float frcp(float x) { return __builtin_amdgcn_rcpf(x); }
DEV float sigmoidf_(float x) { return frcp(1.f + fexp2(-x * LOG2E)); }
DEV float gelu_tanh(float x) { const float u = 0.7978845608028654f * (x + 0.044715f * x * x * x); return x * frcp(1.f + fexp2(-2.f * LOG2E * u)); }
DEV void st_bf4(bf16_t* p, float a, float b, float c, float d) { u32x2 w; w.x = cvt_pk_bf16(a, b); w.y = cvt_pk_bf16(c, d); *(u32x2*)p = w; }
DEV f32x4 ld_bf4(const bf16_t* p) { const u32x2 w = *(const u32x2*)p; return (f32x4){bflo(w.x), bfhi(w.x), bflo(w.y), bfhi(w.y)}; }
DEV float wred_sum(float v) {
#pragma unroll
    for (int o = 32; o >= 1; o >>= 1) v += __shfl_xor(v, o);
    return v;
}

DEV void ln_pass(const float* src, const float* g, const float* b, bf16_t* dstb, float* stats, float* dstf) {
    const int lane = get_tid() & 63, wid = get_tid() >> 6;
    const int nw = gridDim.x * 4;
    for (int row = get_bid() * 4 + wid; row < T_; row += nw) {
        const f32x4* p = (const f32x4*)(src + (size_t)row * 1024);
        f32x4 v[4];
#pragma unroll
        for (int i = 0; i < 4; ++i) v[i] = p[lane + 64 * i];
        float s = 0.f;
#pragma unroll
        for (int i = 0; i < 4; ++i) s += (v[i][0] + v[i][1]) + (v[i][2] + v[i][3]);
        s = wred_sum(s);
        const float mu = s * (1.f / 1024.f);
        float q = 0.f;
#pragma unroll
        for (int i = 0; i < 4; ++i) { const f32x4 d = v[i] - mu; q += (d[0] * d[0] + d[1] * d[1]) + (d[2] * d[2] + d[3] * d[3]); }
        q = wred_sum(q);
        const float rstd = 1.0f / sqrtf(q * (1.f / 1024.f) + LN_EPS);
        if (stats && lane == 0) { stats[row * 2] = mu; stats[row * 2 + 1] = rstd; }
#pragma unroll
        for (int i = 0; i < 4; ++i) {
            const int col = (lane + 64 * i) * 4;
            const f32x4 gg = *(const f32x4*)(g + col), bb = *(const f32x4*)(b + col);
            const f32x4 y = (v[i] - mu) * rstd * gg + bb;
            if (dstb) st_bf4(dstb + (size_t)row * 1024 + col, y[0], y[1], y[2], y[3]);
            if (dstf) *(f32x4*)(dstf + (size_t)row * 1024 + col) = y;
        }
    }
}

DEV int colmap(int mode, int n) {
    if (mode == 0) return n;
    if (mode == 1) return n < 3072 ? n : (n < 5120 ? n + 48 : (n < 5168 ? n - 5120 + 3072 : -1));
    if (mode == 2) { const int blk = n >> 5, r = n & 31; return r < 16 ? blk * 16 + r : 2816 + blk * 16 + (r - 16); }
    return n < 64 ? n : -1;
}
DEV void conv_job(const float* src, int ldsrc, int K, int N, bf16_t* dst, int mode, unsigned char* lds, int& cursor) {
    const int tid = get_tid(), lane = tid & 63, gw = get_bid() * 4 + (tid >> 6), nw = gridDim.x * 4;
    const int kb = K / 32, nitem = (N / 64) * kb;
    for (int t = (gw + nw - (cursor % nw)) % nw; t < nitem; t += nw) {
        const int k0 = (t % kb) * 32, n = (t / kb) * 64 + lane;
        const int sc = colmap(mode, n);
        float e[32];
#pragma unroll
        for (int r = 0; r < 32; ++r) e[r] = sc >= 0 ? src[(size_t)(k0 + r) * ldsrc + sc] : 0.f;
#pragma unroll
        for (int q = 0; q < 4; ++q) { u32x4 w; w.x = cvt_pk_bf16(e[8 * q], e[8 * q + 1]); w.y = cvt_pk_bf16(e[8 * q + 2], e[8 * q + 3]); w.z = cvt_pk_bf16(e[8 * q + 4], e[8 * q + 5]); w.w = cvt_pk_bf16(e[8 * q + 6], e[8 * q + 7]);
            *(u32x4*)(dst + (size_t)n * K + k0 + 8 * q) = w; }
    }
    cursor += nitem;
}

struct SsmIn { const float *a_re, *a_im, *b_re, *b_im, *c_re, *c_im, *log_dt; };
DEV void lb_pow(const SsmIn& s, int g, int n, float p, float& re, float& im) {
    const float lre = fminf(s.a_re[g * 64 + n], -1e-4f), lim = s.a_im[g * 64 + n], dt = expf(s.log_dt[g]);
    const float mag = expf(lre * dt * p); float sn, cs; sincosf(lim * dt * p, &sn, &cs);
    re = mag * cs; im = mag * sn;
}
DEV void bbar(const SsmIn& s, int g, int n, int c, float& re, float& im) {
    const float lre = fminf(s.a_re[g * 64 + n], -1e-4f), lim = s.a_im[g * 64 + n], dt = expf(s.log_dt[g]);
    const float mag = expf(lre * dt); float sn, cs; sincosf(lim * dt, &sn, &cs);
    const float sh = sinf(0.5f * lim * dt);
    const float nr = expm1f(lre * dt) - mag * 2.f * sh * sh, lbi = mag * sn;
    const float den = lre * lre + lim * lim;
    const float fre = (nr * lre + lbi * lim) / den, fim = (lbi * lre - nr * lim) / den;
    const float br = s.b_re[(g * 64 + n) * 16 + c], bi = s.b_im[(g * 64 + n) * 16 + c];
    re = fre * br - fim * bi; im = fre * bi + fim * br;
}
DEV void ssm_prep(const SsmIn& s, bf16_t* BT1, bf16_t* MTW, unsigned char* lds) {
    const int tid = get_tid();
    float* pw = (float*)lds;
    float* bb = pw + 33 * 128;
    float* cc = bb + 2048;
    float* fn = cc + 2048;
    float* km = fn + 128;
    for (int job = get_bid(); job < 512; job += gridDim.x) {
        const int g = job >> 4, pt = job & 15;
        __syncthreads();
        for (int e = tid; e < 33 * 64; e += 256) { float pr, pi; lb_pow(s, g, e & 63, (float)(e >> 6), pr, pi); pw[e * 2] = pr; pw[e * 2 + 1] = pi; }
        if (tid < 64) {
            const int n = tid;
            const float lre = fminf(s.a_re[g * 64 + n], -1e-4f), lim = s.a_im[g * 64 + n], dt = expf(s.log_dt[g]);
            const float mag = expf(lre * dt); float sn, cs; sincosf(lim * dt, &sn, &cs);
            const float sh = sinf(0.5f * lim * dt);
            const float nr = expm1f(lre * dt) - mag * 2.f * sh * sh, lbi = mag * sn;
            const float den = lre * lre + lim * lim;
            fn[n * 2] = (nr * lre + lbi * lim) / den; fn[n * 2 + 1] = (lbi * lre - nr * lim) / den;
        }
        for (int e = tid; e < 1024; e += 256) { const int c = e >> 6, n = e & 63; cc[e * 2] = s.c_re[(g * 16 + c) * 64 + n]; cc[e * 2 + 1] = s.c_im[(g * 16 + c) * 64 + n]; }
        __syncthreads();
        for (int e = tid; e < 1024; e += 256) { const int n = e >> 4; const float fre = fn[n * 2], fim = fn[n * 2 + 1];
            const float br = s.b_re[(g * 64) * 16 + e], bi = s.b_im[(g * 64) * 16 + e];
            bb[e * 2] = fre * br - fim * bi; bb[e * 2 + 1] = fre * bi + fim * br; }
        __syncthreads();
        for (int i = tid; i < 4096; i += 256) { const int e = pt * 4096 + i, nn = e >> 9, kk = e & 511, n = nn & 63, sidx = kk >> 4, c = kk & 15;
            const float pr = pw[((31 - sidx) * 64 + n) * 2], pi = pw[((31 - sidx) * 64 + n) * 2 + 1], br = bb[(n * 16 + c) * 2], bi = bb[(n * 16 + c) * 2 + 1];
            BT1[(size_t)g * 65536 + e] = f2bf((nn >> 6) ? (pr * bi + pi * br) : (pr * br - pi * bi)); }
        for (int i = tid; i < 4096; i += 256) { const int e = pt * 4096 + i, nn = e & 127, r = e >> 7, n = nn & 63, tau = r >> 4, c = r & 15;
            const float pr = pw[((tau + 1) * 64 + n) * 2], pi = pw[((tau + 1) * 64 + n) * 2 + 1], cr = cc[(c * 64 + n) * 2], ci = cc[(c * 64 + n) * 2 + 1];
            MTW[((size_t)g * 512 + r) * 640 + 512 + nn] = f2bf((nn >> 6) ? -(cr * pi + ci * pr) : (cr * pr - ci * pi)); }
        for (int i = tid; i < 32 * 512; i += 256) { const int r = pt * 32 + (i >> 9), kk = i & 511; if ((kk >> 4) > (r >> 4)) MTW[((size_t)g * 512 + r) * 640 + kk] = 0; }
        for (int dd = 0; dd < 2; ++dd) { const int d = 2 * pt + dd, c = tid >> 4, c2 = tid & 15; float acc = 0.f;
            for (int n = 0; n < 64; ++n) { const float cr = cc[(c * 64 + n) * 2], ci = cc[(c * 64 + n) * 2 + 1], pr = pw[(d * 64 + n) * 2], pi = pw[(d * 64 + n) * 2 + 1];
                const float xr = cr * pr - ci * pi, xi = cr * pi + ci * pr; acc += xr * bb[(n * 16 + c2) * 2] - xi * bb[(n * 16 + c2) * 2 + 1]; }
            km[dd * 256 + tid] = acc; }
        __syncthreads();
        for (int dd = 0; dd < 2; ++dd) { const int d = 2 * pt + dd; const bf16_t v = f2bf(km[dd * 256 + tid]); const int c = tid >> 4, c2 = tid & 15;
            for (int sidx = 0; sidx + d < 32; ++sidx) MTW[((size_t)g * 512 + (sidx + d) * 16 + c) * 640 + sidx * 16 + c2] = v; }
    }
    __syncthreads();
}
DEV void ssm_scan(const SsmIn& s, const float* SS, bf16_t* UH) {
    for (int idx = get_bid() * 256 + get_tid(); idx < 32768; idx += gridDim.x * 256) {
        const int n = idx & 63, b = (idx >> 6) & 15, g = idx >> 10;
        float ar, ai; lb_pow(s, g, n, 32.f, ar, ai);
        float hr = 0.f, hi = 0.f;
        const size_t row0 = (size_t)(g * 16 + b) * 64;
#pragma unroll 8
        for (int k = 0; k < 64; ++k) {
            UH[(row0 + k) * 640 + 512 + n] = f2bf(hr); UH[(row0 + k) * 640 + 576 + n] = f2bf(hi);
            const float sr = SS[(row0 + k) * 128 + n], si = SS[(row0 + k) * 128 + 64 + n];
            const float nr = ar * hr - ai * hi + sr, ni = ar * hi + ai * hr + si;
            hr = nr; hi = ni;
        }
    }
}

struct GemmP { const bf16_t* A; const bf16_t* Bt; int lda, ldb, MT, NT, KT, nbatch; };
#define GLAS __attribute__((address_space(3)))
template <int WM, class Addr, class Epi>
DEV void gemm_run(const GemmP p, const Addr ad, const Epi epi, unsigned char* lds_) {
    constexpr int TM = 32 * WM, ABYTES = TM * 64, STAGE = ABYTES + 8192, NST = (WM == 4) ? 4 : 3, NLA = WM / 2, NL = NLA + 2;
    GLAS unsigned char* lds = (GLAS unsigned char*)lds_;
    const int tid = get_tid(), lane = tid & 63, wid = __builtin_amdgcn_readfirstlane(tid >> 6), wr = wid >> 1, wc = wid & 1, l15 = lane & 15, quad = lane >> 4;
    const int G = gridDim.x;
    const int nx = (G % 8 == 0) ? 8 : 1, x = get_bid() % nx, jx = get_bid() / nx, stride = G / nx;
    const int MTT = p.MT / (WM / 4);
    const int SRtot = (p.nbatch * MTT) / 8, per = 8 * p.NT, KT = p.KT * 2;
    int offA[NLA], offB[2];
#pragma unroll
    for (int i = 0; i < NLA; ++i) { const int slot = (wid + 4 * i) * 64 + lane, row = slot >> 2, c = (slot & 3) ^ ((row >> 2) & 3); offA[i] = row * p.lda + c * 8; }
#pragma unroll
    for (int i = 0; i < 2; ++i) { const int slot = (wid + 4 * i) * 64 + lane, row = slot >> 2, c = (slot & 3) ^ ((row >> 2) & 3); offB[i] = row * p.ldb + c * 8; }
    const int swz = ((quad ^ (l15 >> 2)) & 3) * 16;
    const int aoff = (wr * (WM * 16) + l15) * 64 + swz, boff = ABYTES + (wc * 64 + l15) * 64 + swz;
    int ls = jx, lkt = 0; const bf16_t* lA = nullptr; const bf16_t* lB = nullptr; bool lvalid;
#define GEMM_DECODE_L() do { const int q_ = ls / per, rem_ = ls % per, sr_ = x + nx * q_; lvalid = sr_ < SRtot; if (lvalid) { const int R_ = sr_ * 8 + (rem_ & 7), b_ = R_ / MTT; \
        lA = p.A + ad.a_off(b_) + (size_t)((R_ % MTT) * TM) * p.lda; lB = p.Bt + ad.b_off(b_) + (size_t)((rem_ >> 3) * 128) * p.ldb; } } while (0)
#define GEMM_ISSUE(stg) do { _Pragma("unroll") for (int i_ = 0; i_ < NLA; ++i_) \
        __builtin_amdgcn_global_load_lds((const unsigned*)(lA + offA[i_] + lkt * 32), (GLAS unsigned*)(lds + (stg) * STAGE + (wid + 4 * i_) * 1024), 16, 0, 0); \
        _Pragma("unroll") for (int i_ = 0; i_ < 2; ++i_) \
        __builtin_amdgcn_global_load_lds((const unsigned*)(lB + offB[i_] + lkt * 32), (GLAS unsigned*)(lds + (stg) * STAGE + ABYTES + (wid + 4 * i_) * 1024), 16, 0, 0); \
        ++issued; if (++lkt == KT) { lkt = 0; ls += stride; GEMM_DECODE_L(); } } while (0)
    GEMM_DECODE_L();
    int issued = 0;
    asm volatile("s_waitcnt vmcnt(0)" ::: "memory");
    __syncthreads();
#pragma unroll 1
    for (int t = 0; t < NST - 1; ++t) if (lvalid) GEMM_ISSUE(t);
    f32x4 acc[WM][4];
#pragma unroll
    for (int i = 0; i < WM; ++i)
#pragma unroll
        for (int j = 0; j < 4; ++j) acc[i][j] = (f32x4){0.f, 0.f, 0.f, 0.f};
    int cs = jx, ckt = 0, cst = 0; bool drain = false;
#pragma unroll 1
    for (int it = 0; it < issued; ++it) {
        const int y = issued - it - 1;
        if (drain || y == 0) asm volatile("s_waitcnt vmcnt(0)" ::: "memory");
        else if (WM == 4) { if (y == 1) asm volatile("s_waitcnt vmcnt(4)" ::: "memory"); else asm volatile("s_waitcnt vmcnt(8)" ::: "memory"); }
        else asm volatile("s_waitcnt vmcnt(6)" ::: "memory");
        drain = false;
        __builtin_amdgcn_s_barrier();
        asm volatile("" ::: "memory");
        { const int nst = cst == 0 ? NST - 1 : cst - 1;
          if (lvalid) GEMM_ISSUE(nst); }
        asm volatile("" ::: "memory");
        const GLAS unsigned char* st = lds + cst * STAGE;
        cst = cst + 1 == NST ? 0 : cst + 1;
        bf16x8 af[WM], bfr[4];
#pragma unroll
        for (int i = 0; i < 4; ++i) bfr[i] = *(const GLAS bf16x8*)(st + boff + i * 1024);
#pragma unroll
        for (int i = 0; i < WM; ++i) af[i] = *(const GLAS bf16x8*)(st + aoff + i * 1024);
#pragma unroll
        for (int mi = 0; mi < WM; ++mi)
#pragma unroll
            for (int ni = 0; ni < 4; ++ni) acc[mi][ni] = __builtin_amdgcn_mfma_f32_16x16x32_bf16(bfr[ni], af[mi], acc[mi][ni], 0, 0, 0);
        if (++ckt == KT) {
            const int q_ = cs / per, rem_ = cs % per, R_ = (x + nx * q_) * 8 + (rem_ & 7);
#pragma unroll
            for (int h = 0; h < WM / 4; ++h)
                epi(reinterpret_cast<const f32x4 (&)[4][4]>(acc[4 * h]), R_ / MTT, (R_ % MTT) * TM + wr * (WM * 16) + h * 64, (rem_ >> 3) * 128 + wc * 64, l15, quad);
#pragma unroll
            for (int i = 0; i < WM; ++i)
#pragma unroll
                for (int j = 0; j < 4; ++j) acc[i][j] = (f32x4){0.f, 0.f, 0.f, 0.f};
            ckt = 0; cs += stride; drain = true;
        }
    }
    asm volatile("s_waitcnt vmcnt(0) lgkmcnt(0)" ::: "memory");
    __syncthreads();
#undef GEMM_DECODE_L
#undef GEMM_ISSUE
}
struct AddrNone { DEV size_t a_off(int) const { return 0; } DEV size_t b_off(int) const { return 0; } };
struct AddrStride { size_t as, bs; DEV size_t a_off(int b) const { return as * b; } DEV size_t b_off(int b) const { return bs * b; } };
struct AddrCmp1 { DEV size_t a_off(int b) const { return (size_t)b * 2048 * 64; } DEV size_t b_off(int b) const { return (size_t)((b >> 2) & 1) * 256 * 2048; } };
struct AddrCmp2 { DEV size_t a_off(int b) const { return (size_t)b * 128 * 256; } DEV size_t b_off(int b) const { return (size_t)((b >> 2) & 1) * 128 * 256; } };

#define EPI_ARGS const f32x4 (&acc)[4][4], int batch, int m0, int n0, int l15, int quad
struct EpiIn {
    bf16_t *UH, *Qb, *KVC, *KS, *VST, *KW, *VWT, *GM; float* GN;
    DEV void operator()(EPI_ARGS) const {
#pragma unroll
        for (int mi = 0; mi < 4; ++mi) {
            const int t = m0 + mi * 16 + l15, b = t >> 11, tt = t & 2047;
#pragma unroll
            for (int ni = 0; ni < 4; ++ni) {
                const f32x4 v = acc[mi][ni];
                const int c = n0 + ni * 16 + quad * 4;
                if (n0 < 512) {
                    const int g = c >> 4;
                    st_bf4(UH + ((size_t)((g * 16 + b) * 64 + (tt >> 5))) * 640 + (tt & 31) * 16 + (c & 15), v[0], v[1], v[2], v[3]);
                } else if (n0 < 1536) {
                    const float sc = 0.125f * LOG2E;
                    st_bf4(Qb + (size_t)t * 1024 + (c - 512), v[0] * sc, v[1] * sc, v[2] * sc, v[3] * sc);
                } else if (n0 < 2048) {
                    const int cc = c - 1536, z = cc >> 8, h = (cc >> 6) & 3, d = cc & 63;
                    st_bf4(KVC + ((size_t)(((b * 2 + z) * 4 + h) * 2048 + tt)) * 64 + d, v[0], v[1], v[2], v[3]);
                } else if (n0 < 3072) {
                    const int cc = (c - 2048) & 511, isw = (c - 2048) >> 9, h = (cc >> 6) & 3, d = cc & 63;
                    if (cc < 256) st_bf4((isw ? KW : KS) + ((size_t)((b * 4 + h) * 2048 + tt)) * 64 + d, v[0], v[1], v[2], v[3]);
                    else { bf16_t* o = (isw ? VWT : VST) + ((size_t)((b * 4 + h) * 64 + d)) * 2048 + tt;
#pragma unroll
                        for (int i = 0; i < 4; ++i) o[(size_t)i * 2048] = f2bf(v[i]); }
                } else if (n0 < 5120) {
                    st_bf4(GM + (size_t)t * 2048 + (c - 3072), sigmoidf_(v[0]), sigmoidf_(v[1]), sigmoidf_(v[2]), sigmoidf_(v[3]));
                } else {
                    const int cc = c - 5120;
                    if (cc < 48) *(f32x4*)(GN + (size_t)t * 48 + cc) = (f32x4){sigmoidf_(v[0]), sigmoidf_(v[1]), sigmoidf_(v[2]), sigmoidf_(v[3])};
                }
            }
        }
    }
};
struct EpiXkv {
    bf16_t *XK, *XVT;
    DEV void operator()(EPI_ARGS) const {
#pragma unroll
        for (int mi = 0; mi < 4; ++mi) {
            const int r = m0 + mi * 16 + l15, b = r >> 8, m = r & 255;
#pragma unroll
            for (int ni = 0; ni < 4; ++ni) {
                const f32x4 v = acc[mi][ni]; const int c = n0 + ni * 16 + quad * 4;
                if (n0 < 1024) st_bf4(XK + (size_t)r * 1024 + c, v[0], v[1], v[2], v[3]);
                else { const int cc = c - 1024, h = cc >> 8, d = cc & 255; bf16_t* o = XVT + ((size_t)((b * 4 + h) * 256 + d)) * 256 + m;
#pragma unroll
                    for (int i = 0; i < 4; ++i) o[i * 256] = f2bf(v[i]); }
            }
        }
    }
};
struct EpiSsmA { float* SS;
    DEV void operator()(EPI_ARGS) const {
#pragma unroll
        for (int mi = 0; mi < 4; ++mi)
#pragma unroll
            for (int ni = 0; ni < 4; ++ni) *(f32x4*)(SS + ((size_t)batch * 1024 + m0 + mi * 16 + l15) * 128 + n0 + ni * 16 + quad * 4) = acc[mi][ni];
    }
};
struct EpiCmp1 { bf16_t* HID; const float* bias2;
    DEV void operator()(EPI_ARGS) const {
        const int z = (batch >> 2) & 1;
#pragma unroll
        for (int ni = 0; ni < 4; ++ni) {
            const int c = n0 + ni * 16 + quad * 4; const f32x4 bv = *(const f32x4*)(bias2 + z * 256 + c);
#pragma unroll
            for (int mi = 0; mi < 4; ++mi) { const f32x4 v = acc[mi][ni] + bv;
                st_bf4(HID + ((size_t)batch * 128 + m0 + mi * 16 + l15) * 256 + c, gelu_tanh(v[0]), gelu_tanh(v[1]), gelu_tanh(v[2]), gelu_tanh(v[3])); }
        }
    }
};
struct EpiCmp2 { bf16_t *KC, *VCT;
    DEV void operator()(EPI_ARGS) const {
        if (n0 >= 64) return;
        const int z = (batch >> 2) & 1, bh = (batch >> 3) * 4 + (batch & 3);
#pragma unroll
        for (int mi = 0; mi < 4; ++mi) { const int r = m0 + mi * 16 + l15;
#pragma unroll
            for (int ni = 0; ni < 4; ++ni) { const f32x4 v = acc[mi][ni]; const int c = n0 + ni * 16 + quad * 4;
                if (z == 0) st_bf4(KC + ((size_t)bh * 128 + r) * 64 + c, v[0], v[1], v[2], v[3]);
                else {
#pragma unroll
                    for (int i = 0; i < 4; ++i) VCT[((size_t)bh * 64 + c + i) * 128 + r] = f2bf(v[i]); } } }
    }
};
struct EpiSsmB { const bf16_t* UH; const float* dskip; bf16_t* GB;
    DEV void operator()(EPI_ARGS) const {
#pragma unroll
        for (int mi = 0; mi < 4; ++mi) { const int r = m0 + mi * 16 + l15, b = r >> 6, k = r & 63;
#pragma unroll
            for (int ni = 0; ni < 4; ++ni) { const int col = n0 + ni * 16 + quad * 4, tau = col >> 4, c = col & 15;
                const f32x4 u = ld_bf4(UH + ((size_t)batch * 1024 + r) * 640 + col);
                const f32x4 dv = *(const f32x4*)(dskip + batch * 16 + c);
                const f32x4 y = acc[mi][ni] + dv * u;
                st_bf4(GB + ((size_t)(b * 2048 + k * 32 + tau)) * 512 + batch * 16 + c, gelu_tanh(y[0]), gelu_tanh(y[1]), gelu_tanh(y[2]), gelu_tanh(y[3])); } }
    }
};
struct EpiGlu { const bf16_t* GB; const float* bglu; bf16_t* YS;
    DEV void operator()(EPI_ARGS) const {
#pragma unroll
        for (int ni = 0; ni < 4; ++ni) { const int c = n0 + ni * 16 + quad * 4; const f32x4 bv = *(const f32x4*)(bglu + c);
#pragma unroll
            for (int mi = 0; mi < 4; ++mi) { const size_t o = (size_t)(m0 + mi * 16 + l15) * 512 + c; const f32x4 g = ld_bf4(GB + o); const f32x4 v = acc[mi][ni] + bv;
                st_bf4(YS + o, g[0] * sigmoidf_(v[0]), g[1] * sigmoidf_(v[1]), g[2] * sigmoidf_(v[2]), g[3] * sigmoidf_(v[3])); } }
    }
};
struct EpiSout { const bf16_t* GM; bf16_t* P1;
    DEV void operator()(EPI_ARGS) const {
#pragma unroll
        for (int mi = 0; mi < 4; ++mi) { const size_t t = m0 + mi * 16 + l15;
#pragma unroll
            for (int ni = 0; ni < 4; ++ni) { const int c = n0 + ni * 16 + quad * 4; const f32x4 g = ld_bf4(GM + t * 2048 + c); const f32x4 v = acc[mi][ni] * g;
                st_bf4(P1 + t * 1024 + c, v[0], v[1], v[2], v[3]); } }
    }
};
struct EpiNout { const bf16_t* GM; const bf16_t* P1; bf16_t* MIX;
    DEV void operator()(EPI_ARGS) const {
#pragma unroll
        for (int mi = 0; mi < 4; ++mi) { const size_t t = m0 + mi * 16 + l15;
#pragma unroll
            for (int ni = 0; ni < 4; ++ni) { const int c = n0 + ni * 16 + quad * 4; const f32x4 g = ld_bf4(GM + t * 2048 + 1024 + c); const f32x4 v = acc[mi][ni] * g + ld_bf4(P1 + t * 1024 + c);
                st_bf4(MIX + t * 1024 + c, v[0], v[1], v[2], v[3]); } }
    }
};
struct EpiRes { const float* src; const float* stats; const float* g; const float* b; float* dst;
    DEV void operator()(EPI_ARGS) const {
#pragma unroll
        for (int mi = 0; mi < 4; ++mi) { const size_t t = m0 + mi * 16 + l15; const float mu = stats[t * 2], rs = stats[t * 2 + 1];
#pragma unroll
            for (int ni = 0; ni < 4; ++ni) { const int c = n0 + ni * 16 + quad * 4;
                const f32x4 xv = *(const f32x4*)(src + t * 1024 + c), gg = *(const f32x4*)(g + c), bb = *(const f32x4*)(b + c);
                *(f32x4*)(dst + t * 1024 + c) = ((xv - mu) * rs * gg + bb) * ALPHA + acc[mi][ni]; } }
    }
};
struct EpiScaleBf { bf16_t* O; int ldc; float sc;
    DEV void operator()(EPI_ARGS) const {
#pragma unroll
        for (int mi = 0; mi < 4; ++mi)
#pragma unroll
            for (int ni = 0; ni < 4; ++ni) { const f32x4 v = acc[mi][ni] * sc; st_bf4(O + (size_t)(m0 + mi * 16 + l15) * ldc + n0 + ni * 16 + quad * 4, v[0], v[1], v[2], v[3]); }
    }
};
struct EpiFfnIn { bf16_t* FB;
    DEV void operator()(EPI_ARGS) const {
#pragma unroll
        for (int mi = 0; mi < 4; ++mi) { const size_t t = m0 + mi * 16 + l15;
#pragma unroll
            for (int pp = 0; pp < 2; ++pp) { const f32x4 ga = acc[mi][2 * pp], up = acc[mi][2 * pp + 1]; const int j = (n0 + pp * 32) / 2 + quad * 4;
                st_bf4(FB + t * 2816 + j, ga[0] * sigmoidf_(ga[0]) * up[0], ga[1] * sigmoidf_(ga[1]) * up[1], ga[2] * sigmoidf_(ga[2]) * up[2], ga[3] * sigmoidf_(ga[3]) * up[3]); } }
    }
};

DEV float qmax(float v) { v = fmaxf(v, __shfl_xor(v, 16)); return fmaxf(v, __shfl_xor(v, 32)); }
DEV float qsum(float v) { v += __shfl_xor(v, 16); return v + __shfl_xor(v, 32); }
DEV bf16x8 pack_p(const f32x4& a, const f32x4& b) { u32x4 w; w.x = cvt_pk_bf16(a[0], a[1]); w.y = cvt_pk_bf16(a[2], a[3]); w.z = cvt_pk_bf16(b[0], b[1]); w.w = cvt_pk_bf16(b[2], b[3]); return __builtin_bit_cast(bf16x8, w); }
DEV void st_vt(unsigned char* rowbase, int e, const u32x4& v) {
    const int grp = e >> 2, ep = e & 3, a = ep >> 1, qp = (ep & 1) * 2;
    unsigned char* o = rowbase + grp * 64 + (qp * 8 + a * 4) * 2;
    *(u32x2*)o = (u32x2){v.x, v.y}; *(u32x2*)(o + 16) = (u32x2){v.z, v.w};
}

struct NsaCtx { const bf16_t *Qb, *KC, *VCT, *KS, *VST, *KW, *VWT; const float* GN; bf16_t* ON; };
constexpr float MINIT = -1e20f;

template <int MODE, bool BOUND>
DEV void nsa_tile(const unsigned char* Kl, const unsigned char* Vl, const bf16x8 (&Qf)[2][2], f32x4 (&O)[2][4], float (&m)[2], float (&l)[2],
                  const float (&slope)[2], int dist0, bool sel, int l15, int quad) {
    const float d0f = (float)dist0;
#pragma unroll
    for (int g = 0; g < 2; ++g) {
        f32x4 S[4];
#pragma unroll
        for (int kt = 0; kt < 4; ++kt) { S[kt] = (f32x4){0.f, 0.f, 0.f, 0.f};
#pragma unroll
            for (int ks = 0; ks < 2; ++ks) { const bf16x8 kf = *(const bf16x8*)(Kl + (kt * 16 + l15) * 144 + ks * 64 + quad * 16); S[kt] = __builtin_amdgcn_mfma_f32_16x16x32_bf16(kf, Qf[g][ks], S[kt], 0, 0, 0); } }
        float base = -slope[g] * d0f;
        if (MODE == 0) base = sel ? base : NEG;
        float tmax = NEG;
#pragma unroll
        for (int kt = 0; kt < 4; ++kt)
#pragma unroll
            for (int i = 0; i < 4; ++i) { const int cc = 16 * kt + i;
                float s = fmaf(slope[g], (float)cc, S[kt][i] + base);
                if (BOUND) { bool v = cc <= dist0; if (MODE == 1) v = v && (cc > dist0 - 512); s = v ? s : NEG; }
                S[kt][i] = s; tmax = fmaxf(tmax, s); }
        tmax = qmax(tmax);
        const float mnew = fmaxf(m[g], tmax), alpha = fexp2(m[g] - mnew);
        float rs = 0.f;
#pragma unroll
        for (int kt = 0; kt < 4; ++kt)
#pragma unroll
            for (int i = 0; i < 4; ++i) { const float pv = fexp2(S[kt][i] - mnew); S[kt][i] = pv; rs += pv; }
        rs = qsum(rs);
        l[g] = l[g] * alpha + rs; m[g] = mnew;
        const bf16x8 P0 = pack_p(S[0], S[1]), P1 = pack_p(S[2], S[3]);
#pragma unroll
        for (int dt = 0; dt < 4; ++dt) { O[g][dt] = O[g][dt] * alpha;
            const bf16x8 v0 = *(const bf16x8*)(Vl + (dt * 16 + l15) * 144 + quad * 16), v1 = *(const bf16x8*)(Vl + (dt * 16 + l15) * 144 + 64 + quad * 16);
            O[g][dt] = __builtin_amdgcn_mfma_f32_16x16x32_bf16(v0, P0, O[g][dt], 0, 0, 0);
            O[g][dt] = __builtin_amdgcn_mfma_f32_16x16x32_bf16(v1, P1, O[g][dt], 0, 0, 0); }
    }
}

template <int MODE>
DEV void nsa_tiles(unsigned char* lds, const bf16_t* Kg, const bf16_t* VTg, unsigned tilemask, unsigned wmask, unsigned qmask, int jb0, int jb1,
                   const bf16x8 (&Qf)[2][2], f32x4 (&O)[2][4], float (&m)[2], float (&l)[2], const float (&slope)[2], int tq, int l15, int quad) {
    const int tid = get_tid();
    const int prow = tid >> 3, pe = tid & 7;
    unsigned rem = tilemask;
    int j = __builtin_ctz(rem); rem &= rem - 1;
    u32x4 rk[2], rv[2];
#pragma unroll
    for (int i = 0; i < 2; ++i) { rk[i] = *(const u32x4*)(Kg + (size_t)(64 * j + prow + 32 * i) * 64 + pe * 8); rv[i] = *(const u32x4*)(VTg + (size_t)(prow + 32 * i) * 2048 + 64 * j + pe * 8); }
    int cur = 0;
#pragma unroll
    for (int i = 0; i < 2; ++i) { *(u32x4*)(lds + (prow + 32 * i) * 144 + pe * 16) = rk[i]; st_vt(lds + 9216 + (prow + 32 * i) * 144, pe, rv[i]); }
    __syncthreads();
    for (;;) {
        int jn = -1;
        if (rem) { jn = __builtin_ctz(rem); rem &= rem - 1;
#pragma unroll
            for (int i = 0; i < 2; ++i) { rk[i] = *(const u32x4*)(Kg + (size_t)(64 * jn + prow + 32 * i) * 64 + pe * 8); rv[i] = *(const u32x4*)(VTg + (size_t)(prow + 32 * i) * 2048 + 64 * jn + pe * 8); } }
        const unsigned char* st = lds + cur * 18432;
        if (MODE == 1 || ((wmask >> j) & 1u)) {
            const int dist0 = tq - 64 * j - 4 * quad; const bool sel = (qmask >> j) & 1u;
            if (j == jb0 || j == jb1) nsa_tile<MODE, true>(st, st + 9216, Qf, O, m, l, slope, dist0, sel, l15, quad);
            else nsa_tile<MODE, false>(st, st + 9216, Qf, O, m, l, slope, dist0, sel, l15, quad);
        }
        if (jn >= 0) { unsigned char* sn = lds + (cur ^ 1) * 18432;
#pragma unroll
            for (int i = 0; i < 2; ++i) { *(u32x4*)(sn + (prow + 32 * i) * 144 + pe * 16) = rk[i]; st_vt(sn + 9216 + (prow + 32 * i) * 144, pe, rv[i]); } }
        __syncthreads();
        if (jn < 0) break;
        j = jn; cur ^= 1;
    }
}

DEV void nsa_unit(const NsaCtx& c, int b, int hkv, int qb32, unsigned char* lds) {
    const int tid = get_tid(), lane = tid & 63, wid = tid >> 6, l15 = lane & 15, quad = lane >> 4;
    const int qs = wid & 1, hp = wid >> 1;
    const int tq = qb32 * 32 + qs * 16 + l15, cur = qb32 >> 1;
    const size_t trow = (size_t)b * 2048 + tq;
    const int head0 = hkv * 4 + hp * 2;
    const float* gnp = c.GN + trow * 48 + head0 * 3;
    unsigned char* stash = lds + 36864 + wid * 4096;
    float* xch = (float*)(lds + 53248);
    unsigned* smask = (unsigned*)(lds + 69632);
    const int bh = b * 4 + hkv;
    {
        const bf16_t* Kg = c.KC + (size_t)bh * 128 * 64; const bf16_t* Vg = c.VCT + (size_t)bh * 64 * 128;
#pragma unroll
        for (int i = 0; i < 4; ++i) { const int pc = tid + 256 * i;
            *(u32x4*)(lds + (pc >> 3) * 144 + (pc & 7) * 16) = *(const u32x4*)(Kg + pc * 8);
            st_vt(lds + 18432 + (pc >> 4) * 272, pc & 15, *(const u32x4*)(Vg + pc * 8)); }
    }
    __syncthreads();
    const int nkt = (2 * qb32) / 16 + 1;
    float Mx[8], Sm[8];
#pragma unroll
    for (int kt = 0; kt < 8; ++kt) { Mx[kt] = NEG; Sm[kt] = 0.f; }
#ifdef NSA_NO_CMP
    for (int g = 0; g < 0; ++g) {
#else
#pragma unroll 1
    for (int g = 0; g < 2; ++g) {
#endif
        bf16x8 Qg[2];
#pragma unroll
        for (int ks = 0; ks < 2; ++ks) Qg[ks] = *(const bf16x8*)(c.Qb + trow * 1024 + (head0 + g) * 64 + ks * 32 + quad * 8);
        const float slope_g = exp2f(-0.5f * (float)(head0 + g + 1)) * LOG2E;
        f32x4 S[8];
#pragma unroll
        for (int kt = 0; kt < 8; ++kt) { S[kt] = (f32x4){0.f, 0.f, 0.f, 0.f};
            if (kt < nkt) {
#pragma unroll
                for (int ks = 0; ks < 2; ++ks) { const bf16x8 kf = *(const bf16x8*)(lds + (kt * 16 + l15) * 144 + ks * 64 + quad * 16); S[kt] = __builtin_amdgcn_mfma_f32_16x16x32_bf16(kf, Qg[ks], S[kt], 0, 0, 0); } } }
        float mx = NEG;
        const int d0 = tq - 31 - 64 * quad; const float base = -slope_g * (float)d0;
#pragma unroll
        for (int kt = 0; kt < 8; ++kt)
#pragma unroll
            for (int i = 0; i < 4; ++i) { const int cc = 256 * kt + 16 * i; const float s = (kt < nkt && cc <= d0) ? fmaf(slope_g, (float)cc, S[kt][i] + base) : NEG; S[kt][i] = s; mx = fmaxf(mx, s); }
        mx = qmax(mx);
        float ls = 0.f;
#pragma unroll
        for (int kt = 0; kt < 8; ++kt)
#pragma unroll
            for (int i = 0; i < 4; ++i) ls += S[kt][i] > -1e29f ? fexp2(S[kt][i] - mx) : 0.f;
        ls = qsum(ls);
        const float lcl = fmaxf(ls, 1e-30f), lg = __log2f(lcl) + mx;
        float x3[8];
#pragma unroll
        for (int kt = 0; kt < 8; ++kt) {
#pragma unroll
            for (int i = 0; i < 4; ++i) S[kt][i] = S[kt][i] > -1e29f ? S[kt][i] - lg : NEG;
            x3[kt] = __shfl(S[kt][3], (lane + 48) & 63);
        }
#pragma unroll
        for (int kt = 0; kt < 8; ++kt) {
            const float nb = quad >= 1 ? x3[kt] : (kt >= 1 ? x3[kt >= 1 ? kt - 1 : 0] : NEG);
            const float tm = fmaxf(fmaxf(fmaxf(S[kt][0], S[kt][1]), fmaxf(S[kt][2], S[kt][3])), nb);
            const float nm = fmaxf(Mx[kt], tm);
            Sm[kt] = Sm[kt] * fexp2(Mx[kt] - nm) + fexp2(S[kt][0] - nm) + fexp2(S[kt][1] - nm) + fexp2(S[kt][2] - nm) + fexp2(S[kt][3] - nm) + fexp2(nb - nm);
            Mx[kt] = nm;
        }
        const float gate0 = gnp[g * 3];
        f32x4 Oc[4];
#pragma unroll
        for (int dt = 0; dt < 4; ++dt) Oc[dt] = (f32x4){0.f, 0.f, 0.f, 0.f};
#pragma unroll
        for (int k2 = 0; k2 < 4; ++k2) {
            if (2 * k2 < nkt) {
                f32x4 pa, pb;
#pragma unroll
                for (int i = 0; i < 4; ++i) { pa[i] = fexp2(S[2 * k2][i]); pb[i] = fexp2(S[2 * k2 + 1][i]); }
                const bf16x8 pf = pack_p(pa, pb);
#pragma unroll
                for (int dt = 0; dt < 4; ++dt) { const bf16x8 vf = *(const bf16x8*)(lds + 18432 + (dt * 16 + l15) * 272 + k2 * 64 + quad * 16); Oc[dt] = __builtin_amdgcn_mfma_f32_16x16x32_bf16(vf, pf, Oc[dt], 0, 0, 0); }
            }
        }
#pragma unroll
        for (int dt = 0; dt < 4; ++dt) { const f32x4 v = Oc[dt] * gate0; u32x2 w; w.x = cvt_pk_bf16(v[0], v[1]); w.y = cvt_pk_bf16(v[2], v[3]); *(u32x2*)(stash + ((g * 4 + dt) * 64 + lane) * 8) = w; }
    }
    unsigned qmask;
    if (cur < 8) qmask = (2u << cur) - 1u;
    if (cur >= 8) {
#pragma unroll
        for (int kt = 0; kt < 8; ++kt) { xch[(wid * 16 + kt) * 64 + lane] = Mx[kt]; xch[(wid * 16 + 8 + kt) * 64 + lane] = Sm[kt]; }
    }
    __syncthreads();
    if (cur >= 8) {
        float v[8];
#pragma unroll
        for (int kt = 0; kt < 8; ++kt) {
            const float m2 = xch[((wid ^ 2) * 16 + kt) * 64 + lane], s2 = xch[((wid ^ 2) * 16 + 8 + kt) * 64 + lane];
            const float mm = fmaxf(Mx[kt], m2), ss = Sm[kt] * fexp2(Mx[kt] - mm) + s2 * fexp2(m2 - mm);
            const int jb = 4 * kt + quad; v[kt] = (jb >= 1 && jb <= cur - 2) ? mm + __log2f(ss) : -3e38f; }
        qmask = 1u | (1u << cur) | (1u << (cur - 1));
        for (int r = 0; r < 5; ++r) {
            float bv = v[0]; int bj = quad;
#pragma unroll
            for (int kt = 1; kt < 8; ++kt) if (v[kt] > bv) { bv = v[kt]; bj = 4 * kt + quad; }
#pragma unroll
            for (int o = 16; o <= 32; o <<= 1) { const float ov = __shfl_xor(bv, o); const int oj = __shfl_xor(bj, o); if (ov > bv || (ov == bv && oj < bj)) { bv = ov; bj = oj; } }
            qmask |= 1u << bj;
#pragma unroll
            for (int kt = 0; kt < 8; ++kt) if (4 * kt + quad == bj) v[kt] = -3.2e38f;
        }
    }
    unsigned wmask = qmask;
#pragma unroll
    for (int o = 1; o <= 8; o <<= 1) wmask |= __shfl_xor(wmask, o);
    if (lane == 0) smask[wid] = wmask;
    __syncthreads();
    const unsigned umask = smask[0] | smask[1] | smask[2] | smask[3];
    bf16x8 Qf[2][2]; float slope[2];
#pragma unroll
    for (int g = 0; g < 2; ++g) {
#pragma unroll
        for (int ks = 0; ks < 2; ++ks) Qf[g][ks] = *(const bf16x8*)(c.Qb + trow * 1024 + (head0 + g) * 64 + ks * 32 + quad * 8);
        slope[g] = exp2f(-0.5f * (float)(head0 + g + 1)) * LOG2E;
    }
    f32x4 O[2][4]; float m[2], l[2];
#pragma unroll
    for (int g = 0; g < 2; ++g) { m[g] = MINIT; l[g] = 0.f;
#pragma unroll
        for (int dt = 0; dt < 4; ++dt) O[g][dt] = (f32x4){0.f, 0.f, 0.f, 0.f}; }
#ifndef NSA_NO_SLC
    nsa_tiles<0>(lds, c.KS + (size_t)bh * 2048 * 64, c.VST + (size_t)bh * 64 * 2048, umask, wmask, qmask, cur, cur, Qf, O, m, l, slope, tq, l15, quad);
#endif
#pragma unroll
    for (int g = 0; g < 2; ++g) { const float sc = gnp[g * 3 + 1] / fmaxf(l[g], 1e-30f);
#pragma unroll
        for (int dt = 0; dt < 4; ++dt) { u32x2* sp = (u32x2*)(stash + ((g * 4 + dt) * 64 + lane) * 8); const u32x2 w = *sp;
            const f32x4 v = O[g][dt] * sc + (f32x4){bflo(w.x), bfhi(w.x), bflo(w.y), bfhi(w.y)};
            u32x2 w2; w2.x = cvt_pk_bf16(v[0], v[1]); w2.y = cvt_pk_bf16(v[2], v[3]); *sp = w2;
            O[g][dt] = (f32x4){0.f, 0.f, 0.f, 0.f}; }
        m[g] = MINIT; l[g] = 0.f; }
    const int t0 = qb32 * 32;
    const int jlo = t0 >= 511 ? (t0 - 511) >> 6 : 0;
    const unsigned winmask = ((2u << cur) - 1u) & ~((1u << jlo) - 1u);
#ifndef NSA_NO_WIN
    nsa_tiles<1>(lds, c.KW + (size_t)bh * 2048 * 64, c.VWT + (size_t)bh * 64 * 2048, winmask, 0u, 0u, cur, jlo, Qf, O, m, l, slope, tq, l15, quad);
#endif
#pragma unroll
    for (int g = 0; g < 2; ++g) { const float sc = gnp[g * 3 + 2] / fmaxf(l[g], 1e-30f);
#pragma unroll
        for (int dt = 0; dt < 4; ++dt) { const u32x2 w = *(const u32x2*)(stash + ((g * 4 + dt) * 64 + lane) * 8);
            const f32x4 v = O[g][dt] * sc + (f32x4){bflo(w.x), bfhi(w.x), bflo(w.y), bfhi(w.y)};
            st_bf4(c.ON + trow * 1024 + (head0 + g) * 64 + dt * 16 + quad * 4, v[0], v[1], v[2], v[3]); } }
}

DEV void xattn_unit(const bf16_t* Qx, const bf16_t* XK, const bf16_t* XVT, bf16_t* OX, int b, int h, int qblk, unsigned char* lds) {
    const int tid = get_tid(), lane = tid & 63, wid = tid >> 6, l15 = lane & 15, quad = lane >> 4;
    const size_t trow = (size_t)b * 2048 + qblk * 64 + wid * 16 + l15;
    bf16x8 Qf[8];
#pragma unroll
    for (int ks = 0; ks < 8; ++ks) Qf[ks] = *(const bf16x8*)(Qx + trow * 1024 + h * 256 + ks * 32 + quad * 8);
    f32x4 O[16];
#pragma unroll
    for (int dt = 0; dt < 16; ++dt) O[dt] = (f32x4){0.f, 0.f, 0.f, 0.f};
    float m = NEG, l = 0.f;
    const bf16_t* Kg = XK + (size_t)b * 256 * 1024 + h * 256;
    const bf16_t* Vg = XVT + (size_t)(b * 4 + h) * 256 * 256;
    u32x4 rk[4], rv[4];
#pragma unroll
    for (int i = 0; i < 4; ++i) { const int pc = tid + 256 * i; rk[i] = *(const u32x4*)(Kg + (size_t)(pc >> 5) * 1024 + (pc & 31) * 8); rv[i] = *(const u32x4*)(Vg + (size_t)(pc >> 2) * 256 + (pc & 3) * 8); }
#pragma unroll
    for (int i = 0; i < 4; ++i) { const int pc = tid + 256 * i; *(u32x4*)(lds + (pc >> 5) * 528 + (pc & 31) * 16) = rk[i]; st_vt(lds + 16896 + (pc >> 2) * 80, pc & 3, rv[i]); }
    __syncthreads();
    for (int j = 0; j < 8; ++j) {
        const bool more = j + 1 < 8;
        if (more) {
#pragma unroll
            for (int i = 0; i < 4; ++i) { const int pc = tid + 256 * i; rk[i] = *(const u32x4*)(Kg + (size_t)(32 * (j + 1) + (pc >> 5)) * 1024 + (pc & 31) * 8); rv[i] = *(const u32x4*)(Vg + (size_t)(pc >> 2) * 256 + 32 * (j + 1) + (pc & 3) * 8); } }
        const unsigned char* st = lds + (j & 1) * 37376;
        f32x4 S[2];
#pragma unroll
        for (int kt = 0; kt < 2; ++kt) { S[kt] = (f32x4){0.f, 0.f, 0.f, 0.f};
#pragma unroll
            for (int ks = 0; ks < 8; ++ks) { const bf16x8 kf = *(const bf16x8*)(st + (kt * 16 + l15) * 528 + ks * 64 + quad * 16); S[kt] = __builtin_amdgcn_mfma_f32_16x16x32_bf16(kf, Qf[ks], S[kt], 0, 0, 0); } }
        float tmax = fmaxf(fmaxf(fmaxf(S[0][0], S[0][1]), fmaxf(S[0][2], S[0][3])), fmaxf(fmaxf(S[1][0], S[1][1]), fmaxf(S[1][2], S[1][3])));
        tmax = qmax(tmax);
        const float mnew = fmaxf(m, tmax), alpha = fexp2(m - mnew);
        float rs = 0.f;
#pragma unroll
        for (int kt = 0; kt < 2; ++kt)
#pragma unroll
            for (int i = 0; i < 4; ++i) { const float pv = fexp2(S[kt][i] - mnew); S[kt][i] = pv; rs += pv; }
        rs = qsum(rs); l = l * alpha + rs; m = mnew;
        const bf16x8 pf = pack_p(S[0], S[1]);
#pragma unroll
        for (int dt = 0; dt < 16; ++dt) { O[dt] = O[dt] * alpha; const bf16x8 vf = *(const bf16x8*)(st + 16896 + (dt * 16 + l15) * 80 + quad * 16); O[dt] = __builtin_amdgcn_mfma_f32_16x16x32_bf16(vf, pf, O[dt], 0, 0, 0); }
        if (more) { unsigned char* sn = lds + ((j + 1) & 1) * 37376;
#pragma unroll
            for (int i = 0; i < 4; ++i) { const int pc = tid + 256 * i; *(u32x4*)(sn + (pc >> 5) * 528 + (pc & 31) * 16) = rk[i]; st_vt(sn + 16896 + (pc >> 2) * 80, pc & 3, rv[i]); } }
        __syncthreads();
    }
    const float inv = 1.0f / l;
#pragma unroll
    for (int dt = 0; dt < 16; ++dt) { const f32x4 v = O[dt] * inv; st_bf4(OX + trow * 1024 + h * 256 + dt * 16 + quad * 4, v[0], v[1], v[2], v[3]); }
}


#define XB_TMO      128
#define XB_XCNT(j)  (256  + 64 * (j))
#define XB_XSUB(j)  (1280 + 64 * (j))
#define XB_XGEN(j)  (2304 + 64 * (j))
#define XB_TOP      3328
#define XB_TOPGEN   3392
#define XCD_BAR_WORDS 3456
#define XB_SPIN_CAP (1u << 18)
#define LAS __attribute__((address_space(3)))
DEV unsigned xb_ld(unsigned* p)              { return __hip_atomic_load(p, __ATOMIC_RELAXED, __HIP_MEMORY_SCOPE_AGENT); }
DEV unsigned xb_add(unsigned* p, unsigned v) { return __hip_atomic_fetch_add(p, v, __ATOMIC_RELAXED, __HIP_MEMORY_SCOPE_AGENT); }
DEV unsigned xb_xcc_id() { return (unsigned)__builtin_amdgcn_s_getreg((3 << 11) | 20) & 0xFu; }
#define XB_SPIN(cond, bar) do { unsigned _sp = 0; while (cond) { __builtin_amdgcn_s_sleep(1); \
    if ((++_sp & 255u) == 0u) { if (xb_ld(&(bar)[XB_TMO])) break; if (_sp > XB_SPIN_CAP) { atomicAdd(&(bar)[XB_TMO], 1u); break; } } } } while (0)
struct XcdBarrier { unsigned* bar; unsigned x; volatile LAS unsigned* st; };
DEV XcdBarrier xcd_barrier_post(unsigned* bar, volatile LAS unsigned* st) {
    XcdBarrier b; b.bar = bar; b.x = xb_xcc_id(); b.st = st;
    if (threadIdx.x == 0) (void)xb_add(&bar[XB_XCNT(b.x)], 1u);
    return b;
}
DEV void xcd_barrier_complete(unsigned* bar, unsigned x, unsigned& nloc, unsigned& nx) {
    const unsigned G = gridDim.x * gridDim.y * gridDim.z;
    unsigned sum, cnt, mine, sp = 0u;
    for (;;) {
        sum = 0u; cnt = 0u; mine = 0u;
#pragma unroll
        for (unsigned j = 0; j < 16; ++j) { const unsigned c = xb_ld(&bar[XB_XCNT(j)]); sum += c; cnt += (c > 0u) ? 1u : 0u; mine = (j == x) ? c : mine; }
        if (sum == G) break;
        __builtin_amdgcn_s_sleep(1);
        if ((++sp & 255u) == 0u) { if (xb_ld(&bar[XB_TMO])) break; if (sp > XB_SPIN_CAP) { atomicAdd(&bar[XB_TMO], 1u); break; } }
    }
    nloc = mine > 0u ? mine : 1u; nx = cnt > 0u ? cnt : 1u;
}
DEV void xcd_barrier(const XcdBarrier& b) {
    asm volatile("s_waitcnt vmcnt(0)" ::: "memory");
    __syncthreads();
    if (threadIdx.x == 0) {
        unsigned* bar = b.bar;
        __builtin_amdgcn_s_waitcnt(0);
        unsigned nloc = b.st[0], nx = b.st[1];
        if (nloc == 0u) { xcd_barrier_complete(bar, b.x, nloc, nx); b.st[0] = nloc; b.st[1] = nx; }
        const unsigned old = xb_add(&bar[XB_XSUB(b.x)], 1u);
        const unsigned gen = old / nloc;
        if (old + 1u == (gen + 1u) * nloc) {
            __builtin_amdgcn_fence(__ATOMIC_RELEASE, "agent");
            asm volatile("s_waitcnt vmcnt(0)" ::: "memory");
            const unsigned og = xb_add(&bar[XB_TOP], 1u);
            const unsigned tg = og / nx;
            if (og + 1u == (tg + 1u) * nx) xb_add(&bar[XB_TOPGEN], 1u);
            else XB_SPIN(xb_ld(&bar[XB_TOPGEN]) == tg, bar);
            __builtin_amdgcn_fence(__ATOMIC_ACQUIRE, "agent");
            xb_add(&bar[XB_XGEN(b.x)], 1u);
            asm volatile("s_waitcnt vmcnt(0)" ::: "memory");
        } else {
            XB_SPIN(xb_ld(&bar[XB_XGEN(b.x)]) == gen, bar);
            __builtin_amdgcn_fence(__ATOMIC_ACQUIRE, "agent");
            asm volatile("s_waitcnt vmcnt(0)" ::: "memory");
        }
    }
    __syncthreads();
}

constexpr int NPHASE = 17;
__global__ void __launch_bounds__(256, 2) fwd_kernel(P p) {
    extern __shared__ __attribute__((aligned(16))) unsigned char lds[];
#define WSB(off) ((bf16_t*)(ws + (off)))
#define WSF(off) ((float*)(ws + (off)))
    volatile LAS unsigned* bst = (volatile LAS unsigned*)(LAS unsigned char*)(lds + LDS_BYTES - 16);
    if (threadIdx.x == 0) { bst[0] = 0u; bst[1] = 0u; }
    __syncthreads();
    XcdBarrier gbar; gbar.bar = (unsigned*)(p.ws + O_BAR); gbar.x = 0; gbar.st = bst;
    if (p.coop) gbar = xcd_barrier_post((unsigned*)(p.ws + O_BAR), bst);
    const SsmIn sin_{p.in[5], p.in[6], p.in[7], p.in[8], p.in[9], p.in[10], p.in[12]};
    for (int ph = p.ph_lo; ph < p.ph_hi; ++ph) {
        size_t zoff = 0; asm volatile("" : "+s"(zoff)); unsigned char* ws = p.ws + zoff;
        switch (ph) {
#ifdef ONLY_PHASE
        default: break;
#define CASE(k) case (k): if ((k) != ONLY_PHASE) break; else
#else
#define CASE(k) case (k):
#endif
        CASE(0) {
            const int tid = get_tid();
            ln_pass(p.in[0], p.in[2], p.in[3], WSB(O_B), WSF(O_ST0), nullptr);
            int cur = 0;
            conv_job(p.in[4], 5168, 1024, 5376, WSB(O_WIN_T), 1, lds, cur);
            conv_job(p.in[13], 512, 512, 512, WSB(O_WGLU_T), 0, lds, cur);
            conv_job(p.in[15], 1024, 512, 1024, WSB(O_WSOUT_T), 0, lds, cur);
            conv_job(p.in[17], 256, 2048, 256, WSB(O_W1_T), 0, lds, cur);
            conv_job(p.in[17] + 2048 * 256, 256, 2048, 256, WSB(O_W1_T) + 256 * 2048, 0, lds, cur);
            conv_job(p.in[19], 64, 256, 128, WSB(O_W2_T), 3, lds, cur);
            conv_job(p.in[19] + 256 * 64, 64, 256, 128, WSB(O_W2_T) + 128 * 256, 3, lds, cur);
            conv_job(p.in[20], 1024, 1024, 1024, WSB(O_WNOUT_T), 0, lds, cur);
            conv_job(p.in[21], 1024, 1024, 1024, WSB(O_WOUT_T), 0, lds, cur);
            conv_job(p.in[24], 1024, 1024, 1024, WSB(O_WXQ_T), 0, lds, cur);
            conv_job(p.in[25], 2048, 1024, 2048, WSB(O_WXKV_T), 0, lds, cur);
            conv_job(p.in[26], 1024, 1024, 1024, WSB(O_WXO_T), 0, lds, cur);
            conv_job(p.in[29], 5632, 1024, 5632, WSB(O_WFIN_T), 2, lds, cur);
            conv_job(p.in[30], 1024, 2816, 1024, WSB(O_WFOUT_T), 0, lds, cur);
            for (int it = get_bid(); it < 128; it += gridDim.x) {
                const int z = it >> 6, ec = (it >> 4) & 3, fc = it & 15, e = ec * 64 + (tid & 63), fg = tid >> 6;
                float a = 0.f;
#pragma unroll 8
                for (int f = fc * 128 + fg * 32; f < fc * 128 + fg * 32 + 32; ++f) a += p.in[16][z * 2048 + f] * p.in[17][((size_t)z * 2048 + f) * 256 + e];
                float* red = (float*)lds;
                __syncthreads(); red[tid] = a; __syncthreads();
                if (tid < 64) WSF(O_BPART)[(z * 16 + fc) * 256 + e] = red[tid] + red[tid + 64] + red[tid + 128] + red[tid + 192];
                __syncthreads();
            }
            ssm_prep(sin_, WSB(O_BT1), WSB(O_MTW), lds);
        } break;
        CASE(1) {
            if (get_bid() == 0) { for (int e = get_tid(); e < 512; e += 256) { float a = p.in[18][e]; for (int fc = 0; fc < 16; ++fc) a += WSF(O_BPART)[((e >> 8) * 16 + fc) * 256 + (e & 255)]; WSF(O_BIAS2)[e] = a; } }
            { const GemmP g{WSB(O_B), WSB(O_WIN_T), 1024, 1024, 256, 42, 16, 1};
              const EpiIn e{WSB(O_UH), WSB(O_QB), WSB(O_KVC), WSB(O_KS), WSB(O_VST), WSB(O_KW), WSB(O_VWT), WSB(O_GM), WSF(O_GN)};
              gemm_run<8>(g, AddrNone{}, e, lds); }
        } break;
        CASE(2) {
            { const GemmP g{WSB(O_KVC), WSB(O_W1_T), 1024, 2048, 1, 2, 32, 128};
              const EpiCmp1 e{WSB(O_HID), WSF(O_BIAS2)};
              gemm_run<4>(g, AddrCmp1{}, e, lds); }
            { const GemmP g{WSB(O_UH), WSB(O_BT1), 640, 512, 8, 1, 8, 32};
              const EpiSsmA e{WSF(O_SS)};
              gemm_run<8>(g, AddrStride{1024ull * 640, 128ull * 512}, e, lds); }
        } break;
        CASE(3) {
            ssm_scan(sin_, WSF(O_SS), WSB(O_UH));
            { const GemmP g{WSB(O_HID), WSB(O_W2_T), 256, 256, 1, 1, 4, 128};
              const EpiCmp2 e{WSB(O_KC), WSB(O_VCT)};
              gemm_run<4>(g, AddrCmp2{}, e, lds); }
        } break;
        CASE(4) {
            const NsaCtx c{WSB(O_QB), WSB(O_KC), WSB(O_VCT), WSB(O_KS), WSB(O_VST), WSB(O_KW), WSB(O_VWT), WSF(O_GN), WSB(O_B)};
            const int G = gridDim.x;
            for (int i = 0;; ++i) {
                const int u = (i & 1) ? i * G + (G - 1 - get_bid()) : i * G + get_bid();
                if (i * G >= 4096) break;
                if (u < 4096) { const int qb32 = 63 - (u >> 6), bh = u & 63; nsa_unit(c, bh >> 2, bh & 3, qb32, lds); }
                __syncthreads();
            }
            { const GemmP g{WSB(O_UH), WSB(O_MTW), 640, 640, 8, 4, 10, 32};
              const EpiSsmB e{WSB(O_UH), p.in[11], WSB(O_GB)};
              gemm_run<8>(g, AddrStride{1024ull * 640, 512ull * 640}, e, lds); }
        } break;
        CASE(5) { const GemmP g{WSB(O_GB), WSB(O_WGLU_T), 512, 512, 256, 4, 8, 1}; const EpiGlu e{WSB(O_GB), p.in[14], WSB(O_YS)}; gemm_run<8>(g, AddrNone{}, e, lds); } break;
        CASE(6) { const GemmP g{WSB(O_YS), WSB(O_WSOUT_T), 512, 512, 256, 8, 8, 1}; const EpiSout e{WSB(O_GM), WSB(O_QB)}; gemm_run<8>(g, AddrNone{}, e, lds); } break;
        CASE(7) { const GemmP g{WSB(O_B), WSB(O_WNOUT_T), 1024, 1024, 256, 8, 16, 1}; const EpiNout e{WSB(O_GM), WSB(O_QB), WSB(O_MIXIN)}; gemm_run<8>(g, AddrNone{}, e, lds); } break;
        CASE(8) { const GemmP g{WSB(O_MIXIN), WSB(O_WOUT_T), 1024, 1024, 256, 8, 16, 1}; const EpiRes e{p.in[0], WSF(O_ST0), p.in[2], p.in[3], WSF(O_V1)}; gemm_run<8>(g, AddrNone{}, e, lds); } break;
        CASE(9) { ln_pass(WSF(O_V1), p.in[22], p.in[23], WSB(O_B), WSF(O_ST1), nullptr);
            for (size_t i = (size_t)get_bid() * 256 + get_tid(); i < 4096ull * 1024 / 4; i += (size_t)gridDim.x * 256) { const f32x4 v = ((const f32x4*)p.in[1])[i]; st_bf4(WSB(O_MEMB) + i * 4, v[0], v[1], v[2], v[3]); }
        } break;
        CASE(10) { { const GemmP g{WSB(O_B), WSB(O_WXQ_T), 1024, 1024, 256, 8, 16, 1}; const EpiScaleBf e{WSB(O_QB), 1024, 0.0625f * LOG2E}; gemm_run<8>(g, AddrNone{}, e, lds); }
            { const GemmP g{WSB(O_MEMB), WSB(O_WXKV_T), 1024, 1024, 32, 16, 16, 1};
              const EpiXkv e{WSB(O_XK), WSB(O_XVT)};
              gemm_run<8>(g, AddrNone{}, e, lds); }
        } break;
        CASE(11) {
            for (int u = get_bid(); u < 2048; u += gridDim.x) { const int qblk = u >> 6, bh = u & 63; xattn_unit(WSB(O_QB), WSB(O_XK), WSB(O_XVT), WSB(O_B), bh >> 2, bh & 3, qblk, lds); }
        } break;
        CASE(12) { const GemmP g{WSB(O_B), WSB(O_WXO_T), 1024, 1024, 256, 8, 16, 1}; const EpiRes e{WSF(O_V1), WSF(O_ST1), p.in[22], p.in[23], WSF(O_V2)}; gemm_run<8>(g, AddrNone{}, e, lds); } break;
        CASE(13) ln_pass(WSF(O_V2), p.in[27], p.in[28], WSB(O_B), WSF(O_ST2), nullptr); break;
        CASE(14) { const GemmP g{WSB(O_B), WSB(O_WFIN_T), 1024, 1024, 256, 44, 16, 1}; const EpiFfnIn e{WSB(O_FB)}; gemm_run<8>(g, AddrNone{}, e, lds); } break;
        CASE(15) { const GemmP g{WSB(O_FB), WSB(O_WFOUT_T), 2816, 2816, 256, 8, 44, 1}; const EpiRes e{WSF(O_V2), WSF(O_ST2), p.in[27], p.in[28], WSF(O_V2)}; gemm_run<8>(g, AddrNone{}, e, lds); } break;
        CASE(16) ln_pass(WSF(O_V2), p.in[31], p.in[32], nullptr, nullptr, p.out); break;
        }
        if (ph + 1 < p.ph_hi) { if (p.coop) xcd_barrier(gbar); if (p.pad == 0x5eed) cg::this_grid().sync(); }
    }
}

#ifndef ONE_LAUNCH
#define ONE_LAUNCH 1
#endif
extern "C" void kernel_launch(void* const* d_in, const int* in_sizes, int n_in, void* d_out, int out_size, void* d_ws, size_t ws_size, hipStream_t stream) {
    static int grid = 0;
    if (grid == 0) {
        if (n_in != 33 || out_size != T_ * 1024 || ws_size < WS_NEED) { fprintf(stderr, "kernel_launch: unexpected shapes (n_in %d out %d ws %zu need %zu)\n", n_in, out_size, ws_size, (size_t)WS_NEED); grid = -1; return; }
        int dev = 0, cus = 0, per_cu = 0;
        hipGetDevice(&dev);
        hipDeviceGetAttribute(&cus, hipDeviceAttributeMultiprocessorCount, dev);
        if (hipFuncSetAttribute((const void*)fwd_kernel, hipFuncAttributeMaxDynamicSharedMemorySize, LDS_BYTES) != hipSuccess) { fprintf(stderr, "kernel_launch: hipFuncSetAttribute failed\n"); grid = -1; return; }
        if (hipOccupancyMaxActiveBlocksPerMultiprocessor(&per_cu, (const void*)fwd_kernel, 256, LDS_BYTES) != hipSuccess || per_cu < 1) { fprintf(stderr, "kernel_launch: occupancy query failed (%d)\n", per_cu); per_cu = 1; (void)hipGetLastError(); }
        if (per_cu > 2) per_cu = 2;
        grid = cus * per_cu;
    }
    if (grid < 0) return;
    P p{};
    for (int i = 0; i < 33; ++i) p.in[i] = (const float*)d_in[i];
    p.out = (float*)d_out; p.ws = (unsigned char*)d_ws;
#if ONE_LAUNCH
    p.ph_lo = 0; p.ph_hi = NPHASE; p.coop = 1;
    if (hipMemsetAsync((unsigned char*)d_ws + O_BAR, 0, XCD_BAR_WORDS * 4, stream) != hipSuccess) { fprintf(stderr, "kernel_launch: memset of barrier words failed\n"); return; }
    void* args[] = {&p};
    hipError_t e = hipLaunchCooperativeKernel((const void*)fwd_kernel, dim3(grid), dim3(256), args, LDS_BYTES, stream);
    if (e != hipSuccess) fprintf(stderr, "cooperative launch failed: %s (grid %d)\n", hipGetErrorString(e), grid);
#else
#ifdef STOP_AFTER
    const int nrun = STOP_AFTER + 1;
#else
    const int nrun = NPHASE;
#endif
    for (int ph = 0; ph < nrun; ++ph) {
        p.ph_lo = ph; p.ph_hi = ph + 1; p.coop = 0;
        hipLaunchKernelGGL(fwd_kernel, dim3(grid), dim3(256), LDS_BYTES, stream, p);
    }
#endif
}
```

```cpp
#include <hip/hip_runtime.h>
#include <hip/hip_cooperative_groups.h>
#include <cstdio>
#include <cstdint>
namespace cg = cooperative_groups;

typedef unsigned short bf16_t;
typedef short bf16x8 __attribute__((ext_vector_type(8)));
typedef float f32x4 __attribute__((ext_vector_type(4)));
typedef unsigned u32x4 __attribute__((ext_vector_type(4)));
typedef unsigned u32x2 __attribute__((ext_vector_type(2)));
#define DEV __device__ __forceinline__

constexpr int T_ = 32768, L_ = 2048;
constexpr float LOG2E = 1.4426950408889634f;
constexpr float ALPHA = 1.189207115002721f;
constexpr float LN_EPS = 1e-5f;
constexpr float NEG = -1e30f;
constexpr int LDS_BYTES = 147456;
constexpr int NTHR = 512, NWAVE = 8;
constexpr size_t MiB = 1048576;

constexpr size_t O_WIN_T = 0;
constexpr size_t O_WGLU_T = O_WIN_T + 5376ull * 1024 * 2;
constexpr size_t O_WSOUT_T = O_WGLU_T + 512ull * 512 * 2;
constexpr size_t O_W1_T = O_WSOUT_T + 1024ull * 512 * 2;
constexpr size_t O_W2_T = O_W1_T + 2ull * 256 * 2048 * 2;
constexpr size_t O_WNOUT_T = O_W2_T + 2ull * 256 * 256 * 2;
constexpr size_t O_WOUT_T = O_WNOUT_T + 2 * MiB;
constexpr size_t O_WXQ_T = O_WOUT_T + 2 * MiB;
constexpr size_t O_WXKV_T = O_WXQ_T + 2 * MiB;
constexpr size_t O_WXO_T = O_WXKV_T + 4 * MiB;
constexpr size_t O_WFIN_T = O_WXO_T + 2 * MiB;
constexpr size_t O_WFOUT_T = O_WFIN_T + 5632ull * 1024 * 2;
constexpr size_t O_BT1 = O_WFOUT_T + 1024ull * 2816 * 2;
constexpr size_t O_MTW = O_BT1 + 8 * MiB;
constexpr size_t O_KC = O_MTW + 20 * MiB;
constexpr size_t O_VCT = O_KC + 1 * MiB;
constexpr size_t O_GN = O_VCT + 1 * MiB;
constexpr size_t O_ST0 = O_GN + 6 * MiB;
constexpr size_t O_ST1 = O_ST0 + 262144;
constexpr size_t O_ST2 = O_ST1 + 262144;
constexpr size_t O_BIAS2 = O_ST2 + 262144;
constexpr size_t O_BPART = O_BIAS2 + 4096;
constexpr size_t O_BAR = O_BPART + 32768;
constexpr size_t O_A = 81 * MiB;
constexpr size_t O_KVC = O_A;
constexpr size_t O_KS = O_A + 32 * MiB;
constexpr size_t O_VST = O_A + 48 * MiB;
constexpr size_t O_KW = O_A + 64 * MiB;
constexpr size_t O_VWT = O_A + 80 * MiB;
constexpr size_t O_GB = O_A + 96 * MiB;
constexpr size_t O_MIXIN = O_A;
constexpr size_t O_MEMB = O_A + 64 * MiB;
constexpr size_t O_XK = O_A + 72 * MiB;
constexpr size_t O_XVT = O_A + 80 * MiB;
constexpr size_t O_V2 = O_A;
constexpr size_t O_B = O_A + 128 * MiB;
constexpr size_t O_SS = O_B;
constexpr size_t O_HID = O_B + 16 * MiB;
constexpr size_t O_Y = O_B + 64 * MiB;
constexpr size_t O_GM = O_Y;
constexpr size_t O_V1 = O_Y;
constexpr size_t O_X = O_Y + 128 * MiB;
constexpr size_t O_QB = O_X;
constexpr size_t O_UH = O_X + 64 * MiB;
constexpr size_t O_YS = O_X + 64 * MiB;
constexpr size_t O_FB = O_Y;
constexpr size_t WS_NEED = O_X + 104 * MiB;
static_assert(O_BAR + 16384 <= O_A, "F region overflow");

struct P {
    const float* in[33];
    float* out;
    unsigned char* ws;
    int ph_lo, ph_hi, coop, pad;
};

DEV int get_tid() { int t = threadIdx.x; asm volatile("" : "+v"(t)); return t; }
DEV int get_bid() { int t = blockIdx.x; asm volatile("" : "+s"(t)); return t; }
typedef __bf16 bf2_t __attribute__((ext_vector_type(2)));
typedef float f32x2_t __attribute__((ext_vector_type(2)));
DEV unsigned cvt_pk_bf16(float lo, float hi) { const f32x2_t f = {lo, hi}; const bf2_t r = __builtin_convertvector(f, bf2_t); return __builtin_bit_cast(unsigned, r); }
DEV bf16_t f2bf(float v) { return (bf16_t)(cvt_pk_bf16(v, 0.f) & 0xffffu); }
DEV float bf2f(unsigned v) { return __uint_as_float(v << 16); }
DEV float bflo(unsigned w) { return __uint_as_float(w << 16); }
DEV float bfhi(unsigned w) { return __uint_as_float(w & 0xffff0000u); }
DEV float fexp2(float x) { return __builtin_amdgcn_exp2f(x); }
DEV float frcp(float x) { return __builtin_amdgcn_rcpf(x); }
DEV float sigmoidf_(float x) { return frcp(1.f + fexp2(-x * LOG2E)); }
DEV float gelu_tanh(float x) { const float u = 0.7978845608028654f * (x + 0.044715f * x * x * x); return x * frcp(1.f + fexp2(-2.f * LOG2E * u)); }
DEV void st_bf4(bf16_t* p, float a, float b, float c, float d) { u32x2 w; w.x = cvt_pk_bf16(a, b); w.y = cvt_pk_bf16(c, d); *(u32x2*)p = w; }
DEV f32x4 ld_bf4(const bf16_t* p) { const u32x2 w = *(const u32x2*)p; return (f32x4){bflo(w.x), bfhi(w.x), bflo(w.y), bfhi(w.y)}; }
DEV float wred_sum(float v) {
#pragma unroll
    for (int o = 32; o >= 1; o >>= 1) v += __shfl_xor(v, o);
    return v;
}

DEV void ln_pass(const float* src, const float* g, const float* b, bf16_t* dstb, float* stats, float* dstf) {
    const int lane = get_tid() & 63, wid = get_tid() >> 6;
    const int nw = gridDim.x * NWAVE;
    for (int row = get_bid() * NWAVE + wid; row < T_; row += nw) {
        const f32x4* p = (const f32x4*)(src + (size_t)row * 1024);
        f32x4 v[4];
#pragma unroll
        for (int i = 0; i < 4; ++i) v[i] = p[lane + 64 * i];
        float s = 0.f;
#pragma unroll
        for (int i = 0; i < 4; ++i) s += (v[i][0] + v[i][1]) + (v[i][2] + v[i][3]);
        s = wred_sum(s);
        const float mu = s * (1.f / 1024.f);
        float q = 0.f;
#pragma unroll
        for (int i = 0; i < 4; ++i) { const f32x4 d = v[i] - mu; q += (d[0] * d[0] + d[1] * d[1]) + (d[2] * d[2] + d[3] * d[3]); }
        q = wred_sum(q);
        const float rstd = 1.0f / sqrtf(q * (1.f / 1024.f) + LN_EPS);
        if (stats && lane == 0) { stats[row * 2] = mu; stats[row * 2 + 1] = rstd; }
#pragma unroll
        for (int i = 0; i < 4; ++i) {
            const int col = (lane + 64 * i) * 4;
            const f32x4 gg = *(const f32x4*)(g + col), bb = *(const f32x4*)(b + col);
            const f32x4 y = (v[i] - mu) * rstd * gg + bb;
            if (dstb) st_bf4(dstb + (size_t)row * 1024 + col, y[0], y[1], y[2], y[3]);
            if (dstf) *(f32x4*)(dstf + (size_t)row * 1024 + col) = y;
        }
    }
}

DEV int colmap(int mode, int n) {
    if (mode == 0) return n;
    if (mode == 1) return n < 3072 ? n : (n < 5120 ? n + 48 : (n < 5168 ? n - 5120 + 3072 : -1));
    if (mode == 2) { const int blk = n >> 5, r = n & 31; return r < 16 ? blk * 16 + r : 2816 + blk * 16 + (r - 16); }
    return n < 64 ? n : -1;
}
DEV void conv_job(const float* src, int ldsrc, int K, int N, bf16_t* dst, int mode, unsigned char* lds, int& cursor) {
    const int tid = get_tid(), lane = tid & 63, gw = get_bid() * NWAVE + (tid >> 6), nw = gridDim.x * NWAVE;
    const int kb = K / 32, nitem = (N / 64) * kb;
    for (int t = (gw + nw - (cursor % nw)) % nw; t < nitem; t += nw) {
        const int k0 = (t % kb) * 32, n = (t / kb) * 64 + lane;
        const int sc = colmap(mode, n);
        float e[32];
#pragma unroll
        for (int r = 0; r < 32; ++r) e[r] = sc >= 0 ? src[(size_t)(k0 + r) * ldsrc + sc] : 0.f;
#pragma unroll
        for (int q = 0; q < 4; ++q) { u32x4 w; w.x = cvt_pk_bf16(e[8 * q], e[8 * q + 1]); w.y = cvt_pk_bf16(e[8 * q + 2], e[8 * q + 3]); w.z = cvt_pk_bf16(e[8 * q + 4], e[8 * q + 5]); w.w = cvt_pk_bf16(e[8 * q + 6], e[8 * q + 7]);
            *(u32x4*)(dst + (size_t)n * K + k0 + 8 * q) = w; }
    }
    cursor += nitem;
}

struct SsmIn { const float *a_re, *a_im, *b_re, *b_im, *c_re, *c_im, *log_dt; };
DEV void lb_pow(const SsmIn& s, int g, int n, float p, float& re, float& im) {
    const float lre = fminf(s.a_re[g * 64 + n], -1e-4f), lim = s.a_im[g * 64 + n], dt = expf(s.log_dt[g]);
    const float mag = expf(lre * dt * p); float sn, cs; sincosf(lim * dt * p, &sn, &cs);
    re = mag * cs; im = mag * sn;
}
DEV void bbar(const SsmIn& s, int g, int n, int c, float& re, float& im) {
    const float lre = fminf(s.a_re[g * 64 + n], -1e-4f), lim = s.a_im[g * 64 + n], dt = expf(s.log_dt[g]);
    const float mag = expf(lre * dt); float sn, cs; sincosf(lim * dt, &sn, &cs);
    const float sh = sinf(0.5f * lim * dt);
    const float nr = expm1f(lre * dt) - mag * 2.f * sh * sh, lbi = mag * sn;
    const float den = lre * lre + lim * lim;
    const float fre = (nr * lre + lbi * lim) / den, fim = (lbi * lre - nr * lim) / den;
    const float br = s.b_re[(g * 64 + n) * 16 + c], bi = s.b_im[(g * 64 + n) * 16 + c];
    re = fre * br - fim * bi; im = fre * bi + fim * br;
}
DEV void ssm_prep(const SsmIn& s, bf16_t* BT1, bf16_t* MTW, unsigned char* lds) {
    const int tid = get_tid();
    float* pw = (float*)lds;
    float* bb = pw + 33 * 128;
    float* cc = bb + 2048;
    float* fn = cc + 2048;
    float* km = fn + 128;
    for (int job = get_bid(); job < 512; job += gridDim.x) {
        const int g = job >> 4, pt = job & 15;
        __syncthreads();
        for (int e = tid; e < 33 * 64; e += NTHR) { float pr, pi; lb_pow(s, g, e & 63, (float)(e >> 6), pr, pi); pw[e * 2] = pr; pw[e * 2 + 1] = pi; }
        if (tid < 64) {
            const int n = tid;
            const float lre = fminf(s.a_re[g * 64 + n], -1e-4f), lim = s.a_im[g * 64 + n], dt = expf(s.log_dt[g]);
            const float mag = expf(lre * dt); float sn, cs; sincosf(lim * dt, &sn, &cs);
            const float sh = sinf(0.5f * lim * dt);
            const float nr = expm1f(lre * dt) - mag * 2.f * sh * sh, lbi = mag * sn;
            const float den = lre * lre + lim * lim;
            fn[n * 2] = (nr * lre + lbi * lim) / den; fn[n * 2 + 1] = (lbi * lre - nr * lim) / den;
        }
        for (int e = tid; e < 1024; e += NTHR) { const int c = e >> 6, n = e & 63; cc[e * 2] = s.c_re[(g * 16 + c) * 64 + n]; cc[e * 2 + 1] = s.c_im[(g * 16 + c) * 64 + n]; }
        __syncthreads();
        for (int e = tid; e < 1024; e += NTHR) { const int n = e >> 4; const float fre = fn[n * 2], fim = fn[n * 2 + 1];
            const float br = s.b_re[(g * 64) * 16 + e], bi = s.b_im[(g * 64) * 16 + e];
            bb[e * 2] = fre * br - fim * bi; bb[e * 2 + 1] = fre * bi + fim * br; }
        __syncthreads();
        for (int i = tid; i < 4096; i += NTHR) { const int e = pt * 4096 + i, nn = e >> 9, kk = e & 511, n = nn & 63, sidx = kk >> 4, c = kk & 15;
            const float pr = pw[((31 - sidx) * 64 + n) * 2], pi = pw[((31 - sidx) * 64 + n) * 2 + 1], br = bb[(n * 16 + c) * 2], bi = bb[(n * 16 + c) * 2 + 1];
            BT1[(size_t)g * 131072 + e] = f2bf((nn >> 6) ? (pr * bi + pi * br) : (pr * br - pi * bi)); }
        for (int i = tid; i < 4096; i += NTHR) BT1[(size_t)g * 131072 + 65536 + pt * 4096 + i] = 0;
        for (int i = tid; i < 4096; i += NTHR) { const int e = pt * 4096 + i, nn = e & 127, r = e >> 7, n = nn & 63, tau = r >> 4, c = r & 15;
            const float pr = pw[((tau + 1) * 64 + n) * 2], pi = pw[((tau + 1) * 64 + n) * 2 + 1], cr = cc[(c * 64 + n) * 2], ci = cc[(c * 64 + n) * 2 + 1];
            MTW[((size_t)g * 512 + r) * 640 + 512 + nn] = f2bf((nn >> 6) ? -(cr * pi + ci * pr) : (cr * pr - ci * pi)); }
        for (int i = tid; i < 32 * 512; i += NTHR) { const int r = pt * 32 + (i >> 9), kk = i & 511; if ((kk >> 4) > (r >> 4)) MTW[((size_t)g * 512 + r) * 640 + kk] = 0; }
        if (tid < 256) for (int dd = 0; dd < 2; ++dd) { const int d = 2 * pt + dd, c = tid >> 4, c2 = tid & 15; float acc = 0.f;
            for (int n = 0; n < 64; ++n) { const float cr = cc[(c * 64 + n) * 2], ci = cc[(c * 64 + n) * 2 + 1], pr = pw[(d * 64 + n) * 2], pi = pw[(d * 64 + n) * 2 + 1];
                const float xr = cr * pr - ci * pi, xi = cr * pi + ci * pr; acc += xr * bb[(n * 16 + c2) * 2] - xi * bb[(n * 16 + c2) * 2 + 1]; }
            km[dd * 256 + tid] = acc; }
        __syncthreads();
        if (tid < 256) for (int dd = 0; dd < 2; ++dd) { const int d = 2 * pt + dd; const bf16_t v = f2bf(km[dd * 256 + tid]); const int c = tid >> 4, c2 = tid & 15;
            for (int sidx = 0; sidx + d < 32; ++sidx) MTW[((size_t)g * 512 + (sidx + d) * 16 + c) * 640 + sidx * 16 + c2] = v; }
    }
    __syncthreads();
}
DEV void ssm_scan(const SsmIn& s, const float* SS, bf16_t* UH) {
    for (int idx = get_bid() * NTHR + get_tid(); idx < 32768; idx += gridDim.x * NTHR) {
        const int n = idx & 63, b = (idx >> 6) & 15, g = idx >> 10;
        float ar, ai; lb_pow(s, g, n, 32.f, ar, ai);
        float hr = 0.f, hi = 0.f;
        const size_t row0 = (size_t)(g * 16 + b) * 64;
#pragma unroll 8
        for (int k = 0; k < 64; ++k) {
            UH[(row0 + k) * 640 + 512 + n] = f2bf(hr); UH[(row0 + k) * 640 + 576 + n] = f2bf(hi);
            const float sr = SS[(row0 + k) * 128 + n], si = SS[(row0 + k) * 128 + 64 + n];
            const float nr = ar * hr - ai * hi + sr, ni = ar * hi + ai * hr + si;
            hr = nr; hi = ni;
        }
    }
}

struct GemmP { const bf16_t* A; const bf16_t* Bt; int lda, ldb, MT, NT, KT, nbatch; };
#define GLAS __attribute__((address_space(3)))
template <int WM, class Addr, class Epi>
DEV void gemm_run(const GemmP p, const Addr ad, const Epi epi, unsigned char* lds_) {
    constexpr int TM = 32 * WM, ABYTES = TM * 64, STAGE = ABYTES + 16384, NST = 4, NLA = WM / 4, NL = NLA + 2;
    GLAS unsigned char* lds = (GLAS unsigned char*)lds_;
    const int tid = get_tid(), lane = tid & 63, wid = __builtin_amdgcn_readfirstlane(tid >> 6), wr = wid >> 2, wc = wid & 3, l15 = lane & 15, quad = lane >> 4;
    int nx, x, jx, stride;
    { volatile GLAS unsigned* cw = (volatile GLAS unsigned*)(lds + LDS_BYTES - 16);
      const int nloc = (int)cw[0], nxc = (int)cw[1], rank = (int)cw[2], xcc = (int)cw[3];
      if (nloc > 0 && xcc < nxc && rank < nloc) { nx = nxc; x = xcc; jx = rank; stride = nloc; }
      else { nx = 1; x = 0; jx = get_bid(); stride = gridDim.x; } }
    nx = __builtin_amdgcn_readfirstlane(nx); x = __builtin_amdgcn_readfirstlane(x); jx = __builtin_amdgcn_readfirstlane(jx); stride = __builtin_amdgcn_readfirstlane(stride);
    const int MTT = p.MT / (WM / 4), NTT = p.NT / 2;
    const int SRtot = (p.nbatch * MTT) / 8, per = 8 * NTT, KT = p.KT * 2;
    int offA[NLA], offB[2];
#pragma unroll
    for (int i = 0; i < NLA; ++i) { const int slot = (wid + 8 * i) * 64 + lane, row = slot >> 2, c = (slot & 3) ^ ((row >> 2) & 3); offA[i] = row * p.lda + c * 8; }
#pragma unroll
    for (int i = 0; i < 2; ++i) { const int slot = (wid + 8 * i) * 64 + lane, row = slot >> 2, c = (slot & 3) ^ ((row >> 2) & 3); offB[i] = row * p.ldb + c * 8; }
    const int swz = ((quad ^ (l15 >> 2)) & 3) * 16;
    const int aoff = (wr * (WM * 16) + l15) * 64 + swz, boff = ABYTES + (wc * 64 + l15) * 64 + swz;
    int ls = jx, lkt = 0; const bf16_t* lA = nullptr; const bf16_t* lB = nullptr; bool lvalid;
#define GEMM_DECODE_L() do { const int q_ = ls / per, rem_ = ls % per, sr_ = x + nx * q_; lvalid = sr_ < SRtot; if (lvalid) { const int R_ = sr_ * 8 + (rem_ & 7), b_ = R_ / MTT; \
        lA = p.A + ad.a_off(b_) + (size_t)((R_ % MTT) * TM) * p.lda; lB = p.Bt + ad.b_off(b_) + (size_t)((rem_ >> 3) * 256) * p.ldb; } } while (0)
#define GEMM_ISSUE(stg) do { _Pragma("unroll") for (int i_ = 0; i_ < NLA; ++i_) \
        __builtin_amdgcn_global_load_lds((const unsigned*)(lA + offA[i_] + lkt * 32), (GLAS unsigned*)(lds + (stg) * STAGE + (wid + 8 * i_) * 1024), 16, 0, 0); \
        _Pragma("unroll") for (int i_ = 0; i_ < 2; ++i_) \
        __builtin_amdgcn_global_load_lds((const unsigned*)(lB + offB[i_] + lkt * 32), (GLAS unsigned*)(lds + (stg) * STAGE + ABYTES + (wid + 8 * i_) * 1024), 16, 0, 0); \
        ++issued; if (++lkt == KT) { lkt = 0; ls += stride; GEMM_DECODE_L(); } } while (0)
    GEMM_DECODE_L();
    int issued = 0;
    asm volatile("s_waitcnt vmcnt(0)" ::: "memory");
    __syncthreads();
#pragma unroll 1
    for (int t = 0; t < NST - 1; ++t) if (lvalid) GEMM_ISSUE(t);
    f32x4 acc[WM][4];
#pragma unroll
    for (int i = 0; i < WM; ++i)
#pragma unroll
        for (int j = 0; j < 4; ++j) acc[i][j] = (f32x4){0.f, 0.f, 0.f, 0.f};
    int cs = jx, ckt = 0, cst = 0; bool drain = false;
#pragma unroll 1
    for (int it = 0; it < issued; ++it) {
        const int y = issued - it - 1;
        if (drain || y == 0) asm volatile("s_waitcnt vmcnt(0)" ::: "memory");
        else if (WM == 8) { if (y == 1) asm volatile("s_waitcnt vmcnt(4)" ::: "memory"); else asm volatile("s_waitcnt vmcnt(8)" ::: "memory"); }
        else { if (y == 1) asm volatile("s_waitcnt vmcnt(3)" ::: "memory"); else asm volatile("s_waitcnt vmcnt(6)" ::: "memory"); }
        drain = false;
        __builtin_amdgcn_s_barrier();
        asm volatile("" ::: "memory");
        { const int nst = cst == 0 ? NST - 1 : cst - 1;
          if (lvalid) GEMM_ISSUE(nst); }
        asm volatile("" ::: "memory");
        const GLAS unsigned char* st = lds + cst * STAGE;
        cst = cst + 1 == NST ? 0 : cst + 1;
        bf16x8 af[WM], bfr[4];
#pragma unroll
        for (int i = 0; i < 4; ++i) bfr[i] = *(const GLAS bf16x8*)(st + boff + i * 1024);
#pragma unroll
        for (int i = 0; i < WM; ++i) af[i] = *(const GLAS bf16x8*)(st + aoff + i * 1024);
#pragma unroll
        for (int mi = 0; mi < WM; ++mi)
#pragma unroll
            for (int ni = 0; ni < 4; ++ni) acc[mi][ni] = __builtin_amdgcn_mfma_f32_16x16x32_bf16(bfr[ni], af[mi], acc[mi][ni], 0, 0, 0);
        if (++ckt == KT) {
            const int q_ = cs / per, rem_ = cs % per, R_ = (x + nx * q_) * 8 + (rem_ & 7);
#pragma unroll
            for (int h = 0; h < WM / 4; ++h)
                epi(reinterpret_cast<const f32x4 (&)[4][4]>(acc[4 * h]), R_ / MTT, (R_ % MTT) * TM + wr * (WM * 16) + h * 64, (rem_ >> 3) * 256 + wc * 64, l15, quad);
#pragma unroll
            for (int i = 0; i < WM; ++i)
#pragma unroll
                for (int j = 0; j < 4; ++j) acc[i][j] = (f32x4){0.f, 0.f, 0.f, 0.f};
            ckt = 0; cs += stride; drain = true;
        }
    }
    asm volatile("s_waitcnt vmcnt(0) lgkmcnt(0)" ::: "memory");
    __syncthreads();
#undef GEMM_DECODE_L
#undef GEMM_ISSUE
}
struct AddrNone { DEV size_t a_off(int) const { return 0; } DEV size_t b_off(int) const { return 0; } };
struct AddrStride { size_t as, bs; DEV size_t a_off(int b) const { return as * b; } DEV size_t b_off(int b) const { return bs * b; } };
struct AddrCmp1 { DEV size_t a_off(int b) const { return (size_t)b * 2048 * 64; } DEV size_t b_off(int b) const { return (size_t)((b >> 2) & 1) * 256 * 2048; } };
struct AddrCmp2 { DEV size_t a_off(int b) const { return (size_t)b * 128 * 256; } DEV size_t b_off(int b) const { return (size_t)((b >> 2) & 1) * 256 * 256; } };

#define EPI_ARGS const f32x4 (&acc)[4][4], int batch, int m0, int n0, int l15, int quad
struct EpiIn {
    bf16_t *UH, *Qb, *KVC, *KS, *VST, *KW, *VWT, *GM; float* GN;
    DEV void operator()(EPI_ARGS) const {
#pragma unroll
        for (int mi = 0; mi < 4; ++mi) {
            const int t = m0 + mi * 16 + l15, b = t >> 11, tt = t & 2047;
#pragma unroll
            for (int ni = 0; ni < 4; ++ni) {
                const f32x4 v = acc[mi][ni];
                const int c = n0 + ni * 16 + quad * 4;
                if (n0 < 512) {
                    const int g = c >> 4;
                    st_bf4(UH + ((size_t)((g * 16 + b) * 64 + (tt >> 5))) * 640 + (tt & 31) * 16 + (c & 15), v[0], v[1], v[2], v[3]);
                } else if (n0 < 1536) {
                    const float sc = 0.125f * LOG2E;
                    st_bf4(Qb + (size_t)t * 1024 + (c - 512), v[0] * sc, v[1] * sc, v[2] * sc, v[3] * sc);
                } else if (n0 < 2048) {
                    const int cc = c - 1536, z = cc >> 8, h = (cc >> 6) & 3, d = cc & 63;
                    st_bf4(KVC + ((size_t)(((b * 2 + z) * 4 + h) * 2048 + tt)) * 64 + d, v[0], v[1], v[2], v[3]);
                } else if (n0 < 3072) {
                    const int cc = (c - 2048) & 511, isw = (c - 2048) >> 9, h = (cc >> 6) & 3, d = cc & 63;
                    if (cc < 256) st_bf4((isw ? KW : KS) + ((size_t)((b * 4 + h) * 2048 + tt)) * 64 + d, v[0], v[1], v[2], v[3]);
                    else { bf16_t* o = (isw ? VWT : VST) + ((size_t)((b * 4 + h) * 64 + d)) * 2048 + tt;
#pragma unroll
                        for (int i = 0; i < 4; ++i) o[(size_t)i * 2048] = f2bf(v[i]); }
                } else if (n0 < 5120) {
                    st_bf4(GM + (size_t)t * 2048 + (c - 3072), sigmoidf_(v[0]), sigmoidf_(v[1]), sigmoidf_(v[2]), sigmoidf_(v[3]));
                } else {
                    const int cc = c - 5120;
                    if (cc < 48) *(f32x4*)(GN + (size_t)t * 48 + cc) = (f32x4){sigmoidf_(v[0]), sigmoidf_(v[1]), sigmoidf_(v[2]), sigmoidf_(v[3])};
                }
            }
        }
    }
};
struct EpiXkv {
    bf16_t *XK, *XVT;
    DEV void operator()(EPI_ARGS) const {
#pragma unroll
        for (int mi = 0; mi < 4; ++mi) {
            const int r = m0 + mi * 16 + l15, b = r >> 8, m = r & 255;
#pragma unroll
            for (int ni = 0; ni < 4; ++ni) {
                const f32x4 v = acc[mi][ni]; const int c = n0 + ni * 16 + quad * 4;
                if (n0 < 1024) st_bf4(XK + (size_t)r * 1024 + c, v[0], v[1], v[2], v[3]);
                else { const int cc = c - 1024, h = cc >> 8, d = cc & 255; bf16_t* o = XVT + ((size_t)((b * 4 + h) * 256 + d)) * 256 + m;
#pragma unroll
                    for (int i = 0; i < 4; ++i) o[i * 256] = f2bf(v[i]); }
            }
        }
    }
};
struct EpiSsmA { float* SS;
    DEV void operator()(EPI_ARGS) const {
        if (n0 >= 128) return;
#pragma unroll
        for (int mi = 0; mi < 4; ++mi)
#pragma unroll
            for (int ni = 0; ni < 4; ++ni) *(f32x4*)(SS + ((size_t)batch * 1024 + m0 + mi * 16 + l15) * 128 + n0 + ni * 16 + quad * 4) = acc[mi][ni];
    }
};
struct EpiCmp1 { bf16_t* HID; const float* bias2;
    DEV void operator()(EPI_ARGS) const {
        const int z = (batch >> 2) & 1;
#pragma unroll
        for (int ni = 0; ni < 4; ++ni) {
            const int c = n0 + ni * 16 + quad * 4; const f32x4 bv = *(const f32x4*)(bias2 + z * 256 + c);
#pragma unroll
            for (int mi = 0; mi < 4; ++mi) { const f32x4 v = acc[mi][ni] + bv;
                st_bf4(HID + ((size_t)batch * 128 + m0 + mi * 16 + l15) * 256 + c, gelu_tanh(v[0]), gelu_tanh(v[1]), gelu_tanh(v[2]), gelu_tanh(v[3])); }
        }
    }
};
struct EpiCmp2 { bf16_t *KC, *VCT;
    DEV void operator()(EPI_ARGS) const {
        if (n0 >= 64) return;
        const int z = (batch >> 2) & 1, bh = (batch >> 3) * 4 + (batch & 3);
#pragma unroll
        for (int mi = 0; mi < 4; ++mi) { const int r = m0 + mi * 16 + l15;
#pragma unroll
            for (int ni = 0; ni < 4; ++ni) { const f32x4 v = acc[mi][ni]; const int c = n0 + ni * 16 + quad * 4;
                if (z == 0) st_bf4(KC + ((size_t)bh * 128 + r) * 64 + c, v[0], v[1], v[2], v[3]);
                else {
#pragma unroll
                    for (int i = 0; i < 4; ++i) VCT[((size_t)bh * 64 + c + i) * 128 + r] = f2bf(v[i]); } } }
    }
};
struct EpiSsmB { const bf16_t* UH; const float* dskip; bf16_t* GB;
    DEV void operator()(EPI_ARGS) const {
#pragma unroll
        for (int mi = 0; mi < 4; ++mi) { const int r = m0 + mi * 16 + l15, b = r >> 6, k = r & 63;
#pragma unroll
            for (int ni = 0; ni < 4; ++ni) { const int col = n0 + ni * 16 + quad * 4, tau = col >> 4, c = col & 15;
                const f32x4 u = ld_bf4(UH + ((size_t)batch * 1024 + r) * 640 + col);
                const f32x4 dv = *(const f32x4*)(dskip + batch * 16 + c);
                const f32x4 y = acc[mi][ni] + dv * u;
                st_bf4(GB + ((size_t)(b * 2048 + k * 32 + tau)) * 512 + batch * 16 + c, gelu_tanh(y[0]), gelu_tanh(y[1]), gelu_tanh(y[2]), gelu_tanh(y[3])); } }
    }
};
struct EpiGlu { const bf16_t* GB; const float* bglu; bf16_t* YS;
    DEV void operator()(EPI_ARGS) const {
#pragma unroll
        for (int ni = 0; ni < 4; ++ni) { const int c = n0 + ni * 16 + quad * 4; const f32x4 bv = *(const f32x4*)(bglu + c);
#pragma unroll
            for (int mi = 0; mi < 4; ++mi) { const size_t o = (size_t)(m0 + mi * 16 + l15) * 512 + c; const f32x4 g = ld_bf4(GB + o); const f32x4 v = acc[mi][ni] + bv;
                st_bf4(YS + o, g[0] * sigmoidf_(v[0]), g[1] * sigmoidf_(v[1]), g[2] * sigmoidf_(v[2]), g[3] * sigmoidf_(v[3])); } }
    }
};
struct EpiSout { const bf16_t* GM; bf16_t* P1;
    DEV void operator()(EPI_ARGS) const {
#pragma unroll
        for (int mi = 0; mi < 4; ++mi) { const size_t t = m0 + mi * 16 + l15;
#pragma unroll
            for (int ni = 0; ni < 4; ++ni) { const int c = n0 + ni * 16 + quad * 4; const f32x4 g = ld_bf4(GM + t * 2048 + c); const f32x4 v = acc[mi][ni] * g;
                st_bf4(P1 + t * 1024 + c, v[0], v[1], v[2], v[3]); } }
    }
};
struct EpiNout { const bf16_t* GM; const bf16_t* P1; bf16_t* MIX;
    DEV void operator()(EPI_ARGS) const {
#pragma unroll
        for (int mi = 0; mi < 4; ++mi) { const size_t t = m0 + mi * 16 + l15;
#pragma unroll
            for (int ni = 0; ni < 4; ++ni) { const int c = n0 + ni * 16 + quad * 4; const f32x4 g = ld_bf4(GM + t * 2048 + 1024 + c); const f32x4 v = acc[mi][ni] * g + ld_bf4(P1 + t * 1024 + c);
                st_bf4(MIX + t * 1024 + c, v[0], v[1], v[2], v[3]); } }
    }
};
struct EpiRes { const float* src; const float* stats; const float* g; const float* b; float* dst;
    DEV void operator()(EPI_ARGS) const {
#pragma unroll
        for (int mi = 0; mi < 4; ++mi) { const size_t t = m0 + mi * 16 + l15; const float mu = stats[t * 2], rs = stats[t * 2 + 1];
#pragma unroll
            for (int ni = 0; ni < 4; ++ni) { const int c = n0 + ni * 16 + quad * 4;
                const f32x4 xv = *(const f32x4*)(src + t * 1024 + c), gg = *(const f32x4*)(g + c), bb = *(const f32x4*)(b + c);
                *(f32x4*)(dst + t * 1024 + c) = ((xv - mu) * rs * gg + bb) * ALPHA + acc[mi][ni]; } }
    }
};
struct EpiScaleBf { bf16_t* O; int ldc; float sc;
    DEV void operator()(EPI_ARGS) const {
#pragma unroll
        for (int mi = 0; mi < 4; ++mi)
#pragma unroll
            for (int ni = 0; ni < 4; ++ni) { const f32x4 v = acc[mi][ni] * sc; st_bf4(O + (size_t)(m0 + mi * 16 + l15) * ldc + n0 + ni * 16 + quad * 4, v[0], v[1], v[2], v[3]); }
    }
};
struct EpiFfnIn { bf16_t* FB;
    DEV void operator()(EPI_ARGS) const {
#pragma unroll
        for (int mi = 0; mi < 4; ++mi) { const size_t t = m0 + mi * 16 + l15;
#pragma unroll
            for (int pp = 0; pp < 2; ++pp) { const f32x4 ga = acc[mi][2 * pp], up = acc[mi][2 * pp + 1]; const int j = (n0 + pp * 32) / 2 + quad * 4;
                st_bf4(FB + t * 2816 + j, ga[0] * sigmoidf_(ga[0]) * up[0], ga[1] * sigmoidf_(ga[1]) * up[1], ga[2] * sigmoidf_(ga[2]) * up[2], ga[3] * sigmoidf_(ga[3]) * up[3]); } }
    }
};

DEV float qmax(float v) { auto a = __builtin_amdgcn_permlane16_swap(__float_as_uint(v), __float_as_uint(v), false, false); v = fmaxf(__uint_as_float(a[0]), __uint_as_float(a[1]));
    auto b = __builtin_amdgcn_permlane32_swap(__float_as_uint(v), __float_as_uint(v), false, false); return fmaxf(__uint_as_float(b[0]), __uint_as_float(b[1])); }
DEV float qsum(float v) { auto a = __builtin_amdgcn_permlane16_swap(__float_as_uint(v), __float_as_uint(v), false, false); v = __uint_as_float(a[0]) + __uint_as_float(a[1]);
    auto b = __builtin_amdgcn_permlane32_swap(__float_as_uint(v), __float_as_uint(v), false, false); return __uint_as_float(b[0]) + __uint_as_float(b[1]); }
DEV bf16x8 pack_p(const f32x4& a, const f32x4& b) { u32x4 w; w.x = cvt_pk_bf16(a[0], a[1]); w.y = cvt_pk_bf16(a[2], a[3]); w.z = cvt_pk_bf16(b[0], b[1]); w.w = cvt_pk_bf16(b[2], b[3]); return __builtin_bit_cast(bf16x8, w); }
DEV void st_vt(unsigned char* rowbase, int e, const u32x4& v) {
    const int grp = e >> 2, ep = e & 3, a = ep >> 1, qp = (ep & 1) * 2;
    unsigned char* o = rowbase + grp * 64 + (qp * 8 + a * 4) * 2;
    *(u32x2*)o = (u32x2){v.x, v.y}; *(u32x2*)(o + 16) = (u32x2){v.z, v.w};
}

struct NsaCtx { const bf16_t *Qb, *KC, *VCT, *KS, *VST, *KW, *VWT; const float* GN; bf16_t* ON; };
constexpr float MINIT = -1e20f;

template <int MODE, bool BOUND>
DEV void nsa_tile(const unsigned char* Kl, const unsigned char* Vl, const bf16x8 (&Qf)[2][2], f32x4 (&O)[2][4], float (&m)[2], float (&l)[2],
                  const float (&slope)[2], int dist0, bool sel, int l15, int quad) {
    const float d0f = (float)dist0;
#pragma unroll
    for (int g = 0; g < 2; ++g) {
        f32x4 S[4];
#pragma unroll
        for (int kt = 0; kt < 4; ++kt) { S[kt] = (f32x4){0.f, 0.f, 0.f, 0.f};
#pragma unroll
            for (int ks = 0; ks < 2; ++ks) { const bf16x8 kf = *(const bf16x8*)(Kl + (kt * 16 + l15) * 144 + ks * 64 + quad * 16); S[kt] = __builtin_amdgcn_mfma_f32_16x16x32_bf16(kf, Qf[g][ks], S[kt], 0, 0, 0); } }
        float base = -slope[g] * d0f;
        if (MODE == 0) base = sel ? base : NEG;
        typedef float f2 __attribute__((ext_vector_type(2)));
        const f2 sl_lo = {0.f, slope[g]}, sl_hi = {2.f * slope[g], 3.f * slope[g]};
        float tmax = NEG;
        f2 Slo[4], Shi[4];
#pragma unroll
        for (int kt = 0; kt < 4; ++kt) {
            const float bk = fmaf(slope[g], (float)(16 * kt), base);
            f2 lo = (f2){S[kt][0], S[kt][1]} + (sl_lo + bk), hi = (f2){S[kt][2], S[kt][3]} + (sl_hi + bk);
            if (BOUND) {
#pragma unroll
                for (int i = 0; i < 4; ++i) { const int cc = 16 * kt + i; bool v = cc <= dist0; if (MODE == 1) v = v && (cc > dist0 - 512);
                    if (i < 2) lo[i] = v ? lo[i] : NEG; else hi[i - 2] = v ? hi[i - 2] : NEG; }
            }
            Slo[kt] = lo; Shi[kt] = hi;
            tmax = fmaxf(fmaxf(tmax, lo[0]), lo[1]); tmax = fmaxf(fmaxf(tmax, hi[0]), hi[1]);
        }
        tmax = qmax(tmax);
        const float mnew = fmaxf(m[g], tmax), alpha = fexp2(m[g] - mnew);
        f2 rs2 = {0.f, 0.f};
#pragma unroll
        for (int kt = 0; kt < 4; ++kt) {
            const f2 a = Slo[kt] - mnew, b = Shi[kt] - mnew;
            const f2 pa = {fexp2(a[0]), fexp2(a[1])}, pb = {fexp2(b[0]), fexp2(b[1])};
            rs2 += pa; rs2 += pb;
            S[kt] = (f32x4){pa[0], pa[1], pb[0], pb[1]};
        }
        l[g] = l[g] * alpha + (rs2[0] + rs2[1]); m[g] = mnew;
        const bf16x8 P0 = pack_p(S[0], S[1]), P1 = pack_p(S[2], S[3]);
#pragma unroll
        for (int dt = 0; dt < 4; ++dt) { O[g][dt] = O[g][dt] * alpha;
            const bf16x8 v0 = *(const bf16x8*)(Vl + (dt * 16 + l15) * 144 + quad * 16), v1 = *(const bf16x8*)(Vl + (dt * 16 + l15) * 144 + 64 + quad * 16);
            O[g][dt] = __builtin_amdgcn_mfma_f32_16x16x32_bf16(v0, P0, O[g][dt], 0, 0, 0);
            O[g][dt] = __builtin_amdgcn_mfma_f32_16x16x32_bf16(v1, P1, O[g][dt], 0, 0, 0); }
    }
}

template <int MODE>
DEV void nsa_tiles(unsigned char* lds, const bf16_t* Kg, const bf16_t* VTg, unsigned tilemask, unsigned wmask, unsigned qmask, int jb0, int jb1,
                   const bf16x8 (&Qf)[2][2], f32x4 (&O)[2][4], float (&m)[2], float (&l)[2], const float (&slope)[2], int tq, int l15, int quad) {
    const int tid = get_tid();
    const int prow = tid >> 3, pe = tid & 7;
    unsigned rem = tilemask;
    int j = __builtin_ctz(rem); rem &= rem - 1;
    u32x4 rk, rv;
    rk = *(const u32x4*)(Kg + (size_t)(64 * j + prow) * 64 + pe * 8); rv = *(const u32x4*)(VTg + (size_t)prow * 2048 + 64 * j + pe * 8);
    int cur = 0;
    *(u32x4*)(lds + prow * 144 + pe * 16) = rk; st_vt(lds + 9216 + prow * 144, pe, rv);
    __syncthreads();
    for (;;) {
        int jn = -1;
        if (rem) { jn = __builtin_ctz(rem); rem &= rem - 1;
            rk = *(const u32x4*)(Kg + (size_t)(64 * jn + prow) * 64 + pe * 8); rv = *(const u32x4*)(VTg + (size_t)prow * 2048 + 64 * jn + pe * 8); }
        __builtin_amdgcn_sched_barrier(0);
        const unsigned char* st = lds + cur * 18432;
        if (MODE == 1 || ((wmask >> j) & 1u)) {
            const int dist0 = tq - 64 * j - 4 * quad; const bool sel = (qmask >> j) & 1u;
            if (j == jb0 || j == jb1) nsa_tile<MODE, true>(st, st + 9216, Qf, O, m, l, slope, dist0, sel, l15, quad);
            else nsa_tile<MODE, false>(st, st + 9216, Qf, O, m, l, slope, dist0, sel, l15, quad);
        }
        if (jn >= 0) { unsigned char* sn = lds + (cur ^ 1) * 18432; *(u32x4*)(sn + prow * 144 + pe * 16) = rk; st_vt(sn + 9216 + prow * 144, pe, rv); }
        __syncthreads();
        if (jn < 0) break;
        j = jn; cur ^= 1;
    }
}

DEV void nsa_unit(const NsaCtx& c, int b, int hkv, int qb, unsigned char* lds) {
    const int tid = get_tid(), lane = tid & 63, wid = tid >> 6, l15 = lane & 15, quad = lane >> 4;
    const int qs = wid & 3, hp = wid >> 2;
    const int tq = qb * 64 + qs * 16 + l15, cur = qb;
    const size_t trow = (size_t)b * 2048 + tq;
    const int head0 = hkv * 4 + hp * 2;
    const float* gnp = c.GN + trow * 48 + head0 * 3;
    unsigned char* stash = lds + 36864 + wid * 4096;
    float* xch = (float*)(lds + 69632);
    unsigned* smask = (unsigned*)(lds + 102400);
    const int bh = b * 4 + hkv;
    {
        const bf16_t* Kg = c.KC + (size_t)bh * 128 * 64; const bf16_t* Vg = c.VCT + (size_t)bh * 64 * 128;
#pragma unroll
        for (int i = 0; i < 2; ++i) { const int pc = tid + 512 * i;
            *(u32x4*)(lds + (pc >> 3) * 144 + (pc & 7) * 16) = *(const u32x4*)(Kg + pc * 8);
            st_vt(lds + 18432 + (pc >> 4) * 272, pc & 15, *(const u32x4*)(Vg + pc * 8)); }
    }
    __syncthreads();
    const int nkt = (4 * qb + 2) / 16 + 1;
    float Mx[8], Sm[8];
#pragma unroll
    for (int kt = 0; kt < 8; ++kt) { Mx[kt] = NEG; Sm[kt] = 0.f; }
#ifdef NSA_NO_CMP
    for (int g = 0; g < 0; ++g) {
#else
#pragma unroll 1
    for (int g = 0; g < 2; ++g) {
#endif
        bf16x8 Qg[2];
#pragma unroll
        for (int ks = 0; ks < 2; ++ks) Qg[ks] = *(const bf16x8*)(c.Qb + trow * 1024 + (head0 + g) * 64 + ks * 32 + quad * 8);
        const float slope_g = exp2f(-0.5f * (float)(head0 + g + 1)) * LOG2E;
        f32x4 S[8];
#pragma unroll
        for (int kt = 0; kt < 8; ++kt) { S[kt] = (f32x4){0.f, 0.f, 0.f, 0.f};
            if (kt < nkt) {
#pragma unroll
                for (int ks = 0; ks < 2; ++ks) { const bf16x8 kf = *(const bf16x8*)(lds + (kt * 16 + l15) * 144 + ks * 64 + quad * 16); S[kt] = __builtin_amdgcn_mfma_f32_16x16x32_bf16(kf, Qg[ks], S[kt], 0, 0, 0); } } }
        float mx = NEG;
        const int d0 = tq - 31 - 64 * quad; const float base = -slope_g * (float)d0;
#pragma unroll
        for (int kt = 0; kt < 8; ++kt)
#pragma unroll
            for (int i = 0; i < 4; ++i) { const int cc = 256 * kt + 16 * i; const float s = (kt < nkt && cc <= d0) ? fmaf(slope_g, (float)cc, S[kt][i] + base) : NEG; S[kt][i] = s; mx = fmaxf(mx, s); }
        mx = qmax(mx);
        float ls = 0.f;
#pragma unroll
        for (int kt = 0; kt < 8; ++kt)
#pragma unroll
            for (int i = 0; i < 4; ++i) ls += S[kt][i] > -1e29f ? fexp2(S[kt][i] - mx) : 0.f;
        ls = qsum(ls);
        const float lcl = fmaxf(ls, 1e-30f), lg = __log2f(lcl) + mx;
        float x3[8];
#pragma unroll
        for (int kt = 0; kt < 8; ++kt) {
#pragma unroll
            for (int i = 0; i < 4; ++i) S[kt][i] = S[kt][i] > -1e29f ? S[kt][i] - lg : NEG;
            x3[kt] = __shfl(S[kt][3], (lane + 48) & 63);
        }
#pragma unroll
        for (int kt = 0; kt < 8; ++kt) {
            const float nb = quad >= 1 ? x3[kt] : (kt >= 1 ? x3[kt >= 1 ? kt - 1 : 0] : NEG);
            const float tm = fmaxf(fmaxf(fmaxf(S[kt][0], S[kt][1]), fmaxf(S[kt][2], S[kt][3])), nb);
            const float nm = fmaxf(Mx[kt], tm);
            Sm[kt] = Sm[kt] * fexp2(Mx[kt] - nm) + fexp2(S[kt][0] - nm) + fexp2(S[kt][1] - nm) + fexp2(S[kt][2] - nm) + fexp2(S[kt][3] - nm) + fexp2(nb - nm);
            Mx[kt] = nm;
        }
        const float gate0 = gnp[g * 3];
        f32x4 Oc[4];
#pragma unroll
        for (int dt = 0; dt < 4; ++dt) Oc[dt] = (f32x4){0.f, 0.f, 0.f, 0.f};
#pragma unroll
        for (int k2 = 0; k2 < 4; ++k2) {
            if (2 * k2 < nkt) {
                f32x4 pa, pb;
#pragma unroll
                for (int i = 0; i < 4; ++i) { pa[i] = fexp2(S[2 * k2][i]); pb[i] = fexp2(S[2 * k2 + 1][i]); }
                const bf16x8 pf = pack_p(pa, pb);
#pragma unroll
                for (int dt = 0; dt < 4; ++dt) { const bf16x8 vf = *(const bf16x8*)(lds + 18432 + (dt * 16 + l15) * 272 + k2 * 64 + quad * 16); Oc[dt] = __builtin_amdgcn_mfma_f32_16x16x32_bf16(vf, pf, Oc[dt], 0, 0, 0); }
            }
        }
#pragma unroll
        for (int dt = 0; dt < 4; ++dt) { const f32x4 v = Oc[dt] * gate0; u32x2 w; w.x = cvt_pk_bf16(v[0], v[1]); w.y = cvt_pk_bf16(v[2], v[3]); *(u32x2*)(stash + ((g * 4 + dt) * 64 + lane) * 8) = w; }
    }
    unsigned qmask;
    if (cur < 8) qmask = (2u << cur) - 1u;
    if (cur >= 8) {
#pragma unroll
        for (int kt = 0; kt < 8; ++kt) { xch[(wid * 16 + kt) * 64 + lane] = Mx[kt]; xch[(wid * 16 + 8 + kt) * 64 + lane] = Sm[kt]; }
    }
    __syncthreads();
    if (cur >= 8) {
        float v[8];
#pragma unroll
        for (int kt = 0; kt < 8; ++kt) {
            const float m2 = xch[((wid ^ 4) * 16 + kt) * 64 + lane], s2 = xch[((wid ^ 4) * 16 + 8 + kt) * 64 + lane];
            const float mm = fmaxf(Mx[kt], m2), ss = Sm[kt] * fexp2(Mx[kt] - mm) + s2 * fexp2(m2 - mm);
            const int jb = 4 * kt + quad; v[kt] = (jb >= 1 && jb <= cur - 2) ? mm + __log2f(ss) : -3e38f; }
        qmask = 1u | (1u << cur) | (1u << (cur - 1));
        for (int r = 0; r < 5; ++r) {
            float bv = v[0]; int bj = quad;
#pragma unroll
            for (int kt = 1; kt < 8; ++kt) if (v[kt] > bv) { bv = v[kt]; bj = 4 * kt + quad; }
#pragma unroll
            for (int o = 16; o <= 32; o <<= 1) { const float ov = __shfl_xor(bv, o); const int oj = __shfl_xor(bj, o); if (ov > bv || (ov == bv && oj < bj)) { bv = ov; bj = oj; } }
            qmask |= 1u << bj;
#pragma unroll
            for (int kt = 0; kt < 8; ++kt) if (4 * kt + quad == bj) v[kt] = -3.2e38f;
        }
    }
    unsigned wmask = qmask;
#pragma unroll
    for (int o = 1; o <= 8; o <<= 1) wmask |= __shfl_xor(wmask, o);
    if (lane == 0) smask[wid] = wmask;
    __syncthreads();
    const unsigned umask = (smask[0] | smask[1] | smask[2] | smask[3]) | (smask[4] | smask[5] | smask[6] | smask[7]);
    bf16x8 Qf[2][2]; float slope[2];
#pragma unroll
    for (int g = 0; g < 2; ++g) {
#pragma unroll
        for (int ks = 0; ks < 2; ++ks) Qf[g][ks] = *(const bf16x8*)(c.Qb + trow * 1024 + (head0 + g) * 64 + ks * 32 + quad * 8);
        slope[g] = exp2f(-0.5f * (float)(head0 + g + 1)) * LOG2E;
    }
    f32x4 O[2][4]; float m[2], l[2];
#pragma unroll
    for (int g = 0; g < 2; ++g) { m[g] = MINIT; l[g] = 0.f;
#pragma unroll
        for (int dt = 0; dt < 4; ++dt) O[g][dt] = (f32x4){0.f, 0.f, 0.f, 0.f}; }
#ifndef NSA_NO_SLC
    nsa_tiles<0>(lds, c.KS + (size_t)bh * 2048 * 64, c.VST + (size_t)bh * 64 * 2048, umask, wmask, qmask, cur, cur, Qf, O, m, l, slope, tq, l15, quad);
#endif
#pragma unroll
    for (int g = 0; g < 2; ++g) { const float sc = gnp[g * 3 + 1] / fmaxf(qsum(l[g]), 1e-30f);
#pragma unroll
        for (int dt = 0; dt < 4; ++dt) { u32x2* sp = (u32x2*)(stash + ((g * 4 + dt) * 64 + lane) * 8); const u32x2 w = *sp;
            const f32x4 v = O[g][dt] * sc + (f32x4){bflo(w.x), bfhi(w.x), bflo(w.y), bfhi(w.y)};
            u32x2 w2; w2.x = cvt_pk_bf16(v[0], v[1]); w2.y = cvt_pk_bf16(v[2], v[3]); *sp = w2;
            O[g][dt] = (f32x4){0.f, 0.f, 0.f, 0.f}; }
        m[g] = MINIT; l[g] = 0.f; }
    const int jlo = qb >= 8 ? qb - 8 : 0;
    const unsigned winmask = ((2u << cur) - 1u) & ~((1u << jlo) - 1u);
#ifndef NSA_NO_WIN
    nsa_tiles<1>(lds, c.KW + (size_t)bh * 2048 * 64, c.VWT + (size_t)bh * 64 * 2048, winmask, 0u, 0u, cur, jlo, Qf, O, m, l, slope, tq, l15, quad);
#endif
#pragma unroll
    for (int g = 0; g < 2; ++g) { const float sc = gnp[g * 3 + 2] / fmaxf(qsum(l[g]), 1e-30f);
#pragma unroll
        for (int dt = 0; dt < 4; ++dt) { const u32x2 w = *(const u32x2*)(stash + ((g * 4 + dt) * 64 + lane) * 8);
            const f32x4 v = O[g][dt] * sc + (f32x4){bflo(w.x), bfhi(w.x), bflo(w.y), bfhi(w.y)};
            st_bf4(c.ON + trow * 1024 + (head0 + g) * 64 + dt * 16 + quad * 4, v[0], v[1], v[2], v[3]); } }
}

DEV void xattn_unit(const bf16_t* Qx, const bf16_t* XK, const bf16_t* XVT, bf16_t* OX, int b, int h, int qblk  , unsigned char* lds) {
    const int tid = get_tid(), lane = tid & 63, wid = tid >> 6, l15 = lane & 15, quad = lane >> 4;
    const size_t trow = (size_t)b * 2048 + qblk * 128 + wid * 16 + l15;
    bf16x8 Qf[8];
#pragma unroll
    for (int ks = 0; ks < 8; ++ks) Qf[ks] = *(const bf16x8*)(Qx + trow * 1024 + h * 256 + ks * 32 + quad * 8);
    f32x4 O[16];
#pragma unroll
    for (int dt = 0; dt < 16; ++dt) O[dt] = (f32x4){0.f, 0.f, 0.f, 0.f};
    float m = NEG, l = 0.f;
    const bf16_t* Kg = XK + (size_t)b * 256 * 1024 + h * 256;
    const bf16_t* Vg = XVT + (size_t)(b * 4 + h) * 256 * 256;
    u32x4 rk[2], rv[2];
#pragma unroll
    for (int i = 0; i < 2; ++i) { const int pc = tid + 512 * i; rk[i] = *(const u32x4*)(Kg + (size_t)(pc >> 5) * 1024 + (pc & 31) * 8); rv[i] = *(const u32x4*)(Vg + (size_t)(pc >> 2) * 256 + (pc & 3) * 8); }
#pragma unroll
    for (int i = 0; i < 2; ++i) { const int pc = tid + 512 * i; *(u32x4*)(lds + (pc >> 5) * 528 + (pc & 31) * 16) = rk[i]; st_vt(lds + 16896 + (pc >> 2) * 80, pc & 3, rv[i]); }
    __syncthreads();
    for (int j = 0; j < 8; ++j) {
        const bool more = j + 1 < 8;
        if (more) {
#pragma unroll
            for (int i = 0; i < 2; ++i) { const int pc = tid + 512 * i; rk[i] = *(const u32x4*)(Kg + (size_t)(32 * (j + 1) + (pc >> 5)) * 1024 + (pc & 31) * 8); rv[i] = *(const u32x4*)(Vg + (size_t)(pc >> 2) * 256 + 32 * (j + 1) + (pc & 3) * 8); } }
        __builtin_amdgcn_sched_barrier(0);
        const unsigned char* st = lds + (j & 1) * 37376;
        f32x4 S[2];
#pragma unroll
        for (int kt = 0; kt < 2; ++kt) { S[kt] = (f32x4){0.f, 0.f, 0.f, 0.f};
#pragma unroll
            for (int ks = 0; ks < 8; ++ks) { const bf16x8 kf = *(const bf16x8*)(st + (kt * 16 + l15) * 528 + ks * 64 + quad * 16); S[kt] = __builtin_amdgcn_mfma_f32_16x16x32_bf16(kf, Qf[ks], S[kt], 0, 0, 0); } }
        float tmax = fmaxf(fmaxf(fmaxf(S[0][0], S[0][1]), fmaxf(S[0][2], S[0][3])), fmaxf(fmaxf(S[1][0], S[1][1]), fmaxf(S[1][2], S[1][3])));
        tmax = qmax(tmax);
        const float mnew = fmaxf(m, tmax), alpha = fexp2(m - mnew);
        float rs = 0.f;
#pragma unroll
        for (int kt = 0; kt < 2; ++kt)
#pragma unroll
            for (int i = 0; i < 4; ++i) { const float pv = fexp2(S[kt][i] - mnew); S[kt][i] = pv; rs += pv; }
        l = l * alpha + rs; m = mnew;
        const bf16x8 pf = pack_p(S[0], S[1]);
#pragma unroll
        for (int dt = 0; dt < 16; ++dt) { O[dt] = O[dt] * alpha; const bf16x8 vf = *(const bf16x8*)(st + 16896 + (dt * 16 + l15) * 80 + quad * 16); O[dt] = __builtin_amdgcn_mfma_f32_16x16x32_bf16(vf, pf, O[dt], 0, 0, 0); }
        if (more) { unsigned char* sn = lds + ((j + 1) & 1) * 37376;
#pragma unroll
            for (int i = 0; i < 2; ++i) { const int pc = tid + 512 * i; *(u32x4*)(sn + (pc >> 5) * 528 + (pc & 31) * 16) = rk[i]; st_vt(sn + 16896 + (pc >> 2) * 80, pc & 3, rv[i]); } }
        __syncthreads();
    }
    const float inv = 1.0f / qsum(l);
#pragma unroll
    for (int dt = 0; dt < 16; ++dt) { const f32x4 v = O[dt] * inv; st_bf4(OX + trow * 1024 + h * 256 + dt * 16 + quad * 4, v[0], v[1], v[2], v[3]); }
}


#define XB_TMO      128
#define XB_XCNT(j)  (256  + 64 * (j))
#define XB_XSUB(j)  (1280 + 64 * (j))
#define XB_XGEN(j)  (2304 + 64 * (j))
#define XB_TOP      3328
#define XB_TOPGEN   3392
#define XCD_BAR_WORDS 3456
#define XB_SPIN_CAP (1u << 18)
#define LAS __attribute__((address_space(3)))
DEV unsigned xb_ld(unsigned* p)              { return __hip_atomic_load(p, __ATOMIC_RELAXED, __HIP_MEMORY_SCOPE_AGENT); }
DEV unsigned xb_add(unsigned* p, unsigned v) { return __hip_atomic_fetch_add(p, v, __ATOMIC_RELAXED, __HIP_MEMORY_SCOPE_AGENT); }
DEV unsigned xb_xcc_id() { return (unsigned)__builtin_amdgcn_s_getreg((3 << 11) | 20) & 0xFu; }
#define XB_SPIN(cond, bar) do { unsigned _sp = 0; while (cond) { __builtin_amdgcn_s_sleep(1); \
    if ((++_sp & 255u) == 0u) { if (xb_ld(&(bar)[XB_TMO])) break; if (_sp > XB_SPIN_CAP) { atomicAdd(&(bar)[XB_TMO], 1u); break; } } } } while (0)
struct XcdBarrier { unsigned* bar; unsigned x; volatile LAS unsigned* st; };
DEV XcdBarrier xcd_barrier_post(unsigned* bar, volatile LAS unsigned* st) {
    XcdBarrier b; b.bar = bar; b.x = xb_xcc_id(); b.st = st;
    if (threadIdx.x == 0) { st[2] = xb_add(&bar[XB_XCNT(b.x)], 1u); st[3] = b.x; }
    return b;
}
DEV void xcd_barrier_complete(unsigned* bar, unsigned x, unsigned& nloc, unsigned& nx) {
    const unsigned G = gridDim.x * gridDim.y * gridDim.z;
    unsigned sum, cnt, mine, sp = 0u;
    for (;;) {
        sum = 0u; cnt = 0u; mine = 0u;
#pragma unroll
        for (unsigned j = 0; j < 16; ++j) { const unsigned c = xb_ld(&bar[XB_XCNT(j)]); sum += c; cnt += (c > 0u) ? 1u : 0u; mine = (j == x) ? c : mine; }
        if (sum == G) break;
        __builtin_amdgcn_s_sleep(1);
        if ((++sp & 255u) == 0u) { if (xb_ld(&bar[XB_TMO])) break; if (sp > XB_SPIN_CAP) { atomicAdd(&bar[XB_TMO], 1u); break; } }
    }
    nloc = mine > 0u ? mine : 1u; nx = cnt > 0u ? cnt : 1u;
}
DEV void xcd_barrier(const XcdBarrier& b) {
    asm volatile("s_waitcnt vmcnt(0)" ::: "memory");
    __syncthreads();
    if (threadIdx.x == 0) {
        unsigned* bar = b.bar;
        __builtin_amdgcn_s_waitcnt(0);
        unsigned nloc = b.st[0], nx = b.st[1];
        if (nloc == 0u) { xcd_barrier_complete(bar, b.x, nloc, nx); b.st[0] = nloc; b.st[1] = nx; }
        const unsigned old = xb_add(&bar[XB_XSUB(b.x)], 1u);
        const unsigned gen = old / nloc;
        if (old + 1u == (gen + 1u) * nloc) {
            __builtin_amdgcn_fence(__ATOMIC_RELEASE, "agent");
            asm volatile("s_waitcnt vmcnt(0)" ::: "memory");
            const unsigned og = xb_add(&bar[XB_TOP], 1u);
            const unsigned tg = og / nx;
            if (og + 1u == (tg + 1u) * nx) xb_add(&bar[XB_TOPGEN], 1u);
            else XB_SPIN(xb_ld(&bar[XB_TOPGEN]) == tg, bar);
            __builtin_amdgcn_fence(__ATOMIC_ACQUIRE, "agent");
            xb_add(&bar[XB_XGEN(b.x)], 1u);
            asm volatile("s_waitcnt vmcnt(0)" ::: "memory");
        } else {
            XB_SPIN(xb_ld(&bar[XB_XGEN(b.x)]) == gen, bar);
            __builtin_amdgcn_fence(__ATOMIC_ACQUIRE, "agent");
            asm volatile("s_waitcnt vmcnt(0)" ::: "memory");
        }
    }
    __syncthreads();
}

constexpr int NPHASE = 17;
__global__ void __launch_bounds__(512, 2) fwd_kernel(P p) {
    extern __shared__ __attribute__((aligned(16))) unsigned char lds[];
#define WSB(off) ((bf16_t*)(ws + (off)))
#define WSF(off) ((float*)(ws + (off)))
    volatile LAS unsigned* bst = (volatile LAS unsigned*)(LAS unsigned char*)(lds + LDS_BYTES - 16);
    if (threadIdx.x == 0) { bst[0] = 0u; bst[1] = 0u; bst[2] = 0u; bst[3] = 0u; }
    __syncthreads();
    XcdBarrier gbar; gbar.bar = (unsigned*)(p.ws + O_BAR); gbar.x = 0; gbar.st = bst;
    if (p.coop) gbar = xcd_barrier_post((unsigned*)(p.ws + O_BAR), bst);
    const SsmIn sin_{p.in[5], p.in[6], p.in[7], p.in[8], p.in[9], p.in[10], p.in[12]};
    for (int ph = p.ph_lo; ph < p.ph_hi; ++ph) {
        size_t zoff = 0; asm volatile("" : "+s"(zoff)); unsigned char* ws = p.ws + zoff;
        switch (ph) {
#ifdef ONLY_PHASE
        default: break;
#define CASE(k) case (k): if ((k) != ONLY_PHASE) break; else
#else
#define CASE(k) case (k):
#endif
        CASE(0) {
            const int tid = get_tid();
            ln_pass(p.in[0], p.in[2], p.in[3], WSB(O_B), WSF(O_ST0), nullptr);
            int cur = 0;
            conv_job(p.in[4], 5168, 1024, 5376, WSB(O_WIN_T), 1, lds, cur);
            conv_job(p.in[13], 512, 512, 512, WSB(O_WGLU_T), 0, lds, cur);
            conv_job(p.in[15], 1024, 512, 1024, WSB(O_WSOUT_T), 0, lds, cur);
            conv_job(p.in[17], 256, 2048, 256, WSB(O_W1_T), 0, lds, cur);
            conv_job(p.in[17] + 2048 * 256, 256, 2048, 256, WSB(O_W1_T) + 256 * 2048, 0, lds, cur);
            conv_job(p.in[19], 64, 256, 256, WSB(O_W2_T), 3, lds, cur);
            conv_job(p.in[19] + 256 * 64, 64, 256, 256, WSB(O_W2_T) + 256 * 256, 3, lds, cur);
            conv_job(p.in[20], 1024, 1024, 1024, WSB(O_WNOUT_T), 0, lds, cur);
            conv_job(p.in[21], 1024, 1024, 1024, WSB(O_WOUT_T), 0, lds, cur);
            conv_job(p.in[24], 1024, 1024, 1024, WSB(O_WXQ_T), 0, lds, cur);
            conv_job(p.in[25], 2048, 1024, 2048, WSB(O_WXKV_T), 0, lds, cur);
            conv_job(p.in[26], 1024, 1024, 1024, WSB(O_WXO_T), 0, lds, cur);
            conv_job(p.in[29], 5632, 1024, 5632, WSB(O_WFIN_T), 2, lds, cur);
            conv_job(p.in[30], 1024, 2816, 1024, WSB(O_WFOUT_T), 0, lds, cur);
            for (int it = get_bid(); it < 128; it += gridDim.x) {
                const int z = it >> 6, ec = (it >> 4) & 3, fc = it & 15, e = ec * 64 + (tid & 63), fg = tid >> 6;
                float a = 0.f;
#pragma unroll 8
                for (int f = fc * 128 + fg * 16; f < fc * 128 + fg * 16 + 16; ++f) a += p.in[16][z * 2048 + f] * p.in[17][((size_t)z * 2048 + f) * 256 + e];
                float* red = (float*)lds;
                __syncthreads(); red[tid] = a; __syncthreads();
                if (tid < 64) { float t = 0.f; for (int k = 0; k < 8; ++k) t += red[tid + 64 * k]; WSF(O_BPART)[(z * 16 + fc) * 256 + e] = t; }
                __syncthreads();
            }
            ssm_prep(sin_, WSB(O_BT1), WSB(O_MTW), lds);
        } break;
        CASE(1) {
            if (get_bid() == 0) { for (int e = get_tid(); e < 512; e += NTHR) { float a = p.in[18][e]; for (int fc = 0; fc < 16; ++fc) a += WSF(O_BPART)[((e >> 8) * 16 + fc) * 256 + (e & 255)]; WSF(O_BIAS2)[e] = a; } }
            { const GemmP g{WSB(O_B), WSB(O_WIN_T), 1024, 1024, 256, 42, 16, 1};
              const EpiIn e{WSB(O_UH), WSB(O_QB), WSB(O_KVC), WSB(O_KS), WSB(O_VST), WSB(O_KW), WSB(O_VWT), WSB(O_GM), WSF(O_GN)};
              gemm_run<8>(g, AddrNone{}, e, lds); }
        } break;
        CASE(2) {
            { const GemmP g{WSB(O_KVC), WSB(O_W1_T), 1024, 2048, 1, 2, 32, 128};
              const EpiCmp1 e{WSB(O_HID), WSF(O_BIAS2)};
              gemm_run<4>(g, AddrCmp1{}, e, lds); }
            { const GemmP g{WSB(O_UH), WSB(O_BT1), 640, 512, 8, 2, 8, 32};
              const EpiSsmA e{WSF(O_SS)};
              gemm_run<8>(g, AddrStride{1024ull * 640, 256ull * 512}, e, lds); }
        } break;
        CASE(3) {
            ssm_scan(sin_, WSF(O_SS), WSB(O_UH));
            { const GemmP g{WSB(O_HID), WSB(O_W2_T), 256, 256, 1, 2, 4, 128};
              const EpiCmp2 e{WSB(O_KC), WSB(O_VCT)};
              gemm_run<4>(g, AddrCmp2{}, e, lds); }
        } break;
        CASE(4) {
            const NsaCtx c{WSB(O_QB), WSB(O_KC), WSB(O_VCT), WSB(O_KS), WSB(O_VST), WSB(O_KW), WSB(O_VWT), WSF(O_GN), WSB(O_B)};
            const int G = gridDim.x;
            for (int i = 0;; ++i) {
                const int u = (i & 1) ? i * G + (G - 1 - get_bid()) : i * G + get_bid();
                if (i * G >= 2048) break;
                if (u < 2048) { const int qb = 31 - (u >> 6), bh = u & 63; nsa_unit(c, bh >> 2, bh & 3, qb, lds); }
                __syncthreads();
            }
            { const GemmP g{WSB(O_UH), WSB(O_MTW), 640, 640, 8, 4, 10, 32};
              const EpiSsmB e{WSB(O_UH), p.in[11], WSB(O_GB)};
              gemm_run<8>(g, AddrStride{1024ull * 640, 512ull * 640}, e, lds); }
        } break;
        CASE(5) { const GemmP g{WSB(O_GB), WSB(O_WGLU_T), 512, 512, 256, 4, 8, 1}; const EpiGlu e{WSB(O_GB), p.in[14], WSB(O_YS)}; gemm_run<8>(g, AddrNone{}, e, lds); } break;
        CASE(6) { const GemmP g{WSB(O_YS), WSB(O_WSOUT_T), 512, 512, 256, 8, 8, 1}; const EpiSout e{WSB(O_GM), WSB(O_QB)}; gemm_run<8>(g, AddrNone{}, e, lds); } break;
        CASE(7) { const GemmP g{WSB(O_B), WSB(O_WNOUT_T), 1024, 1024, 256, 8, 16, 1}; const EpiNout e{WSB(O_GM), WSB(O_QB), WSB(O_MIXIN)}; gemm_run<8>(g, AddrNone{}, e, lds); } break;
        CASE(8) { const GemmP g{WSB(O_MIXIN), WSB(O_WOUT_T), 1024, 1024, 256, 8, 16, 1}; const EpiRes e{p.in[0], WSF(O_ST0), p.in[2], p.in[3], WSF(O_V1)}; gemm_run<8>(g, AddrNone{}, e, lds); } break;
        CASE(9) { ln_pass(WSF(O_V1), p.in[22], p.in[23], WSB(O_B), WSF(O_ST1), nullptr);
            for (size_t i = (size_t)get_bid() * NTHR + get_tid(); i < 4096ull * 1024 / 4; i += (size_t)gridDim.x * NTHR) { const f32x4 v = ((const f32x4*)p.in[1])[i]; st_bf4(WSB(O_MEMB) + i * 4, v[0], v[1], v[2], v[3]); }
        } break;
        CASE(10) { { const GemmP g{WSB(O_B), WSB(O_WXQ_T), 1024, 1024, 256, 8, 16, 1}; const EpiScaleBf e{WSB(O_QB), 1024, 0.0625f * LOG2E}; gemm_run<8>(g, AddrNone{}, e, lds); }
            { const GemmP g{WSB(O_MEMB), WSB(O_WXKV_T), 1024, 1024, 32, 16, 16, 1};
              const EpiXkv e{WSB(O_XK), WSB(O_XVT)};
              gemm_run<8>(g, AddrNone{}, e, lds); }
        } break;
        CASE(11) {
            for (int u = get_bid(); u < 1024; u += gridDim.x) { const int qblk = u >> 6, bh = u & 63; xattn_unit(WSB(O_QB), WSB(O_XK), WSB(O_XVT), WSB(O_B), bh >> 2, bh & 3, qblk, lds); }
        } break;
        CASE(12) { const GemmP g{WSB(O_B), WSB(O_WXO_T), 1024, 1024, 256, 8, 16, 1}; const EpiRes e{WSF(O_V1), WSF(O_ST1), p.in[22], p.in[23], WSF(O_V2)}; gemm_run<8>(g, AddrNone{}, e, lds); } break;
        CASE(13) ln_pass(WSF(O_V2), p.in[27], p.in[28], WSB(O_B), WSF(O_ST2), nullptr); break;
        CASE(14) { const GemmP g{WSB(O_B), WSB(O_WFIN_T), 1024, 1024, 256, 44, 16, 1}; const EpiFfnIn e{WSB(O_FB)}; gemm_run<8>(g, AddrNone{}, e, lds); } break;
        CASE(15) { const GemmP g{WSB(O_FB), WSB(O_WFOUT_T), 2816, 2816, 256, 8, 44, 1}; const EpiRes e{WSF(O_V2), WSF(O_ST2), p.in[27], p.in[28], WSF(O_V2)}; gemm_run<8>(g, AddrNone{}, e, lds); } break;
        CASE(16) ln_pass(WSF(O_V2), p.in[31], p.in[32], nullptr, nullptr, p.out); break;
        }
        if (ph + 1 < p.ph_hi) { if (p.coop) xcd_barrier(gbar); if (p.pad == 0x5eed) cg::this_grid().sync(); }
    }
}

#ifndef ONE_LAUNCH
#define ONE_LAUNCH 1
#endif
extern "C" void kernel_launch(void* const* d_in, const int* in_sizes, int n_in, void* d_out, int out_size, void* d_ws, size_t ws_size, hipStream_t stream) {
    static int grid = 0;
    if (grid == 0) {
        if (n_in != 33 || out_size != T_ * 1024 || ws_size < WS_NEED) { fprintf(stderr, "kernel_launch: unexpected shapes (n_in %d out %d ws %zu need %zu)\n", n_in, out_size, ws_size, (size_t)WS_NEED); grid = -1; return; }
        int dev = 0, cus = 0, per_cu = 0;
        hipGetDevice(&dev);
        hipDeviceGetAttribute(&cus, hipDeviceAttributeMultiprocessorCount, dev);
        if (hipFuncSetAttribute((const void*)fwd_kernel, hipFuncAttributeMaxDynamicSharedMemorySize, LDS_BYTES) != hipSuccess) { fprintf(stderr, "kernel_launch: hipFuncSetAttribute failed\n"); grid = -1; return; }
        if (hipOccupancyMaxActiveBlocksPerMultiprocessor(&per_cu, (const void*)fwd_kernel, NTHR, LDS_BYTES) != hipSuccess || per_cu < 1) { fprintf(stderr, "kernel_launch: occupancy query failed (%d)\n", per_cu); per_cu = 1; (void)hipGetLastError(); }
        if (per_cu > 1) per_cu = 1;
        grid = cus * per_cu;
    }
    if (grid < 0) return;
    P p{};
    for (int i = 0; i < 33; ++i) p.in[i] = (const float*)d_in[i];
    p.out = (float*)d_out; p.ws = (unsigned char*)d_ws;
#if ONE_LAUNCH
    p.ph_lo = 0; p.ph_hi = NPHASE; p.coop = 1;
    if (hipMemsetAsync((unsigned char*)d_ws + O_BAR, 0, XCD_BAR_WORDS * 4, stream) != hipSuccess) { fprintf(stderr, "kernel_launch: memset of barrier words failed\n"); return; }
    void* args[] = {&p};
    hipError_t e = hipLaunchCooperativeKernel((const void*)fwd_kernel, dim3(grid), dim3(NTHR), args, LDS_BYTES, stream);
    if (e != hipSuccess) fprintf(stderr, "cooperative launch failed: %s (grid %d)\n", hipGetErrorString(e), grid);
#else
#ifdef STOP_AFTER
    const int nrun = STOP_AFTER + 1;
#else
    const int nrun = NPHASE;
#endif
    for (int ph = 0; ph < nrun; ++ph) {
        p.ph_lo = ph; p.ph_hi = ph + 1; p.coop = 0;
        hipLaunchKernelGGL(fwd_kernel, dim3(grid), dim3(NTHR), LDS_BYTES, stream, p);
    }
#endif
}
```

```cpp
#include <hip/hip_runtime.h>
#include <hip/hip_cooperative_groups.h>
#include <cstdio>
#include <cstdint>
namespace cg = cooperative_groups;

typedef unsigned short bf16_t;
typedef short bf16x8 __attribute__((ext_vector_type(8)));
typedef float f32x4 __attribute__((ext_vector_type(4)));
typedef unsigned u32x4 __attribute__((ext_vector_type(4)));
typedef unsigned u32x2 __attribute__((ext_vector_type(2)));
#define DEV __device__ __forceinline__

constexpr int T_ = 32768, L_ = 2048;
constexpr float LOG2E = 1.4426950408889634f;
constexpr float ALPHA = 1.189207115002721f;
constexpr float LN_EPS = 1e-5f;
constexpr float NEG = -1e30f;
constexpr int LDS_BYTES = 147456;
constexpr int NTHR = 512, NWAVE = 8;
constexpr size_t MiB = 1048576;

constexpr size_t O_WIN_T = 0;
constexpr size_t O_WGLU_T = O_WIN_T + 5376ull * 1024 * 2;
constexpr size_t O_WSOUT_T = O_WGLU_T + 512ull * 512 * 2;
constexpr size_t O_W1_T = O_WSOUT_T + 1024ull * 512 * 2;
constexpr size_t O_W2_T = O_W1_T + 2ull * 256 * 2048 * 2;
constexpr size_t O_WNOUT_T = O_W2_T + 2ull * 256 * 256 * 2;
constexpr size_t O_WOUT_T = O_WNOUT_T + 2 * MiB;
constexpr size_t O_WXQ_T = O_WOUT_T + 2 * MiB;
constexpr size_t O_WXKV_T = O_WXQ_T + 2 * MiB;
constexpr size_t O_WXO_T = O_WXKV_T + 4 * MiB;
constexpr size_t O_WFIN_T = O_WXO_T + 2 * MiB;
constexpr size_t O_WFOUT_T = O_WFIN_T + 5632ull * 1024 * 2;
constexpr size_t O_BT1 = O_WFOUT_T + 1024ull * 2816 * 2;
constexpr size_t O_MTW = O_BT1 + 8 * MiB;
constexpr size_t O_KC = O_MTW + 20 * MiB;
constexpr size_t O_VCT = O_KC + 1 * MiB;
constexpr size_t O_GN = O_VCT + 1 * MiB;
constexpr size_t O_ST0 = O_GN + 6 * MiB;
constexpr size_t O_ST1 = O_ST0 + 262144;
constexpr size_t O_ST2 = O_ST1 + 262144;
constexpr size_t O_BIAS2 = O_ST2 + 262144;
constexpr size_t O_BPART = O_BIAS2 + 4096;
constexpr size_t O_BAR = O_BPART + 32768;
constexpr size_t O_A = 81 * MiB;
constexpr size_t O_KVC = O_A;
constexpr size_t O_KS = O_A + 32 * MiB;
constexpr size_t O_VST = O_A + 48 * MiB;
constexpr size_t O_KW = O_A + 64 * MiB;
constexpr size_t O_VWT = O_A + 80 * MiB;
constexpr size_t O_GB = O_A + 96 * MiB;
constexpr size_t O_MIXIN = O_A;
constexpr size_t O_MEMB = O_A + 64 * MiB;
constexpr size_t O_XK = O_A + 72 * MiB;
constexpr size_t O_XVT = O_A + 80 * MiB;
constexpr size_t O_V2 = O_A;
constexpr size_t O_B = O_A + 128 * MiB;
constexpr size_t O_SS = O_B;
constexpr size_t O_HID = O_B + 16 * MiB;
constexpr size_t O_Y = O_B + 64 * MiB;
constexpr size_t O_GM = O_Y;
constexpr size_t O_V1 = O_Y;
constexpr size_t O_X = O_Y + 128 * MiB;
constexpr size_t O_QB = O_X;
constexpr size_t O_UH = O_X + 64 * MiB;
constexpr size_t O_YS = O_X + 64 * MiB;
constexpr size_t O_FB = O_Y;
constexpr size_t WS_NEED = O_X + 104 * MiB;
static_assert(O_BAR + 16384 <= O_A, "F region overflow");

struct P {
    const float* in[33];
    float* out;
    unsigned char* ws;
    int ph_lo, ph_hi, coop, pad;
};

DEV int get_tid() { int t = threadIdx.x; asm volatile("" : "+v"(t)); return t; }
DEV int get_bid() { int t = blockIdx.x; asm volatile("" : "+s"(t)); return t; }
typedef __bf16 bf2_t __attribute__((ext_vector_type(2)));
typedef float f32x2_t __attribute__((ext_vector_type(2)));
DEV unsigned cvt_pk_bf16(float lo, float hi) { const f32x2_t f = {lo, hi}; const bf2_t r = __builtin_convertvector(f, bf2_t); return __builtin_bit_cast(unsigned, r); }
DEV bf16_t f2bf(float v) { return (bf16_t)(cvt_pk_bf16(v, 0.f) & 0xffffu); }
DEV float bf2f(unsigned v) { return __uint_as_float(v << 16); }
DEV float bflo(unsigned w) { return __uint_as_float(w << 16); }
DEV float bfhi(unsigned w) { return __uint_as_float(w & 0xffff0000u); }
DEV float fexp2(float x) { return __builtin_amdgcn_exp2f(x); }
DEV float frcp(float x) { return __builtin_amdgcn_rcpf(x); }
DEV float sigmoidf_(float x) { return frcp(1.f + fexp2(-x * LOG2E)); }
DEV float gelu_tanh(float x) { const float u = 0.7978845608028654f * (x + 0.044715f * x * x * x); return x * frcp(1.f + fexp2(-2.f * LOG2E * u)); }
DEV void st_bf4(bf16_t* p, float a, float b, float c, float d) { u32x2 w; w.x = cvt_pk_bf16(a, b); w.y = cvt_pk_bf16(c, d); *(u32x2*)p = w; }
DEV f32x4 ld_bf4(const bf16_t* p) { const u32x2 w = *(const u32x2*)p; return (f32x4){bflo(w.x), bfhi(w.x), bflo(w.y), bfhi(w.y)}; }
DEV float wred_sum(float v) {
#pragma unroll
    for (int o = 32; o >= 1; o >>= 1) v += __shfl_xor(v, o);
    return v;
}

DEV void ln_pass(const float* src, const float* g, const float* b, bf16_t* dstb, float* stats, float* dstf) {
    const int lane = get_tid() & 63, wid = get_tid() >> 6;
    const int nw = gridDim.x * NWAVE;
    for (int row = get_bid() * NWAVE + wid; row < T_; row += nw) {
        const f32x4* p = (const f32x4*)(src + (size_t)row * 1024);
        f32x4 v[4];
#pragma unroll
        for (int i = 0; i < 4; ++i) v[i] = p[lane + 64 * i];
        float s = 0.f;
#pragma unroll
        for (int i = 0; i < 4; ++i) s += (v[i][0] + v[i][1]) + (v[i][2] + v[i][3]);
        s = wred_sum(s);
        const float mu = s * (1.f / 1024.f);
        float q = 0.f;
#pragma unroll
        for (int i = 0; i < 4; ++i) { const f32x4 d = v[i] - mu; q += (d[0] * d[0] + d[1] * d[1]) + (d[2] * d[2] + d[3] * d[3]); }
        q = wred_sum(q);
        const float rstd = 1.0f / sqrtf(q * (1.f / 1024.f) + LN_EPS);
        if (stats && lane == 0) { stats[row * 2] = mu; stats[row * 2 + 1] = rstd; }
#pragma unroll
        for (int i = 0; i < 4; ++i) {
            const int col = (lane + 64 * i) * 4;
            const f32x4 gg = *(const f32x4*)(g + col), bb = *(const f32x4*)(b + col);
            const f32x4 y = (v[i] - mu) * rstd * gg + bb;
            if (dstb) st_bf4(dstb + (size_t)row * 1024 + col, y[0], y[1], y[2], y[3]);
            if (dstf) *(f32x4*)(dstf + (size_t)row * 1024 + col) = y;
        }
    }
}

DEV int colmap(int mode, int n) {
    if (mode == 0) return n;
    if (mode == 1) return n < 3072 ? n : (n < 5120 ? n + 48 : (n < 5168 ? n - 5120 + 3072 : -1));
    if (mode == 2) { const int blk = n >> 5, r = n & 31; return r < 16 ? blk * 16 + r : 2816 + blk * 16 + (r - 16); }
    return n < 64 ? n : -1;
}
DEV void conv_job(const float* src, int ldsrc, int K, int N, bf16_t* dst, int mode, unsigned char* lds, int& cursor) {
    const int tid = get_tid(), lane = tid & 63, gw = get_bid() * NWAVE + (tid >> 6), nw = gridDim.x * NWAVE;
    const int kb = K / 32, nitem = (N / 64) * kb;
    for (int t = (gw + nw - (cursor % nw)) % nw; t < nitem; t += nw) {
        const int k0 = (t % kb) * 32, n = (t / kb) * 64 + lane;
        const int sc = colmap(mode, n);
        float e[32];
#pragma unroll
        for (int r = 0; r < 32; ++r) e[r] = sc >= 0 ? src[(size_t)(k0 + r) * ldsrc + sc] : 0.f;
#pragma unroll
        for (int q = 0; q < 4; ++q) { u32x4 w; w.x = cvt_pk_bf16(e[8 * q], e[8 * q + 1]); w.y = cvt_pk_bf16(e[8 * q + 2], e[8 * q + 3]); w.z = cvt_pk_bf16(e[8 * q + 4], e[8 * q + 5]); w.w = cvt_pk_bf16(e[8 * q + 6], e[8 * q + 7]);
            *(u32x4*)(dst + (size_t)n * K + k0 + 8 * q) = w; }
    }
    cursor += nitem;
}

struct SsmIn { const float *a_re, *a_im, *b_re, *b_im, *c_re, *c_im, *log_dt; };
DEV void lb_pow(const SsmIn& s, int g, int n, float p, float& re, float& im) {
    const float lre = fminf(s.a_re[g * 64 + n], -1e-4f), lim = s.a_im[g * 64 + n], dt = expf(s.log_dt[g]);
    const float mag = expf(lre * dt * p); float sn, cs; sincosf(lim * dt * p, &sn, &cs);
    re = mag * cs; im = mag * sn;
}
DEV void bbar(const SsmIn& s, int g, int n, int c, float& re, float& im) {
    const float lre = fminf(s.a_re[g * 64 + n], -1e-4f), lim = s.a_im[g * 64 + n], dt = expf(s.log_dt[g]);
    const float mag = expf(lre * dt); float sn, cs; sincosf(lim * dt, &sn, &cs);
    const float sh = sinf(0.5f * lim * dt);
    const float nr = expm1f(lre * dt) - mag * 2.f * sh * sh, lbi = mag * sn;
    const float den = lre * lre + lim * lim;
    const float fre = (nr * lre + lbi * lim) / den, fim = (lbi * lre - nr * lim) / den;
    const float br = s.b_re[(g * 64 + n) * 16 + c], bi = s.b_im[(g * 64 + n) * 16 + c];
    re = fre * br - fim * bi; im = fre * bi + fim * br;
}
DEV void ssm_prep(const SsmIn& s, bf16_t* BT1, bf16_t* MTW, unsigned char* lds) {
    const int tid = get_tid();
    float* pw = (float*)lds;
    float* bb = pw + 33 * 128;
    float* cc = bb + 2048;
    float* fn = cc + 2048;
    float* km = fn + 128;
    for (int job = get_bid(); job < 512; job += gridDim.x) {
        const int g = job >> 4, pt = job & 15;
        __syncthreads();
        for (int e = tid; e < 33 * 64; e += NTHR) { float pr, pi; lb_pow(s, g, e & 63, (float)(e >> 6), pr, pi); pw[e * 2] = pr; pw[e * 2 + 1] = pi; }
        if (tid < 64) {
            const int n = tid;
            const float lre = fminf(s.a_re[g * 64 + n], -1e-4f), lim = s.a_im[g * 64 + n], dt = expf(s.log_dt[g]);
            const float mag = expf(lre * dt); float sn, cs; sincosf(lim * dt, &sn, &cs);
            const float sh = sinf(0.5f * lim * dt);
            const float nr = expm1f(lre * dt) - mag * 2.f * sh * sh, lbi = mag * sn;
            const float den = lre * lre + lim * lim;
            fn[n * 2] = (nr * lre + lbi * lim) / den; fn[n * 2 + 1] = (lbi * lre - nr * lim) / den;
        }
        for (int e = tid; e < 1024; e += NTHR) { const int c = e >> 6, n = e & 63; cc[e * 2] = s.c_re[(g * 16 + c) * 64 + n]; cc[e * 2 + 1] = s.c_im[(g * 16 + c) * 64 + n]; }
        __syncthreads();
        for (int e = tid; e < 1024; e += NTHR) { const int n = e >> 4; const float fre = fn[n * 2], fim = fn[n * 2 + 1];
            const float br = s.b_re[(g * 64) * 16 + e], bi = s.b_im[(g * 64) * 16 + e];
            bb[e * 2] = fre * br - fim * bi; bb[e * 2 + 1] = fre * bi + fim * br; }
        __syncthreads();
        for (int i = tid; i < 4096; i += NTHR) { const int e = pt * 4096 + i, nn = e >> 9, kk = e & 511, n = nn & 63, sidx = kk >> 4, c = kk & 15;
            const float pr = pw[((31 - sidx) * 64 + n) * 2], pi = pw[((31 - sidx) * 64 + n) * 2 + 1], br = bb[(n * 16 + c) * 2], bi = bb[(n * 16 + c) * 2 + 1];
            BT1[(size_t)g * 131072 + e] = f2bf((nn >> 6) ? (pr * bi + pi * br) : (pr * br - pi * bi)); }
        for (int i = tid; i < 4096; i += NTHR) BT1[(size_t)g * 131072 + 65536 + pt * 4096 + i] = 0;
        for (int i = tid; i < 4096; i += NTHR) { const int e = pt * 4096 + i, nn = e & 127, r = e >> 7, n = nn & 63, tau = r >> 4, c = r & 15;
            const float pr = pw[((tau + 1) * 64 + n) * 2], pi = pw[((tau + 1) * 64 + n) * 2 + 1], cr = cc[(c * 64 + n) * 2], ci = cc[(c * 64 + n) * 2 + 1];
            MTW[((size_t)g * 512 + r) * 640 + 512 + nn] = f2bf((nn >> 6) ? -(cr * pi + ci * pr) : (cr * pr - ci * pi)); }
        for (int i = tid; i < 32 * 512; i += NTHR) { const int r = pt * 32 + (i >> 9), kk = i & 511; if ((kk >> 4) > (r >> 4)) MTW[((size_t)g * 512 + r) * 640 + kk] = 0; }
        if (tid < 256) for (int dd = 0; dd < 2; ++dd) { const int d = 2 * pt + dd, c = tid >> 4, c2 = tid & 15; float acc = 0.f;
            for (int n = 0; n < 64; ++n) { const float cr = cc[(c * 64 + n) * 2], ci = cc[(c * 64 + n) * 2 + 1], pr = pw[(d * 64 + n) * 2], pi = pw[(d * 64 + n) * 2 + 1];
                const float xr = cr * pr - ci * pi, xi = cr * pi + ci * pr; acc += xr * bb[(n * 16 + c2) * 2] - xi * bb[(n * 16 + c2) * 2 + 1]; }
            km[dd * 256 + tid] = acc; }
        __syncthreads();
        if (tid < 256) for (int dd = 0; dd < 2; ++dd) { const int d = 2 * pt + dd; const bf16_t v = f2bf(km[dd * 256 + tid]); const int c = tid >> 4, c2 = tid & 15;
            for (int sidx = 0; sidx + d < 32; ++sidx) MTW[((size_t)g * 512 + (sidx + d) * 16 + c) * 640 + sidx * 16 + c2] = v; }
    }
    __syncthreads();
}
DEV void ssm_scan(const SsmIn& s, const float* SS, bf16_t* UH) {
    for (int idx = get_bid() * NTHR + get_tid(); idx < 32768; idx += gridDim.x * NTHR) {
        const int n = idx & 63, b = (idx >> 6) & 15, g = idx >> 10;
        float ar, ai; lb_pow(s, g, n, 32.f, ar, ai);
        float hr = 0.f, hi = 0.f;
        const size_t row0 = (size_t)(g * 16 + b) * 64;
#pragma unroll 8
        for (int k = 0; k < 64; ++k) {
            UH[(row0 + k) * 640 + 512 + n] = f2bf(hr); UH[(row0 + k) * 640 + 576 + n] = f2bf(hi);
            const float sr = SS[(row0 + k) * 128 + n], si = SS[(row0 + k) * 128 + 64 + n];
            const float nr = ar * hr - ai * hi + sr, ni = ar * hi + ai * hr + si;
            hr = nr; hi = ni;
        }
    }
}

struct GemmP { const bf16_t* A; const bf16_t* Bt; int lda, ldb, MT, NT, KT, nbatch; };
#define GLAS __attribute__((address_space(3)))
template <int WM, class Addr, class Epi>
DEV void gemm_run(const GemmP p, const Addr ad, const Epi epi, unsigned char* lds_) {
    constexpr int TM = 32 * WM, ABYTES = TM * 128, STAGE = ABYTES + 32768, NLA = WM / 2;
    GLAS unsigned char* lds = (GLAS unsigned char*)lds_;
    const int tid = get_tid(), lane = tid & 63, wid = __builtin_amdgcn_readfirstlane(tid >> 6), wr = wid >> 2, wc = wid & 3, l15 = lane & 15, quad = lane >> 4;
    int nx, x, jx, stride;
    { volatile GLAS unsigned* cw = (volatile GLAS unsigned*)(lds + LDS_BYTES - 16);
      const int nloc = (int)cw[0], nxc = (int)cw[1], rank = (int)cw[2], xcc = (int)cw[3];
      if (nloc > 0 && xcc < nxc && rank < nloc) { nx = nxc; x = xcc; jx = rank; stride = nloc; }
      else { nx = 1; x = 0; jx = get_bid(); stride = gridDim.x; } }
    nx = __builtin_amdgcn_readfirstlane(nx); x = __builtin_amdgcn_readfirstlane(x); jx = __builtin_amdgcn_readfirstlane(jx); stride = __builtin_amdgcn_readfirstlane(stride);
    const int MTT = p.MT / (WM / 4), NTT = p.NT / 2;
    const int SRtot = (p.nbatch * MTT) / 8, per = 8 * NTT, KT = p.KT;
    int offA[NLA], offB[4];
#pragma unroll
    for (int i = 0; i < NLA; ++i) { const int row = (wid + 8 * i) * 8 + (lane >> 3), c = (lane & 7) ^ ((row >> 1) & 7); offA[i] = row * p.lda + c * 8; }
#pragma unroll
    for (int i = 0; i < 4; ++i) { const int row = (wid + 8 * i) * 8 + (lane >> 3), c = (lane & 7) ^ ((row >> 1) & 7); offB[i] = row * p.ldb + c * 8; }
    const int sw = (l15 >> 1) & 7;
    int aoff[2], boff[2];
#pragma unroll
    for (int ks = 0; ks < 2; ++ks) { const int c = ((ks * 4 + quad) ^ sw) * 16; aoff[ks] = (wr * (WM * 16) + l15) * 128 + c; boff[ks] = ABYTES + (wc * 64 + l15) * 128 + c; }
    int ls = jx, lkt = 0; const bf16_t* lA = nullptr; const bf16_t* lB = nullptr; bool lvalid;
#define GEMM_DECODE_L() do { const int q_ = ls / per, rem_ = ls % per, sr_ = x + nx * q_; lvalid = sr_ < SRtot; if (lvalid) { const int R_ = sr_ * 8 + (rem_ & 7), b_ = R_ / MTT; \
        lA = p.A + ad.a_off(b_) + (size_t)((R_ % MTT) * TM) * p.lda; lB = p.Bt + ad.b_off(b_) + (size_t)((rem_ >> 3) * 256) * p.ldb; } } while (0)
#define GEMM_ISSUE(stg) do { _Pragma("unroll") for (int i_ = 0; i_ < NLA; ++i_) \
        __builtin_amdgcn_global_load_lds((const unsigned*)(lA + offA[i_] + lkt * 64), (GLAS unsigned*)(lds + (stg) * STAGE + (wid + 8 * i_) * 1024), 16, 0, 0); \
        _Pragma("unroll") for (int i_ = 0; i_ < 4; ++i_) \
        __builtin_amdgcn_global_load_lds((const unsigned*)(lB + offB[i_] + lkt * 64), (GLAS unsigned*)(lds + (stg) * STAGE + ABYTES + (wid + 8 * i_) * 1024), 16, 0, 0); \
        ++issued; if (++lkt == KT) { lkt = 0; ls += stride; GEMM_DECODE_L(); } } while (0)
    GEMM_DECODE_L();
    int issued = 0;
    asm volatile("s_waitcnt vmcnt(0)" ::: "memory");
    __syncthreads();
    if (lvalid) GEMM_ISSUE(0);
    f32x4 acc[WM][4];
#pragma unroll
    for (int i = 0; i < WM; ++i)
#pragma unroll
        for (int j = 0; j < 4; ++j) acc[i][j] = (f32x4){0.f, 0.f, 0.f, 0.f};
    int cs = jx, ckt = 0;
#pragma unroll 1
    for (int it = 0; it < issued; ++it) {
        asm volatile("s_waitcnt vmcnt(0)" ::: "memory");
        __builtin_amdgcn_s_barrier();
        asm volatile("" ::: "memory");
        if (lvalid) GEMM_ISSUE((it + 1) & 1);
        asm volatile("" ::: "memory");
        const GLAS unsigned char* st = lds + (it & 1) * STAGE;
#pragma unroll
        for (int ks = 0; ks < 2; ++ks) {
            bf16x8 af[WM], bfr[4];
#pragma unroll
            for (int i = 0; i < 4; ++i) bfr[i] = *(const GLAS bf16x8*)(st + boff[ks] + i * 2048);
#pragma unroll
            for (int i = 0; i < WM; ++i) af[i] = *(const GLAS bf16x8*)(st + aoff[ks] + i * 2048);
#pragma unroll
            for (int mi = 0; mi < WM; ++mi)
#pragma unroll
                for (int ni = 0; ni < 4; ++ni) acc[mi][ni] = __builtin_amdgcn_mfma_f32_16x16x32_bf16(bfr[ni], af[mi], acc[mi][ni], 0, 0, 0);
        }
        if (++ckt == KT) {
            const int q_ = cs / per, rem_ = cs % per, R_ = (x + nx * q_) * 8 + (rem_ & 7);
#pragma unroll
            for (int h = 0; h < WM / 4; ++h)
                epi(reinterpret_cast<const f32x4 (&)[4][4]>(acc[4 * h]), R_ / MTT, (R_ % MTT) * TM + wr * (WM * 16) + h * 64, (rem_ >> 3) * 256 + wc * 64, l15, quad);
#pragma unroll
            for (int i = 0; i < WM; ++i)
#pragma unroll
                for (int j = 0; j < 4; ++j) acc[i][j] = (f32x4){0.f, 0.f, 0.f, 0.f};
            ckt = 0; cs += stride;
        }
    }
    asm volatile("s_waitcnt vmcnt(0) lgkmcnt(0)" ::: "memory");
    __syncthreads();
#undef GEMM_DECODE_L
#undef GEMM_ISSUE
}
struct AddrNone { DEV size_t a_off(int) const { return 0; } DEV size_t b_off(int) const { return 0; } };
struct AddrStride { size_t as, bs; DEV size_t a_off(int b) const { return as * b; } DEV size_t b_off(int b) const { return bs * b; } };
struct AddrCmp1 { DEV size_t a_off(int b) const { return (size_t)b * 2048 * 64; } DEV size_t b_off(int b) const { return (size_t)((b >> 2) & 1) * 256 * 2048; } };
struct AddrCmp2 { DEV size_t a_off(int b) const { return (size_t)b * 128 * 256; } DEV size_t b_off(int b) const { return (size_t)((b >> 2) & 1) * 256 * 256; } };

#define EPI_ARGS const f32x4 (&acc)[4][4], int batch, int m0, int n0, int l15, int quad
struct EpiIn {
    bf16_t *UH, *Qb, *KVC, *KS, *VST, *KW, *VWT, *GM; float* GN;
    DEV void operator()(EPI_ARGS) const {
#pragma unroll
        for (int mi = 0; mi < 4; ++mi) {
            const int t = m0 + mi * 16 + l15, b = t >> 11, tt = t & 2047;
#pragma unroll
            for (int ni = 0; ni < 4; ++ni) {
                const f32x4 v = acc[mi][ni];
                const int c = n0 + ni * 16 + quad * 4;
                if (n0 < 512) {
                    const int g = c >> 4;
                    st_bf4(UH + ((size_t)((g * 16 + b) * 64 + (tt >> 5))) * 640 + (tt & 31) * 16 + (c & 15), v[0], v[1], v[2], v[3]);
                } else if (n0 < 1536) {
                    const float sc = 0.125f * LOG2E;
                    st_bf4(Qb + (size_t)t * 1024 + (c - 512), v[0] * sc, v[1] * sc, v[2] * sc, v[3] * sc);
                } else if (n0 < 2048) {
                    const int cc = c - 1536, z = cc >> 8, h = (cc >> 6) & 3, d = cc & 63;
                    st_bf4(KVC + ((size_t)(((b * 2 + z) * 4 + h) * 2048 + tt)) * 64 + d, v[0], v[1], v[2], v[3]);
                } else if (n0 < 3072) {
                    const int cc = (c - 2048) & 511, isw = (c - 2048) >> 9, h = (cc >> 6) & 3, d = cc & 63;
                    if (cc < 256) st_bf4((isw ? KW : KS) + ((size_t)((b * 4 + h) * 2048 + tt)) * 64 + d, v[0], v[1], v[2], v[3]);
                    else { bf16_t* o = (isw ? VWT : VST) + ((size_t)((b * 4 + h) * 64 + d)) * 2048 + tt;
#pragma unroll
                        for (int i = 0; i < 4; ++i) o[(size_t)i * 2048] = f2bf(v[i]); }
                } else if (n0 < 5120) {
                    st_bf4(GM + (size_t)t * 2048 + (c - 3072), sigmoidf_(v[0]), sigmoidf_(v[1]), sigmoidf_(v[2]), sigmoidf_(v[3]));
                } else {
                    const int cc = c - 5120;
                    if (cc < 48) *(f32x4*)(GN + (size_t)t * 48 + cc) = (f32x4){sigmoidf_(v[0]), sigmoidf_(v[1]), sigmoidf_(v[2]), sigmoidf_(v[3])};
                }
            }
        }
    }
};
struct EpiXkv {
    bf16_t *XK, *XVT;
    DEV void operator()(EPI_ARGS) const {
#pragma unroll
        for (int mi = 0; mi < 4; ++mi) {
            const int r = m0 + mi * 16 + l15, b = r >> 8, m = r & 255;
#pragma unroll
            for (int ni = 0; ni < 4; ++ni) {
                const f32x4 v = acc[mi][ni]; const int c = n0 + ni * 16 + quad * 4;
                if (n0 < 1024) st_bf4(XK + (size_t)r * 1024 + c, v[0], v[1], v[2], v[3]);
                else { const int cc = c - 1024, h = cc >> 8, d = cc & 255; bf16_t* o = XVT + ((size_t)((b * 4 + h) * 256 + d)) * 256 + m;
#pragma unroll
                    for (int i = 0; i < 4; ++i) o[i * 256] = f2bf(v[i]); }
            }
        }
    }
};
struct EpiSsmA { float* SS;
    DEV void operator()(EPI_ARGS) const {
        if (n0 >= 128) return;
#pragma unroll
        for (int mi = 0; mi < 4; ++mi)
#pragma unroll
            for (int ni = 0; ni < 4; ++ni) *(f32x4*)(SS + ((size_t)batch * 1024 + m0 + mi * 16 + l15) * 128 + n0 + ni * 16 + quad * 4) = acc[mi][ni];
    }
};
struct EpiCmp1 { bf16_t* HID; const float* bias2;
    DEV void operator()(EPI_ARGS) const {
        const int z = (batch >> 2) & 1;
#pragma unroll
        for (int ni = 0; ni < 4; ++ni) {
            const int c = n0 + ni * 16 + quad * 4; const f32x4 bv = *(const f32x4*)(bias2 + z * 256 + c);
#pragma unroll
            for (int mi = 0; mi < 4; ++mi) { const f32x4 v = acc[mi][ni] + bv;
                st_bf4(HID + ((size_t)batch * 128 + m0 + mi * 16 + l15) * 256 + c, gelu_tanh(v[0]), gelu_tanh(v[1]), gelu_tanh(v[2]), gelu_tanh(v[3])); }
        }
    }
};
struct EpiCmp2 { bf16_t *KC, *VCT;
    DEV void operator()(EPI_ARGS) const {
        if (n0 >= 64) return;
        const int z = (batch >> 2) & 1, bh = (batch >> 3) * 4 + (batch & 3);
#pragma unroll
        for (int mi = 0; mi < 4; ++mi) { const int r = m0 + mi * 16 + l15;
#pragma unroll
            for (int ni = 0; ni < 4; ++ni) { const f32x4 v = acc[mi][ni]; const int c = n0 + ni * 16 + quad * 4;
                if (z == 0) st_bf4(KC + ((size_t)bh * 128 + r) * 64 + c, v[0], v[1], v[2], v[3]);
                else {
#pragma unroll
                    for (int i = 0; i < 4; ++i) VCT[((size_t)bh * 64 + c + i) * 128 + r] = f2bf(v[i]); } } }
    }
};
struct EpiSsmB { const bf16_t* UH; const float* dskip; bf16_t* GB;
    DEV void operator()(EPI_ARGS) const {
#pragma unroll
        for (int mi = 0; mi < 4; ++mi) { const int r = m0 + mi * 16 + l15, b = r >> 6, k = r & 63;
#pragma unroll
            for (int ni = 0; ni < 4; ++ni) { const int col = n0 + ni * 16 + quad * 4, tau = col >> 4, c = col & 15;
                const f32x4 u = ld_bf4(UH + ((size_t)batch * 1024 + r) * 640 + col);
                const f32x4 dv = *(const f32x4*)(dskip + batch * 16 + c);
                const f32x4 y = acc[mi][ni] + dv * u;
                st_bf4(GB + ((size_t)(b * 2048 + k * 32 + tau)) * 512 + batch * 16 + c, gelu_tanh(y[0]), gelu_tanh(y[1]), gelu_tanh(y[2]), gelu_tanh(y[3])); } }
    }
};
struct EpiGlu { const bf16_t* GB; const float* bglu; bf16_t* YS;
    DEV void operator()(EPI_ARGS) const {
#pragma unroll
        for (int ni = 0; ni < 4; ++ni) { const int c = n0 + ni * 16 + quad * 4; const f32x4 bv = *(const f32x4*)(bglu + c);
#pragma unroll
            for (int mi = 0; mi < 4; ++mi) { const size_t o = (size_t)(m0 + mi * 16 + l15) * 512 + c; const f32x4 g = ld_bf4(GB + o); const f32x4 v = acc[mi][ni] + bv;
                st_bf4(YS + o, g[0] * sigmoidf_(v[0]), g[1] * sigmoidf_(v[1]), g[2] * sigmoidf_(v[2]), g[3] * sigmoidf_(v[3])); } }
    }
};
struct EpiSout { const bf16_t* GM; bf16_t* P1;
    DEV void operator()(EPI_ARGS) const {
#pragma unroll
        for (int mi = 0; mi < 4; ++mi) { const size_t t = m0 + mi * 16 + l15;
#pragma unroll
            for (int ni = 0; ni < 4; ++ni) { const int c = n0 + ni * 16 + quad * 4; const f32x4 g = ld_bf4(GM + t * 2048 + c); const f32x4 v = acc[mi][ni] * g;
                st_bf4(P1 + t * 1024 + c, v[0], v[1], v[2], v[3]); } }
    }
};
struct EpiNout { const bf16_t* GM; const bf16_t* P1; bf16_t* MIX;
    DEV void operator()(EPI_ARGS) const {
#pragma unroll
        for (int mi = 0; mi < 4; ++mi) { const size_t t = m0 + mi * 16 + l15;
#pragma unroll
            for (int ni = 0; ni < 4; ++ni) { const int c = n0 + ni * 16 + quad * 4; const f32x4 g = ld_bf4(GM + t * 2048 + 1024 + c); const f32x4 v = acc[mi][ni] * g + ld_bf4(P1 + t * 1024 + c);
                st_bf4(MIX + t * 1024 + c, v[0], v[1], v[2], v[3]); } }
    }
};
struct EpiRes { const float* src; const float* stats; const float* g; const float* b; float* dst;
    DEV void operator()(EPI_ARGS) const {
#pragma unroll
        for (int mi = 0; mi < 4; ++mi) { const size_t t = m0 + mi * 16 + l15; const float mu = stats[t * 2], rs = stats[t * 2 + 1];
#pragma unroll
            for (int ni = 0; ni < 4; ++ni) { const int c = n0 + ni * 16 + quad * 4;
                const f32x4 xv = *(const f32x4*)(src + t * 1024 + c), gg = *(const f32x4*)(g + c), bb = *(const f32x4*)(b + c);
                *(f32x4*)(dst + t * 1024 + c) = ((xv - mu) * rs * gg + bb) * ALPHA + acc[mi][ni]; } }
    }
};
struct EpiScaleBf { bf16_t* O; int ldc; float sc;
    DEV void operator()(EPI_ARGS) const {
#pragma unroll
        for (int mi = 0; mi < 4; ++mi)
#pragma unroll
            for (int ni = 0; ni < 4; ++ni) { const f32x4 v = acc[mi][ni] * sc; st_bf4(O + (size_t)(m0 + mi * 16 + l15) * ldc + n0 + ni * 16 + quad * 4, v[0], v[1], v[2], v[3]); }
    }
};
struct EpiFfnIn { bf16_t* FB;
    DEV void operator()(EPI_ARGS) const {
#pragma unroll
        for (int mi = 0; mi < 4; ++mi) { const size_t t = m0 + mi * 16 + l15;
#pragma unroll
            for (int pp = 0; pp < 2; ++pp) { const f32x4 ga = acc[mi][2 * pp], up = acc[mi][2 * pp + 1]; const int j = (n0 + pp * 32) / 2 + quad * 4;
                st_bf4(FB + t * 2816 + j, ga[0] * sigmoidf_(ga[0]) * up[0], ga[1] * sigmoidf_(ga[1]) * up[1], ga[2] * sigmoidf_(ga[2]) * up[2], ga[3] * sigmoidf_(ga[3]) * up[3]); } }
    }
};

DEV float qmax(float v) { auto a = __builtin_amdgcn_permlane16_swap(__float_as_uint(v), __float_as_uint(v), false, false); v = fmaxf(__uint_as_float(a[0]), __uint_as_float(a[1]));
    auto b = __builtin_amdgcn_permlane32_swap(__float_as_uint(v), __float_as_uint(v), false, false); return fmaxf(__uint_as_float(b[0]), __uint_as_float(b[1])); }
DEV float qsum(float v) { auto a = __builtin_amdgcn_permlane16_swap(__float_as_uint(v), __float_as_uint(v), false, false); v = __uint_as_float(a[0]) + __uint_as_float(a[1]);
    auto b = __builtin_amdgcn_permlane32_swap(__float_as_uint(v), __float_as_uint(v), false, false); return __uint_as_float(b[0]) + __uint_as_float(b[1]); }
DEV bf16x8 pack_p(const f32x4& a, const f32x4& b) { u32x4 w; w.x = cvt_pk_bf16(a[0], a[1]); w.y = cvt_pk_bf16(a[2], a[3]); w.z = cvt_pk_bf16(b[0], b[1]); w.w = cvt_pk_bf16(b[2], b[3]); return __builtin_bit_cast(bf16x8, w); }
DEV void st_vt(unsigned char* rowbase, int e, const u32x4& v) {
    const int grp = e >> 2, ep = e & 3, a = ep >> 1, qp = (ep & 1) * 2;
    unsigned char* o = rowbase + grp * 64 + (qp * 8 + a * 4) * 2;
    *(u32x2*)o = (u32x2){v.x, v.y}; *(u32x2*)(o + 16) = (u32x2){v.z, v.w};
}

struct NsaCtx { const bf16_t *Qb, *KC, *VCT, *KS, *VST, *KW, *VWT; const float* GN; bf16_t* ON; };
constexpr float MINIT = -1e20f;

template <int MODE, bool BOUND>
DEV void nsa_tile(const unsigned char* Kl, const unsigned char* Vl, const bf16x8 (&Qf)[2][2], f32x4 (&O)[2][4], float (&m)[2], float (&l)[2],
                  const float (&slope)[2], int dist0, bool sel, int l15, int quad) {
    const float d0f = (float)dist0;
#pragma unroll
    for (int g = 0; g < 2; ++g) {
        f32x4 S[4];
#pragma unroll
        for (int kt = 0; kt < 4; ++kt) { S[kt] = (f32x4){0.f, 0.f, 0.f, 0.f};
#pragma unroll
            for (int ks = 0; ks < 2; ++ks) { const bf16x8 kf = *(const bf16x8*)(Kl + (kt * 16 + l15) * 144 + ks * 64 + quad * 16); S[kt] = __builtin_amdgcn_mfma_f32_16x16x32_bf16(kf, Qf[g][ks], S[kt], 0, 0, 0); } }
        float base = -slope[g] * d0f;
        if (MODE == 0) base = sel ? base : NEG;
        typedef float f2 __attribute__((ext_vector_type(2)));
        const f2 sl_lo = {0.f, slope[g]}, sl_hi = {2.f * slope[g], 3.f * slope[g]};
        float tmax = NEG;
        f2 Slo[4], Shi[4];
#pragma unroll
        for (int kt = 0; kt < 4; ++kt) {
            const float bk = fmaf(slope[g], (float)(16 * kt), base);
            f2 lo = (f2){S[kt][0], S[kt][1]} + (sl_lo + bk), hi = (f2){S[kt][2], S[kt][3]} + (sl_hi + bk);
            if (BOUND) {
#pragma unroll
                for (int i = 0; i < 4; ++i) { const int cc = 16 * kt + i; bool v = cc <= dist0; if (MODE == 1) v = v && (cc > dist0 - 512);
                    if (i < 2) lo[i] = v ? lo[i] : NEG; else hi[i - 2] = v ? hi[i - 2] : NEG; }
            }
            Slo[kt] = lo; Shi[kt] = hi;
            tmax = fmaxf(fmaxf(tmax, lo[0]), lo[1]); tmax = fmaxf(fmaxf(tmax, hi[0]), hi[1]);
        }
        tmax = qmax(tmax);
        const float mnew = fmaxf(m[g], tmax), alpha = fexp2(m[g] - mnew);
        f2 rs2 = {0.f, 0.f};
#pragma unroll
        for (int kt = 0; kt < 4; ++kt) {
            const f2 a = Slo[kt] - mnew, b = Shi[kt] - mnew;
            const f2 pa = {fexp2(a[0]), fexp2(a[1])}, pb = {fexp2(b[0]), fexp2(b[1])};
            rs2 += pa; rs2 += pb;
            S[kt] = (f32x4){pa[0], pa[1], pb[0], pb[1]};
        }
        l[g] = l[g] * alpha + (rs2[0] + rs2[1]); m[g] = mnew;
        const bf16x8 P0 = pack_p(S[0], S[1]), P1 = pack_p(S[2], S[3]);
#pragma unroll
        for (int dt = 0; dt < 4; ++dt) { O[g][dt] = O[g][dt] * alpha;
            const bf16x8 v0 = *(const bf16x8*)(Vl + (dt * 16 + l15) * 144 + quad * 16), v1 = *(const bf16x8*)(Vl + (dt * 16 + l15) * 144 + 64 + quad * 16);
            O[g][dt] = __builtin_amdgcn_mfma_f32_16x16x32_bf16(v0, P0, O[g][dt], 0, 0, 0);
            O[g][dt] = __builtin_amdgcn_mfma_f32_16x16x32_bf16(v1, P1, O[g][dt], 0, 0, 0); }
    }
}

template <int MODE>
DEV void nsa_tiles(unsigned char* lds, const bf16_t* Kg, const bf16_t* VTg, unsigned tilemask, unsigned wmask, unsigned qmask, int jb0, int jb1,
                   const bf16x8 (&Qf)[2][2], f32x4 (&O)[2][4], float (&m)[2], float (&l)[2], const float (&slope)[2], int tq, int l15, int quad) {
    const int tid = get_tid();
    const int prow = tid >> 3, pe = tid & 7;
    unsigned rem = tilemask;
    int j = __builtin_ctz(rem); rem &= rem - 1;
    u32x4 rk, rv;
    rk = *(const u32x4*)(Kg + (size_t)(64 * j + prow) * 64 + pe * 8); rv = *(const u32x4*)(VTg + (size_t)prow * 2048 + 64 * j + pe * 8);
    int cur = 0;
    *(u32x4*)(lds + prow * 144 + pe * 16) = rk; st_vt(lds + 9216 + prow * 144, pe, rv);
    __syncthreads();
    for (;;) {
        int jn = -1;
        if (rem) { jn = __builtin_ctz(rem); rem &= rem - 1;
            rk = *(const u32x4*)(Kg + (size_t)(64 * jn + prow) * 64 + pe * 8); rv = *(const u32x4*)(VTg + (size_t)prow * 2048 + 64 * jn + pe * 8); }
        __builtin_amdgcn_sched_barrier(0);
        const unsigned char* st = lds + cur * 18432;
        if (MODE == 1 || ((wmask >> j) & 1u)) {
            const int dist0 = tq - 64 * j - 4 * quad; const bool sel = (qmask >> j) & 1u;
            if (j == jb0 || j == jb1) nsa_tile<MODE, true>(st, st + 9216, Qf, O, m, l, slope, dist0, sel, l15, quad);
            else nsa_tile<MODE, false>(st, st + 9216, Qf, O, m, l, slope, dist0, sel, l15, quad);
        }
        if (jn >= 0) { unsigned char* sn = lds + (cur ^ 1) * 18432; *(u32x4*)(sn + prow * 144 + pe * 16) = rk; st_vt(sn + 9216 + prow * 144, pe, rv); }
        __syncthreads();
        if (jn < 0) break;
        j = jn; cur ^= 1;
    }
}

DEV void nsa_unit(const NsaCtx& c, int b, int hkv, int qb, unsigned char* lds) {
    const int tid = get_tid(), lane = tid & 63, wid = tid >> 6, l15 = lane & 15, quad = lane >> 4;
    const int qs = wid & 3, hp = wid >> 2;
    const int tq = qb * 64 + qs * 16 + l15, cur = qb;
    const size_t trow = (size_t)b * 2048 + tq;
    const int head0 = hkv * 4 + hp * 2;
    const float* gnp = c.GN + trow * 48 + head0 * 3;
    unsigned char* stash = lds + 36864 + wid * 4096;
    float* xch = (float*)(lds + 69632);
    unsigned* smask = (unsigned*)(lds + 102400);
    const int bh = b * 4 + hkv;
    {
        const bf16_t* Kg = c.KC + (size_t)bh * 128 * 64; const bf16_t* Vg = c.VCT + (size_t)bh * 64 * 128;
#pragma unroll
        for (int i = 0; i < 2; ++i) { const int pc = tid + 512 * i;
            *(u32x4*)(lds + (pc >> 3) * 144 + (pc & 7) * 16) = *(const u32x4*)(Kg + pc * 8);
            st_vt(lds + 18432 + (pc >> 4) * 272, pc & 15, *(const u32x4*)(Vg + pc * 8)); }
    }
    __syncthreads();
    const int nkt = (4 * qb + 2) / 16 + 1;
    float Mx[8], Sm[8];
#pragma unroll
    for (int kt = 0; kt < 8; ++kt) { Mx[kt] = NEG; Sm[kt] = 0.f; }
#ifdef NSA_NO_CMP
    for (int g = 0; g < 0; ++g) {
#else
#pragma unroll 1
    for (int g = 0; g < 2; ++g) {
#endif
        bf16x8 Qg[2];
#pragma unroll
        for (int ks = 0; ks < 2; ++ks) Qg[ks] = *(const bf16x8*)(c.Qb + trow * 1024 + (head0 + g) * 64 + ks * 32 + quad * 8);
        const float slope_g = exp2f(-0.5f * (float)(head0 + g + 1)) * LOG2E;
        f32x4 S[8];
#pragma unroll
        for (int kt = 0; kt < 8; ++kt) { S[kt] = (f32x4){0.f, 0.f, 0.f, 0.f};
            if (kt < nkt) {
#pragma unroll
                for (int ks = 0; ks < 2; ++ks) { const bf16x8 kf = *(const bf16x8*)(lds + (kt * 16 + l15) * 144 + ks * 64 + quad * 16); S[kt] = __builtin_amdgcn_mfma_f32_16x16x32_bf16(kf, Qg[ks], S[kt], 0, 0, 0); } } }
        float mx = NEG;
        const int d0 = tq - 31 - 64 * quad; const float base = -slope_g * (float)d0;
#pragma unroll
        for (int kt = 0; kt < 8; ++kt)
#pragma unroll
            for (int i = 0; i < 4; ++i) { const int cc = 256 * kt + 16 * i; const float s = (kt < nkt && cc <= d0) ? fmaf(slope_g, (float)cc, S[kt][i] + base) : NEG; S[kt][i] = s; mx = fmaxf(mx, s); }
        mx = qmax(mx);
        float ls = 0.f;
#pragma unroll
        for (int kt = 0; kt < 8; ++kt)
#pragma unroll
            for (int i = 0; i < 4; ++i) ls += S[kt][i] > -1e29f ? fexp2(S[kt][i] - mx) : 0.f;
        ls = qsum(ls);
        const float lcl = fmaxf(ls, 1e-30f), lg = __log2f(lcl) + mx;
        float x3[8];
#pragma unroll
        for (int kt = 0; kt < 8; ++kt) {
#pragma unroll
            for (int i = 0; i < 4; ++i) S[kt][i] = S[kt][i] > -1e29f ? S[kt][i] - lg : NEG;
            x3[kt] = __shfl(S[kt][3], (lane + 48) & 63);
        }
#pragma unroll
        for (int kt = 0; kt < 8; ++kt) {
            const float nb = quad >= 1 ? x3[kt] : (kt >= 1 ? x3[kt >= 1 ? kt - 1 : 0] : NEG);
            const float tm = fmaxf(fmaxf(fmaxf(S[kt][0], S[kt][1]), fmaxf(S[kt][2], S[kt][3])), nb);
            const float nm = fmaxf(Mx[kt], tm);
            Sm[kt] = Sm[kt] * fexp2(Mx[kt] - nm) + fexp2(S[kt][0] - nm) + fexp2(S[kt][1] - nm) + fexp2(S[kt][2] - nm) + fexp2(S[kt][3] - nm) + fexp2(nb - nm);
            Mx[kt] = nm;
        }
        const float gate0 = gnp[g * 3];
        f32x4 Oc[4];
#pragma unroll
        for (int dt = 0; dt < 4; ++dt) Oc[dt] = (f32x4){0.f, 0.f, 0.f, 0.f};
#pragma unroll
        for (int k2 = 0; k2 < 4; ++k2) {
            if (2 * k2 < nkt) {
                f32x4 pa, pb;
#pragma unroll
                for (int i = 0; i < 4; ++i) { pa[i] = fexp2(S[2 * k2][i]); pb[i] = fexp2(S[2 * k2 + 1][i]); }
                const bf16x8 pf = pack_p(pa, pb);
#pragma unroll
                for (int dt = 0; dt < 4; ++dt) { const bf16x8 vf = *(const bf16x8*)(lds + 18432 + (dt * 16 + l15) * 272 + k2 * 64 + quad * 16); Oc[dt] = __builtin_amdgcn_mfma_f32_16x16x32_bf16(vf, pf, Oc[dt], 0, 0, 0); }
            }
        }
#pragma unroll
        for (int dt = 0; dt < 4; ++dt) { const f32x4 v = Oc[dt] * gate0; u32x2 w; w.x = cvt_pk_bf16(v[0], v[1]); w.y = cvt_pk_bf16(v[2], v[3]); *(u32x2*)(stash + ((g * 4 + dt) * 64 + lane) * 8) = w; }
    }
    unsigned qmask;
    if (cur < 8) qmask = (2u << cur) - 1u;
    if (cur >= 8) {
#pragma unroll
        for (int kt = 0; kt < 8; ++kt) { xch[(wid * 16 + kt) * 64 + lane] = Mx[kt]; xch[(wid * 16 + 8 + kt) * 64 + lane] = Sm[kt]; }
    }
    __syncthreads();
    if (cur >= 8) {
        float v[8];
#pragma unroll
        for (int kt = 0; kt < 8; ++kt) {
            const float m2 = xch[((wid ^ 4) * 16 + kt) * 64 + lane], s2 = xch[((wid ^ 4) * 16 + 8 + kt) * 64 + lane];
            const float mm = fmaxf(Mx[kt], m2), ss = Sm[kt] * fexp2(Mx[kt] - mm) + s2 * fexp2(m2 - mm);
            const int jb = 4 * kt + quad; v[kt] = (jb >= 1 && jb <= cur - 2) ? mm + __log2f(ss) : -3e38f; }
        qmask = 1u | (1u << cur) | (1u << (cur - 1));
        for (int r = 0; r < 5; ++r) {
            float bv = v[0]; int bj = quad;
#pragma unroll
            for (int kt = 1; kt < 8; ++kt) if (v[kt] > bv) { bv = v[kt]; bj = 4 * kt + quad; }
#pragma unroll
            for (int o = 16; o <= 32; o <<= 1) { const float ov = __shfl_xor(bv, o); const int oj = __shfl_xor(bj, o); if (ov > bv || (ov == bv && oj < bj)) { bv = ov; bj = oj; } }
            qmask |= 1u << bj;
#pragma unroll
            for (int kt = 0; kt < 8; ++kt) if (4 * kt + quad == bj) v[kt] = -3.2e38f;
        }
    }
    unsigned wmask = qmask;
#pragma unroll
    for (int o = 1; o <= 8; o <<= 1) wmask |= __shfl_xor(wmask, o);
    if (lane == 0) smask[wid] = wmask;
    __syncthreads();
    const unsigned umask = (smask[0] | smask[1] | smask[2] | smask[3]) | (smask[4] | smask[5] | smask[6] | smask[7]);
    bf16x8 Qf[2][2]; float slope[2];
#pragma unroll
    for (int g = 0; g < 2; ++g) {
#pragma unroll
        for (int ks = 0; ks < 2; ++ks) Qf[g][ks] = *(const bf16x8*)(c.Qb + trow * 1024 + (head0 + g) * 64 + ks * 32 + quad * 8);
        slope[g] = exp2f(-0.5f * (float)(head0 + g + 1)) * LOG2E;
    }
    f32x4 O[2][4]; float m[2], l[2];
#pragma unroll
    for (int g = 0; g < 2; ++g) { m[g] = MINIT; l[g] = 0.f;
#pragma unroll
        for (int dt = 0; dt < 4; ++dt) O[g][dt] = (f32x4){0.f, 0.f, 0.f, 0.f}; }
#ifndef NSA_NO_SLC
    nsa_tiles<0>(lds, c.KS + (size_t)bh * 2048 * 64, c.VST + (size_t)bh * 64 * 2048, umask, wmask, qmask, cur, cur, Qf, O, m, l, slope, tq, l15, quad);
#endif
#pragma unroll
    for (int g = 0; g < 2; ++g) { const float sc = gnp[g * 3 + 1] / fmaxf(qsum(l[g]), 1e-30f);
#pragma unroll
        for (int dt = 0; dt < 4; ++dt) { u32x2* sp = (u32x2*)(stash + ((g * 4 + dt) * 64 + lane) * 8); const u32x2 w = *sp;
            const f32x4 v = O[g][dt] * sc + (f32x4){bflo(w.x), bfhi(w.x), bflo(w.y), bfhi(w.y)};
            u32x2 w2; w2.x = cvt_pk_bf16(v[0], v[1]); w2.y = cvt_pk_bf16(v[2], v[3]); *sp = w2;
            O[g][dt] = (f32x4){0.f, 0.f, 0.f, 0.f}; }
        m[g] = MINIT; l[g] = 0.f; }
    const int jlo = qb >= 8 ? qb - 8 : 0;
    const unsigned winmask = ((2u << cur) - 1u) & ~((1u << jlo) - 1u);
#ifndef NSA_NO_WIN
    nsa_tiles<1>(lds, c.KW + (size_t)bh * 2048 * 64, c.VWT + (size_t)bh * 64 * 2048, winmask, 0u, 0u, cur, jlo, Qf, O, m, l, slope, tq, l15, quad);
#endif
#pragma unroll
    for (int g = 0; g < 2; ++g) { const float sc = gnp[g * 3 + 2] / fmaxf(qsum(l[g]), 1e-30f);
#pragma unroll
        for (int dt = 0; dt < 4; ++dt) { const u32x2 w = *(const u32x2*)(stash + ((g * 4 + dt) * 64 + lane) * 8);
            const f32x4 v = O[g][dt] * sc + (f32x4){bflo(w.x), bfhi(w.x), bflo(w.y), bfhi(w.y)};
            st_bf4(c.ON + trow * 1024 + (head0 + g) * 64 + dt * 16 + quad * 4, v[0], v[1], v[2], v[3]); } }
}

DEV void xattn_unit(const bf16_t* Qx, const bf16_t* XK, const bf16_t* XVT, bf16_t* OX, int b, int h, int qblk  , unsigned char* lds) {
    const int tid = get_tid(), lane = tid & 63, wid = tid >> 6, l15 = lane & 15, quad = lane >> 4;
    const size_t trow = (size_t)b * 2048 + qblk * 128 + wid * 16 + l15;
    bf16x8 Qf[8];
#pragma unroll
    for (int ks = 0; ks < 8; ++ks) Qf[ks] = *(const bf16x8*)(Qx + trow * 1024 + h * 256 + ks * 32 + quad * 8);
    f32x4 O[16];
#pragma unroll
    for (int dt = 0; dt < 16; ++dt) O[dt] = (f32x4){0.f, 0.f, 0.f, 0.f};
    float m = NEG, l = 0.f;
    const bf16_t* Kg = XK + (size_t)b * 256 * 1024 + h * 256;
    const bf16_t* Vg = XVT + (size_t)(b * 4 + h) * 256 * 256;
    u32x4 rk[2], rv[2];
#pragma unroll
    for (int i = 0; i < 2; ++i) { const int pc = tid + 512 * i; rk[i] = *(const u32x4*)(Kg + (size_t)(pc >> 5) * 1024 + (pc & 31) * 8); rv[i] = *(const u32x4*)(Vg + (size_t)(pc >> 2) * 256 + (pc & 3) * 8); }
#pragma unroll
    for (int i = 0; i < 2; ++i) { const int pc = tid + 512 * i; *(u32x4*)(lds + (pc >> 5) * 528 + (pc & 31) * 16) = rk[i]; st_vt(lds + 16896 + (pc >> 2) * 80, pc & 3, rv[i]); }
    __syncthreads();
    for (int j = 0; j < 8; ++j) {
        const bool more = j + 1 < 8;
        if (more) {
#pragma unroll
            for (int i = 0; i < 2; ++i) { const int pc = tid + 512 * i; rk[i] = *(const u32x4*)(Kg + (size_t)(32 * (j + 1) + (pc >> 5)) * 1024 + (pc & 31) * 8); rv[i] = *(const u32x4*)(Vg + (size_t)(pc >> 2) * 256 + 32 * (j + 1) + (pc & 3) * 8); } }
        __builtin_amdgcn_sched_barrier(0);
        const unsigned char* st = lds + (j & 1) * 37376;
        f32x4 S[2];
#pragma unroll
        for (int kt = 0; kt < 2; ++kt) { S[kt] = (f32x4){0.f, 0.f, 0.f, 0.f};
#pragma unroll
            for (int ks = 0; ks < 8; ++ks) { const bf16x8 kf = *(const bf16x8*)(st + (kt * 16 + l15) * 528 + ks * 64 + quad * 16); S[kt] = __builtin_amdgcn_mfma_f32_16x16x32_bf16(kf, Qf[ks], S[kt], 0, 0, 0); } }
        float tmax = fmaxf(fmaxf(fmaxf(S[0][0], S[0][1]), fmaxf(S[0][2], S[0][3])), fmaxf(fmaxf(S[1][0], S[1][1]), fmaxf(S[1][2], S[1][3])));
        tmax = qmax(tmax);
        const float mnew = fmaxf(m, tmax), alpha = fexp2(m - mnew);
        float rs = 0.f;
#pragma unroll
        for (int kt = 0; kt < 2; ++kt)
#pragma unroll
            for (int i = 0; i < 4; ++i) { const float pv = fexp2(S[kt][i] - mnew); S[kt][i] = pv; rs += pv; }
        l = l * alpha + rs; m = mnew;
        const bf16x8 pf = pack_p(S[0], S[1]);
#pragma unroll
        for (int dt = 0; dt < 16; ++dt) { O[dt] = O[dt] * alpha; const bf16x8 vf = *(const bf16x8*)(st + 16896 + (dt * 16 + l15) * 80 + quad * 16); O[dt] = __builtin_amdgcn_mfma_f32_16x16x32_bf16(vf, pf, O[dt], 0, 0, 0); }
        if (more) { unsigned char* sn = lds + ((j + 1) & 1) * 37376;
#pragma unroll
            for (int i = 0; i < 2; ++i) { const int pc = tid + 512 * i; *(u32x4*)(sn + (pc >> 5) * 528 + (pc & 31) * 16) = rk[i]; st_vt(sn + 16896 + (pc >> 2) * 80, pc & 3, rv[i]); } }
        __syncthreads();
    }
    const float inv = 1.0f / qsum(l);
#pragma unroll
    for (int dt = 0; dt < 16; ++dt) { const f32x4 v = O[dt] * inv; st_bf4(OX + trow * 1024 + h * 256 + dt * 16 + quad * 4, v[0], v[1], v[2], v[3]); }
}


#define XB_TMO      128
#define XB_XCNT(j)  (256  + 64 * (j))
#define XB_XSUB(j)  (1280 + 64 * (j))
#define XB_XGEN(j)  (2304 + 64 * (j))
#define XB_TOP      3328
#define XB_TOPGEN   3392
#define XCD_BAR_WORDS 3456
#define XB_SPIN_CAP (1u << 18)
#define LAS __attribute__((address_space(3)))
DEV unsigned xb_ld(unsigned* p)              { return __hip_atomic_load(p, __ATOMIC_RELAXED, __HIP_MEMORY_SCOPE_AGENT); }
DEV unsigned xb_add(unsigned* p, unsigned v) { return __hip_atomic_fetch_add(p, v, __ATOMIC_RELAXED, __HIP_MEMORY_SCOPE_AGENT); }
DEV unsigned xb_xcc_id() { return (unsigned)__builtin_amdgcn_s_getreg((3 << 11) | 20) & 0xFu; }
#define XB_SPIN(cond, bar) do { unsigned _sp = 0; while (cond) { __builtin_amdgcn_s_sleep(1); \
    if ((++_sp & 255u) == 0u) { if (xb_ld(&(bar)[XB_TMO])) break; if (_sp > XB_SPIN_CAP) { atomicAdd(&(bar)[XB_TMO], 1u); break; } } } } while (0)
struct XcdBarrier { unsigned* bar; unsigned x; volatile LAS unsigned* st; };
DEV XcdBarrier xcd_barrier_post(unsigned* bar, volatile LAS unsigned* st) {
    XcdBarrier b; b.bar = bar; b.x = xb_xcc_id(); b.st = st;
    if (threadIdx.x == 0) { st[2] = xb_add(&bar[XB_XCNT(b.x)], 1u); st[3] = b.x; }
    return b;
}
DEV void xcd_barrier_complete(unsigned* bar, unsigned x, unsigned& nloc, unsigned& nx) {
    const unsigned G = gridDim.x * gridDim.y * gridDim.z;
    unsigned sum, cnt, mine, sp = 0u;
    for (;;) {
        sum = 0u; cnt = 0u; mine = 0u;
#pragma unroll
        for (unsigned j = 0; j < 16; ++j) { const unsigned c = xb_ld(&bar[XB_XCNT(j)]); sum += c; cnt += (c > 0u) ? 1u : 0u; mine = (j == x) ? c : mine; }
        if (sum == G) break;
        __builtin_amdgcn_s_sleep(1);
        if ((++sp & 255u) == 0u) { if (xb_ld(&bar[XB_TMO])) break; if (sp > XB_SPIN_CAP) { atomicAdd(&bar[XB_TMO], 1u); break; } }
    }
    nloc = mine > 0u ? mine : 1u; nx = cnt > 0u ? cnt : 1u;
}
DEV void xcd_barrier(const XcdBarrier& b) {
    asm volatile("s_waitcnt vmcnt(0)" ::: "memory");
    __syncthreads();
    if (threadIdx.x == 0) {
        unsigned* bar = b.bar;
        __builtin_amdgcn_s_waitcnt(0);
        unsigned nloc = b.st[0], nx = b.st[1];
        if (nloc == 0u) { xcd_barrier_complete(bar, b.x, nloc, nx); b.st[0] = nloc; b.st[1] = nx; }
        const unsigned old = xb_add(&bar[XB_XSUB(b.x)], 1u);
        const unsigned gen = old / nloc;
        if (old + 1u == (gen + 1u) * nloc) {
            __builtin_amdgcn_fence(__ATOMIC_RELEASE, "agent");
            asm volatile("s_waitcnt vmcnt(0)" ::: "memory");
            const unsigned og = xb_add(&bar[XB_TOP], 1u);
            const unsigned tg = og / nx;
            if (og + 1u == (tg + 1u) * nx) xb_add(&bar[XB_TOPGEN], 1u);
            else XB_SPIN(xb_ld(&bar[XB_TOPGEN]) == tg, bar);
            __builtin_amdgcn_fence(__ATOMIC_ACQUIRE, "agent");
            xb_add(&bar[XB_XGEN(b.x)], 1u);
            asm volatile("s_waitcnt vmcnt(0)" ::: "memory");
        } else {
            XB_SPIN(xb_ld(&bar[XB_XGEN(b.x)]) == gen, bar);
            __builtin_amdgcn_fence(__ATOMIC_ACQUIRE, "agent");
            asm volatile("s_waitcnt vmcnt(0)" ::: "memory");
        }
    }
    __syncthreads();
}

constexpr int NPHASE = 17;
__global__ void __launch_bounds__(512, 2) fwd_kernel(P p) {
    extern __shared__ __attribute__((aligned(16))) unsigned char lds[];
#define WSB(off) ((bf16_t*)(ws + (off)))
#define WSF(off) ((float*)(ws + (off)))
    volatile LAS unsigned* bst = (volatile LAS unsigned*)(LAS unsigned char*)(lds + LDS_BYTES - 16);
    if (threadIdx.x == 0) { bst[0] = 0u; bst[1] = 0u; bst[2] = 0u; bst[3] = 0u; }
    __syncthreads();
    XcdBarrier gbar; gbar.bar = (unsigned*)(p.ws + O_BAR); gbar.x = 0; gbar.st = bst;
    if (p.coop) gbar = xcd_barrier_post((unsigned*)(p.ws + O_BAR), bst);
    const SsmIn sin_{p.in[5], p.in[6], p.in[7], p.in[8], p.in[9], p.in[10], p.in[12]};
    for (int ph = p.ph_lo; ph < p.ph_hi; ++ph) {
        size_t zoff = 0; asm volatile("" : "+s"(zoff)); unsigned char* ws = p.ws + zoff;
        switch (ph) {
#ifdef ONLY_PHASE
        default: break;
#define CASE(k) case (k): if ((k) != ONLY_PHASE) break; else
#else
#define CASE(k) case (k):
#endif
        CASE(0) {
            const int tid = get_tid();
            ln_pass(p.in[0], p.in[2], p.in[3], WSB(O_B), WSF(O_ST0), nullptr);
            int cur = 0;
            conv_job(p.in[4], 5168, 1024, 5376, WSB(O_WIN_T), 1, lds, cur);
            conv_job(p.in[13], 512, 512, 512, WSB(O_WGLU_T), 0, lds, cur);
            conv_job(p.in[15], 1024, 512, 1024, WSB(O_WSOUT_T), 0, lds, cur);
            conv_job(p.in[17], 256, 2048, 256, WSB(O_W1_T), 0, lds, cur);
            conv_job(p.in[17] + 2048 * 256, 256, 2048, 256, WSB(O_W1_T) + 256 * 2048, 0, lds, cur);
            conv_job(p.in[19], 64, 256, 256, WSB(O_W2_T), 3, lds, cur);
            conv_job(p.in[19] + 256 * 64, 64, 256, 256, WSB(O_W2_T) + 256 * 256, 3, lds, cur);
            conv_job(p.in[20], 1024, 1024, 1024, WSB(O_WNOUT_T), 0, lds, cur);
            conv_job(p.in[21], 1024, 1024, 1024, WSB(O_WOUT_T), 0, lds, cur);
            conv_job(p.in[24], 1024, 1024, 1024, WSB(O_WXQ_T), 0, lds, cur);
            conv_job(p.in[25], 2048, 1024, 2048, WSB(O_WXKV_T), 0, lds, cur);
            conv_job(p.in[26], 1024, 1024, 1024, WSB(O_WXO_T), 0, lds, cur);
            conv_job(p.in[29], 5632, 1024, 5632, WSB(O_WFIN_T), 2, lds, cur);
            conv_job(p.in[30], 1024, 2816, 1024, WSB(O_WFOUT_T), 0, lds, cur);
            for (int it = get_bid(); it < 128; it += gridDim.x) {
                const int z = it >> 6, ec = (it >> 4) & 3, fc = it & 15, e = ec * 64 + (tid & 63), fg = tid >> 6;
                float a = 0.f;
#pragma unroll 8
                for (int f = fc * 128 + fg * 16; f < fc * 128 + fg * 16 + 16; ++f) a += p.in[16][z * 2048 + f] * p.in[17][((size_t)z * 2048 + f) * 256 + e];
                float* red = (float*)lds;
                __syncthreads(); red[tid] = a; __syncthreads();
                if (tid < 64) { float t = 0.f; for (int k = 0; k < 8; ++k) t += red[tid + 64 * k]; WSF(O_BPART)[(z * 16 + fc) * 256 + e] = t; }
                __syncthreads();
            }
            ssm_prep(sin_, WSB(O_BT1), WSB(O_MTW), lds);
        } break;
        CASE(1) {
            if (get_bid() == 0) { for (int e = get_tid(); e < 512; e += NTHR) { float a = p.in[18][e]; for (int fc = 0; fc < 16; ++fc) a += WSF(O_BPART)[((e >> 8) * 16 + fc) * 256 + (e & 255)]; WSF(O_BIAS2)[e] = a; } }
            { const GemmP g{WSB(O_B), WSB(O_WIN_T), 1024, 1024, 256, 42, 16, 1};
              const EpiIn e{WSB(O_UH), WSB(O_QB), WSB(O_KVC), WSB(O_KS), WSB(O_VST), WSB(O_KW), WSB(O_VWT), WSB(O_GM), WSF(O_GN)};
              gemm_run<8>(g, AddrNone{}, e, lds); }
        } break;
        CASE(2) {
            { const GemmP g{WSB(O_KVC), WSB(O_W1_T), 1024, 2048, 1, 2, 32, 128};
              const EpiCmp1 e{WSB(O_HID), WSF(O_BIAS2)};
              gemm_run<4>(g, AddrCmp1{}, e, lds); }
            { const GemmP g{WSB(O_UH), WSB(O_BT1), 640, 512, 8, 2, 8, 32};
              const EpiSsmA e{WSF(O_SS)};
              gemm_run<8>(g, AddrStride{1024ull * 640, 256ull * 512}, e, lds); }
        } break;
        CASE(3) {
            ssm_scan(sin_, WSF(O_SS), WSB(O_UH));
            { const GemmP g{WSB(O_HID), WSB(O_W2_T), 256, 256, 1, 2, 4, 128};
              const EpiCmp2 e{WSB(O_KC), WSB(O_VCT)};
              gemm_run<4>(g, AddrCmp2{}, e, lds); }
        } break;
        CASE(4) {
            const NsaCtx c{WSB(O_QB), WSB(O_KC), WSB(O_VCT), WSB(O_KS), WSB(O_VST), WSB(O_KW), WSB(O_VWT), WSF(O_GN), WSB(O_B)};
            const int G = gridDim.x;
            for (int i = 0;; ++i) {
                const int u = (i & 1) ? i * G + (G - 1 - get_bid()) : i * G + get_bid();
                if (i * G >= 2048) break;
                if (u < 2048) { const int qb = 31 - (u >> 6), bh = u & 63; nsa_unit(c, bh >> 2, bh & 3, qb, lds); }
                __syncthreads();
            }
            { const GemmP g{WSB(O_UH), WSB(O_MTW), 640, 640, 8, 4, 10, 32};
              const EpiSsmB e{WSB(O_UH), p.in[11], WSB(O_GB)};
              gemm_run<8>(g, AddrStride{1024ull * 640, 512ull * 640}, e, lds); }
        } break;
        CASE(5) { const GemmP g{WSB(O_GB), WSB(O_WGLU_T), 512, 512, 256, 4, 8, 1}; const EpiGlu e{WSB(O_GB), p.in[14], WSB(O_YS)}; gemm_run<8>(g, AddrNone{}, e, lds); } break;
        CASE(6) { const GemmP g{WSB(O_YS), WSB(O_WSOUT_T), 512, 512, 256, 8, 8, 1}; const EpiSout e{WSB(O_GM), WSB(O_QB)}; gemm_run<8>(g, AddrNone{}, e, lds); } break;
        CASE(7) { const GemmP g{WSB(O_B), WSB(O_WNOUT_T), 1024, 1024, 256, 8, 16, 1}; const EpiNout e{WSB(O_GM), WSB(O_QB), WSB(O_MIXIN)}; gemm_run<8>(g, AddrNone{}, e, lds); } break;
        CASE(8) { const GemmP g{WSB(O_MIXIN), WSB(O_WOUT_T), 1024, 1024, 256, 8, 16, 1}; const EpiRes e{p.in[0], WSF(O_ST0), p.in[2], p.in[3], WSF(O_V1)}; gemm_run<8>(g, AddrNone{}, e, lds); } break;
        CASE(9) { ln_pass(WSF(O_V1), p.in[22], p.in[23], WSB(O_B), WSF(O_ST1), nullptr);
            for (size_t i = (size_t)get_bid() * NTHR + get_tid(); i < 4096ull * 1024 / 4; i += (size_t)gridDim.x * NTHR) { const f32x4 v = ((const f32x4*)p.in[1])[i]; st_bf4(WSB(O_MEMB) + i * 4, v[0], v[1], v[2], v[3]); }
        } break;
        CASE(10) { { const GemmP g{WSB(O_B), WSB(O_WXQ_T), 1024, 1024, 256, 8, 16, 1}; const EpiScaleBf e{WSB(O_QB), 1024, 0.0625f * LOG2E}; gemm_run<8>(g, AddrNone{}, e, lds); }
            { const GemmP g{WSB(O_MEMB), WSB(O_WXKV_T), 1024, 1024, 32, 16, 16, 1};
              const EpiXkv e{WSB(O_XK), WSB(O_XVT)};
              gemm_run<8>(g, AddrNone{}, e, lds); }
        } break;
        CASE(11) {
            for (int u = get_bid(); u < 1024; u += gridDim.x) { const int qblk = u >> 6, bh = u & 63; xattn_unit(WSB(O_QB), WSB(O_XK), WSB(O_XVT), WSB(O_B), bh >> 2, bh & 3, qblk, lds); }
        } break;
        CASE(12) { const GemmP g{WSB(O_B), WSB(O_WXO_T), 1024, 1024, 256, 8, 16, 1}; const EpiRes e{WSF(O_V1), WSF(O_ST1), p.in[22], p.in[23], WSF(O_V2)}; gemm_run<8>(g, AddrNone{}, e, lds); } break;
        CASE(13) ln_pass(WSF(O_V2), p.in[27], p.in[28], WSB(O_B), WSF(O_ST2), nullptr); break;
        CASE(14) { const GemmP g{WSB(O_B), WSB(O_WFIN_T), 1024, 1024, 256, 44, 16, 1}; const EpiFfnIn e{WSB(O_FB)}; gemm_run<8>(g, AddrNone{}, e, lds); } break;
        CASE(15) { const GemmP g{WSB(O_FB), WSB(O_WFOUT_T), 2816, 2816, 256, 8, 44, 1}; const EpiRes e{WSF(O_V2), WSF(O_ST2), p.in[27], p.in[28], WSF(O_V2)}; gemm_run<8>(g, AddrNone{}, e, lds); } break;
        CASE(16) ln_pass(WSF(O_V2), p.in[31], p.in[32], nullptr, nullptr, p.out); break;
        }
        if (ph + 1 < p.ph_hi) { if (p.coop) xcd_barrier(gbar); if (p.pad == 0x5eed) cg::this_grid().sync(); }
    }
}

#ifndef ONE_LAUNCH
#define ONE_LAUNCH 1
#endif
extern "C" void kernel_launch(void* const* d_in, const int* in_sizes, int n_in, void* d_out, int out_size, void* d_ws, size_t ws_size, hipStream_t stream) {
    static int grid = 0;
    if (grid == 0) {
        if (n_in != 33 || out_size != T_ * 1024 || ws_size < WS_NEED) { fprintf(stderr, "kernel_launch: unexpected shapes (n_in %d out %d ws %zu need %zu)\n", n_in, out_size, ws_size, (size_t)WS_NEED); grid = -1; return; }
        int dev = 0, cus = 0, per_cu = 0;
        hipGetDevice(&dev);
        hipDeviceGetAttribute(&cus, hipDeviceAttributeMultiprocessorCount, dev);
        if (hipFuncSetAttribute((const void*)fwd_kernel, hipFuncAttributeMaxDynamicSharedMemorySize, LDS_BYTES) != hipSuccess) { fprintf(stderr, "kernel_launch: hipFuncSetAttribute failed\n"); grid = -1; return; }
        if (hipOccupancyMaxActiveBlocksPerMultiprocessor(&per_cu, (const void*)fwd_kernel, NTHR, LDS_BYTES) != hipSuccess || per_cu < 1) { fprintf(stderr, "kernel_launch: occupancy query failed (%d)\n", per_cu); per_cu = 1; (void)hipGetLastError(); }
        if (per_cu > 1) per_cu = 1;
        grid = cus * per_cu;
    }
    if (grid < 0) return;
    P p{};
    for (int i = 0; i < 33; ++i) p.in[i] = (const float*)d_in[i];
    p.out = (float*)d_out; p.ws = (unsigned char*)d_ws;
#if ONE_LAUNCH
    p.ph_lo = 0; p.ph_hi = NPHASE; p.coop = 1;
    if (hipMemsetAsync((unsigned char*)d_ws + O_BAR, 0, XCD_BAR_WORDS * 4, stream) != hipSuccess) { fprintf(stderr, "kernel_launch: memset of barrier words failed\n"); return; }
    void* args[] = {&p};
    hipError_t e = hipLaunchCooperativeKernel((const void*)fwd_kernel, dim3(grid), dim3(NTHR), args, LDS_BYTES, stream);
    if (e != hipSuccess) fprintf(stderr, "cooperative launch failed: %s (grid %d)\n", hipGetErrorString(e), grid);
#else
#ifdef STOP_AFTER
    const int nrun = STOP_AFTER + 1;
#else
    const int nrun = NPHASE;
#endif
    for (int ph = 0; ph < nrun; ++ph) {
        p.ph_lo = ph; p.ph_hi = ph + 1; p.coop = 0;
        hipLaunchKernelGGL(fwd_kernel, dim3(grid), dim3(NTHR), LDS_BYTES, stream, p);
    }
#endif
}
```

```cpp
#include <hip/hip_runtime.h>
#include <hip/hip_cooperative_groups.h>
#include <cstdio>
#include <cstdint>
namespace cg = cooperative_groups;

typedef unsigned short bf16_t;
typedef short bf16x8 __attribute__((ext_vector_type(8)));
typedef float f32x4 __attribute__((ext_vector_type(4)));
typedef unsigned u32x4 __attribute__((ext_vector_type(4)));
typedef unsigned u32x2 __attribute__((ext_vector_type(2)));
#define DEV __device__ __forceinline__

constexpr int T_ = 32768, L_ = 2048;
constexpr float LOG2E = 1.4426950408889634f;
constexpr float ALPHA = 1.189207115002721f;
constexpr float LN_EPS = 1e-5f;
constexpr float NEG = -1e30f;
constexpr int LDS_BYTES = 147456;
constexpr int NTHR = 512, NWAVE = 8;
constexpr size_t MiB = 1048576;

constexpr size_t O_WIN_T = 0;
constexpr size_t O_WGLU_T = O_WIN_T + 5376ull * 1024 * 2;
constexpr size_t O_WSOUT_T = O_WGLU_T + 512ull * 512 * 2;
constexpr size_t O_W1_T = O_WSOUT_T + 1024ull * 512 * 2;
constexpr size_t O_W2_T = O_W1_T + 2ull * 256 * 2048 * 2;
constexpr size_t O_WNOUT_T = O_W2_T + 2ull * 256 * 256 * 2;
constexpr size_t O_WOUT_T = O_WNOUT_T + 2 * MiB;
constexpr size_t O_WXQ_T = O_WOUT_T + 2 * MiB;
constexpr size_t O_WXKV_T = O_WXQ_T + 2 * MiB;
constexpr size_t O_WXO_T = O_WXKV_T + 4 * MiB;
constexpr size_t O_WFIN_T = O_WXO_T + 2 * MiB;
constexpr size_t O_WFOUT_T = O_WFIN_T + 5632ull * 1024 * 2;
constexpr size_t O_BT1 = O_WFOUT_T + 1024ull * 2816 * 2;
constexpr size_t O_MTW = O_BT1 + 8 * MiB;
constexpr size_t O_KC = O_MTW + 20 * MiB;
constexpr size_t O_VCT = O_KC + 1 * MiB;
constexpr size_t O_GN = O_VCT + 1 * MiB;
constexpr size_t O_ST0 = O_GN + 6 * MiB;
constexpr size_t O_ST1 = O_ST0 + 262144;
constexpr size_t O_ST2 = O_ST1 + 262144;
constexpr size_t O_BIAS2 = O_ST2 + 262144;
constexpr size_t O_BPART = O_BIAS2 + 4096;
constexpr size_t O_BAR = O_BPART + 32768;
constexpr size_t O_A = 81 * MiB;
constexpr size_t O_KVC = O_A;
constexpr size_t O_KS = O_A + 32 * MiB;
constexpr size_t O_VST = O_A + 48 * MiB;
constexpr size_t O_KW = O_A + 64 * MiB;
constexpr size_t O_VWT = O_A + 80 * MiB;
constexpr size_t O_GB = O_A + 96 * MiB;
constexpr size_t O_MIXIN = O_A;
constexpr size_t O_MEMB = O_A + 64 * MiB;
constexpr size_t O_XK = O_A + 72 * MiB;
constexpr size_t O_XVT = O_A + 80 * MiB;
constexpr size_t O_V2 = O_A;
constexpr size_t O_B = O_A + 128 * MiB;
constexpr size_t O_SS = O_B;
constexpr size_t O_HID = O_B + 16 * MiB;
constexpr size_t O_Y = O_B + 64 * MiB;
constexpr size_t O_GM = O_Y;
constexpr size_t O_V1 = O_Y;
constexpr size_t O_X = O_Y + 128 * MiB;
constexpr size_t O_QB = O_X;
constexpr size_t O_UH = O_X + 64 * MiB;
constexpr size_t O_YS = O_X + 64 * MiB;
constexpr size_t O_FB = O_Y;
constexpr size_t WS_NEED = O_X + 104 * MiB;
static_assert(O_BAR + 16384 <= O_A, "F region overflow");

struct P {
    const float* in[33];
    float* out;
    unsigned char* ws;
    int ph_lo, ph_hi, coop, pad;
};

DEV int get_tid() { int t = threadIdx.x; asm volatile("" : "+v"(t)); return t; }
DEV int get_bid() { int t = blockIdx.x; asm volatile("" : "+s"(t)); return t; }
typedef __bf16 bf2_t __attribute__((ext_vector_type(2)));
typedef float f32x2_t __attribute__((ext_vector_type(2)));
DEV unsigned cvt_pk_bf16(float lo, float hi) { const f32x2_t f = {lo, hi}; const bf2_t r = __builtin_convertvector(f, bf2_t); return __builtin_bit_cast(unsigned, r); }
DEV bf16_t f2bf(float v) { return (bf16_t)(cvt_pk_bf16(v, 0.f) & 0xffffu); }
DEV float bf2f(unsigned v) { return __uint_as_float(v << 16); }
DEV float bflo(unsigned w) { return __uint_as_float(w << 16); }
DEV float bfhi(unsigned w) { return __uint_as_float(w & 0xffff0000u); }
DEV float fexp2(float x) { return __builtin_amdgcn_exp2f(x); }
DEV float frcp(float x) { return __builtin_amdgcn_rcpf(x); }
DEV float sigmoidf_(float x) { return frcp(1.f + fexp2(-x * LOG2E)); }
DEV float gelu_tanh(float x) { const float u = 0.7978845608028654f * (x + 0.044715f * x * x * x); return x * frcp(1.f + fexp2(-2.f * LOG2E * u)); }
DEV void st_bf4(bf16_t* p, float a, float b, float c, float d) { u32x2 w; w.x = cvt_pk_bf16(a, b); w.y = cvt_pk_bf16(c, d); *(u32x2*)p = w; }
DEV f32x4 ld_bf4(const bf16_t* p) { const u32x2 w = *(const u32x2*)p; return (f32x4){bflo(w.x), bfhi(w.x), bflo(w.y), bfhi(w.y)}; }
DEV float wred_sum(float v) {
#pragma unroll
    for (int o = 32; o >= 1; o >>= 1) v += __shfl_xor(v, o);
    return v;
}

DEV void ln_pass(const float* src, const float* g, const float* b, bf16_t* dstb, float* stats, float* dstf) {
    const int lane = get_tid() & 63, wid = get_tid() >> 6;
    const int nw = gridDim.x * NWAVE;
    for (int row = get_bid() * NWAVE + wid; row < T_; row += nw) {
        const f32x4* p = (const f32x4*)(src + (size_t)row * 1024);
        f32x4 v[4];
#pragma unroll
        for (int i = 0; i < 4; ++i) v[i] = p[lane + 64 * i];
        float s = 0.f;
#pragma unroll
        for (int i = 0; i < 4; ++i) s += (v[i][0] + v[i][1]) + (v[i][2] + v[i][3]);
        s = wred_sum(s);
        const float mu = s * (1.f / 1024.f);
        float q = 0.f;
#pragma unroll
        for (int i = 0; i < 4; ++i) { const f32x4 d = v[i] - mu; q += (d[0] * d[0] + d[1] * d[1]) + (d[2] * d[2] + d[3] * d[3]); }
        q = wred_sum(q);
        const float rstd = 1.0f / sqrtf(q * (1.f / 1024.f) + LN_EPS);
        if (stats && lane == 0) { stats[row * 2] = mu; stats[row * 2 + 1] = rstd; }
#pragma unroll
        for (int i = 0; i < 4; ++i) {
            const int col = (lane + 64 * i) * 4;
            const f32x4 gg = *(const f32x4*)(g + col), bb = *(const f32x4*)(b + col);
            const f32x4 y = (v[i] - mu) * rstd * gg + bb;
            if (dstb) st_bf4(dstb + (size_t)row * 1024 + col, y[0], y[1], y[2], y[3]);
            if (dstf) *(f32x4*)(dstf + (size_t)row * 1024 + col) = y;
        }
    }
}

DEV int colmap(int mode, int n) {
    if (mode == 0) return n;
    if (mode == 1) return n < 3072 ? n : (n < 5120 ? n + 48 : (n < 5168 ? n - 5120 + 3072 : -1));
    if (mode == 2) { const int blk = n >> 5, r = n & 31; return r < 16 ? blk * 16 + r : 2816 + blk * 16 + (r - 16); }
    return n < 64 ? n : -1;
}
DEV void conv_job(const float* src, int ldsrc, int K, int N, bf16_t* dst, int mode, unsigned char* lds, int& cursor) {
    const int tid = get_tid(), lane = tid & 63, gw = get_bid() * NWAVE + (tid >> 6), nw = gridDim.x * NWAVE;
    const int kb = K / 32, nitem = (N / 64) * kb;
    for (int t = (gw + nw - (cursor % nw)) % nw; t < nitem; t += nw) {
        const int k0 = (t % kb) * 32, n = (t / kb) * 64 + lane;
        const int sc = colmap(mode, n);
        float e[32];
#pragma unroll
        for (int r = 0; r < 32; ++r) e[r] = sc >= 0 ? src[(size_t)(k0 + r) * ldsrc + sc] : 0.f;
#pragma unroll
        for (int q = 0; q < 4; ++q) { u32x4 w; w.x = cvt_pk_bf16(e[8 * q], e[8 * q + 1]); w.y = cvt_pk_bf16(e[8 * q + 2], e[8 * q + 3]); w.z = cvt_pk_bf16(e[8 * q + 4], e[8 * q + 5]); w.w = cvt_pk_bf16(e[8 * q + 6], e[8 * q + 7]);
            *(u32x4*)(dst + (size_t)n * K + k0 + 8 * q) = w; }
    }
    cursor += nitem;
}

struct SsmIn { const float *a_re, *a_im, *b_re, *b_im, *c_re, *c_im, *log_dt; };
DEV void lb_pow(const SsmIn& s, int g, int n, float p, float& re, float& im) {
    const float lre = fminf(s.a_re[g * 64 + n], -1e-4f), lim = s.a_im[g * 64 + n], dt = expf(s.log_dt[g]);
    const float mag = expf(lre * dt * p); float sn, cs; sincosf(lim * dt * p, &sn, &cs);
    re = mag * cs; im = mag * sn;
}
DEV void bbar(const SsmIn& s, int g, int n, int c, float& re, float& im) {
    const float lre = fminf(s.a_re[g * 64 + n], -1e-4f), lim = s.a_im[g * 64 + n], dt = expf(s.log_dt[g]);
    const float mag = expf(lre * dt); float sn, cs; sincosf(lim * dt, &sn, &cs);
    const float sh = sinf(0.5f * lim * dt);
    const float nr = expm1f(lre * dt) - mag * 2.f * sh * sh, lbi = mag * sn;
    const float den = lre * lre + lim * lim;
    const float fre = (nr * lre + lbi * lim) / den, fim = (lbi * lre - nr * lim) / den;
    const float br = s.b_re[(g * 64 + n) * 16 + c], bi = s.b_im[(g * 64 + n) * 16 + c];
    re = fre * br - fim * bi; im = fre * bi + fim * br;
}
DEV void ssm_prep(const SsmIn& s, bf16_t* BT1, bf16_t* MTW, unsigned char* lds) {
    const int tid = get_tid();
    float* pw = (float*)lds;
    float* bb = pw + 33 * 128;
    float* cc = bb + 2048;
    float* fn = cc + 2048;
    float* km = fn + 128;
    for (int job = get_bid(); job < 512; job += gridDim.x) {
        const int g = job >> 4, pt = job & 15;
        __syncthreads();
        for (int e = tid; e < 33 * 64; e += NTHR) { float pr, pi; lb_pow(s, g, e & 63, (float)(e >> 6), pr, pi); pw[e * 2] = pr; pw[e * 2 + 1] = pi; }
        if (tid < 64) {
            const int n = tid;
            const float lre = fminf(s.a_re[g * 64 + n], -1e-4f), lim = s.a_im[g * 64 + n], dt = expf(s.log_dt[g]);
            const float mag = expf(lre * dt); float sn, cs; sincosf(lim * dt, &sn, &cs);
            const float sh = sinf(0.5f * lim * dt);
            const float nr = expm1f(lre * dt) - mag * 2.f * sh * sh, lbi = mag * sn;
            const float den = lre * lre + lim * lim;
            fn[n * 2] = (nr * lre + lbi * lim) / den; fn[n * 2 + 1] = (lbi * lre - nr * lim) / den;
        }
        for (int e = tid; e < 1024; e += NTHR) { const int c = e >> 6, n = e & 63; cc[e * 2] = s.c_re[(g * 16 + c) * 64 + n]; cc[e * 2 + 1] = s.c_im[(g * 16 + c) * 64 + n]; }
        __syncthreads();
        for (int e = tid; e < 1024; e += NTHR) { const int n = e >> 4; const float fre = fn[n * 2], fim = fn[n * 2 + 1];
            const float br = s.b_re[(g * 64) * 16 + e], bi = s.b_im[(g * 64) * 16 + e];
            bb[e * 2] = fre * br - fim * bi; bb[e * 2 + 1] = fre * bi + fim * br; }
        __syncthreads();
        for (int i = tid; i < 4096; i += NTHR) { const int e = pt * 4096 + i, nn = e >> 9, kk = e & 511, n = nn & 63, sidx = kk >> 4, c = kk & 15;
            const float pr = pw[((31 - sidx) * 64 + n) * 2], pi = pw[((31 - sidx) * 64 + n) * 2 + 1], br = bb[(n * 16 + c) * 2], bi = bb[(n * 16 + c) * 2 + 1];
            BT1[(size_t)g * 131072 + e] = f2bf((nn >> 6) ? (pr * bi + pi * br) : (pr * br - pi * bi)); }
        for (int i = tid; i < 4096; i += NTHR) BT1[(size_t)g * 131072 + 65536 + pt * 4096 + i] = 0;
        for (int i = tid; i < 4096; i += NTHR) { const int e = pt * 4096 + i, nn = e & 127, r = e >> 7, n = nn & 63, tau = r >> 4, c = r & 15;
            const float pr = pw[((tau + 1) * 64 + n) * 2], pi = pw[((tau + 1) * 64 + n) * 2 + 1], cr = cc[(c * 64 + n) * 2], ci = cc[(c * 64 + n) * 2 + 1];
            MTW[((size_t)g * 512 + r) * 640 + 512 + nn] = f2bf((nn >> 6) ? -(cr * pi + ci * pr) : (cr * pr - ci * pi)); }
        for (int i = tid; i < 32 * 512; i += NTHR) { const int r = pt * 32 + (i >> 9), kk = i & 511; if ((kk >> 4) > (r >> 4)) MTW[((size_t)g * 512 + r) * 640 + kk] = 0; }
        if (tid < 256) for (int dd = 0; dd < 2; ++dd) { const int d = 2 * pt + dd, c = tid >> 4, c2 = tid & 15; float acc = 0.f;
            for (int n = 0; n < 64; ++n) { const float cr = cc[(c * 64 + n) * 2], ci = cc[(c * 64 + n) * 2 + 1], pr = pw[(d * 64 + n) * 2], pi = pw[(d * 64 + n) * 2 + 1];
                const float xr = cr * pr - ci * pi, xi = cr * pi + ci * pr; acc += xr * bb[(n * 16 + c2) * 2] - xi * bb[(n * 16 + c2) * 2 + 1]; }
            km[dd * 256 + tid] = acc; }
        __syncthreads();
        if (tid < 256) for (int dd = 0; dd < 2; ++dd) { const int d = 2 * pt + dd; const bf16_t v = f2bf(km[dd * 256 + tid]); const int c = tid >> 4, c2 = tid & 15;
            for (int sidx = 0; sidx + d < 32; ++sidx) MTW[((size_t)g * 512 + (sidx + d) * 16 + c) * 640 + sidx * 16 + c2] = v; }
    }
    __syncthreads();
}
DEV void ssm_scan(const SsmIn& s, const float* SS, bf16_t* UH) {
    for (int idx = get_bid() * NTHR + get_tid(); idx < 32768; idx += gridDim.x * NTHR) {
        const int n = idx & 63, b = (idx >> 6) & 15, g = idx >> 10;
        float ar, ai; lb_pow(s, g, n, 32.f, ar, ai);
        float hr = 0.f, hi = 0.f;
        const size_t row0 = (size_t)(g * 16 + b) * 64;
#pragma unroll 8
        for (int k = 0; k < 64; ++k) {
            UH[(row0 + k) * 640 + 512 + n] = f2bf(hr); UH[(row0 + k) * 640 + 576 + n] = f2bf(hi);
            const float sr = SS[(row0 + k) * 128 + n], si = SS[(row0 + k) * 128 + 64 + n];
            const float nr = ar * hr - ai * hi + sr, ni = ar * hi + ai * hr + si;
            hr = nr; hi = ni;
        }
    }
}

struct GemmP { const bf16_t* A; const bf16_t* Bt; int lda, ldb, MT, NT, KT, nbatch; };
#define GLAS __attribute__((address_space(3)))
template <int WM, class Addr, class Epi>
DEV void gemm_run(const GemmP p, const Addr ad, const Epi epi, unsigned char* lds_) {
    constexpr int TM = 32 * WM, ABYTES = TM * 128, STAGE = ABYTES + 32768, NLA = WM / 2;
    GLAS unsigned char* lds = (GLAS unsigned char*)lds_;
    const int tid = get_tid(), lane = tid & 63, wid = __builtin_amdgcn_readfirstlane(tid >> 6), wr = wid >> 2, wc = wid & 3, l15 = lane & 15, quad = lane >> 4;
    int nx, x, jx, stride;
    { volatile GLAS unsigned* cw = (volatile GLAS unsigned*)(lds + LDS_BYTES - 16);
      const int nloc = (int)cw[0], nxc = (int)cw[1], rank = (int)cw[2], xcc = (int)cw[3];
      if (nloc > 0 && xcc < nxc && rank < nloc) { nx = nxc; x = xcc; jx = rank; stride = nloc; }
      else { nx = 1; x = 0; jx = get_bid(); stride = gridDim.x; } }
    nx = __builtin_amdgcn_readfirstlane(nx); x = __builtin_amdgcn_readfirstlane(x); jx = __builtin_amdgcn_readfirstlane(jx); stride = __builtin_amdgcn_readfirstlane(stride);
    const int MTT = p.MT / (WM / 4), NTT = p.NT / 2;
    const int SRtot = (p.nbatch * MTT) / 8, per = 8 * NTT, KT = p.KT;
    int offA[NLA], offB[4];
#pragma unroll
    for (int i = 0; i < NLA; ++i) { const int row = (wid + 8 * i) * 8 + (lane >> 3), c = (lane & 7) ^ ((row >> 1) & 7); offA[i] = row * p.lda + c * 8; }
#pragma unroll
    for (int i = 0; i < 4; ++i) { const int row = (wid + 8 * i) * 8 + (lane >> 3), c = (lane & 7) ^ ((row >> 1) & 7); offB[i] = row * p.ldb + c * 8; }
    const int sw = (l15 >> 1) & 7;
    int aoff[2], boff[2];
#pragma unroll
    for (int ks = 0; ks < 2; ++ks) { const int c = ((ks * 4 + quad) ^ sw) * 16; aoff[ks] = (wr * (WM * 16) + l15) * 128 + c; boff[ks] = ABYTES + (wc * 64 + l15) * 128 + c; }
    int ls = jx, lkt = 0; const bf16_t* lA = nullptr; const bf16_t* lB = nullptr; bool lvalid;
#define GEMM_DECODE_L() do { const int q_ = ls / per, rem_ = ls % per, sr_ = x + nx * q_; lvalid = sr_ < SRtot; if (lvalid) { const int R_ = sr_ * 8 + (rem_ & 7), b_ = R_ / MTT; \
        lA = p.A + ad.a_off(b_) + (size_t)((R_ % MTT) * TM) * p.lda; lB = p.Bt + ad.b_off(b_) + (size_t)((rem_ >> 3) * 256) * p.ldb; } } while (0)
#define GEMM_ISSUE(stg) do { _Pragma("unroll") for (int i_ = 0; i_ < NLA; ++i_) \
        __builtin_amdgcn_global_load_lds((const unsigned*)(lA + offA[i_] + lkt * 64), (GLAS unsigned*)(lds + (stg) * STAGE + (wid + 8 * i_) * 1024), 16, 0, 0); \
        _Pragma("unroll") for (int i_ = 0; i_ < 4; ++i_) \
        __builtin_amdgcn_global_load_lds((const unsigned*)(lB + offB[i_] + lkt * 64), (GLAS unsigned*)(lds + (stg) * STAGE + ABYTES + (wid + 8 * i_) * 1024), 16, 0, 0); \
        ++issued; if (++lkt == KT) { lkt = 0; ls += stride; GEMM_DECODE_L(); } } while (0)
    GEMM_DECODE_L();
    int issued = 0;
    asm volatile("s_waitcnt vmcnt(0)" ::: "memory");
    __syncthreads();
    if (lvalid) GEMM_ISSUE(0);
    if (lvalid) GEMM_ISSUE(1);
    f32x4 acc[WM][4];
#pragma unroll
    for (int i = 0; i < WM; ++i)
#pragma unroll
        for (int j = 0; j < 4; ++j) acc[i][j] = (f32x4){0.f, 0.f, 0.f, 0.f};
    int cs = jx, ckt = 0; bool drain = false;
#pragma unroll 1
    for (int it = 0; it < issued; ++it) {
        if (drain || issued - it - 1 == 0) asm volatile("s_waitcnt vmcnt(0)" ::: "memory");
        else asm volatile("s_waitcnt vmcnt(%0)" :: "n"(NLA + 4) : "memory");
        drain = false;
        __builtin_amdgcn_s_barrier();
        asm volatile("" ::: "memory");
        const GLAS unsigned char* st = lds + (it & 1) * STAGE;
        bf16x8 af[WM], bfr[4];
#pragma unroll
        for (int i = 0; i < 4; ++i) bfr[i] = *(const GLAS bf16x8*)(st + boff[0] + i * 2048);
#pragma unroll
        for (int i = 0; i < WM; ++i) af[i] = *(const GLAS bf16x8*)(st + aoff[0] + i * 2048);
#pragma unroll
        for (int mi = 0; mi < WM; ++mi)
#pragma unroll
            for (int ni = 0; ni < 4; ++ni) acc[mi][ni] = __builtin_amdgcn_mfma_f32_16x16x32_bf16(bfr[ni], af[mi], acc[mi][ni], 0, 0, 0);
#pragma unroll
        for (int i = 0; i < 4; ++i) bfr[i] = *(const GLAS bf16x8*)(st + boff[1] + i * 2048);
#pragma unroll
        for (int i = 0; i < WM; ++i) af[i] = *(const GLAS bf16x8*)(st + aoff[1] + i * 2048);
        asm volatile("s_waitcnt lgkmcnt(0)" ::: "memory");
        __builtin_amdgcn_s_barrier();
        asm volatile("" ::: "memory");
        if (lvalid) GEMM_ISSUE(it & 1);
        asm volatile("" ::: "memory");
#pragma unroll
        for (int mi = 0; mi < WM; ++mi)
#pragma unroll
            for (int ni = 0; ni < 4; ++ni) acc[mi][ni] = __builtin_amdgcn_mfma_f32_16x16x32_bf16(bfr[ni], af[mi], acc[mi][ni], 0, 0, 0);
        if (++ckt == KT) {
            const int q_ = cs / per, rem_ = cs % per, R_ = (x + nx * q_) * 8 + (rem_ & 7);
#pragma unroll
            for (int h = 0; h < WM / 4; ++h)
                epi(reinterpret_cast<const f32x4 (&)[4][4]>(acc[4 * h]), R_ / MTT, (R_ % MTT) * TM + wr * (WM * 16) + h * 64, (rem_ >> 3) * 256 + wc * 64, l15, quad);
#pragma unroll
            for (int i = 0; i < WM; ++i)
#pragma unroll
                for (int j = 0; j < 4; ++j) acc[i][j] = (f32x4){0.f, 0.f, 0.f, 0.f};
            ckt = 0; cs += stride; drain = true;
        }
    }
    asm volatile("s_waitcnt vmcnt(0) lgkmcnt(0)" ::: "memory");
    __syncthreads();
#undef GEMM_DECODE_L
#undef GEMM_ISSUE
}
struct AddrNone { DEV size_t a_off(int) const { return 0; } DEV size_t b_off(int) const { return 0; } };
struct AddrStride { size_t as, bs; DEV size_t a_off(int b) const { return as * b; } DEV size_t b_off(int b) const { return bs * b; } };
struct AddrCmp1 { DEV size_t a_off(int b) const { return (size_t)b * 2048 * 64; } DEV size_t b_off(int b) const { return (size_t)((b >> 2) & 1) * 256 * 2048; } };
struct AddrCmp2 { DEV size_t a_off(int b) const { return (size_t)b * 128 * 256; } DEV size_t b_off(int b) const { return (size_t)((b >> 2) & 1) * 256 * 256; } };

#define EPI_ARGS const f32x4 (&acc)[4][4], int batch, int m0, int n0, int l15, int quad
struct EpiIn {
    bf16_t *UH, *Qb, *KVC, *KS, *VST, *KW, *VWT, *GM; float* GN;
    DEV void operator()(EPI_ARGS) const {
#pragma unroll
        for (int mi = 0; mi < 4; ++mi) {
            const int t = m0 + mi * 16 + l15, b = t >> 11, tt = t & 2047;
#pragma unroll
            for (int ni = 0; ni < 4; ++ni) {
                const f32x4 v = acc[mi][ni];
                const int c = n0 + ni * 16 + quad * 4;
                if (n0 < 512) {
                    const int g = c >> 4;
                    st_bf4(UH + ((size_t)((g * 16 + b) * 64 + (tt >> 5))) * 640 + (tt & 31) * 16 + (c & 15), v[0], v[1], v[2], v[3]);
                } else if (n0 < 1536) {
                    const float sc = 0.125f * LOG2E;
                    st_bf4(Qb + (size_t)t * 1024 + (c - 512), v[0] * sc, v[1] * sc, v[2] * sc, v[3] * sc);
                } else if (n0 < 2048) {
                    const int cc = c - 1536, z = cc >> 8, h = (cc >> 6) & 3, d = cc & 63;
                    st_bf4(KVC + ((size_t)(((b * 2 + z) * 4 + h) * 2048 + tt)) * 64 + d, v[0], v[1], v[2], v[3]);
                } else if (n0 < 3072) {
                    const int cc = (c - 2048) & 511, isw = (c - 2048) >> 9, h = (cc >> 6) & 3, d = cc & 63;
                    if (cc < 256) st_bf4((isw ? KW : KS) + ((size_t)((b * 4 + h) * 2048 + tt)) * 64 + d, v[0], v[1], v[2], v[3]);
                    else { bf16_t* o = (isw ? VWT : VST) + ((size_t)((b * 4 + h) * 64 + d)) * 2048 + tt;
#pragma unroll
                        for (int i = 0; i < 4; ++i) o[(size_t)i * 2048] = f2bf(v[i]); }
                } else if (n0 < 5120) {
                    st_bf4(GM + (size_t)t * 2048 + (c - 3072), sigmoidf_(v[0]), sigmoidf_(v[1]), sigmoidf_(v[2]), sigmoidf_(v[3]));
                } else {
                    const int cc = c - 5120;
                    if (cc < 48) *(f32x4*)(GN + (size_t)t * 48 + cc) = (f32x4){sigmoidf_(v[0]), sigmoidf_(v[1]), sigmoidf_(v[2]), sigmoidf_(v[3])};
                }
            }
        }
    }
};
struct EpiXkv {
    bf16_t *XK, *XVT;
    DEV void operator()(EPI_ARGS) const {
#pragma unroll
        for (int mi = 0; mi < 4; ++mi) {
            const int r = m0 + mi * 16 + l15, b = r >> 8, m = r & 255;
#pragma unroll
            for (int ni = 0; ni < 4; ++ni) {
                const f32x4 v = acc[mi][ni]; const int c = n0 + ni * 16 + quad * 4;
                if (n0 < 1024) st_bf4(XK + (size_t)r * 1024 + c, v[0], v[1], v[2], v[3]);
                else { const int cc = c - 1024, h = cc >> 8, d = cc & 255; bf16_t* o = XVT + ((size_t)((b * 4 + h) * 256 + d)) * 256 + m;
#pragma unroll
                    for (int i = 0; i < 4; ++i) o[i * 256] = f2bf(v[i]); }
            }
        }
    }
};
struct EpiSsmA { float* SS;
    DEV void operator()(EPI_ARGS) const {
        if (n0 >= 128) return;
#pragma unroll
        for (int mi = 0; mi < 4; ++mi)
#pragma unroll
            for (int ni = 0; ni < 4; ++ni) *(f32x4*)(SS + ((size_t)batch * 1024 + m0 + mi * 16 + l15) * 128 + n0 + ni * 16 + quad * 4) = acc[mi][ni];
    }
};
struct EpiCmp1 { bf16_t* HID; const float* bias2;
    DEV void operator()(EPI_ARGS) const {
        const int z = (batch >> 2) & 1;
#pragma unroll
        for (int ni = 0; ni < 4; ++ni) {
            const int c = n0 + ni * 16 + quad * 4; const f32x4 bv = *(const f32x4*)(bias2 + z * 256 + c);
#pragma unroll
            for (int mi = 0; mi < 4; ++mi) { const f32x4 v = acc[mi][ni] + bv;
                st_bf4(HID + ((size_t)batch * 128 + m0 + mi * 16 + l15) * 256 + c, gelu_tanh(v[0]), gelu_tanh(v[1]), gelu_tanh(v[2]), gelu_tanh(v[3])); }
        }
    }
};
struct EpiCmp2 { bf16_t *KC, *VCT;
    DEV void operator()(EPI_ARGS) const {
        if (n0 >= 64) return;
        const int z = (batch >> 2) & 1, bh = (batch >> 3) * 4 + (batch & 3);
#pragma unroll
        for (int mi = 0; mi < 4; ++mi) { const int r = m0 + mi * 16 + l15;
#pragma unroll
            for (int ni = 0; ni < 4; ++ni) { const f32x4 v = acc[mi][ni]; const int c = n0 + ni * 16 + quad * 4;
                if (z == 0) st_bf4(KC + ((size_t)bh * 128 + r) * 64 + c, v[0], v[1], v[2], v[3]);
                else {
#pragma unroll
                    for (int i = 0; i < 4; ++i) VCT[((size_t)bh * 64 + c + i) * 128 + r] = f2bf(v[i]); } } }
    }
};
struct EpiSsmB { const bf16_t* UH; const float* dskip; bf16_t* GB;
    DEV void operator()(EPI_ARGS) const {
#pragma unroll
        for (int mi = 0; mi < 4; ++mi) { const int r = m0 + mi * 16 + l15, b = r >> 6, k = r & 63;
#pragma unroll
            for (int ni = 0; ni < 4; ++ni) { const int col = n0 + ni * 16 + quad * 4, tau = col >> 4, c = col & 15;
                const f32x4 u = ld_bf4(UH + ((size_t)batch * 1024 + r) * 640 + col);
                const f32x4 dv = *(const f32x4*)(dskip + batch * 16 + c);
                const f32x4 y = acc[mi][ni] + dv * u;
                st_bf4(GB + ((size_t)(b * 2048 + k * 32 + tau)) * 512 + batch * 16 + c, gelu_tanh(y[0]), gelu_tanh(y[1]), gelu_tanh(y[2]), gelu_tanh(y[3])); } }
    }
};
struct EpiGlu { const bf16_t* GB; const float* bglu; bf16_t* YS;
    DEV void operator()(EPI_ARGS) const {
#pragma unroll
        for (int ni = 0; ni < 4; ++ni) { const int c = n0 + ni * 16 + quad * 4; const f32x4 bv = *(const f32x4*)(bglu + c);
#pragma unroll
            for (int mi = 0; mi < 4; ++mi) { const size_t o = (size_t)(m0 + mi * 16 + l15) * 512 + c; const f32x4 g = ld_bf4(GB + o); const f32x4 v = acc[mi][ni] + bv;
                st_bf4(YS + o, g[0] * sigmoidf_(v[0]), g[1] * sigmoidf_(v[1]), g[2] * sigmoidf_(v[2]), g[3] * sigmoidf_(v[3])); } }
    }
};
struct EpiSout { const bf16_t* GM; bf16_t* P1;
    DEV void operator()(EPI_ARGS) const {
#pragma unroll
        for (int mi = 0; mi < 4; ++mi) { const size_t t = m0 + mi * 16 + l15;
#pragma unroll
            for (int ni = 0; ni < 4; ++ni) { const int c = n0 + ni * 16 + quad * 4; const f32x4 g = ld_bf4(GM + t * 2048 + c); const f32x4 v = acc[mi][ni] * g;
                st_bf4(P1 + t * 1024 + c, v[0], v[1], v[2], v[3]); } }
    }
};
struct EpiNout { const bf16_t* GM; const bf16_t* P1; bf16_t* MIX;
    DEV void operator()(EPI_ARGS) const {
#pragma unroll
        for (int mi = 0; mi < 4; ++mi) { const size_t t = m0 + mi * 16 + l15;
#pragma unroll
            for (int ni = 0; ni < 4; ++ni) { const int c = n0 + ni * 16 + quad * 4; const f32x4 g = ld_bf4(GM + t * 2048 + 1024 + c); const f32x4 v = acc[mi][ni] * g + ld_bf4(P1 + t * 1024 + c);
                st_bf4(MIX + t * 1024 + c, v[0], v[1], v[2], v[3]); } }
    }
};
struct EpiRes { const float* src; const float* stats; const float* g; const float* b; float* dst;
    DEV void operator()(EPI_ARGS) const {
#pragma unroll
        for (int mi = 0; mi < 4; ++mi) { const size_t t = m0 + mi * 16 + l15; const float mu = stats[t * 2], rs = stats[t * 2 + 1];
#pragma unroll
            for (int ni = 0; ni < 4; ++ni) { const int c = n0 + ni * 16 + quad * 4;
                const f32x4 xv = *(const f32x4*)(src + t * 1024 + c), gg = *(const f32x4*)(g + c), bb = *(const f32x4*)(b + c);
                *(f32x4*)(dst + t * 1024 + c) = ((xv - mu) * rs * gg + bb) * ALPHA + acc[mi][ni]; } }
    }
};
struct EpiScaleBf { bf16_t* O; int ldc; float sc;
    DEV void operator()(EPI_ARGS) const {
#pragma unroll
        for (int mi = 0; mi < 4; ++mi)
#pragma unroll
            for (int ni = 0; ni < 4; ++ni) { const f32x4 v = acc[mi][ni] * sc; st_bf4(O + (size_t)(m0 + mi * 16 + l15) * ldc + n0 + ni * 16 + quad * 4, v[0], v[1], v[2], v[3]); }
    }
};
struct EpiFfnIn { bf16_t* FB;
    DEV void operator()(EPI_ARGS) const {
#pragma unroll
        for (int mi = 0; mi < 4; ++mi) { const size_t t = m0 + mi * 16 + l15;
#pragma unroll
            for (int pp = 0; pp < 2; ++pp) { const f32x4 ga = acc[mi][2 * pp], up = acc[mi][2 * pp + 1]; const int j = (n0 + pp * 32) / 2 + quad * 4;
                st_bf4(FB + t * 2816 + j, ga[0] * sigmoidf_(ga[0]) * up[0], ga[1] * sigmoidf_(ga[1]) * up[1], ga[2] * sigmoidf_(ga[2]) * up[2], ga[3] * sigmoidf_(ga[3]) * up[3]); } }
    }
};

DEV float qmax(float v) { auto a = __builtin_amdgcn_permlane16_swap(__float_as_uint(v), __float_as_uint(v), false, false); v = fmaxf(__uint_as_float(a[0]), __uint_as_float(a[1]));
    auto b = __builtin_amdgcn_permlane32_swap(__float_as_uint(v), __float_as_uint(v), false, false); return fmaxf(__uint_as_float(b[0]), __uint_as_float(b[1])); }
DEV float qsum(float v) { auto a = __builtin_amdgcn_permlane16_swap(__float_as_uint(v), __float_as_uint(v), false, false); v = __uint_as_float(a[0]) + __uint_as_float(a[1]);
    auto b = __builtin_amdgcn_permlane32_swap(__float_as_uint(v), __float_as_uint(v), false, false); return __uint_as_float(b[0]) + __uint_as_float(b[1]); }
DEV bf16x8 pack_p(const f32x4& a, const f32x4& b) { u32x4 w; w.x = cvt_pk_bf16(a[0], a[1]); w.y = cvt_pk_bf16(a[2], a[3]); w.z = cvt_pk_bf16(b[0], b[1]); w.w = cvt_pk_bf16(b[2], b[3]); return __builtin_bit_cast(bf16x8, w); }
DEV void st_vt(unsigned char* rowbase, int e, const u32x4& v) {
    const int grp = e >> 2, ep = e & 3, a = ep >> 1, qp = (ep & 1) * 2;
    unsigned char* o = rowbase + grp * 64 + (qp * 8 + a * 4) * 2;
    *(u32x2*)o = (u32x2){v.x, v.y}; *(u32x2*)(o + 16) = (u32x2){v.z, v.w};
}

struct NsaCtx { const bf16_t *Qb, *KC, *VCT, *KS, *VST, *KW, *VWT; const float* GN; bf16_t* ON; };
constexpr float MINIT = -1e20f;

template <int MODE, bool BOUND>
DEV void nsa_tile(const unsigned char* Kl, const unsigned char* Vl, const bf16x8 (&Qf)[2][2], f32x4 (&O)[2][4], float (&m)[2], float (&l)[2],
                  const float (&slope)[2], int dist0, bool sel, int l15, int quad) {
    const float d0f = (float)dist0;
#pragma unroll
    for (int g = 0; g < 2; ++g) {
        f32x4 S[4];
#pragma unroll
        for (int kt = 0; kt < 4; ++kt) { S[kt] = (f32x4){0.f, 0.f, 0.f, 0.f};
#pragma unroll
            for (int ks = 0; ks < 2; ++ks) { const bf16x8 kf = *(const bf16x8*)(Kl + (kt * 16 + l15) * 144 + ks * 64 + quad * 16); S[kt] = __builtin_amdgcn_mfma_f32_16x16x32_bf16(kf, Qf[g][ks], S[kt], 0, 0, 0); } }
        float base = -slope[g] * d0f;
        if (MODE == 0) base = sel ? base : NEG;
        typedef float f2 __attribute__((ext_vector_type(2)));
        const f2 sl_lo = {0.f, slope[g]}, sl_hi = {2.f * slope[g], 3.f * slope[g]};
        float tmax = NEG;
        f2 Slo[4], Shi[4];
#pragma unroll
        for (int kt = 0; kt < 4; ++kt) {
            const float bk = fmaf(slope[g], (float)(16 * kt), base);
            f2 lo = (f2){S[kt][0], S[kt][1]} + (sl_lo + bk), hi = (f2){S[kt][2], S[kt][3]} + (sl_hi + bk);
            if (BOUND) {
#pragma unroll
                for (int i = 0; i < 4; ++i) { const int cc = 16 * kt + i; bool v = cc <= dist0; if (MODE == 1) v = v && (cc > dist0 - 512);
                    if (i < 2) lo[i] = v ? lo[i] : NEG; else hi[i - 2] = v ? hi[i - 2] : NEG; }
            }
            Slo[kt] = lo; Shi[kt] = hi;
            tmax = fmaxf(fmaxf(tmax, lo[0]), lo[1]); tmax = fmaxf(fmaxf(tmax, hi[0]), hi[1]);
        }
        tmax = qmax(tmax);
        const float mnew = fmaxf(m[g], tmax), alpha = fexp2(m[g] - mnew);
        f2 rs2 = {0.f, 0.f};
#pragma unroll
        for (int kt = 0; kt < 4; ++kt) {
            const f2 a = Slo[kt] - mnew, b = Shi[kt] - mnew;
            const f2 pa = {fexp2(a[0]), fexp2(a[1])}, pb = {fexp2(b[0]), fexp2(b[1])};
            rs2 += pa; rs2 += pb;
            S[kt] = (f32x4){pa[0], pa[1], pb[0], pb[1]};
        }
        l[g] = l[g] * alpha + (rs2[0] + rs2[1]); m[g] = mnew;
        const bf16x8 P0 = pack_p(S[0], S[1]), P1 = pack_p(S[2], S[3]);
#pragma unroll
        for (int dt = 0; dt < 4; ++dt) { O[g][dt] = O[g][dt] * alpha;
            const bf16x8 v0 = *(const bf16x8*)(Vl + (dt * 16 + l15) * 144 + quad * 16), v1 = *(const bf16x8*)(Vl + (dt * 16 + l15) * 144 + 64 + quad * 16);
            O[g][dt] = __builtin_amdgcn_mfma_f32_16x16x32_bf16(v0, P0, O[g][dt], 0, 0, 0);
            O[g][dt] = __builtin_amdgcn_mfma_f32_16x16x32_bf16(v1, P1, O[g][dt], 0, 0, 0); }
    }
}

template <int MODE>
DEV void nsa_tiles(unsigned char* lds, const bf16_t* Kg, const bf16_t* VTg, unsigned tilemask, unsigned wmask, unsigned qmask, int jb0, int jb1,
                   const bf16x8 (&Qf)[2][2], f32x4 (&O)[2][4], float (&m)[2], float (&l)[2], const float (&slope)[2], int tq, int l15, int quad) {
    const int tid = get_tid();
    const int prow = tid >> 3, pe = tid & 7;
    unsigned rem = tilemask;
    int j = __builtin_ctz(rem); rem &= rem - 1;
    u32x4 rk, rv;
    rk = *(const u32x4*)(Kg + (size_t)(64 * j + prow) * 64 + pe * 8); rv = *(const u32x4*)(VTg + (size_t)prow * 2048 + 64 * j + pe * 8);
    int cur = 0;
    *(u32x4*)(lds + prow * 144 + pe * 16) = rk; st_vt(lds + 9216 + prow * 144, pe, rv);
    __syncthreads();
    for (;;) {
        int jn = -1;
        if (rem) { jn = __builtin_ctz(rem); rem &= rem - 1;
            rk = *(const u32x4*)(Kg + (size_t)(64 * jn + prow) * 64 + pe * 8); rv = *(const u32x4*)(VTg + (size_t)prow * 2048 + 64 * jn + pe * 8); }
        __builtin_amdgcn_sched_barrier(0);
        const unsigned char* st = lds + cur * 18432;
        if (MODE == 1 || ((wmask >> j) & 1u)) {
            const int dist0 = tq - 64 * j - 4 * quad; const bool sel = (qmask >> j) & 1u;
            if (j == jb0 || j == jb1) nsa_tile<MODE, true>(st, st + 9216, Qf, O, m, l, slope, dist0, sel, l15, quad);
            else nsa_tile<MODE, false>(st, st + 9216, Qf, O, m, l, slope, dist0, sel, l15, quad);
        }
        if (jn >= 0) { unsigned char* sn = lds + (cur ^ 1) * 18432; *(u32x4*)(sn + prow * 144 + pe * 16) = rk; st_vt(sn + 9216 + prow * 144, pe, rv); }
        __syncthreads();
        if (jn < 0) break;
        j = jn; cur ^= 1;
    }
}

DEV void nsa_unit(const NsaCtx& c, int b, int hkv, int qb, unsigned char* lds) {
    const int tid = get_tid(), lane = tid & 63, wid = tid >> 6, l15 = lane & 15, quad = lane >> 4;
    const int qs = wid & 3, hp = wid >> 2;
    const int tq = qb * 64 + qs * 16 + l15, cur = qb;
    const size_t trow = (size_t)b * 2048 + tq;
    const int head0 = hkv * 4 + hp * 2;
    const float* gnp = c.GN + trow * 48 + head0 * 3;
    unsigned char* stash = lds + 36864 + wid * 4096;
    float* xch = (float*)(lds + 69632);
    unsigned* smask = (unsigned*)(lds + 102400);
    const int bh = b * 4 + hkv;
    {
        const bf16_t* Kg = c.KC + (size_t)bh * 128 * 64; const bf16_t* Vg = c.VCT + (size_t)bh * 64 * 128;
#pragma unroll
        for (int i = 0; i < 2; ++i) { const int pc = tid + 512 * i;
            *(u32x4*)(lds + (pc >> 3) * 144 + (pc & 7) * 16) = *(const u32x4*)(Kg + pc * 8);
            st_vt(lds + 18432 + (pc >> 4) * 272, pc & 15, *(const u32x4*)(Vg + pc * 8)); }
    }
    __syncthreads();
    const int nkt = (4 * qb + 2) / 16 + 1;
    float Mx[8], Sm[8];
#pragma unroll
    for (int kt = 0; kt < 8; ++kt) { Mx[kt] = NEG; Sm[kt] = 0.f; }
#ifdef NSA_NO_CMP
    for (int g = 0; g < 0; ++g) {
#else
#pragma unroll 1
    for (int g = 0; g < 2; ++g) {
#endif
        bf16x8 Qg[2];
#pragma unroll
        for (int ks = 0; ks < 2; ++ks) Qg[ks] = *(const bf16x8*)(c.Qb + trow * 1024 + (head0 + g) * 64 + ks * 32 + quad * 8);
        const float slope_g = exp2f(-0.5f * (float)(head0 + g + 1)) * LOG2E;
        f32x4 S[8];
#pragma unroll
        for (int kt = 0; kt < 8; ++kt) { S[kt] = (f32x4){0.f, 0.f, 0.f, 0.f};
            if (kt < nkt) {
#pragma unroll
                for (int ks = 0; ks < 2; ++ks) { const bf16x8 kf = *(const bf16x8*)(lds + (kt * 16 + l15) * 144 + ks * 64 + quad * 16); S[kt] = __builtin_amdgcn_mfma_f32_16x16x32_bf16(kf, Qg[ks], S[kt], 0, 0, 0); } } }
        float mx = NEG;
        const int d0 = tq - 31 - 64 * quad; const float base = -slope_g * (float)d0;
#pragma unroll
        for (int kt = 0; kt < 8; ++kt)
#pragma unroll
            for (int i = 0; i < 4; ++i) { const int cc = 256 * kt + 16 * i; const float s = (kt < nkt && cc <= d0) ? fmaf(slope_g, (float)cc, S[kt][i] + base) : NEG; S[kt][i] = s; mx = fmaxf(mx, s); }
        mx = qmax(mx);
        float ls = 0.f;
#pragma unroll
        for (int kt = 0; kt < 8; ++kt)
#pragma unroll
            for (int i = 0; i < 4; ++i) ls += S[kt][i] > -1e29f ? fexp2(S[kt][i] - mx) : 0.f;
        ls = qsum(ls);
        const float lcl = fmaxf(ls, 1e-30f), lg = __log2f(lcl) + mx;
        float x3[8];
#pragma unroll
        for (int kt = 0; kt < 8; ++kt) {
#pragma unroll
            for (int i = 0; i < 4; ++i) S[kt][i] = S[kt][i] > -1e29f ? S[kt][i] - lg : NEG;
            x3[kt] = __shfl(S[kt][3], (lane + 48) & 63);
        }
#pragma unroll
        for (int kt = 0; kt < 8; ++kt) {
            const float nb = quad >= 1 ? x3[kt] : (kt >= 1 ? x3[kt >= 1 ? kt - 1 : 0] : NEG);
            const float tm = fmaxf(fmaxf(fmaxf(S[kt][0], S[kt][1]), fmaxf(S[kt][2], S[kt][3])), nb);
            const float nm = fmaxf(Mx[kt], tm);
            Sm[kt] = Sm[kt] * fexp2(Mx[kt] - nm) + fexp2(S[kt][0] - nm) + fexp2(S[kt][1] - nm) + fexp2(S[kt][2] - nm) + fexp2(S[kt][3] - nm) + fexp2(nb - nm);
            Mx[kt] = nm;
        }
        const float gate0 = gnp[g * 3];
        f32x4 Oc[4];
#pragma unroll
        for (int dt = 0; dt < 4; ++dt) Oc[dt] = (f32x4){0.f, 0.f, 0.f, 0.f};
#pragma unroll
        for (int k2 = 0; k2 < 4; ++k2) {
            if (2 * k2 < nkt) {
                f32x4 pa, pb;
#pragma unroll
                for (int i = 0; i < 4; ++i) { pa[i] = fexp2(S[2 * k2][i]); pb[i] = fexp2(S[2 * k2 + 1][i]); }
                const bf16x8 pf = pack_p(pa, pb);
#pragma unroll
                for (int dt = 0; dt < 4; ++dt) { const bf16x8 vf = *(const bf16x8*)(lds + 18432 + (dt * 16 + l15) * 272 + k2 * 64 + quad * 16); Oc[dt] = __builtin_amdgcn_mfma_f32_16x16x32_bf16(vf, pf, Oc[dt], 0, 0, 0); }
            }
        }
#pragma unroll
        for (int dt = 0; dt < 4; ++dt) { const f32x4 v = Oc[dt] * gate0; u32x2 w; w.x = cvt_pk_bf16(v[0], v[1]); w.y = cvt_pk_bf16(v[2], v[3]); *(u32x2*)(stash + ((g * 4 + dt) * 64 + lane) * 8) = w; }
    }
    unsigned qmask;
    if (cur < 8) qmask = (2u << cur) - 1u;
    if (cur >= 8) {
#pragma unroll
        for (int kt = 0; kt < 8; ++kt) { xch[(wid * 16 + kt) * 64 + lane] = Mx[kt]; xch[(wid * 16 + 8 + kt) * 64 + lane] = Sm[kt]; }
    }
    __syncthreads();
    if (cur >= 8) {
        float v[8];
#pragma unroll
        for (int kt = 0; kt < 8; ++kt) {
            const float m2 = xch[((wid ^ 4) * 16 + kt) * 64 + lane], s2 = xch[((wid ^ 4) * 16 + 8 + kt) * 64 + lane];
            const float mm = fmaxf(Mx[kt], m2), ss = Sm[kt] * fexp2(Mx[kt] - mm) + s2 * fexp2(m2 - mm);
            const int jb = 4 * kt + quad; v[kt] = (jb >= 1 && jb <= cur - 2) ? mm + __log2f(ss) : -3e38f; }
        qmask = 1u | (1u << cur) | (1u << (cur - 1));
        for (int r = 0; r < 5; ++r) {
            float bv = v[0]; int bj = quad;
#pragma unroll
            for (int kt = 1; kt < 8; ++kt) if (v[kt] > bv) { bv = v[kt]; bj = 4 * kt + quad; }
#pragma unroll
            for (int o = 16; o <= 32; o <<= 1) { const float ov = __shfl_xor(bv, o); const int oj = __shfl_xor(bj, o); if (ov > bv || (ov == bv && oj < bj)) { bv = ov; bj = oj; } }
            qmask |= 1u << bj;
#pragma unroll
            for (int kt = 0; kt < 8; ++kt) if (4 * kt + quad == bj) v[kt] = -3.2e38f;
        }
    }
    unsigned wmask = qmask;
#pragma unroll
    for (int o = 1; o <= 8; o <<= 1) wmask |= __shfl_xor(wmask, o);
    if (lane == 0) smask[wid] = wmask;
    __syncthreads();
    const unsigned umask = (smask[0] | smask[1] | smask[2] | smask[3]) | (smask[4] | smask[5] | smask[6] | smask[7]);
    bf16x8 Qf[2][2]; float slope[2];
#pragma unroll
    for (int g = 0; g < 2; ++g) {
#pragma unroll
        for (int ks = 0; ks < 2; ++ks) Qf[g][ks] = *(const bf16x8*)(c.Qb + trow * 1024 + (head0 + g) * 64 + ks * 32 + quad * 8);
        slope[g] = exp2f(-0.5f * (float)(head0 + g + 1)) * LOG2E;
    }
    f32x4 O[2][4]; float m[2], l[2];
#pragma unroll
    for (int g = 0; g < 2; ++g) { m[g] = MINIT; l[g] = 0.f;
#pragma unroll
        for (int dt = 0; dt < 4; ++dt) O[g][dt] = (f32x4){0.f, 0.f, 0.f, 0.f}; }
#ifndef NSA_NO_SLC
    nsa_tiles<0>(lds, c.KS + (size_t)bh * 2048 * 64, c.VST + (size_t)bh * 64 * 2048, umask, wmask, qmask, cur, cur, Qf, O, m, l, slope, tq, l15, quad);
#endif
#pragma unroll
    for (int g = 0; g < 2; ++g) { const float sc = gnp[g * 3 + 1] / fmaxf(qsum(l[g]), 1e-30f);
#pragma unroll
        for (int dt = 0; dt < 4; ++dt) { u32x2* sp = (u32x2*)(stash + ((g * 4 + dt) * 64 + lane) * 8); const u32x2 w = *sp;
            const f32x4 v = O[g][dt] * sc + (f32x4){bflo(w.x), bfhi(w.x), bflo(w.y), bfhi(w.y)};
            u32x2 w2; w2.x = cvt_pk_bf16(v[0], v[1]); w2.y = cvt_pk_bf16(v[2], v[3]); *sp = w2;
            O[g][dt] = (f32x4){0.f, 0.f, 0.f, 0.f}; }
        m[g] = MINIT; l[g] = 0.f; }
    const int jlo = qb >= 8 ? qb - 8 : 0;
    const unsigned winmask = ((2u << cur) - 1u) & ~((1u << jlo) - 1u);
#ifndef NSA_NO_WIN
    nsa_tiles<1>(lds, c.KW + (size_t)bh * 2048 * 64, c.VWT + (size_t)bh * 64 * 2048, winmask, 0u, 0u, cur, jlo, Qf, O, m, l, slope, tq, l15, quad);
#endif
#pragma unroll
    for (int g = 0; g < 2; ++g) { const float sc = gnp[g * 3 + 2] / fmaxf(qsum(l[g]), 1e-30f);
#pragma unroll
        for (int dt = 0; dt < 4; ++dt) { const u32x2 w = *(const u32x2*)(stash + ((g * 4 + dt) * 64 + lane) * 8);
            const f32x4 v = O[g][dt] * sc + (f32x4){bflo(w.x), bfhi(w.x), bflo(w.y), bfhi(w.y)};
            st_bf4(c.ON + trow * 1024 + (head0 + g) * 64 + dt * 16 + quad * 4, v[0], v[1], v[2], v[3]); } }
}

DEV void xattn_unit(const bf16_t* Qx, const bf16_t* XK, const bf16_t* XVT, bf16_t* OX, int b, int h, int qblk  , unsigned char* lds) {
    const int tid = get_tid(), lane = tid & 63, wid = tid >> 6, l15 = lane & 15, quad = lane >> 4;
    const size_t trow = (size_t)b * 2048 + qblk * 128 + wid * 16 + l15;
    bf16x8 Qf[8];
#pragma unroll
    for (int ks = 0; ks < 8; ++ks) Qf[ks] = *(const bf16x8*)(Qx + trow * 1024 + h * 256 + ks * 32 + quad * 8);
    f32x4 O[16];
#pragma unroll
    for (int dt = 0; dt < 16; ++dt) O[dt] = (f32x4){0.f, 0.f, 0.f, 0.f};
    float m = NEG, l = 0.f;
    const bf16_t* Kg = XK + (size_t)b * 256 * 1024 + h * 256;
    const bf16_t* Vg = XVT + (size_t)(b * 4 + h) * 256 * 256;
    u32x4 rk[2], rv[2];
#pragma unroll
    for (int i = 0; i < 2; ++i) { const int pc = tid + 512 * i; rk[i] = *(const u32x4*)(Kg + (size_t)(pc >> 5) * 1024 + (pc & 31) * 8); rv[i] = *(const u32x4*)(Vg + (size_t)(pc >> 2) * 256 + (pc & 3) * 8); }
#pragma unroll
    for (int i = 0; i < 2; ++i) { const int pc = tid + 512 * i; *(u32x4*)(lds + (pc >> 5) * 528 + (pc & 31) * 16) = rk[i]; st_vt(lds + 16896 + (pc >> 2) * 80, pc & 3, rv[i]); }
    __syncthreads();
    for (int j = 0; j < 8; ++j) {
        const bool more = j + 1 < 8;
        if (more) {
#pragma unroll
            for (int i = 0; i < 2; ++i) { const int pc = tid + 512 * i; rk[i] = *(const u32x4*)(Kg + (size_t)(32 * (j + 1) + (pc >> 5)) * 1024 + (pc & 31) * 8); rv[i] = *(const u32x4*)(Vg + (size_t)(pc >> 2) * 256 + 32 * (j + 1) + (pc & 3) * 8); } }
        __builtin_amdgcn_sched_barrier(0);
        const unsigned char* st = lds + (j & 1) * 37376;
        f32x4 S[2];
#pragma unroll
        for (int kt = 0; kt < 2; ++kt) { S[kt] = (f32x4){0.f, 0.f, 0.f, 0.f};
#pragma unroll
            for (int ks = 0; ks < 8; ++ks) { const bf16x8 kf = *(const bf16x8*)(st + (kt * 16 + l15) * 528 + ks * 64 + quad * 16); S[kt] = __builtin_amdgcn_mfma_f32_16x16x32_bf16(kf, Qf[ks], S[kt], 0, 0, 0); } }
        float tmax = fmaxf(fmaxf(fmaxf(S[0][0], S[0][1]), fmaxf(S[0][2], S[0][3])), fmaxf(fmaxf(S[1][0], S[1][1]), fmaxf(S[1][2], S[1][3])));
        tmax = qmax(tmax);
        const float mnew = fmaxf(m, tmax), alpha = fexp2(m - mnew);
        float rs = 0.f;
#pragma unroll
        for (int kt = 0; kt < 2; ++kt)
#pragma unroll
            for (int i = 0; i < 4; ++i) { const float pv = fexp2(S[kt][i] - mnew); S[kt][i] = pv; rs += pv; }
        l = l * alpha + rs; m = mnew;
        const bf16x8 pf = pack_p(S[0], S[1]);
#pragma unroll
        for (int dt = 0; dt < 16; ++dt) { O[dt] = O[dt] * alpha; const bf16x8 vf = *(const bf16x8*)(st + 16896 + (dt * 16 + l15) * 80 + quad * 16); O[dt] = __builtin_amdgcn_mfma_f32_16x16x32_bf16(vf, pf, O[dt], 0, 0, 0); }
        if (more) { unsigned char* sn = lds + ((j + 1) & 1) * 37376;
#pragma unroll
            for (int i = 0; i < 2; ++i) { const int pc = tid + 512 * i; *(u32x4*)(sn + (pc >> 5) * 528 + (pc & 31) * 16) = rk[i]; st_vt(sn + 16896 + (pc >> 2) * 80, pc & 3, rv[i]); } }
        __syncthreads();
    }
    const float inv = 1.0f / qsum(l);
#pragma unroll
    for (int dt = 0; dt < 16; ++dt) { const f32x4 v = O[dt] * inv; st_bf4(OX + trow * 1024 + h * 256 + dt * 16 + quad * 4, v[0], v[1], v[2], v[3]); }
}


#define XB_TMO      128
#define XB_XCNT(j)  (256  + 64 * (j))
#define XB_XSUB(j)  (1280 + 64 * (j))
#define XB_XGEN(j)  (2304 + 64 * (j))
#define XB_TOP      3328
#define XB_TOPGEN   3392
#define XCD_BAR_WORDS 3456
#define XB_SPIN_CAP (1u << 18)
#define LAS __attribute__((address_space(3)))
DEV unsigned xb_ld(unsigned* p)              { return __hip_atomic_load(p, __ATOMIC_RELAXED, __HIP_MEMORY_SCOPE_AGENT); }
DEV unsigned xb_add(unsigned* p, unsigned v) { return __hip_atomic_fetch_add(p, v, __ATOMIC_RELAXED, __HIP_MEMORY_SCOPE_AGENT); }
DEV unsigned xb_xcc_id() { return (unsigned)__builtin_amdgcn_s_getreg((3 << 11) | 20) & 0xFu; }
#define XB_SPIN(cond, bar) do { unsigned _sp = 0; while (cond) { __builtin_amdgcn_s_sleep(1); \
    if ((++_sp & 255u) == 0u) { if (xb_ld(&(bar)[XB_TMO])) break; if (_sp > XB_SPIN_CAP) { atomicAdd(&(bar)[XB_TMO], 1u); break; } } } } while (0)
struct XcdBarrier { unsigned* bar; unsigned x; volatile LAS unsigned* st; };
DEV XcdBarrier xcd_barrier_post(unsigned* bar, volatile LAS unsigned* st) {
    XcdBarrier b; b.bar = bar; b.x = xb_xcc_id(); b.st = st;
    if (threadIdx.x == 0) { st[2] = xb_add(&bar[XB_XCNT(b.x)], 1u); st[3] = b.x; }
    return b;
}
DEV void xcd_barrier_complete(unsigned* bar, unsigned x, unsigned& nloc, unsigned& nx) {
    const unsigned G = gridDim.x * gridDim.y * gridDim.z;
    unsigned sum, cnt, mine, sp = 0u;
    for (;;) {
        sum = 0u; cnt = 0u; mine = 0u;
#pragma unroll
        for (unsigned j = 0; j < 16; ++j) { const unsigned c = xb_ld(&bar[XB_XCNT(j)]); sum += c; cnt += (c > 0u) ? 1u : 0u; mine = (j == x) ? c : mine; }
        if (sum == G) break;
        __builtin_amdgcn_s_sleep(1);
        if ((++sp & 255u) == 0u) { if (xb_ld(&bar[XB_TMO])) break; if (sp > XB_SPIN_CAP) { atomicAdd(&bar[XB_TMO], 1u); break; } }
    }
    nloc = mine > 0u ? mine : 1u; nx = cnt > 0u ? cnt : 1u;
}
DEV void xcd_barrier(const XcdBarrier& b) {
    asm volatile("s_waitcnt vmcnt(0)" ::: "memory");
    __syncthreads();
    if (threadIdx.x == 0) {
        unsigned* bar = b.bar;
        __builtin_amdgcn_s_waitcnt(0);
        unsigned nloc = b.st[0], nx = b.st[1];
        if (nloc == 0u) { xcd_barrier_complete(bar, b.x, nloc, nx); b.st[0] = nloc; b.st[1] = nx; }
        const unsigned old = xb_add(&bar[XB_XSUB(b.x)], 1u);
        const unsigned gen = old / nloc;
        if (old + 1u == (gen + 1u) * nloc) {
            __builtin_amdgcn_fence(__ATOMIC_RELEASE, "agent");
            asm volatile("s_waitcnt vmcnt(0)" ::: "memory");
            const unsigned og = xb_add(&bar[XB_TOP], 1u);
            const unsigned tg = og / nx;
            if (og + 1u == (tg + 1u) * nx) xb_add(&bar[XB_TOPGEN], 1u);
            else XB_SPIN(xb_ld(&bar[XB_TOPGEN]) == tg, bar);
            __builtin_amdgcn_fence(__ATOMIC_ACQUIRE, "agent");
            xb_add(&bar[XB_XGEN(b.x)], 1u);
            asm volatile("s_waitcnt vmcnt(0)" ::: "memory");
        } else {
            XB_SPIN(xb_ld(&bar[XB_XGEN(b.x)]) == gen, bar);
            __builtin_amdgcn_fence(__ATOMIC_ACQUIRE, "agent");
            asm volatile("s_waitcnt vmcnt(0)" ::: "memory");
        }
    }
    __syncthreads();
}

constexpr int NPHASE = 17;
__global__ void __launch_bounds__(512, 2) fwd_kernel(P p) {
    extern __shared__ __attribute__((aligned(16))) unsigned char lds[];
#define WSB(off) ((bf16_t*)(ws + (off)))
#define WSF(off) ((float*)(ws + (off)))
    volatile LAS unsigned* bst = (volatile LAS unsigned*)(LAS unsigned char*)(lds + LDS_BYTES - 16);
    if (threadIdx.x == 0) { bst[0] = 0u; bst[1] = 0u; bst[2] = 0u; bst[3] = 0u; }
    __syncthreads();
    XcdBarrier gbar; gbar.bar = (unsigned*)(p.ws + O_BAR); gbar.x = 0; gbar.st = bst;
    if (p.coop) gbar = xcd_barrier_post((unsigned*)(p.ws + O_BAR), bst);
    const SsmIn sin_{p.in[5], p.in[6], p.in[7], p.in[8], p.in[9], p.in[10], p.in[12]};
    for (int ph = p.ph_lo; ph < p.ph_hi; ++ph) {
        size_t zoff = 0; asm volatile("" : "+s"(zoff)); unsigned char* ws = p.ws + zoff;
        switch (ph) {
#ifdef ONLY_PHASE
        default: break;
#define CASE(k) case (k): if ((k) != ONLY_PHASE) break; else
#else
#define CASE(k) case (k):
#endif
        CASE(0) {
            const int tid = get_tid();
            ln_pass(p.in[0], p.in[2], p.in[3], WSB(O_B), WSF(O_ST0), nullptr);
            int cur = 0;
            conv_job(p.in[4], 5168, 1024, 5376, WSB(O_WIN_T), 1, lds, cur);
            conv_job(p.in[13], 512, 512, 512, WSB(O_WGLU_T), 0, lds, cur);
            conv_job(p.in[15], 1024, 512, 1024, WSB(O_WSOUT_T), 0, lds, cur);
            conv_job(p.in[17], 256, 2048, 256, WSB(O_W1_T), 0, lds, cur);
            conv_job(p.in[17] + 2048 * 256, 256, 2048, 256, WSB(O_W1_T) + 256 * 2048, 0, lds, cur);
            conv_job(p.in[19], 64, 256, 256, WSB(O_W2_T), 3, lds, cur);
            conv_job(p.in[19] + 256 * 64, 64, 256, 256, WSB(O_W2_T) + 256 * 256, 3, lds, cur);
            conv_job(p.in[20], 1024, 1024, 1024, WSB(O_WNOUT_T), 0, lds, cur);
            conv_job(p.in[21], 1024, 1024, 1024, WSB(O_WOUT_T), 0, lds, cur);
            conv_job(p.in[24], 1024, 1024, 1024, WSB(O_WXQ_T), 0, lds, cur);
            conv_job(p.in[25], 2048, 1024, 2048, WSB(O_WXKV_T), 0, lds, cur);
            conv_job(p.in[26], 1024, 1024, 1024, WSB(O_WXO_T), 0, lds, cur);
            conv_job(p.in[29], 5632, 1024, 5632, WSB(O_WFIN_T), 2, lds, cur);
            conv_job(p.in[30], 1024, 2816, 1024, WSB(O_WFOUT_T), 0, lds, cur);
            for (int it = get_bid(); it < 128; it += gridDim.x) {
                const int z = it >> 6, ec = (it >> 4) & 3, fc = it & 15, e = ec * 64 + (tid & 63), fg = tid >> 6;
                float a = 0.f;
#pragma unroll 8
                for (int f = fc * 128 + fg * 16; f < fc * 128 + fg * 16 + 16; ++f) a += p.in[16][z * 2048 + f] * p.in[17][((size_t)z * 2048 + f) * 256 + e];
                float* red = (float*)lds;
                __syncthreads(); red[tid] = a; __syncthreads();
                if (tid < 64) { float t = 0.f; for (int k = 0; k < 8; ++k) t += red[tid + 64 * k]; WSF(O_BPART)[(z * 16 + fc) * 256 + e] = t; }
                __syncthreads();
            }
            ssm_prep(sin_, WSB(O_BT1), WSB(O_MTW), lds);
        } break;
        CASE(1) {
            if (get_bid() == 0) { for (int e = get_tid(); e < 512; e += NTHR) { float a = p.in[18][e]; for (int fc = 0; fc < 16; ++fc) a += WSF(O_BPART)[((e >> 8) * 16 + fc) * 256 + (e & 255)]; WSF(O_BIAS2)[e] = a; } }
            { const GemmP g{WSB(O_B), WSB(O_WIN_T), 1024, 1024, 256, 42, 16, 1};
              const EpiIn e{WSB(O_UH), WSB(O_QB), WSB(O_KVC), WSB(O_KS), WSB(O_VST), WSB(O_KW), WSB(O_VWT), WSB(O_GM), WSF(O_GN)};
              gemm_run<8>(g, AddrNone{}, e, lds); }
        } break;
        CASE(2) {
            { const GemmP g{WSB(O_KVC), WSB(O_W1_T), 1024, 2048, 1, 2, 32, 128};
              const EpiCmp1 e{WSB(O_HID), WSF(O_BIAS2)};
              gemm_run<4>(g, AddrCmp1{}, e, lds); }
            { const GemmP g{WSB(O_UH), WSB(O_BT1), 640, 512, 8, 2, 8, 32};
              const EpiSsmA e{WSF(O_SS)};
              gemm_run<8>(g, AddrStride{1024ull * 640, 256ull * 512}, e, lds); }
        } break;
        CASE(3) {
            ssm_scan(sin_, WSF(O_SS), WSB(O_UH));
            { const GemmP g{WSB(O_HID), WSB(O_W2_T), 256, 256, 1, 2, 4, 128};
              const EpiCmp2 e{WSB(O_KC), WSB(O_VCT)};
              gemm_run<4>(g, AddrCmp2{}, e, lds); }
        } break;
        CASE(4) {
            const NsaCtx c{WSB(O_QB), WSB(O_KC), WSB(O_VCT), WSB(O_KS), WSB(O_VST), WSB(O_KW), WSB(O_VWT), WSF(O_GN), WSB(O_B)};
            const int G = gridDim.x;
            for (int i = 0;; ++i) {
                const int u = (i & 1) ? i * G + (G - 1 - get_bid()) : i * G + get_bid();
                if (i * G >= 2048) break;
                if (u < 2048) { const int qb = 31 - (u >> 6), bh = u & 63; nsa_unit(c, bh >> 2, bh & 3, qb, lds); }
                __syncthreads();
            }
            { const GemmP g{WSB(O_UH), WSB(O_MTW), 640, 640, 8, 4, 10, 32};
              const EpiSsmB e{WSB(O_UH), p.in[11], WSB(O_GB)};
              gemm_run<8>(g, AddrStride{1024ull * 640, 512ull * 640}, e, lds); }
        } break;
        CASE(5) { const GemmP g{WSB(O_GB), WSB(O_WGLU_T), 512, 512, 256, 4, 8, 1}; const EpiGlu e{WSB(O_GB), p.in[14], WSB(O_YS)}; gemm_run<8>(g, AddrNone{}, e, lds); } break;
        CASE(6) { const GemmP g{WSB(O_YS), WSB(O_WSOUT_T), 512, 512, 256, 8, 8, 1}; const EpiSout e{WSB(O_GM), WSB(O_QB)}; gemm_run<8>(g, AddrNone{}, e, lds); } break;
        CASE(7) { const GemmP g{WSB(O_B), WSB(O_WNOUT_T), 1024, 1024, 256, 8, 16, 1}; const EpiNout e{WSB(O_GM), WSB(O_QB), WSB(O_MIXIN)}; gemm_run<8>(g, AddrNone{}, e, lds); } break;
        CASE(8) { const GemmP g{WSB(O_MIXIN), WSB(O_WOUT_T), 1024, 1024, 256, 8, 16, 1}; const EpiRes e{p.in[0], WSF(O_ST0), p.in[2], p.in[3], WSF(O_V1)}; gemm_run<8>(g, AddrNone{}, e, lds); } break;
        CASE(9) { ln_pass(WSF(O_V1), p.in[22], p.in[23], WSB(O_B), WSF(O_ST1), nullptr);
            for (size_t i = (size_t)get_bid() * NTHR + get_tid(); i < 4096ull * 1024 / 4; i += (size_t)gridDim.x * NTHR) { const f32x4 v = ((const f32x4*)p.in[1])[i]; st_bf4(WSB(O_MEMB) + i * 4, v[0], v[1], v[2], v[3]); }
        } break;
        CASE(10) { { const GemmP g{WSB(O_B), WSB(O_WXQ_T), 1024, 1024, 256, 8, 16, 1}; const EpiScaleBf e{WSB(O_QB), 1024, 0.0625f * LOG2E}; gemm_run<8>(g, AddrNone{}, e, lds); }
            { const GemmP g{WSB(O_MEMB), WSB(O_WXKV_T), 1024, 1024, 32, 16, 16, 1};
              const EpiXkv e{WSB(O_XK), WSB(O_XVT)};
              gemm_run<8>(g, AddrNone{}, e, lds); }
        } break;
        CASE(11) {
            for (int u = get_bid(); u < 1024; u += gridDim.x) { const int qblk = u >> 6, bh = u & 63; xattn_unit(WSB(O_QB), WSB(O_XK), WSB(O_XVT), WSB(O_B), bh >> 2, bh & 3, qblk, lds); }
        } break;
        CASE(12) { const GemmP g{WSB(O_B), WSB(O_WXO_T), 1024, 1024, 256, 8, 16, 1}; const EpiRes e{WSF(O_V1), WSF(O_ST1), p.in[22], p.in[23], WSF(O_V2)}; gemm_run<8>(g, AddrNone{}, e, lds); } break;
        CASE(13) ln_pass(WSF(O_V2), p.in[27], p.in[28], WSB(O_B), WSF(O_ST2), nullptr); break;
        CASE(14) { const GemmP g{WSB(O_B), WSB(O_WFIN_T), 1024, 1024, 256, 44, 16, 1}; const EpiFfnIn e{WSB(O_FB)}; gemm_run<8>(g, AddrNone{}, e, lds); } break;
        CASE(15) { const GemmP g{WSB(O_FB), WSB(O_WFOUT_T), 2816, 2816, 256, 8, 44, 1}; const EpiRes e{WSF(O_V2), WSF(O_ST2), p.in[27], p.in[28], WSF(O_V2)}; gemm_run<8>(g, AddrNone{}, e, lds); } break;
        CASE(16) ln_pass(WSF(O_V2), p.in[31], p.in[32], nullptr, nullptr, p.out); break;
        }
        if (ph + 1 < p.ph_hi) { if (p.coop) xcd_barrier(gbar); if (p.pad == 0x5eed) cg::this_grid().sync(); }
    }
}

#ifndef ONE_LAUNCH
#define ONE_LAUNCH 1
#endif
extern "C" void kernel_launch(void* const* d_in, const int* in_sizes, int n_in, void* d_out, int out_size, void* d_ws, size_t ws_size, hipStream_t stream) {
    static int grid = 0;
    if (grid == 0) {
        if (n_in != 33 || out_size != T_ * 1024 || ws_size < WS_NEED) { fprintf(stderr, "kernel_launch: unexpected shapes (n_in %d out %d ws %zu need %zu)\n", n_in, out_size, ws_size, (size_t)WS_NEED); grid = -1; return; }
        int dev = 0, cus = 0, per_cu = 0;
        hipGetDevice(&dev);
        hipDeviceGetAttribute(&cus, hipDeviceAttributeMultiprocessorCount, dev);
        if (hipFuncSetAttribute((const void*)fwd_kernel, hipFuncAttributeMaxDynamicSharedMemorySize, LDS_BYTES) != hipSuccess) { fprintf(stderr, "kernel_launch: hipFuncSetAttribute failed\n"); grid = -1; return; }
        if (hipOccupancyMaxActiveBlocksPerMultiprocessor(&per_cu, (const void*)fwd_kernel, NTHR, LDS_BYTES) != hipSuccess || per_cu < 1) { fprintf(stderr, "kernel_launch: occupancy query failed (%d)\n", per_cu); per_cu = 1; (void)hipGetLastError(); }
        if (per_cu > 1) per_cu = 1;
        grid = cus * per_cu;
    }
    if (grid < 0) return;
    P p{};
    for (int i = 0; i < 33; ++i) p.in[i] = (const float*)d_in[i];
    p.out = (float*)d_out; p.ws = (unsigned char*)d_ws;
#if ONE_LAUNCH
    p.ph_lo = 0; p.ph_hi = NPHASE; p.coop = 1;
    if (hipMemsetAsync((unsigned char*)d_ws + O_BAR, 0, XCD_BAR_WORDS * 4, stream) != hipSuccess) { fprintf(stderr, "kernel_launch: memset of barrier words failed\n"); return; }
    void* args[] = {&p};
    hipError_t e = hipLaunchCooperativeKernel((const void*)fwd_kernel, dim3(grid), dim3(NTHR), args, LDS_BYTES, stream);
    if (e != hipSuccess) fprintf(stderr, "cooperative launch failed: %s (grid %d)\n", hipGetErrorString(e), grid);
#else
#ifdef STOP_AFTER
    const int nrun = STOP_AFTER + 1;
#else
    const int nrun = NPHASE;
#endif
    for (int ph = 0; ph < nrun; ++ph) {
        p.ph_lo = ph; p.ph_hi = ph + 1; p.coop = 0;
        hipLaunchKernelGGL(fwd_kernel, dim3(grid), dim3(NTHR), LDS_BYTES, stream, p);
    }
#endif
}
```

```cpp
#include <hip/hip_runtime.h>
#include <hip/hip_cooperative_groups.h>
#include <cstdio>
#include <cstdint>
namespace cg = cooperative_groups;

typedef unsigned short bf16_t;
typedef short bf16x8 __attribute__((ext_vector_type(8)));
typedef float f32x4 __attribute__((ext_vector_type(4)));
typedef unsigned u32x4 __attribute__((ext_vector_type(4)));
typedef unsigned u32x2 __attribute__((ext_vector_type(2)));
#define DEV __device__ __forceinline__

constexpr int T_ = 32768, L_ = 2048;
constexpr float LOG2E = 1.4426950408889634f;
constexpr float ALPHA = 1.189207115002721f;
constexpr float LN_EPS = 1e-5f;
constexpr float NEG = -1e30f;
constexpr int LDS_BYTES = 147456;
constexpr int NTHR = 512, NWAVE = 8;
constexpr size_t MiB = 1048576;

constexpr size_t O_WIN_T = 0;
constexpr size_t O_WGLU_T = O_WIN_T + 5376ull * 1024 * 2;
constexpr size_t O_WSOUT_T = O_WGLU_T + 512ull * 512 * 2;
constexpr size_t O_W1_T = O_WSOUT_T + 1024ull * 512 * 2;
constexpr size_t O_W2_T = O_W1_T + 2ull * 256 * 2048 * 2;
constexpr size_t O_WNOUT_T = O_W2_T + 2ull * 256 * 256 * 2;
constexpr size_t O_WOUT_T = O_WNOUT_T + 2 * MiB;
constexpr size_t O_WXQ_T = O_WOUT_T + 2 * MiB;
constexpr size_t O_WXKV_T = O_WXQ_T + 2 * MiB;
constexpr size_t O_WXO_T = O_WXKV_T + 4 * MiB;
constexpr size_t O_WFIN_T = O_WXO_T + 2 * MiB;
constexpr size_t O_WFOUT_T = O_WFIN_T + 5632ull * 1024 * 2;
constexpr size_t O_BT1 = O_WFOUT_T + 1024ull * 2816 * 2;
constexpr size_t O_MTW = O_BT1 + 8 * MiB;
constexpr size_t O_KC = O_MTW + 20 * MiB;
constexpr size_t O_VCT = O_KC + 1 * MiB;
constexpr size_t O_GN = O_VCT + 1 * MiB;
constexpr size_t O_ST0 = O_GN + 6 * MiB;
constexpr size_t O_ST1 = O_ST0 + 262144;
constexpr size_t O_ST2 = O_ST1 + 262144;
constexpr size_t O_BIAS2 = O_ST2 + 262144;
constexpr size_t O_BPART = O_BIAS2 + 4096;
constexpr size_t O_BAR = O_BPART + 32768;
constexpr size_t O_A = 81 * MiB;
constexpr size_t O_KVC = O_A;
constexpr size_t O_KS = O_A + 32 * MiB;
constexpr size_t O_VST = O_A + 48 * MiB;
constexpr size_t O_KW = O_A + 64 * MiB;
constexpr size_t O_VWT = O_A + 80 * MiB;
constexpr size_t O_GB = O_A + 96 * MiB;
constexpr size_t O_MIXIN = O_A;
constexpr size_t O_MEMB = O_A + 64 * MiB;
constexpr size_t O_XK = O_A + 72 * MiB;
constexpr size_t O_XVT = O_A + 80 * MiB;
constexpr size_t O_V2 = O_A;
constexpr size_t O_B = O_A + 128 * MiB;
constexpr size_t O_SS = O_B;
constexpr size_t O_HID = O_B + 16 * MiB;
constexpr size_t O_Y = O_B + 64 * MiB;
constexpr size_t O_GM = O_Y;
constexpr size_t O_V1 = O_Y;
constexpr size_t O_X = O_Y + 128 * MiB;
constexpr size_t O_QB = O_X;
constexpr size_t O_UH = O_X + 64 * MiB;
constexpr size_t O_YS = O_X + 64 * MiB;
constexpr size_t O_FB = O_Y;
constexpr size_t WS_NEED = O_X + 104 * MiB;
static_assert(O_BAR + 16384 <= O_A, "F region overflow");

struct P {
    const float* in[33];
    float* out;
    unsigned char* ws;
    int ph_lo, ph_hi, coop, pad;
};

DEV int get_tid() { int t = threadIdx.x; asm volatile("" : "+v"(t)); return t; }
DEV int get_bid() { int t = blockIdx.x; asm volatile("" : "+s"(t)); return t; }
typedef __bf16 bf2_t __attribute__((ext_vector_type(2)));
typedef float f32x2_t __attribute__((ext_vector_type(2)));
DEV unsigned cvt_pk_bf16(float lo, float hi) { const f32x2_t f = {lo, hi}; const bf2_t r = __builtin_convertvector(f, bf2_t); return __builtin_bit_cast(unsigned, r); }
DEV bf16_t f2bf(float v) { return (bf16_t)(cvt_pk_bf16(v, 0.f) & 0xffffu); }
DEV float bf2f(unsigned v) { return __uint_as_float(v << 16); }
DEV float bflo(unsigned w) { return __uint_as_float(w << 16); }
DEV float bfhi(unsigned w) { return __uint_as_float(w & 0xffff0000u); }
DEV float fexp2(float x) { return __builtin_amdgcn_exp2f(x); }
DEV float frcp(float x) { return __builtin_amdgcn_rcpf(x); }
DEV float sigmoidf_(float x) { return frcp(1.f + fexp2(-x * LOG2E)); }
DEV float gelu_tanh(float x) { const float u = 0.7978845608028654f * (x + 0.044715f * x * x * x); return x * frcp(1.f + fexp2(-2.f * LOG2E * u)); }
DEV void st_bf4(bf16_t* p, float a, float b, float c, float d) { u32x2 w; w.x = cvt_pk_bf16(a, b); w.y = cvt_pk_bf16(c, d); *(u32x2*)p = w; }
DEV f32x4 ld_bf4(const bf16_t* p) { const u32x2 w = *(const u32x2*)p; return (f32x4){bflo(w.x), bfhi(w.x), bflo(w.y), bfhi(w.y)}; }
DEV float wred_sum(float v) {
#pragma unroll
    for (int o = 32; o >= 1; o >>= 1) v += __shfl_xor(v, o);
    return v;
}

DEV void ln_pass(const float* src, const float* g, const float* b, bf16_t* dstb, float* stats, float* dstf) {
    const int lane = get_tid() & 63, wid = get_tid() >> 6;
    const int nw = gridDim.x * NWAVE;
    for (int row = get_bid() * NWAVE + wid; row < T_; row += nw) {
        const f32x4* p = (const f32x4*)(src + (size_t)row * 1024);
        f32x4 v[4];
#pragma unroll
        for (int i = 0; i < 4; ++i) v[i] = p[lane + 64 * i];
        float s = 0.f;
#pragma unroll
        for (int i = 0; i < 4; ++i) s += (v[i][0] + v[i][1]) + (v[i][2] + v[i][3]);
        s = wred_sum(s);
        const float mu = s * (1.f / 1024.f);
        float q = 0.f;
#pragma unroll
        for (int i = 0; i < 4; ++i) { const f32x4 d = v[i] - mu; q += (d[0] * d[0] + d[1] * d[1]) + (d[2] * d[2] + d[3] * d[3]); }
        q = wred_sum(q);
        const float rstd = 1.0f / sqrtf(q * (1.f / 1024.f) + LN_EPS);
        if (stats && lane == 0) { stats[row * 2] = mu; stats[row * 2 + 1] = rstd; }
#pragma unroll
        for (int i = 0; i < 4; ++i) {
            const int col = (lane + 64 * i) * 4;
            const f32x4 gg = *(const f32x4*)(g + col), bb = *(const f32x4*)(b + col);
            const f32x4 y = (v[i] - mu) * rstd * gg + bb;
            if (dstb) st_bf4(dstb + (size_t)row * 1024 + col, y[0], y[1], y[2], y[3]);
            if (dstf) *(f32x4*)(dstf + (size_t)row * 1024 + col) = y;
        }
    }
}

DEV int colmap(int mode, int n) {
    if (mode == 0) return n;
    if (mode == 1) return n < 3072 ? n : (n < 5120 ? n + 48 : (n < 5168 ? n - 5120 + 3072 : -1));
    if (mode == 2) { const int blk = n >> 5, r = n & 31; return r < 16 ? blk * 16 + r : 2816 + blk * 16 + (r - 16); }
    return n < 64 ? n : -1;
}
DEV void conv_job(const float* src, int ldsrc, int K, int N, bf16_t* dst, int mode, unsigned char* lds, int& cursor) {
    const int tid = get_tid(), lane = tid & 63, gw = get_bid() * NWAVE + (tid >> 6), nw = gridDim.x * NWAVE;
    const int kb = K / 32, nitem = (N / 64) * kb;
    for (int t = (gw + nw - (cursor % nw)) % nw; t < nitem; t += nw) {
        const int k0 = (t % kb) * 32, n = (t / kb) * 64 + lane;
        const int sc = colmap(mode, n);
        float e[32];
#pragma unroll
        for (int r = 0; r < 32; ++r) e[r] = sc >= 0 ? src[(size_t)(k0 + r) * ldsrc + sc] : 0.f;
#pragma unroll
        for (int q = 0; q < 4; ++q) { u32x4 w; w.x = cvt_pk_bf16(e[8 * q], e[8 * q + 1]); w.y = cvt_pk_bf16(e[8 * q + 2], e[8 * q + 3]); w.z = cvt_pk_bf16(e[8 * q + 4], e[8 * q + 5]); w.w = cvt_pk_bf16(e[8 * q + 6], e[8 * q + 7]);
            *(u32x4*)(dst + (size_t)n * K + k0 + 8 * q) = w; }
    }
    cursor += nitem;
}

struct SsmIn { const float *a_re, *a_im, *b_re, *b_im, *c_re, *c_im, *log_dt; };
DEV void lb_pow(const SsmIn& s, int g, int n, float p, float& re, float& im) {
    const float lre = fminf(s.a_re[g * 64 + n], -1e-4f), lim = s.a_im[g * 64 + n], dt = expf(s.log_dt[g]);
    const float mag = expf(lre * dt * p); float sn, cs; sincosf(lim * dt * p, &sn, &cs);
    re = mag * cs; im = mag * sn;
}
DEV void bbar(const SsmIn& s, int g, int n, int c, float& re, float& im) {
    const float lre = fminf(s.a_re[g * 64 + n], -1e-4f), lim = s.a_im[g * 64 + n], dt = expf(s.log_dt[g]);
    const float mag = expf(lre * dt); float sn, cs; sincosf(lim * dt, &sn, &cs);
    const float sh = sinf(0.5f * lim * dt);
    const float nr = expm1f(lre * dt) - mag * 2.f * sh * sh, lbi = mag * sn;
    const float den = lre * lre + lim * lim;
    const float fre = (nr * lre + lbi * lim) / den, fim = (lbi * lre - nr * lim) / den;
    const float br = s.b_re[(g * 64 + n) * 16 + c], bi = s.b_im[(g * 64 + n) * 16 + c];
    re = fre * br - fim * bi; im = fre * bi + fim * br;
}
DEV void ssm_prep(const SsmIn& s, bf16_t* BT1, bf16_t* MTW, unsigned char* lds) {
    const int tid = get_tid();
    float* pw = (float*)lds;
    float* bb = pw + 33 * 128;
    float* cc = bb + 2048;
    float* fn = cc + 2048;
    float* km = fn + 128;
    for (int job = get_bid(); job < 512; job += gridDim.x) {
        const int g = job >> 4, pt = job & 15;
        __syncthreads();
        for (int e = tid; e < 33 * 64; e += NTHR) { float pr, pi; lb_pow(s, g, e & 63, (float)(e >> 6), pr, pi); pw[e * 2] = pr; pw[e * 2 + 1] = pi; }
        if (tid < 64) {
            const int n = tid;
            const float lre = fminf(s.a_re[g * 64 + n], -1e-4f), lim = s.a_im[g * 64 + n], dt = expf(s.log_dt[g]);
            const float mag = expf(lre * dt); float sn, cs; sincosf(lim * dt, &sn, &cs);
            const float sh = sinf(0.5f * lim * dt);
            const float nr = expm1f(lre * dt) - mag * 2.f * sh * sh, lbi = mag * sn;
            const float den = lre * lre + lim * lim;
            fn[n * 2] = (nr * lre + lbi * lim) / den; fn[n * 2 + 1] = (lbi * lre - nr * lim) / den;
        }
        for (int e = tid; e < 1024; e += NTHR) { const int c = e >> 6, n = e & 63; cc[e * 2] = s.c_re[(g * 16 + c) * 64 + n]; cc[e * 2 + 1] = s.c_im[(g * 16 + c) * 64 + n]; }
        __syncthreads();
        for (int e = tid; e < 1024; e += NTHR) { const int n = e >> 4; const float fre = fn[n * 2], fim = fn[n * 2 + 1];
            const float br = s.b_re[(g * 64) * 16 + e], bi = s.b_im[(g * 64) * 16 + e];
            bb[e * 2] = fre * br - fim * bi; bb[e * 2 + 1] = fre * bi + fim * br; }
        __syncthreads();
        for (int i = tid; i < 4096; i += NTHR) { const int e = pt * 4096 + i, nn = e >> 9, kk = e & 511, n = nn & 63, sidx = kk >> 4, c = kk & 15;
            const float pr = pw[((31 - sidx) * 64 + n) * 2], pi = pw[((31 - sidx) * 64 + n) * 2 + 1], br = bb[(n * 16 + c) * 2], bi = bb[(n * 16 + c) * 2 + 1];
            BT1[(size_t)g * 131072 + e] = f2bf((nn >> 6) ? (pr * bi + pi * br) : (pr * br - pi * bi)); }
        for (int i = tid; i < 4096; i += NTHR) BT1[(size_t)g * 131072 + 65536 + pt * 4096 + i] = 0;
        for (int i = tid; i < 4096; i += NTHR) { const int e = pt * 4096 + i, nn = e & 127, r = e >> 7, n = nn & 63, tau = r >> 4, c = r & 15;
            const float pr = pw[((tau + 1) * 64 + n) * 2], pi = pw[((tau + 1) * 64 + n) * 2 + 1], cr = cc[(c * 64 + n) * 2], ci = cc[(c * 64 + n) * 2 + 1];
            MTW[((size_t)g * 512 + r) * 640 + 512 + nn] = f2bf((nn >> 6) ? -(cr * pi + ci * pr) : (cr * pr - ci * pi)); }
        for (int i = tid; i < 32 * 512; i += NTHR) { const int r = pt * 32 + (i >> 9), kk = i & 511; if ((kk >> 4) > (r >> 4)) MTW[((size_t)g * 512 + r) * 640 + kk] = 0; }
        if (tid < 256) for (int dd = 0; dd < 2; ++dd) { const int d = 2 * pt + dd, c = tid >> 4, c2 = tid & 15; float acc = 0.f;
            for (int n = 0; n < 64; ++n) { const float cr = cc[(c * 64 + n) * 2], ci = cc[(c * 64 + n) * 2 + 1], pr = pw[(d * 64 + n) * 2], pi = pw[(d * 64 + n) * 2 + 1];
                const float xr = cr * pr - ci * pi, xi = cr * pi + ci * pr; acc += xr * bb[(n * 16 + c2) * 2] - xi * bb[(n * 16 + c2) * 2 + 1]; }
            km[dd * 256 + tid] = acc; }
        __syncthreads();
        if (tid < 256) for (int dd = 0; dd < 2; ++dd) { const int d = 2 * pt + dd; const bf16_t v = f2bf(km[dd * 256 + tid]); const int c = tid >> 4, c2 = tid & 15;
            for (int sidx = 0; sidx + d < 32; ++sidx) MTW[((size_t)g * 512 + (sidx + d) * 16 + c) * 640 + sidx * 16 + c2] = v; }
    }
    __syncthreads();
}
DEV void ssm_scan(const SsmIn& s, const float* SS, bf16_t* UH) {
    for (int idx = get_bid() * NTHR + get_tid(); idx < 32768; idx += gridDim.x * NTHR) {
        const int n = idx & 63, b = (idx >> 6) & 15, g = idx >> 10;
        float ar, ai; lb_pow(s, g, n, 32.f, ar, ai);
        float hr = 0.f, hi = 0.f;
        const size_t row0 = (size_t)(g * 16 + b) * 64;
#pragma unroll 8
        for (int k = 0; k < 64; ++k) {
            UH[(row0 + k) * 640 + 512 + n] = f2bf(hr); UH[(row0 + k) * 640 + 576 + n] = f2bf(hi);
            const float sr = SS[(row0 + k) * 128 + n], si = SS[(row0 + k) * 128 + 64 + n];
            const float nr = ar * hr - ai * hi + sr, ni = ar * hi + ai * hr + si;
            hr = nr; hi = ni;
        }
    }
}

struct GemmP { const bf16_t* A; const bf16_t* Bt; int lda, ldb, MT, NT, KT, nbatch; };
#define GLAS __attribute__((address_space(3)))
template <int WM, class Addr, class Epi>
DEV void gemm_run(const GemmP p, const Addr ad, const Epi epi, unsigned char* lds_, int rshift = 0) {
    constexpr int TM = 32 * WM, ABYTES = TM * 128, STAGE = ABYTES + 32768, NLA = WM / 2;
    GLAS unsigned char* lds = (GLAS unsigned char*)lds_;
    const int tid = get_tid(), lane = tid & 63, wid = __builtin_amdgcn_readfirstlane(tid >> 6), wr = wid >> 2, wc = wid & 3, l15 = lane & 15, quad = lane >> 4;
    int nx, x, jx, stride;
    { volatile GLAS unsigned* cw = (volatile GLAS unsigned*)(lds + LDS_BYTES - 16);
      const int nloc = (int)cw[0], nxc = (int)cw[1], rank = (int)cw[2], xcc = (int)cw[3];
      if (nloc > 0 && xcc < nxc && rank < nloc) { nx = nxc; x = xcc; jx = (rank + rshift) % nloc; stride = nloc; }
      else { nx = 1; x = 0; jx = get_bid(); stride = gridDim.x; } }
    nx = __builtin_amdgcn_readfirstlane(nx); x = __builtin_amdgcn_readfirstlane(x); jx = __builtin_amdgcn_readfirstlane(jx); stride = __builtin_amdgcn_readfirstlane(stride);
    const int MTT = p.MT / (WM / 4), NTT = p.NT / 2;
    const int SRtot = (p.nbatch * MTT) / 8, per = 8 * NTT, KT = p.KT;
    if (SRtot < nx) { nx = 1; x = 0; jx = get_bid(); stride = gridDim.x; }
    int offA[NLA], offB[4];
#pragma unroll
    for (int i = 0; i < NLA; ++i) { const int row = (wid + 8 * i) * 8 + (lane >> 3), c = (lane & 7) ^ ((row >> 1) & 7); offA[i] = row * p.lda + c * 8; }
#pragma unroll
    for (int i = 0; i < 4; ++i) { const int row = (wid + 8 * i) * 8 + (lane >> 3), c = (lane & 7) ^ ((row >> 1) & 7); offB[i] = row * p.ldb + c * 8; }
    const int sw = (l15 >> 1) & 7;
    int aoff[2], boff[2];
#pragma unroll
    for (int ks = 0; ks < 2; ++ks) { const int c = ((ks * 4 + quad) ^ sw) * 16; aoff[ks] = (wr * (WM * 16) + l15) * 128 + c; boff[ks] = ABYTES + (wc * 64 + l15) * 128 + c; }
    int ls = jx, lkt = 0; const bf16_t* lA = nullptr; const bf16_t* lB = nullptr; bool lvalid;
#define GEMM_DECODE_L() do { const int q_ = ls / per, rem_ = ls % per, sr_ = x + nx * q_; lvalid = sr_ < SRtot; if (lvalid) { const int R_ = sr_ * 8 + (rem_ & 7), b_ = R_ / MTT; \
        lA = p.A + ad.a_off(b_) + (size_t)((R_ % MTT) * TM) * p.lda; lB = p.Bt + ad.b_off(b_) + (size_t)((rem_ >> 3) * 256) * p.ldb; } } while (0)
#define GEMM_ISSUE(stg) do { _Pragma("unroll") for (int i_ = 0; i_ < NLA; ++i_) \
        __builtin_amdgcn_global_load_lds((const unsigned*)(lA + offA[i_] + lkt * 64), (GLAS unsigned*)(lds + (stg) * STAGE + (wid + 8 * i_) * 1024), 16, 0, 0); \
        _Pragma("unroll") for (int i_ = 0; i_ < 4; ++i_) \
        __builtin_amdgcn_global_load_lds((const unsigned*)(lB + offB[i_] + lkt * 64), (GLAS unsigned*)(lds + (stg) * STAGE + ABYTES + (wid + 8 * i_) * 1024), 16, 0, 0); \
        ++issued; if (++lkt == KT) { lkt = 0; ls += stride; GEMM_DECODE_L(); } } while (0)
    GEMM_DECODE_L();
    int issued = 0;
    asm volatile("s_waitcnt vmcnt(0)" ::: "memory");
    __syncthreads();
    if (lvalid) GEMM_ISSUE(0);
    if (lvalid) GEMM_ISSUE(1);
    f32x4 acc[WM][4];
#pragma unroll
    for (int i = 0; i < WM; ++i)
#pragma unroll
        for (int j = 0; j < 4; ++j) acc[i][j] = (f32x4){0.f, 0.f, 0.f, 0.f};
    int cs = jx, ckt = 0; bool drain = false;
#pragma unroll 1
    for (int it = 0; it < issued; ++it) {
        if (drain || issued - it - 1 == 0) asm volatile("s_waitcnt vmcnt(0)" ::: "memory");
        else asm volatile("s_waitcnt vmcnt(%0)" :: "n"(NLA + 4) : "memory");
        drain = false;
        __builtin_amdgcn_s_barrier();
        asm volatile("" ::: "memory");
        const GLAS unsigned char* st = lds + (it & 1) * STAGE;
        bf16x8 af[WM], bfr[4];
#pragma unroll
        for (int i = 0; i < 4; ++i) bfr[i] = *(const GLAS bf16x8*)(st + boff[0] + i * 2048);
#pragma unroll
        for (int i = 0; i < WM; ++i) af[i] = *(const GLAS bf16x8*)(st + aoff[0] + i * 2048);
#pragma unroll
        for (int mi = 0; mi < WM; ++mi)
#pragma unroll
            for (int ni = 0; ni < 4; ++ni) acc[mi][ni] = __builtin_amdgcn_mfma_f32_16x16x32_bf16(bfr[ni], af[mi], acc[mi][ni], 0, 0, 0);
#pragma unroll
        for (int i = 0; i < 4; ++i) bfr[i] = *(const GLAS bf16x8*)(st + boff[1] + i * 2048);
#pragma unroll
        for (int i = 0; i < WM; ++i) af[i] = *(const GLAS bf16x8*)(st + aoff[1] + i * 2048);
        asm volatile("s_waitcnt lgkmcnt(0)" ::: "memory");
        __builtin_amdgcn_s_barrier();
        asm volatile("" ::: "memory");
        if (lvalid) GEMM_ISSUE(it & 1);
        asm volatile("" ::: "memory");
#pragma unroll
        for (int mi = 0; mi < WM; ++mi)
#pragma unroll
            for (int ni = 0; ni < 4; ++ni) acc[mi][ni] = __builtin_amdgcn_mfma_f32_16x16x32_bf16(bfr[ni], af[mi], acc[mi][ni], 0, 0, 0);
        if (++ckt == KT) {
            const int q_ = cs / per, rem_ = cs % per, R_ = (x + nx * q_) * 8 + (rem_ & 7);
#pragma unroll
            for (int h = 0; h < WM / 4; ++h)
                epi(reinterpret_cast<const f32x4 (&)[4][4]>(acc[4 * h]), R_ / MTT, (R_ % MTT) * TM + wr * (WM * 16) + h * 64, (rem_ >> 3) * 256 + wc * 64, l15, quad);
#pragma unroll
            for (int i = 0; i < WM; ++i)
#pragma unroll
                for (int j = 0; j < 4; ++j) acc[i][j] = (f32x4){0.f, 0.f, 0.f, 0.f};
            ckt = 0; cs += stride; drain = true;
        }
    }
    asm volatile("s_waitcnt vmcnt(0) lgkmcnt(0)" ::: "memory");
    __syncthreads();
#undef GEMM_DECODE_L
#undef GEMM_ISSUE
}
struct AddrNone { DEV size_t a_off(int) const { return 0; } DEV size_t b_off(int) const { return 0; } };
struct AddrStride { size_t as, bs; DEV size_t a_off(int b) const { return as * b; } DEV size_t b_off(int b) const { return bs * b; } };
struct AddrCmp1 { DEV size_t a_off(int b) const { return (size_t)b * 2048 * 64; } DEV size_t b_off(int b) const { return (size_t)((b >> 2) & 1) * 256 * 2048; } };
struct AddrCmp2 { DEV size_t a_off(int b) const { return (size_t)b * 128 * 256; } DEV size_t b_off(int b) const { return (size_t)((b >> 2) & 1) * 256 * 256; } };

#define EPI_ARGS const f32x4 (&acc)[4][4], int batch, int m0, int n0, int l15, int quad
struct EpiIn {
    bf16_t *UH, *Qb, *KVC, *KS, *VST, *KW, *VWT, *GM; float* GN;
    DEV void operator()(EPI_ARGS) const {
#pragma unroll
        for (int mi = 0; mi < 4; ++mi) {
            const int t = m0 + mi * 16 + l15, b = t >> 11, tt = t & 2047;
#pragma unroll
            for (int ni = 0; ni < 4; ++ni) {
                const f32x4 v = acc[mi][ni];
                const int c = n0 + ni * 16 + quad * 4;
                if (n0 < 512) {
                    const int g = c >> 4;
                    st_bf4(UH + ((size_t)((g * 16 + b) * 64 + (tt >> 5))) * 640 + (tt & 31) * 16 + (c & 15), v[0], v[1], v[2], v[3]);
                } else if (n0 < 1536) {
                    const float sc = 0.125f * LOG2E;
                    st_bf4(Qb + (size_t)t * 1024 + (c - 512), v[0] * sc, v[1] * sc, v[2] * sc, v[3] * sc);
                } else if (n0 < 2048) {
                    const int cc = c - 1536, z = cc >> 8, h = (cc >> 6) & 3, d = cc & 63;
                    st_bf4(KVC + ((size_t)(((b * 2 + z) * 4 + h) * 2048 + tt)) * 64 + d, v[0], v[1], v[2], v[3]);
                } else if (n0 < 3072) {
                    const int cc = (c - 2048) & 511, isw = (c - 2048) >> 9, h = (cc >> 6) & 3, d = cc & 63;
                    if (cc < 256) st_bf4((isw ? KW : KS) + ((size_t)((b * 4 + h) * 2048 + tt)) * 64 + d, v[0], v[1], v[2], v[3]);
                    else { bf16_t* o = (isw ? VWT : VST) + ((size_t)((b * 4 + h) * 64 + d)) * 2048 + tt;
#pragma unroll
                        for (int i = 0; i < 4; ++i) o[(size_t)i * 2048] = f2bf(v[i]); }
                } else if (n0 < 5120) {
                    st_bf4(GM + (size_t)t * 2048 + (c - 3072), sigmoidf_(v[0]), sigmoidf_(v[1]), sigmoidf_(v[2]), sigmoidf_(v[3]));
                } else {
                    const int cc = c - 5120;
                    if (cc < 48) *(f32x4*)(GN + (size_t)t * 48 + cc) = (f32x4){sigmoidf_(v[0]), sigmoidf_(v[1]), sigmoidf_(v[2]), sigmoidf_(v[3])};
                }
            }
        }
    }
};
struct EpiXkv {
    bf16_t *XK, *XVT;
    DEV void operator()(EPI_ARGS) const {
#pragma unroll
        for (int mi = 0; mi < 4; ++mi) {
            const int r = m0 + mi * 16 + l15, b = r >> 8, m = r & 255;
#pragma unroll
            for (int ni = 0; ni < 4; ++ni) {
                const f32x4 v = acc[mi][ni]; const int c = n0 + ni * 16 + quad * 4;
                if (n0 < 1024) st_bf4(XK + (size_t)r * 1024 + c, v[0], v[1], v[2], v[3]);
                else { const int cc = c - 1024, h = cc >> 8, d = cc & 255; bf16_t* o = XVT + ((size_t)((b * 4 + h) * 256 + d)) * 256 + m;
#pragma unroll
                    for (int i = 0; i < 4; ++i) o[i * 256] = f2bf(v[i]); }
            }
        }
    }
};
struct EpiSsmA { float* SS;
    DEV void operator()(EPI_ARGS) const {
        if (n0 >= 128) return;
#pragma unroll
        for (int mi = 0; mi < 4; ++mi)
#pragma unroll
            for (int ni = 0; ni < 4; ++ni) *(f32x4*)(SS + ((size_t)batch * 1024 + m0 + mi * 16 + l15) * 128 + n0 + ni * 16 + quad * 4) = acc[mi][ni];
    }
};
struct EpiCmp1 { bf16_t* HID; const float* bias2;
    DEV void operator()(EPI_ARGS) const {
        const int z = (batch >> 2) & 1;
#pragma unroll
        for (int ni = 0; ni < 4; ++ni) {
            const int c = n0 + ni * 16 + quad * 4; const f32x4 bv = *(const f32x4*)(bias2 + z * 256 + c);
#pragma unroll
            for (int mi = 0; mi < 4; ++mi) { const f32x4 v = acc[mi][ni] + bv;
                st_bf4(HID + ((size_t)batch * 128 + m0 + mi * 16 + l15) * 256 + c, gelu_tanh(v[0]), gelu_tanh(v[1]), gelu_tanh(v[2]), gelu_tanh(v[3])); }
        }
    }
};
struct EpiCmp2 { bf16_t *KC, *VCT;
    DEV void operator()(EPI_ARGS) const {
        if (n0 >= 64) return;
        const int z = (batch >> 2) & 1, bh = (batch >> 3) * 4 + (batch & 3);
#pragma unroll
        for (int mi = 0; mi < 4; ++mi) { const int r = m0 + mi * 16 + l15;
#pragma unroll
            for (int ni = 0; ni < 4; ++ni) { const f32x4 v = acc[mi][ni]; const int c = n0 + ni * 16 + quad * 4;
                if (z == 0) st_bf4(KC + ((size_t)bh * 128 + r) * 64 + c, v[0], v[1], v[2], v[3]);
                else {
#pragma unroll
                    for (int i = 0; i < 4; ++i) VCT[((size_t)bh * 64 + c + i) * 128 + r] = f2bf(v[i]); } } }
    }
};
struct EpiSsmB { const bf16_t* UH; const float* dskip; bf16_t* GB;
    DEV void operator()(EPI_ARGS) const {
#pragma unroll
        for (int mi = 0; mi < 4; ++mi) { const int r = m0 + mi * 16 + l15, b = r >> 6, k = r & 63;
#pragma unroll
            for (int ni = 0; ni < 4; ++ni) { const int col = n0 + ni * 16 + quad * 4, tau = col >> 4, c = col & 15;
                const f32x4 u = ld_bf4(UH + ((size_t)batch * 1024 + r) * 640 + col);
                const f32x4 dv = *(const f32x4*)(dskip + batch * 16 + c);
                const f32x4 y = acc[mi][ni] + dv * u;
                st_bf4(GB + ((size_t)(b * 2048 + k * 32 + tau)) * 512 + batch * 16 + c, gelu_tanh(y[0]), gelu_tanh(y[1]), gelu_tanh(y[2]), gelu_tanh(y[3])); } }
    }
};
struct EpiGlu { const bf16_t* GB; const float* bglu; bf16_t* YS;
    DEV void operator()(EPI_ARGS) const {
#pragma unroll
        for (int ni = 0; ni < 4; ++ni) { const int c = n0 + ni * 16 + quad * 4; const f32x4 bv = *(const f32x4*)(bglu + c);
#pragma unroll
            for (int mi = 0; mi < 4; ++mi) { const size_t o = (size_t)(m0 + mi * 16 + l15) * 512 + c; const f32x4 g = ld_bf4(GB + o); const f32x4 v = acc[mi][ni] + bv;
                st_bf4(YS + o, g[0] * sigmoidf_(v[0]), g[1] * sigmoidf_(v[1]), g[2] * sigmoidf_(v[2]), g[3] * sigmoidf_(v[3])); } }
    }
};
struct EpiSout { const bf16_t* GM; bf16_t* P1;
    DEV void operator()(EPI_ARGS) const {
#pragma unroll
        for (int mi = 0; mi < 4; ++mi) { const size_t t = m0 + mi * 16 + l15;
#pragma unroll
            for (int ni = 0; ni < 4; ++ni) { const int c = n0 + ni * 16 + quad * 4; const f32x4 g = ld_bf4(GM + t * 2048 + c); const f32x4 v = acc[mi][ni] * g;
                st_bf4(P1 + t * 1024 + c, v[0], v[1], v[2], v[3]); } }
    }
};
struct EpiNout { const bf16_t* GM; const bf16_t* P1; bf16_t* MIX;
    DEV void operator()(EPI_ARGS) const {
#pragma unroll
        for (int mi = 0; mi < 4; ++mi) { const size_t t = m0 + mi * 16 + l15;
#pragma unroll
            for (int ni = 0; ni < 4; ++ni) { const int c = n0 + ni * 16 + quad * 4; const f32x4 g = ld_bf4(GM + t * 2048 + 1024 + c); const f32x4 v = acc[mi][ni] * g + ld_bf4(P1 + t * 1024 + c);
                st_bf4(MIX + t * 1024 + c, v[0], v[1], v[2], v[3]); } }
    }
};
struct EpiRes { const float* src; const float* stats; const float* g; const float* b; float* dst;
    DEV void operator()(EPI_ARGS) const {
#pragma unroll
        for (int mi = 0; mi < 4; ++mi) { const size_t t = m0 + mi * 16 + l15; const float mu = stats[t * 2], rs = stats[t * 2 + 1];
#pragma unroll
            for (int ni = 0; ni < 4; ++ni) { const int c = n0 + ni * 16 + quad * 4;
                const f32x4 xv = *(const f32x4*)(src + t * 1024 + c), gg = *(const f32x4*)(g + c), bb = *(const f32x4*)(b + c);
                *(f32x4*)(dst + t * 1024 + c) = ((xv - mu) * rs * gg + bb) * ALPHA + acc[mi][ni]; } }
    }
};
struct EpiScaleBf { bf16_t* O; int ldc; float sc;
    DEV void operator()(EPI_ARGS) const {
#pragma unroll
        for (int mi = 0; mi < 4; ++mi)
#pragma unroll
            for (int ni = 0; ni < 4; ++ni) { const f32x4 v = acc[mi][ni] * sc; st_bf4(O + (size_t)(m0 + mi * 16 + l15) * ldc + n0 + ni * 16 + quad * 4, v[0], v[1], v[2], v[3]); }
    }
};
struct EpiFfnIn { bf16_t* FB;
    DEV void operator()(EPI_ARGS) const {
#pragma unroll
        for (int mi = 0; mi < 4; ++mi) { const size_t t = m0 + mi * 16 + l15;
#pragma unroll
            for (int pp = 0; pp < 2; ++pp) { const f32x4 ga = acc[mi][2 * pp], up = acc[mi][2 * pp + 1]; const int j = (n0 + pp * 32) / 2 + quad * 4;
                st_bf4(FB + t * 2816 + j, ga[0] * sigmoidf_(ga[0]) * up[0], ga[1] * sigmoidf_(ga[1]) * up[1], ga[2] * sigmoidf_(ga[2]) * up[2], ga[3] * sigmoidf_(ga[3]) * up[3]); } }
    }
};

DEV float qmax(float v) { auto a = __builtin_amdgcn_permlane16_swap(__float_as_uint(v), __float_as_uint(v), false, false); v = fmaxf(__uint_as_float(a[0]), __uint_as_float(a[1]));
    auto b = __builtin_amdgcn_permlane32_swap(__float_as_uint(v), __float_as_uint(v), false, false); return fmaxf(__uint_as_float(b[0]), __uint_as_float(b[1])); }
DEV float qsum(float v) { auto a = __builtin_amdgcn_permlane16_swap(__float_as_uint(v), __float_as_uint(v), false, false); v = __uint_as_float(a[0]) + __uint_as_float(a[1]);
    auto b = __builtin_amdgcn_permlane32_swap(__float_as_uint(v), __float_as_uint(v), false, false); return __uint_as_float(b[0]) + __uint_as_float(b[1]); }
DEV bf16x8 pack_p(const f32x4& a, const f32x4& b) { u32x4 w; w.x = cvt_pk_bf16(a[0], a[1]); w.y = cvt_pk_bf16(a[2], a[3]); w.z = cvt_pk_bf16(b[0], b[1]); w.w = cvt_pk_bf16(b[2], b[3]); return __builtin_bit_cast(bf16x8, w); }
DEV void st_vt(unsigned char* rowbase, int e, const u32x4& v) {
    const int grp = e >> 2, ep = e & 3, a = ep >> 1, qp = (ep & 1) * 2;
    unsigned char* o = rowbase + grp * 64 + (qp * 8 + a * 4) * 2;
    *(u32x2*)o = (u32x2){v.x, v.y}; *(u32x2*)(o + 16) = (u32x2){v.z, v.w};
}

struct NsaCtx { const bf16_t *Qb, *KC, *VCT, *KS, *VST, *KW, *VWT; const float* GN; bf16_t* ON; };
constexpr float MINIT = -1e20f;

template <int MODE, bool BOUND>
DEV void nsa_tile(const unsigned char* Kl, const unsigned char* Vl, const bf16x8 (&Qf)[2][2], f32x4 (&O)[2][4], float (&m)[2], float (&l)[2],
                  const float (&slope)[2], int dist0, bool sel, int l15, int quad) {
    const float d0f = (float)dist0;
#pragma unroll
    for (int g = 0; g < 2; ++g) {
        f32x4 S[4];
#pragma unroll
        for (int kt = 0; kt < 4; ++kt) { S[kt] = (f32x4){0.f, 0.f, 0.f, 0.f};
#pragma unroll
            for (int ks = 0; ks < 2; ++ks) { const bf16x8 kf = *(const bf16x8*)(Kl + (kt * 16 + l15) * 144 + ks * 64 + quad * 16); S[kt] = __builtin_amdgcn_mfma_f32_16x16x32_bf16(kf, Qf[g][ks], S[kt], 0, 0, 0); } }
        float base = -slope[g] * d0f;
        if (MODE == 0) base = sel ? base : NEG;
        typedef float f2 __attribute__((ext_vector_type(2)));
        const f2 sl_lo = {0.f, slope[g]}, sl_hi = {2.f * slope[g], 3.f * slope[g]};
        float tmax = NEG;
        f2 Slo[4], Shi[4];
#pragma unroll
        for (int kt = 0; kt < 4; ++kt) {
            const float bk = fmaf(slope[g], (float)(16 * kt), base);
            f2 lo = (f2){S[kt][0], S[kt][1]} + (sl_lo + bk), hi = (f2){S[kt][2], S[kt][3]} + (sl_hi + bk);
            if (BOUND) {
#pragma unroll
                for (int i = 0; i < 4; ++i) { const int cc = 16 * kt + i; bool v = cc <= dist0; if (MODE == 1) v = v && (cc > dist0 - 512);
                    if (i < 2) lo[i] = v ? lo[i] : NEG; else hi[i - 2] = v ? hi[i - 2] : NEG; }
            }
            Slo[kt] = lo; Shi[kt] = hi;
            tmax = fmaxf(fmaxf(tmax, lo[0]), lo[1]); tmax = fmaxf(fmaxf(tmax, hi[0]), hi[1]);
        }
        tmax = qmax(tmax);
        const float mnew = fmaxf(m[g], tmax), alpha = fexp2(m[g] - mnew);
        f2 rs2 = {0.f, 0.f};
#pragma unroll
        for (int kt = 0; kt < 4; ++kt) {
            const f2 a = Slo[kt] - mnew, b = Shi[kt] - mnew;
            const f2 pa = {fexp2(a[0]), fexp2(a[1])}, pb = {fexp2(b[0]), fexp2(b[1])};
            rs2 += pa; rs2 += pb;
            S[kt] = (f32x4){pa[0], pa[1], pb[0], pb[1]};
        }
        l[g] = l[g] * alpha + (rs2[0] + rs2[1]); m[g] = mnew;
        const bf16x8 P0 = pack_p(S[0], S[1]), P1 = pack_p(S[2], S[3]);
#pragma unroll
        for (int dt = 0; dt < 4; ++dt) { O[g][dt] = O[g][dt] * alpha;
            const bf16x8 v0 = *(const bf16x8*)(Vl + (dt * 16 + l15) * 144 + quad * 16), v1 = *(const bf16x8*)(Vl + (dt * 16 + l15) * 144 + 64 + quad * 16);
            O[g][dt] = __builtin_amdgcn_mfma_f32_16x16x32_bf16(v0, P0, O[g][dt], 0, 0, 0);
            O[g][dt] = __builtin_amdgcn_mfma_f32_16x16x32_bf16(v1, P1, O[g][dt], 0, 0, 0); }
    }
}

template <int MODE>
DEV void nsa_tiles(unsigned char* lds, const bf16_t* Kg, const bf16_t* VTg, unsigned tilemask, unsigned wmask, unsigned qmask, int jb0, int jb1,
                   const bf16x8 (&Qf)[2][2], f32x4 (&O)[2][4], float (&m)[2], float (&l)[2], const float (&slope)[2], int tq, int l15, int quad) {
    const int tid = get_tid();
    const int prow = tid >> 3, pe = tid & 7;
    unsigned rem = tilemask;
    int j = __builtin_ctz(rem); rem &= rem - 1;
    u32x4 rk, rv;
    rk = *(const u32x4*)(Kg + (size_t)(64 * j + prow) * 64 + pe * 8); rv = *(const u32x4*)(VTg + (size_t)prow * 2048 + 64 * j + pe * 8);
    int cur = 0;
    *(u32x4*)(lds + prow * 144 + pe * 16) = rk; st_vt(lds + 9216 + prow * 144, pe, rv);
    __syncthreads();
    for (;;) {
        int jn = -1;
        if (rem) { jn = __builtin_ctz(rem); rem &= rem - 1;
            rk = *(const u32x4*)(Kg + (size_t)(64 * jn + prow) * 64 + pe * 8); rv = *(const u32x4*)(VTg + (size_t)prow * 2048 + 64 * jn + pe * 8); }
        __builtin_amdgcn_sched_barrier(0);
        const unsigned char* st = lds + cur * 18432;
        if (MODE == 1 || ((wmask >> j) & 1u)) {
            const int dist0 = tq - 64 * j - 4 * quad; const bool sel = (qmask >> j) & 1u;
            if (j == jb0 || j == jb1) nsa_tile<MODE, true>(st, st + 9216, Qf, O, m, l, slope, dist0, sel, l15, quad);
            else nsa_tile<MODE, false>(st, st + 9216, Qf, O, m, l, slope, dist0, sel, l15, quad);
        }
        if (jn >= 0) { unsigned char* sn = lds + (cur ^ 1) * 18432; *(u32x4*)(sn + prow * 144 + pe * 16) = rk; st_vt(sn + 9216 + prow * 144, pe, rv); }
        __syncthreads();
        if (jn < 0) break;
        j = jn; cur ^= 1;
    }
}

DEV void nsa_unit(const NsaCtx& c, int b, int hkv, int qb, unsigned char* lds) {
    const int tid = get_tid(), lane = tid & 63, wid = tid >> 6, l15 = lane & 15, quad = lane >> 4;
    const int qs = wid & 3, hp = wid >> 2;
    const int tq = qb * 64 + qs * 16 + l15, cur = qb;
    const size_t trow = (size_t)b * 2048 + tq;
    const int head0 = hkv * 4 + hp * 2;
    const float* gnp = c.GN + trow * 48 + head0 * 3;
    unsigned char* stash = lds + 36864 + wid * 4096;
    float* xch = (float*)(lds + 69632);
    unsigned* smask = (unsigned*)(lds + 102400);
    const int bh = b * 4 + hkv;
    {
        const bf16_t* Kg = c.KC + (size_t)bh * 128 * 64; const bf16_t* Vg = c.VCT + (size_t)bh * 64 * 128;
#pragma unroll
        for (int i = 0; i < 2; ++i) { const int pc = tid + 512 * i;
            *(u32x4*)(lds + (pc >> 3) * 144 + (pc & 7) * 16) = *(const u32x4*)(Kg + pc * 8);
            st_vt(lds + 18432 + (pc >> 4) * 272, pc & 15, *(const u32x4*)(Vg + pc * 8)); }
    }
    __syncthreads();
    const int nkt = (4 * qb + 2) / 16 + 1;
    float Mx[8], Sm[8];
#pragma unroll
    for (int kt = 0; kt < 8; ++kt) { Mx[kt] = NEG; Sm[kt] = 0.f; }
#ifdef NSA_NO_CMP
    for (int g = 0; g < 0; ++g) {
#else
#pragma unroll 1
    for (int g = 0; g < 2; ++g) {
#endif
        bf16x8 Qg[2];
#pragma unroll
        for (int ks = 0; ks < 2; ++ks) Qg[ks] = *(const bf16x8*)(c.Qb + trow * 1024 + (head0 + g) * 64 + ks * 32 + quad * 8);
        const float slope_g = exp2f(-0.5f * (float)(head0 + g + 1)) * LOG2E;
        f32x4 S[8];
#pragma unroll
        for (int kt = 0; kt < 8; ++kt) { S[kt] = (f32x4){0.f, 0.f, 0.f, 0.f};
            if (kt < nkt) {
#pragma unroll
                for (int ks = 0; ks < 2; ++ks) { const bf16x8 kf = *(const bf16x8*)(lds + (kt * 16 + l15) * 144 + ks * 64 + quad * 16); S[kt] = __builtin_amdgcn_mfma_f32_16x16x32_bf16(kf, Qg[ks], S[kt], 0, 0, 0); } } }
        float mx = NEG;
        const int d0 = tq - 31 - 64 * quad; const float base = -slope_g * (float)d0;
#pragma unroll
        for (int kt = 0; kt < 8; ++kt)
#pragma unroll
            for (int i = 0; i < 4; ++i) { const int cc = 256 * kt + 16 * i; const float s = (kt < nkt && cc <= d0) ? fmaf(slope_g, (float)cc, S[kt][i] + base) : NEG; S[kt][i] = s; mx = fmaxf(mx, s); }
        mx = qmax(mx);
        float ls = 0.f;
#pragma unroll
        for (int kt = 0; kt < 8; ++kt)
#pragma unroll
            for (int i = 0; i < 4; ++i) ls += S[kt][i] > -1e29f ? fexp2(S[kt][i] - mx) : 0.f;
        ls = qsum(ls);
        const float lcl = fmaxf(ls, 1e-30f), lg = __log2f(lcl) + mx;
        float x3[8];
#pragma unroll
        for (int kt = 0; kt < 8; ++kt) {
#pragma unroll
            for (int i = 0; i < 4; ++i) S[kt][i] = S[kt][i] > -1e29f ? S[kt][i] - lg : NEG;
            x3[kt] = __shfl(S[kt][3], (lane + 48) & 63);
        }
#pragma unroll
        for (int kt = 0; kt < 8; ++kt) {
            const float nb = quad >= 1 ? x3[kt] : (kt >= 1 ? x3[kt >= 1 ? kt - 1 : 0] : NEG);
            const float tm = fmaxf(fmaxf(fmaxf(S[kt][0], S[kt][1]), fmaxf(S[kt][2], S[kt][3])), nb);
            const float nm = fmaxf(Mx[kt], tm);
            Sm[kt] = Sm[kt] * fexp2(Mx[kt] - nm) + fexp2(S[kt][0] - nm) + fexp2(S[kt][1] - nm) + fexp2(S[kt][2] - nm) + fexp2(S[kt][3] - nm) + fexp2(nb - nm);
            Mx[kt] = nm;
        }
        const float gate0 = gnp[g * 3];
        f32x4 Oc[4];
#pragma unroll
        for (int dt = 0; dt < 4; ++dt) Oc[dt] = (f32x4){0.f, 0.f, 0.f, 0.f};
#pragma unroll
        for (int k2 = 0; k2 < 4; ++k2) {
            if (2 * k2 < nkt) {
                f32x4 pa, pb;
#pragma unroll
                for (int i = 0; i < 4; ++i) { pa[i] = fexp2(S[2 * k2][i]); pb[i] = fexp2(S[2 * k2 + 1][i]); }
                const bf16x8 pf = pack_p(pa, pb);
#pragma unroll
                for (int dt = 0; dt < 4; ++dt) { const bf16x8 vf = *(const bf16x8*)(lds + 18432 + (dt * 16 + l15) * 272 + k2 * 64 + quad * 16); Oc[dt] = __builtin_amdgcn_mfma_f32_16x16x32_bf16(vf, pf, Oc[dt], 0, 0, 0); }
            }
        }
#pragma unroll
        for (int dt = 0; dt < 4; ++dt) { const f32x4 v = Oc[dt] * gate0; u32x2 w; w.x = cvt_pk_bf16(v[0], v[1]); w.y = cvt_pk_bf16(v[2], v[3]); *(u32x2*)(stash + ((g * 4 + dt) * 64 + lane) * 8) = w; }
    }
    unsigned qmask;
    if (cur < 8) qmask = (2u << cur) - 1u;
    if (cur >= 8) {
#pragma unroll
        for (int kt = 0; kt < 8; ++kt) { xch[(wid * 16 + kt) * 64 + lane] = Mx[kt]; xch[(wid * 16 + 8 + kt) * 64 + lane] = Sm[kt]; }
    }
    __syncthreads();
    if (cur >= 8) {
        float v[8];
#pragma unroll
        for (int kt = 0; kt < 8; ++kt) {
            const float m2 = xch[((wid ^ 4) * 16 + kt) * 64 + lane], s2 = xch[((wid ^ 4) * 16 + 8 + kt) * 64 + lane];
            const float mm = fmaxf(Mx[kt], m2), ss = Sm[kt] * fexp2(Mx[kt] - mm) + s2 * fexp2(m2 - mm);
            const int jb = 4 * kt + quad; v[kt] = (jb >= 1 && jb <= cur - 2) ? mm + __log2f(ss) : -3e38f; }
        qmask = 1u | (1u << cur) | (1u << (cur - 1));
        for (int r = 0; r < 5; ++r) {
            float bv = v[0]; int bj = quad;
#pragma unroll
            for (int kt = 1; kt < 8; ++kt) if (v[kt] > bv) { bv = v[kt]; bj = 4 * kt + quad; }
#pragma unroll
            for (int o = 16; o <= 32; o <<= 1) { const float ov = __shfl_xor(bv, o); const int oj = __shfl_xor(bj, o); if (ov > bv || (ov == bv && oj < bj)) { bv = ov; bj = oj; } }
            qmask |= 1u << bj;
#pragma unroll
            for (int kt = 0; kt < 8; ++kt) if (4 * kt + quad == bj) v[kt] = -3.2e38f;
        }
    }
    unsigned wmask = qmask;
#pragma unroll
    for (int o = 1; o <= 8; o <<= 1) wmask |= __shfl_xor(wmask, o);
    if (lane == 0) smask[wid] = wmask;
    __syncthreads();
    const unsigned umask = (smask[0] | smask[1] | smask[2] | smask[3]) | (smask[4] | smask[5] | smask[6] | smask[7]);
    bf16x8 Qf[2][2]; float slope[2];
#pragma unroll
    for (int g = 0; g < 2; ++g) {
#pragma unroll
        for (int ks = 0; ks < 2; ++ks) Qf[g][ks] = *(const bf16x8*)(c.Qb + trow * 1024 + (head0 + g) * 64 + ks * 32 + quad * 8);
        slope[g] = exp2f(-0.5f * (float)(head0 + g + 1)) * LOG2E;
    }
    f32x4 O[2][4]; float m[2], l[2];
#pragma unroll
    for (int g = 0; g < 2; ++g) { m[g] = MINIT; l[g] = 0.f;
#pragma unroll
        for (int dt = 0; dt < 4; ++dt) O[g][dt] = (f32x4){0.f, 0.f, 0.f, 0.f}; }
#ifndef NSA_NO_SLC
    nsa_tiles<0>(lds, c.KS + (size_t)bh * 2048 * 64, c.VST + (size_t)bh * 64 * 2048, umask, wmask, qmask, cur, cur, Qf, O, m, l, slope, tq, l15, quad);
#endif
#pragma unroll
    for (int g = 0; g < 2; ++g) { const float sc = gnp[g * 3 + 1] / fmaxf(qsum(l[g]), 1e-30f);
#pragma unroll
        for (int dt = 0; dt < 4; ++dt) { u32x2* sp = (u32x2*)(stash + ((g * 4 + dt) * 64 + lane) * 8); const u32x2 w = *sp;
            const f32x4 v = O[g][dt] * sc + (f32x4){bflo(w.x), bfhi(w.x), bflo(w.y), bfhi(w.y)};
            u32x2 w2; w2.x = cvt_pk_bf16(v[0], v[1]); w2.y = cvt_pk_bf16(v[2], v[3]); *sp = w2;
            O[g][dt] = (f32x4){0.f, 0.f, 0.f, 0.f}; }
        m[g] = MINIT; l[g] = 0.f; }
    const int jlo = qb >= 8 ? qb - 8 : 0;
    const unsigned winmask = ((2u << cur) - 1u) & ~((1u << jlo) - 1u);
#ifndef NSA_NO_WIN
    nsa_tiles<1>(lds, c.KW + (size_t)bh * 2048 * 64, c.VWT + (size_t)bh * 64 * 2048, winmask, 0u, 0u, cur, jlo, Qf, O, m, l, slope, tq, l15, quad);
#endif
#pragma unroll
    for (int g = 0; g < 2; ++g) { const float sc = gnp[g * 3 + 2] / fmaxf(qsum(l[g]), 1e-30f);
#pragma unroll
        for (int dt = 0; dt < 4; ++dt) { const u32x2 w = *(const u32x2*)(stash + ((g * 4 + dt) * 64 + lane) * 8);
            const f32x4 v = O[g][dt] * sc + (f32x4){bflo(w.x), bfhi(w.x), bflo(w.y), bfhi(w.y)};
            st_bf4(c.ON + trow * 1024 + (head0 + g) * 64 + dt * 16 + quad * 4, v[0], v[1], v[2], v[3]); } }
}

DEV void xattn_unit(const bf16_t* Qx, const bf16_t* XK, const bf16_t* XVT, bf16_t* OX, int b, int h, int qblk  , unsigned char* lds) {
    const int tid = get_tid(), lane = tid & 63, wid = tid >> 6, l15 = lane & 15, quad = lane >> 4;
    const size_t trow = (size_t)b * 2048 + qblk * 128 + wid * 16 + l15;
    bf16x8 Qf[8];
#pragma unroll
    for (int ks = 0; ks < 8; ++ks) Qf[ks] = *(const bf16x8*)(Qx + trow * 1024 + h * 256 + ks * 32 + quad * 8);
    f32x4 O[16];
#pragma unroll
    for (int dt = 0; dt < 16; ++dt) O[dt] = (f32x4){0.f, 0.f, 0.f, 0.f};
    float m = NEG, l = 0.f;
    const bf16_t* Kg = XK + (size_t)b * 256 * 1024 + h * 256;
    const bf16_t* Vg = XVT + (size_t)(b * 4 + h) * 256 * 256;
    u32x4 rk[2], rv[2];
#pragma unroll
    for (int i = 0; i < 2; ++i) { const int pc = tid + 512 * i; rk[i] = *(const u32x4*)(Kg + (size_t)(pc >> 5) * 1024 + (pc & 31) * 8); rv[i] = *(const u32x4*)(Vg + (size_t)(pc >> 2) * 256 + (pc & 3) * 8); }
#pragma unroll
    for (int i = 0; i < 2; ++i) { const int pc = tid + 512 * i; *(u32x4*)(lds + (pc >> 5) * 528 + (pc & 31) * 16) = rk[i]; st_vt(lds + 16896 + (pc >> 2) * 80, pc & 3, rv[i]); }
    __syncthreads();
    for (int j = 0; j < 8; ++j) {
        const bool more = j + 1 < 8;
        if (more) {
#pragma unroll
            for (int i = 0; i < 2; ++i) { const int pc = tid + 512 * i; rk[i] = *(const u32x4*)(Kg + (size_t)(32 * (j + 1) + (pc >> 5)) * 1024 + (pc & 31) * 8); rv[i] = *(const u32x4*)(Vg + (size_t)(pc >> 2) * 256 + 32 * (j + 1) + (pc & 3) * 8); } }
        __builtin_amdgcn_sched_barrier(0);
        const unsigned char* st = lds + (j & 1) * 37376;
        f32x4 S[2];
#pragma unroll
        for (int kt = 0; kt < 2; ++kt) { S[kt] = (f32x4){0.f, 0.f, 0.f, 0.f};
#pragma unroll
            for (int ks = 0; ks < 8; ++ks) { const bf16x8 kf = *(const bf16x8*)(st + (kt * 16 + l15) * 528 + ks * 64 + quad * 16); S[kt] = __builtin_amdgcn_mfma_f32_16x16x32_bf16(kf, Qf[ks], S[kt], 0, 0, 0); } }
        float tmax = fmaxf(fmaxf(fmaxf(S[0][0], S[0][1]), fmaxf(S[0][2], S[0][3])), fmaxf(fmaxf(S[1][0], S[1][1]), fmaxf(S[1][2], S[1][3])));
        tmax = qmax(tmax);
        const float mnew = fmaxf(m, tmax), alpha = fexp2(m - mnew);
        float rs = 0.f;
#pragma unroll
        for (int kt = 0; kt < 2; ++kt)
#pragma unroll
            for (int i = 0; i < 4; ++i) { const float pv = fexp2(S[kt][i] - mnew); S[kt][i] = pv; rs += pv; }
        l = l * alpha + rs; m = mnew;
        const bf16x8 pf = pack_p(S[0], S[1]);
#pragma unroll
        for (int dt = 0; dt < 16; ++dt) { O[dt] = O[dt] * alpha; const bf16x8 vf = *(const bf16x8*)(st + 16896 + (dt * 16 + l15) * 80 + quad * 16); O[dt] = __builtin_amdgcn_mfma_f32_16x16x32_bf16(vf, pf, O[dt], 0, 0, 0); }
        if (more) { unsigned char* sn = lds + ((j + 1) & 1) * 37376;
#pragma unroll
            for (int i = 0; i < 2; ++i) { const int pc = tid + 512 * i; *(u32x4*)(sn + (pc >> 5) * 528 + (pc & 31) * 16) = rk[i]; st_vt(sn + 16896 + (pc >> 2) * 80, pc & 3, rv[i]); } }
        __syncthreads();
    }
    const float inv = 1.0f / qsum(l);
#pragma unroll
    for (int dt = 0; dt < 16; ++dt) { const f32x4 v = O[dt] * inv; st_bf4(OX + trow * 1024 + h * 256 + dt * 16 + quad * 4, v[0], v[1], v[2], v[3]); }
}


#define XB_TMO      128
#define XB_XCNT(j)  (256  + 64 * (j))
#define XB_XSUB(j)  (1280 + 64 * (j))
#define XB_XGEN(j)  (2304 + 64 * (j))
#define XB_TOP      3328
#define XB_TOPGEN   3392
#define XCD_BAR_WORDS 3456
#define XB_SPIN_CAP (1u << 18)
#define LAS __attribute__((address_space(3)))
DEV unsigned xb_ld(unsigned* p)              { return __hip_atomic_load(p, __ATOMIC_RELAXED, __HIP_MEMORY_SCOPE_AGENT); }
DEV unsigned xb_add(unsigned* p, unsigned v) { return __hip_atomic_fetch_add(p, v, __ATOMIC_RELAXED, __HIP_MEMORY_SCOPE_AGENT); }
DEV unsigned xb_xcc_id() { return (unsigned)__builtin_amdgcn_s_getreg((3 << 11) | 20) & 0xFu; }
#define XB_SPIN(cond, bar) do { unsigned _sp = 0; while (cond) { __builtin_amdgcn_s_sleep(1); \
    if ((++_sp & 255u) == 0u) { if (xb_ld(&(bar)[XB_TMO])) break; if (_sp > XB_SPIN_CAP) { atomicAdd(&(bar)[XB_TMO], 1u); break; } } } } while (0)
struct XcdBarrier { unsigned* bar; unsigned x; volatile LAS unsigned* st; };
DEV XcdBarrier xcd_barrier_post(unsigned* bar, volatile LAS unsigned* st) {
    XcdBarrier b; b.bar = bar; b.x = xb_xcc_id(); b.st = st;
    if (threadIdx.x == 0) { st[2] = xb_add(&bar[XB_XCNT(b.x)], 1u); st[3] = b.x; }
    return b;
}
DEV void xcd_barrier_complete(unsigned* bar, unsigned x, unsigned& nloc, unsigned& nx) {
    const unsigned G = gridDim.x * gridDim.y * gridDim.z;
    unsigned sum, cnt, mine, sp = 0u;
    for (;;) {
        sum = 0u; cnt = 0u; mine = 0u;
#pragma unroll
        for (unsigned j = 0; j < 16; ++j) { const unsigned c = xb_ld(&bar[XB_XCNT(j)]); sum += c; cnt += (c > 0u) ? 1u : 0u; mine = (j == x) ? c : mine; }
        if (sum == G) break;
        __builtin_amdgcn_s_sleep(1);
        if ((++sp & 255u) == 0u) { if (xb_ld(&bar[XB_TMO])) break; if (sp > XB_SPIN_CAP) { atomicAdd(&bar[XB_TMO], 1u); break; } }
    }
    nloc = mine > 0u ? mine : 1u; nx = cnt > 0u ? cnt : 1u;
}
DEV void xcd_barrier(const XcdBarrier& b) {
    asm volatile("s_waitcnt vmcnt(0)" ::: "memory");
    __syncthreads();
    if (threadIdx.x == 0) {
        unsigned* bar = b.bar;
        __builtin_amdgcn_s_waitcnt(0);
        unsigned nloc = b.st[0], nx = b.st[1];
        if (nloc == 0u) { xcd_barrier_complete(bar, b.x, nloc, nx); b.st[0] = nloc; b.st[1] = nx; }
        const unsigned old = xb_add(&bar[XB_XSUB(b.x)], 1u);
        const unsigned gen = old / nloc;
        if (old + 1u == (gen + 1u) * nloc) {
            __builtin_amdgcn_fence(__ATOMIC_RELEASE, "agent");
            asm volatile("s_waitcnt vmcnt(0)" ::: "memory");
            const unsigned og = xb_add(&bar[XB_TOP], 1u);
            const unsigned tg = og / nx;
            if (og + 1u == (tg + 1u) * nx) xb_add(&bar[XB_TOPGEN], 1u);
            else XB_SPIN(xb_ld(&bar[XB_TOPGEN]) == tg, bar);
            __builtin_amdgcn_fence(__ATOMIC_ACQUIRE, "agent");
            xb_add(&bar[XB_XGEN(b.x)], 1u);
            asm volatile("s_waitcnt vmcnt(0)" ::: "memory");
        } else {
            XB_SPIN(xb_ld(&bar[XB_XGEN(b.x)]) == gen, bar);
            __builtin_amdgcn_fence(__ATOMIC_ACQUIRE, "agent");
            asm volatile("s_waitcnt vmcnt(0)" ::: "memory");
        }
    }
    __syncthreads();
}

constexpr int NPHASE = 17;
__global__ void __launch_bounds__(512, 2) fwd_kernel(P p) {
    extern __shared__ __attribute__((aligned(16))) unsigned char lds[];
#define WSB(off) ((bf16_t*)(ws + (off)))
#define WSF(off) ((float*)(ws + (off)))
    volatile LAS unsigned* bst = (volatile LAS unsigned*)(LAS unsigned char*)(lds + LDS_BYTES - 16);
    if (threadIdx.x == 0) { bst[0] = 0u; bst[1] = 0u; bst[2] = 0u; bst[3] = 0u; }
    __syncthreads();
    XcdBarrier gbar; gbar.bar = (unsigned*)(p.ws + O_BAR); gbar.x = 0; gbar.st = bst;
    if (p.coop) gbar = xcd_barrier_post((unsigned*)(p.ws + O_BAR), bst);
    const SsmIn sin_{p.in[5], p.in[6], p.in[7], p.in[8], p.in[9], p.in[10], p.in[12]};
    for (int ph = p.ph_lo; ph < p.ph_hi; ++ph) {
        size_t zoff = 0; asm volatile("" : "+s"(zoff)); unsigned char* ws = p.ws + zoff;
        switch (ph) {
#ifdef ONLY_PHASE
        default: break;
#define CASE(k) case (k): if ((k) != ONLY_PHASE) break; else
#else
#define CASE(k) case (k):
#endif
        CASE(0) {
            const int tid = get_tid();
            ln_pass(p.in[0], p.in[2], p.in[3], WSB(O_B), WSF(O_ST0), nullptr);
            int cur = 0;
            conv_job(p.in[4], 5168, 1024, 5376, WSB(O_WIN_T), 1, lds, cur);
            conv_job(p.in[13], 512, 512, 512, WSB(O_WGLU_T), 0, lds, cur);
            conv_job(p.in[15], 1024, 512, 1024, WSB(O_WSOUT_T), 0, lds, cur);
            conv_job(p.in[17], 256, 2048, 256, WSB(O_W1_T), 0, lds, cur);
            conv_job(p.in[17] + 2048 * 256, 256, 2048, 256, WSB(O_W1_T) + 256 * 2048, 0, lds, cur);
            conv_job(p.in[19], 64, 256, 256, WSB(O_W2_T), 3, lds, cur);
            conv_job(p.in[19] + 256 * 64, 64, 256, 256, WSB(O_W2_T) + 256 * 256, 3, lds, cur);
            conv_job(p.in[20], 1024, 1024, 1024, WSB(O_WNOUT_T), 0, lds, cur);
            conv_job(p.in[21], 1024, 1024, 1024, WSB(O_WOUT_T), 0, lds, cur);
            conv_job(p.in[24], 1024, 1024, 1024, WSB(O_WXQ_T), 0, lds, cur);
            conv_job(p.in[25], 2048, 1024, 2048, WSB(O_WXKV_T), 0, lds, cur);
            conv_job(p.in[26], 1024, 1024, 1024, WSB(O_WXO_T), 0, lds, cur);
            conv_job(p.in[29], 5632, 1024, 5632, WSB(O_WFIN_T), 2, lds, cur);
            conv_job(p.in[30], 1024, 2816, 1024, WSB(O_WFOUT_T), 0, lds, cur);
            for (int it = get_bid(); it < 128; it += gridDim.x) {
                const int z = it >> 6, ec = (it >> 4) & 3, fc = it & 15, e = ec * 64 + (tid & 63), fg = tid >> 6;
                float a = 0.f;
#pragma unroll 8
                for (int f = fc * 128 + fg * 16; f < fc * 128 + fg * 16 + 16; ++f) a += p.in[16][z * 2048 + f] * p.in[17][((size_t)z * 2048 + f) * 256 + e];
                float* red = (float*)lds;
                __syncthreads(); red[tid] = a; __syncthreads();
                if (tid < 64) { float t = 0.f; for (int k = 0; k < 8; ++k) t += red[tid + 64 * k]; WSF(O_BPART)[(z * 16 + fc) * 256 + e] = t; }
                __syncthreads();
            }
            ssm_prep(sin_, WSB(O_BT1), WSB(O_MTW), lds);
        } break;
        CASE(1) {
            if (get_bid() == 0) { for (int e = get_tid(); e < 512; e += NTHR) { float a = p.in[18][e]; for (int fc = 0; fc < 16; ++fc) a += WSF(O_BPART)[((e >> 8) * 16 + fc) * 256 + (e & 255)]; WSF(O_BIAS2)[e] = a; } }
            { const GemmP g{WSB(O_B), WSB(O_WIN_T), 1024, 1024, 256, 42, 16, 1};
              const EpiIn e{WSB(O_UH), WSB(O_QB), WSB(O_KVC), WSB(O_KS), WSB(O_VST), WSB(O_KW), WSB(O_VWT), WSB(O_GM), WSF(O_GN)};
              gemm_run<8>(g, AddrNone{}, e, lds); }
        } break;
        CASE(2) {
            { const GemmP g{WSB(O_KVC), WSB(O_W1_T), 1024, 2048, 1, 2, 32, 128};
              const EpiCmp1 e{WSB(O_HID), WSF(O_BIAS2)};
              gemm_run<4>(g, AddrCmp1{}, e, lds); }
            { const GemmP g{WSB(O_UH), WSB(O_BT1), 640, 512, 8, 2, 8, 32};
              const EpiSsmA e{WSF(O_SS)};
              gemm_run<8>(g, AddrStride{1024ull * 640, 256ull * 512}, e, lds, 16); }
        } break;
        CASE(3) {
            ssm_scan(sin_, WSF(O_SS), WSB(O_UH));
            { const GemmP g{WSB(O_HID), WSB(O_W2_T), 256, 256, 1, 2, 4, 128};
              const EpiCmp2 e{WSB(O_KC), WSB(O_VCT)};
              gemm_run<4>(g, AddrCmp2{}, e, lds, 16); }
        } break;
        CASE(4) {
            const NsaCtx c{WSB(O_QB), WSB(O_KC), WSB(O_VCT), WSB(O_KS), WSB(O_VST), WSB(O_KW), WSB(O_VWT), WSF(O_GN), WSB(O_B)};
            const int G = gridDim.x;
            for (int i = 0;; ++i) {
                const int u = (i & 1) ? i * G + (G - 1 - get_bid()) : i * G + get_bid();
                if (i * G >= 2048) break;
                if (u < 2048) { const int qb = 31 - (u >> 6), bh = u & 63; nsa_unit(c, bh >> 2, bh & 3, qb, lds); }
                __syncthreads();
            }
            { const GemmP g{WSB(O_UH), WSB(O_MTW), 640, 640, 8, 4, 10, 32};
              const EpiSsmB e{WSB(O_UH), p.in[11], WSB(O_GB)};
              gemm_run<8>(g, AddrStride{1024ull * 640, 512ull * 640}, e, lds); }
        } break;
        CASE(5) { const GemmP g{WSB(O_GB), WSB(O_WGLU_T), 512, 512, 256, 4, 8, 1}; const EpiGlu e{WSB(O_GB), p.in[14], WSB(O_YS)}; gemm_run<8>(g, AddrNone{}, e, lds); } break;
        CASE(6) { const GemmP g{WSB(O_YS), WSB(O_WSOUT_T), 512, 512, 256, 8, 8, 1}; const EpiSout e{WSB(O_GM), WSB(O_QB)}; gemm_run<8>(g, AddrNone{}, e, lds); } break;
        CASE(7) { const GemmP g{WSB(O_B), WSB(O_WNOUT_T), 1024, 1024, 256, 8, 16, 1}; const EpiNout e{WSB(O_GM), WSB(O_QB), WSB(O_MIXIN)}; gemm_run<8>(g, AddrNone{}, e, lds); } break;
        CASE(8) { const GemmP g{WSB(O_MIXIN), WSB(O_WOUT_T), 1024, 1024, 256, 8, 16, 1}; const EpiRes e{p.in[0], WSF(O_ST0), p.in[2], p.in[3], WSF(O_V1)}; gemm_run<8>(g, AddrNone{}, e, lds); } break;
        CASE(9) { ln_pass(WSF(O_V1), p.in[22], p.in[23], WSB(O_B), WSF(O_ST1), nullptr);
            for (size_t i = (size_t)get_bid() * NTHR + get_tid(); i < 4096ull * 1024 / 4; i += (size_t)gridDim.x * NTHR) { const f32x4 v = ((const f32x4*)p.in[1])[i]; st_bf4(WSB(O_MEMB) + i * 4, v[0], v[1], v[2], v[3]); }
        } break;
        CASE(10) { { const GemmP g{WSB(O_B), WSB(O_WXQ_T), 1024, 1024, 256, 8, 16, 1}; const EpiScaleBf e{WSB(O_QB), 1024, 0.0625f * LOG2E}; gemm_run<8>(g, AddrNone{}, e, lds); }
            { const GemmP g{WSB(O_MEMB), WSB(O_WXKV_T), 1024, 1024, 32, 16, 16, 1};
              const EpiXkv e{WSB(O_XK), WSB(O_XVT)};
              gemm_run<8>(g, AddrNone{}, e, lds); }
        } break;
        CASE(11) {
            for (int u = get_bid(); u < 1024; u += gridDim.x) { const int qblk = u >> 6, bh = u & 63; xattn_unit(WSB(O_QB), WSB(O_XK), WSB(O_XVT), WSB(O_B), bh >> 2, bh & 3, qblk, lds); }
        } break;
        CASE(12) { const GemmP g{WSB(O_B), WSB(O_WXO_T), 1024, 1024, 256, 8, 16, 1}; const EpiRes e{WSF(O_V1), WSF(O_ST1), p.in[22], p.in[23], WSF(O_V2)}; gemm_run<8>(g, AddrNone{}, e, lds); } break;
        CASE(13) ln_pass(WSF(O_V2), p.in[27], p.in[28], WSB(O_B), WSF(O_ST2), nullptr); break;
        CASE(14) { const GemmP g{WSB(O_B), WSB(O_WFIN_T), 1024, 1024, 256, 44, 16, 1}; const EpiFfnIn e{WSB(O_FB)}; gemm_run<8>(g, AddrNone{}, e, lds); } break;
        CASE(15) { const GemmP g{WSB(O_FB), WSB(O_WFOUT_T), 2816, 2816, 256, 8, 44, 1}; const EpiRes e{WSF(O_V2), WSF(O_ST2), p.in[27], p.in[28], WSF(O_V2)}; gemm_run<8>(g, AddrNone{}, e, lds); } break;
        CASE(16) ln_pass(WSF(O_V2), p.in[31], p.in[32], nullptr, nullptr, p.out); break;
        }
        if (ph + 1 < p.ph_hi) { if (p.coop) xcd_barrier(gbar); if (p.pad == 0x5eed) cg::this_grid().sync(); }
    }
}

#ifndef ONE_LAUNCH
#define ONE_LAUNCH 1
#endif
extern "C" void kernel_launch(void* const* d_in, const int* in_sizes, int n_in, void* d_out, int out_size, void* d_ws, size_t ws_size, hipStream_t stream) {
    static int grid = 0;
    if (grid == 0) {
        if (n_in != 33 || out_size != T_ * 1024 || ws_size < WS_NEED) { fprintf(stderr, "kernel_launch: unexpected shapes (n_in %d out %d ws %zu need %zu)\n", n_in, out_size, ws_size, (size_t)WS_NEED); grid = -1; return; }
        int dev = 0, cus = 0, per_cu = 0;
        hipGetDevice(&dev);
        hipDeviceGetAttribute(&cus, hipDeviceAttributeMultiprocessorCount, dev);
        if (hipFuncSetAttribute((const void*)fwd_kernel, hipFuncAttributeMaxDynamicSharedMemorySize, LDS_BYTES) != hipSuccess) { fprintf(stderr, "kernel_launch: hipFuncSetAttribute failed\n"); grid = -1; return; }
        if (hipOccupancyMaxActiveBlocksPerMultiprocessor(&per_cu, (const void*)fwd_kernel, NTHR, LDS_BYTES) != hipSuccess || per_cu < 1) { fprintf(stderr, "kernel_launch: occupancy query failed (%d)\n", per_cu); per_cu = 1; (void)hipGetLastError(); }
        if (per_cu > 1) per_cu = 1;
        grid = cus * per_cu;
    }
    if (grid < 0) return;
    P p{};
    for (int i = 0; i < 33; ++i) p.in[i] = (const float*)d_in[i];
    p.out = (float*)d_out; p.ws = (unsigned char*)d_ws;
#if ONE_LAUNCH
    p.ph_lo = 0; p.ph_hi = NPHASE; p.coop = 1;
    if (hipMemsetAsync((unsigned char*)d_ws + O_BAR, 0, XCD_BAR_WORDS * 4, stream) != hipSuccess) { fprintf(stderr, "kernel_launch: memset of barrier words failed\n"); return; }
    void* args[] = {&p};
    hipError_t e = hipLaunchCooperativeKernel((const void*)fwd_kernel, dim3(grid), dim3(NTHR), args, LDS_BYTES, stream);
    if (e != hipSuccess) fprintf(stderr, "cooperative launch failed: %s (grid %d)\n", hipGetErrorString(e), grid);
#else
#ifdef STOP_AFTER
    const int nrun = STOP_AFTER + 1;
#else
    const int nrun = NPHASE;
#endif
    for (int ph = 0; ph < nrun; ++ph) {
        p.ph_lo = ph; p.ph_hi = ph + 1; p.coop = 0;
        hipLaunchKernelGGL(fwd_kernel, dim3(grid), dim3(NTHR), LDS_BYTES, stream, p);
    }
#endif
}
```

```cpp
#include <hip/hip_runtime.h>
#include <hip/hip_cooperative_groups.h>
#include <cstdio>
#include <cstdint>
namespace cg = cooperative_groups;

typedef unsigned short bf16_t;
typedef short bf16x8 __attribute__((ext_vector_type(8)));
typedef float f32x4 __attribute__((ext_vector_type(4)));
typedef unsigned u32x4 __attribute__((ext_vector_type(4)));
typedef unsigned u32x2 __attribute__((ext_vector_type(2)));
#define DEV __device__ __forceinline__

constexpr int T_ = 32768, L_ = 2048;
constexpr float LOG2E = 1.4426950408889634f;
constexpr float ALPHA = 1.189207115002721f;
constexpr float LN_EPS = 1e-5f;
constexpr float NEG = -1e30f;
constexpr int LDS_BYTES = 147456;
constexpr int NTHR = 512, NWAVE = 8;
constexpr size_t MiB = 1048576;

constexpr size_t O_WIN_T = 0;
constexpr size_t O_WGLU_T = O_WIN_T + 5376ull * 1024 * 2;
constexpr size_t O_WSOUT_T = O_WGLU_T + 512ull * 512 * 2;
constexpr size_t O_W1_T = O_WSOUT_T + 1024ull * 512 * 2;
constexpr size_t O_W2_T = O_W1_T + 2ull * 256 * 2048 * 2;
constexpr size_t O_WNOUT_T = O_W2_T + 2ull * 256 * 256 * 2;
constexpr size_t O_WOUT_T = O_WNOUT_T + 2 * MiB;
constexpr size_t O_WXQ_T = O_WOUT_T + 2 * MiB;
constexpr size_t O_WXKV_T = O_WXQ_T + 2 * MiB;
constexpr size_t O_WXO_T = O_WXKV_T + 4 * MiB;
constexpr size_t O_WFIN_T = O_WXO_T + 2 * MiB;
constexpr size_t O_WFOUT_T = O_WFIN_T + 5632ull * 1024 * 2;
constexpr size_t O_BT1 = O_WFOUT_T + 1024ull * 2816 * 2;
constexpr size_t O_MTW = O_BT1 + 8 * MiB;
constexpr size_t O_KC = O_MTW + 20 * MiB;
constexpr size_t O_VCT = O_KC + 1 * MiB;
constexpr size_t O_GN = O_VCT + 1 * MiB;
constexpr size_t O_ST0 = O_GN + 6 * MiB;
constexpr size_t O_ST1 = O_ST0 + 262144;
constexpr size_t O_ST2 = O_ST1 + 262144;
constexpr size_t O_BIAS2 = O_ST2 + 262144;
constexpr size_t O_BPART = O_BIAS2 + 4096;
constexpr size_t O_BAR = O_BPART + 32768;
constexpr size_t O_A = 81 * MiB;
constexpr size_t O_KVC = O_A;
constexpr size_t O_KS = O_A + 32 * MiB;
constexpr size_t O_VST = O_A + 48 * MiB;
constexpr size_t O_KW = O_A + 64 * MiB;
constexpr size_t O_VWT = O_A + 80 * MiB;
constexpr size_t O_GB = O_A + 96 * MiB;
constexpr size_t O_MIXIN = O_A;
constexpr size_t O_MEMB = O_A + 64 * MiB;
constexpr size_t O_XK = O_A + 72 * MiB;
constexpr size_t O_XVT = O_A + 80 * MiB;
constexpr size_t O_V2 = O_A;
constexpr size_t O_B = O_A + 128 * MiB;
constexpr size_t O_SS = O_B;
constexpr size_t O_HID = O_B + 16 * MiB;
constexpr size_t O_Y = O_B + 64 * MiB;
constexpr size_t O_GM = O_Y;
constexpr size_t O_V1 = O_Y;
constexpr size_t O_X = O_Y + 128 * MiB;
constexpr size_t O_QB = O_X;
constexpr size_t O_UH = O_X + 64 * MiB;
constexpr size_t O_YS = O_X + 64 * MiB;
constexpr size_t O_FB = O_Y;
constexpr size_t WS_NEED = O_X + 104 * MiB;
static_assert(O_BAR + 16384 <= O_A, "F region overflow");

struct P {
    const float* in[33];
    float* out;
    unsigned char* ws;
    int ph_lo, ph_hi, coop, pad;
};

DEV int get_tid() { int t = threadIdx.x; asm volatile("" : "+v"(t)); return t; }
DEV int get_bid() { int t = blockIdx.x; asm volatile("" : "+s"(t)); return t; }
typedef __bf16 bf2_t __attribute__((ext_vector_type(2)));
typedef float f32x2_t __attribute__((ext_vector_type(2)));
DEV unsigned cvt_pk_bf16(float lo, float hi) { const f32x2_t f = {lo, hi}; const bf2_t r = __builtin_convertvector(f, bf2_t); return __builtin_bit_cast(unsigned, r); }
DEV bf16_t f2bf(float v) { return (bf16_t)(cvt_pk_bf16(v, 0.f) & 0xffffu); }
DEV float bf2f(unsigned v) { return __uint_as_float(v << 16); }
DEV float bflo(unsigned w) { return __uint_as_float(w << 16); }
DEV float bfhi(unsigned w) { return __uint_as_float(w & 0xffff0000u); }
DEV float fexp2(float x) { return __builtin_amdgcn_exp2f(x); }
DEV float frcp(float x) { return __builtin_amdgcn_rcpf(x); }
DEV float sigmoidf_(float x) { return frcp(1.f + fexp2(-x * LOG2E)); }
DEV float gelu_tanh(float x) { const float u = 0.7978845608028654f * (x + 0.044715f * x * x * x); return x * frcp(1.f + fexp2(-2.f * LOG2E * u)); }
DEV void st_bf4(bf16_t* p, float a, float b, float c, float d) { u32x2 w; w.x = cvt_pk_bf16(a, b); w.y = cvt_pk_bf16(c, d); *(u32x2*)p = w; }
DEV f32x4 ld_bf4(const bf16_t* p) { const u32x2 w = *(const u32x2*)p; return (f32x4){bflo(w.x), bfhi(w.x), bflo(w.y), bfhi(w.y)}; }
DEV float wred_sum(float v) {
#pragma unroll
    for (int o = 32; o >= 1; o >>= 1) v += __shfl_xor(v, o);
    return v;
}

DEV void ln_pass(const float* src, const float* g, const float* b, bf16_t* dstb, float* stats, float* dstf) {
    const int lane = get_tid() & 63, wid = get_tid() >> 6;
    const int nw = gridDim.x * NWAVE;
    for (int row = get_bid() * NWAVE + wid; row < T_; row += nw) {
        const f32x4* p = (const f32x4*)(src + (size_t)row * 1024);
        f32x4 v[4];
#pragma unroll
        for (int i = 0; i < 4; ++i) v[i] = p[lane + 64 * i];
        float s = 0.f;
#pragma unroll
        for (int i = 0; i < 4; ++i) s += (v[i][0] + v[i][1]) + (v[i][2] + v[i][3]);
        s = wred_sum(s);
        const float mu = s * (1.f / 1024.f);
        float q = 0.f;
#pragma unroll
        for (int i = 0; i < 4; ++i) { const f32x4 d = v[i] - mu; q += (d[0] * d[0] + d[1] * d[1]) + (d[2] * d[2] + d[3] * d[3]); }
        q = wred_sum(q);
        const float rstd = 1.0f / sqrtf(q * (1.f / 1024.f) + LN_EPS);
        if (stats && lane == 0) { stats[row * 2] = mu; stats[row * 2 + 1] = rstd; }
#pragma unroll
        for (int i = 0; i < 4; ++i) {
            const int col = (lane + 64 * i) * 4;
            const f32x4 gg = *(const f32x4*)(g + col), bb = *(const f32x4*)(b + col);
            const f32x4 y = (v[i] - mu) * rstd * gg + bb;
            if (dstb) st_bf4(dstb + (size_t)row * 1024 + col, y[0], y[1], y[2], y[3]);
            if (dstf) *(f32x4*)(dstf + (size_t)row * 1024 + col) = y;
        }
    }
}

DEV int colmap(int mode, int n) {
    if (mode == 0) return n;
    if (mode == 1) return n < 3072 ? n : (n < 5120 ? n + 48 : (n < 5168 ? n - 5120 + 3072 : -1));
    if (mode == 2) { const int blk = n >> 5, r = n & 31; return r < 16 ? blk * 16 + r : 2816 + blk * 16 + (r - 16); }
    return n < 64 ? n : -1;
}
DEV void conv_job(const float* src, int ldsrc, int K, int N, bf16_t* dst, int mode, unsigned char* lds, int& cursor) {
    const int tid = get_tid(), lane = tid & 63, gw = get_bid() * NWAVE + (tid >> 6), nw = gridDim.x * NWAVE;
    const int kb = K / 32, nitem = (N / 64) * kb;
    for (int t = (gw + nw - (cursor % nw)) % nw; t < nitem; t += nw) {
        const int k0 = (t % kb) * 32, n = (t / kb) * 64 + lane;
        const int sc = colmap(mode, n);
        float e[32];
#pragma unroll
        for (int r = 0; r < 32; ++r) e[r] = sc >= 0 ? src[(size_t)(k0 + r) * ldsrc + sc] : 0.f;
#pragma unroll
        for (int q = 0; q < 4; ++q) { u32x4 w; w.x = cvt_pk_bf16(e[8 * q], e[8 * q + 1]); w.y = cvt_pk_bf16(e[8 * q + 2], e[8 * q + 3]); w.z = cvt_pk_bf16(e[8 * q + 4], e[8 * q + 5]); w.w = cvt_pk_bf16(e[8 * q + 6], e[8 * q + 7]);
            *(u32x4*)(dst + (size_t)n * K + k0 + 8 * q) = w; }
    }
    cursor += nitem;
}

struct SsmIn { const float *a_re, *a_im, *b_re, *b_im, *c_re, *c_im, *log_dt; };
DEV void lb_pow(const SsmIn& s, int g, int n, float p, float& re, float& im) {
    const float lre = fminf(s.a_re[g * 64 + n], -1e-4f), lim = s.a_im[g * 64 + n], dt = expf(s.log_dt[g]);
    const float mag = expf(lre * dt * p); float sn, cs; sincosf(lim * dt * p, &sn, &cs);
    re = mag * cs; im = mag * sn;
}
DEV void bbar(const SsmIn& s, int g, int n, int c, float& re, float& im) {
    const float lre = fminf(s.a_re[g * 64 + n], -1e-4f), lim = s.a_im[g * 64 + n], dt = expf(s.log_dt[g]);
    const float mag = expf(lre * dt); float sn, cs; sincosf(lim * dt, &sn, &cs);
    const float sh = sinf(0.5f * lim * dt);
    const float nr = expm1f(lre * dt) - mag * 2.f * sh * sh, lbi = mag * sn;
    const float den = lre * lre + lim * lim;
    const float fre = (nr * lre + lbi * lim) / den, fim = (lbi * lre - nr * lim) / den;
    const float br = s.b_re[(g * 64 + n) * 16 + c], bi = s.b_im[(g * 64 + n) * 16 + c];
    re = fre * br - fim * bi; im = fre * bi + fim * br;
}
DEV void ssm_prep(const SsmIn& s, bf16_t* BT1, bf16_t* MTW, unsigned char* lds) {
    const int tid = get_tid();
    float* pw = (float*)lds;
    float* bb = pw + 33 * 128;
    float* cc = bb + 2048;
    float* fn = cc + 2048;
    float* km = fn + 128;
    for (int job = get_bid(); job < 512; job += gridDim.x) {
        const int g = job >> 4, pt = job & 15;
        __syncthreads();
        for (int e = tid; e < 33 * 64; e += NTHR) { float pr, pi; lb_pow(s, g, e & 63, (float)(e >> 6), pr, pi); pw[e * 2] = pr; pw[e * 2 + 1] = pi; }
        if (tid < 64) {
            const int n = tid;
            const float lre = fminf(s.a_re[g * 64 + n], -1e-4f), lim = s.a_im[g * 64 + n], dt = expf(s.log_dt[g]);
            const float mag = expf(lre * dt); float sn, cs; sincosf(lim * dt, &sn, &cs);
            const float sh = sinf(0.5f * lim * dt);
            const float nr = expm1f(lre * dt) - mag * 2.f * sh * sh, lbi = mag * sn;
            const float den = lre * lre + lim * lim;
            fn[n * 2] = (nr * lre + lbi * lim) / den; fn[n * 2 + 1] = (lbi * lre - nr * lim) / den;
        }
        for (int e = tid; e < 1024; e += NTHR) { const int c = e >> 6, n = e & 63; cc[e * 2] = s.c_re[(g * 16 + c) * 64 + n]; cc[e * 2 + 1] = s.c_im[(g * 16 + c) * 64 + n]; }
        __syncthreads();
        for (int e = tid; e < 1024; e += NTHR) { const int n = e >> 4; const float fre = fn[n * 2], fim = fn[n * 2 + 1];
            const float br = s.b_re[(g * 64) * 16 + e], bi = s.b_im[(g * 64) * 16 + e];
            bb[e * 2] = fre * br - fim * bi; bb[e * 2 + 1] = fre * bi + fim * br; }
        __syncthreads();
        for (int i = tid; i < 4096; i += NTHR) { const int e = pt * 4096 + i, nn = e >> 9, kk = e & 511, n = nn & 63, sidx = kk >> 4, c = kk & 15;
            const float pr = pw[((31 - sidx) * 64 + n) * 2], pi = pw[((31 - sidx) * 64 + n) * 2 + 1], br = bb[(n * 16 + c) * 2], bi = bb[(n * 16 + c) * 2 + 1];
            BT1[(size_t)g * 131072 + e] = f2bf((nn >> 6) ? (pr * bi + pi * br) : (pr * br - pi * bi)); }
        for (int i = tid; i < 4096; i += NTHR) BT1[(size_t)g * 131072 + 65536 + pt * 4096 + i] = 0;
        for (int i = tid; i < 4096; i += NTHR) { const int e = pt * 4096 + i, nn = e & 127, r = e >> 7, n = nn & 63, tau = r >> 4, c = r & 15;
            const float pr = pw[((tau + 1) * 64 + n) * 2], pi = pw[((tau + 1) * 64 + n) * 2 + 1], cr = cc[(c * 64 + n) * 2], ci = cc[(c * 64 + n) * 2 + 1];
            MTW[((size_t)g * 512 + r) * 640 + 512 + nn] = f2bf((nn >> 6) ? -(cr * pi + ci * pr) : (cr * pr - ci * pi)); }
        for (int i = tid; i < 32 * 512; i += NTHR) { const int r = pt * 32 + (i >> 9), kk = i & 511; if ((kk >> 4) > (r >> 4)) MTW[((size_t)g * 512 + r) * 640 + kk] = 0; }
        if (tid < 256) for (int dd = 0; dd < 2; ++dd) { const int d = 2 * pt + dd, c = tid >> 4, c2 = tid & 15; float acc = 0.f;
            for (int n = 0; n < 64; ++n) { const float cr = cc[(c * 64 + n) * 2], ci = cc[(c * 64 + n) * 2 + 1], pr = pw[(d * 64 + n) * 2], pi = pw[(d * 64 + n) * 2 + 1];
                const float xr = cr * pr - ci * pi, xi = cr * pi + ci * pr; acc += xr * bb[(n * 16 + c2) * 2] - xi * bb[(n * 16 + c2) * 2 + 1]; }
            km[dd * 256 + tid] = acc; }
        __syncthreads();
        if (tid < 256) for (int dd = 0; dd < 2; ++dd) { const int d = 2 * pt + dd; const bf16_t v = f2bf(km[dd * 256 + tid]); const int c = tid >> 4, c2 = tid & 15;
            for (int sidx = 0; sidx + d < 32; ++sidx) MTW[((size_t)g * 512 + (sidx + d) * 16 + c) * 640 + sidx * 16 + c2] = v; }
    }
    __syncthreads();
}
DEV void ssm_scan(const SsmIn& s, const float* SS, bf16_t* UH) {
    for (int idx = get_bid() * NTHR + get_tid(); idx < 32768; idx += gridDim.x * NTHR) {
        const int n = idx & 63, b = (idx >> 6) & 15, g = idx >> 10;
        float ar, ai; lb_pow(s, g, n, 32.f, ar, ai);
        float hr = 0.f, hi = 0.f;
        const size_t row0 = (size_t)(g * 16 + b) * 64;
#pragma unroll 8
        for (int k = 0; k < 64; ++k) {
            UH[(row0 + k) * 640 + 512 + n] = f2bf(hr); UH[(row0 + k) * 640 + 576 + n] = f2bf(hi);
            const float sr = SS[(row0 + k) * 128 + n], si = SS[(row0 + k) * 128 + 64 + n];
            const float nr = ar * hr - ai * hi + sr, ni = ar * hi + ai * hr + si;
            hr = nr; hi = ni;
        }
    }
}

struct GemmP { const bf16_t* A; const bf16_t* Bt; int lda, ldb, MT, NT, KT, nbatch; };
#define GLAS __attribute__((address_space(3)))
template <int WM, class Addr, class Epi>
DEV void gemm_run(const GemmP p, const Addr ad, const Epi epi, unsigned char* lds_, int rshift = 0) {
    constexpr int TM = 32 * WM, ABYTES = TM * 128, STAGE = ABYTES + 32768, NLA = WM / 2;
    GLAS unsigned char* lds = (GLAS unsigned char*)lds_;
    const int tid = get_tid(), lane = tid & 63, wid = __builtin_amdgcn_readfirstlane(tid >> 6), wr = wid >> 2, wc = wid & 3, l15 = lane & 15, quad = lane >> 4;
    int nx, x, jx, stride;
    { volatile GLAS unsigned* cw = (volatile GLAS unsigned*)(lds + LDS_BYTES - 16);
      const int nloc = (int)cw[0], nxc = (int)cw[1], rank = (int)cw[2], xcc = (int)cw[3];
      if (nloc > 0 && xcc < nxc && rank < nloc) { nx = nxc; x = xcc; jx = (rank + rshift) % nloc; stride = nloc; }
      else { nx = 1; x = 0; jx = get_bid(); stride = gridDim.x; } }
    nx = __builtin_amdgcn_readfirstlane(nx); x = __builtin_amdgcn_readfirstlane(x); jx = __builtin_amdgcn_readfirstlane(jx); stride = __builtin_amdgcn_readfirstlane(stride);
    const int MTT = p.MT / (WM / 4), NTT = p.NT / 2;
    const int SRtot = (p.nbatch * MTT) / 8, per = 8 * NTT, KT = p.KT;
    if (SRtot < nx) { nx = 1; x = 0; jx = get_bid(); stride = gridDim.x; }
    int offA[NLA], offB[4];
#pragma unroll
    for (int i = 0; i < NLA; ++i) { const int row = (wid + 8 * i) * 8 + (lane >> 3), c = (lane & 7) ^ ((row >> 1) & 7); offA[i] = row * p.lda + c * 8; }
#pragma unroll
    for (int i = 0; i < 4; ++i) { const int row = (wid + 8 * i) * 8 + (lane >> 3), c = (lane & 7) ^ ((row >> 1) & 7); offB[i] = row * p.ldb + c * 8; }
    const int sw = (l15 >> 1) & 7;
    int aoff[2], boff[2];
#pragma unroll
    for (int ks = 0; ks < 2; ++ks) { const int c = ((ks * 4 + quad) ^ sw) * 16; aoff[ks] = (wr * (WM * 16) + l15) * 128 + c; boff[ks] = ABYTES + (wc * 64 + l15) * 128 + c; }
    int ls = jx, lkt = 0; const bf16_t* lA = nullptr; const bf16_t* lB = nullptr; bool lvalid;
#define GEMM_DECODE_L() do { const int q_ = ls / per, rem_ = ls % per, sr_ = x + nx * q_; lvalid = sr_ < SRtot; if (lvalid) { const int R_ = sr_ * 8 + (rem_ & 7), b_ = R_ / MTT; \
        lA = p.A + ad.a_off(b_) + (size_t)((R_ % MTT) * TM) * p.lda; lB = p.Bt + ad.b_off(b_) + (size_t)((rem_ >> 3) * 256) * p.ldb; } } while (0)
#define GEMM_ISSUE(stg) do { _Pragma("unroll") for (int i_ = 0; i_ < NLA; ++i_) \
        __builtin_amdgcn_global_load_lds((const unsigned*)(lA + offA[i_] + lkt * 64), (GLAS unsigned*)(lds + (stg) * STAGE + (wid + 8 * i_) * 1024), 16, 0, 0); \
        _Pragma("unroll") for (int i_ = 0; i_ < 4; ++i_) \
        __builtin_amdgcn_global_load_lds((const unsigned*)(lB + offB[i_] + lkt * 64), (GLAS unsigned*)(lds + (stg) * STAGE + ABYTES + (wid + 8 * i_) * 1024), 16, 0, 0); \
        ++issued; if (++lkt == KT) { lkt = 0; ls += stride; GEMM_DECODE_L(); } } while (0)
    GEMM_DECODE_L();
    int issued = 0;
    asm volatile("s_waitcnt vmcnt(0)" ::: "memory");
    __syncthreads();
    if (lvalid) GEMM_ISSUE(0);
    if (lvalid) GEMM_ISSUE(1);
    f32x4 acc[WM][4];
#pragma unroll
    for (int i = 0; i < WM; ++i)
#pragma unroll
        for (int j = 0; j < 4; ++j) acc[i][j] = (f32x4){0.f, 0.f, 0.f, 0.f};
    int cs = jx, ckt = 0; bool drain = false;
#pragma unroll 1
    for (int it = 0; it < issued; ++it) {
        if (drain || issued - it - 1 == 0) asm volatile("s_waitcnt vmcnt(0)" ::: "memory");
        else asm volatile("s_waitcnt vmcnt(%0)" :: "n"(NLA + 4) : "memory");
        drain = false;
        __builtin_amdgcn_s_barrier();
        asm volatile("" ::: "memory");
        const GLAS unsigned char* st = lds + (it & 1) * STAGE;
        bf16x8 af[WM], bfr[4];
#pragma unroll
        for (int i = 0; i < 4; ++i) bfr[i] = *(const GLAS bf16x8*)(st + boff[0] + i * 2048);
#pragma unroll
        for (int i = 0; i < WM; ++i) af[i] = *(const GLAS bf16x8*)(st + aoff[0] + i * 2048);
#pragma unroll
        for (int mi = 0; mi < WM; ++mi)
#pragma unroll
            for (int ni = 0; ni < 4; ++ni) acc[mi][ni] = __builtin_amdgcn_mfma_f32_16x16x32_bf16(bfr[ni], af[mi], acc[mi][ni], 0, 0, 0);
#pragma unroll
        for (int i = 0; i < 4; ++i) bfr[i] = *(const GLAS bf16x8*)(st + boff[1] + i * 2048);
#pragma unroll
        for (int i = 0; i < WM; ++i) af[i] = *(const GLAS bf16x8*)(st + aoff[1] + i * 2048);
        asm volatile("s_waitcnt lgkmcnt(0)" ::: "memory");
        __builtin_amdgcn_s_barrier();
        asm volatile("" ::: "memory");
        if (lvalid) GEMM_ISSUE(it & 1);
        asm volatile("" ::: "memory");
#pragma unroll
        for (int mi = 0; mi < WM; ++mi)
#pragma unroll
            for (int ni = 0; ni < 4; ++ni) acc[mi][ni] = __builtin_amdgcn_mfma_f32_16x16x32_bf16(bfr[ni], af[mi], acc[mi][ni], 0, 0, 0);
        if (++ckt == KT) {
            const int q_ = cs / per, rem_ = cs % per, R_ = (x + nx * q_) * 8 + (rem_ & 7);
#pragma unroll
            for (int h = 0; h < WM / 4; ++h)
                epi(reinterpret_cast<const f32x4 (&)[4][4]>(acc[4 * h]), R_ / MTT, (R_ % MTT) * TM + wr * (WM * 16) + h * 64, (rem_ >> 3) * 256 + wc * 64, l15, quad);
#pragma unroll
            for (int i = 0; i < WM; ++i)
#pragma unroll
                for (int j = 0; j < 4; ++j) acc[i][j] = (f32x4){0.f, 0.f, 0.f, 0.f};
            ckt = 0; cs += stride; drain = true;
        }
    }
    asm volatile("s_waitcnt vmcnt(0) lgkmcnt(0)" ::: "memory");
    __syncthreads();
#undef GEMM_DECODE_L
#undef GEMM_ISSUE
}
struct AddrNone { DEV size_t a_off(int) const { return 0; } DEV size_t b_off(int) const { return 0; } };
struct AddrStride { size_t as, bs; DEV size_t a_off(int b) const { return as * b; } DEV size_t b_off(int b) const { return bs * b; } };
struct AddrCmp1 { DEV size_t a_off(int b) const { return (size_t)b * 2048 * 64; } DEV size_t b_off(int b) const { return (size_t)((b >> 2) & 1) * 256 * 2048; } };
struct AddrCmp2 { DEV size_t a_off(int b) const { return (size_t)b * 128 * 256; } DEV size_t b_off(int b) const { return (size_t)((b >> 2) & 1) * 256 * 256; } };

#define EPI_ARGS const f32x4 (&acc)[4][4], int batch, int m0, int n0, int l15, int quad
struct EpiIn {
    bf16_t *UH, *Qb, *KVC, *KS, *VST, *KW, *VWT, *GM; float* GN;
    DEV void operator()(EPI_ARGS) const {
#pragma unroll
        for (int mi = 0; mi < 4; ++mi) {
            const int t = m0 + mi * 16 + l15, b = t >> 11, tt = t & 2047;
#pragma unroll
            for (int ni = 0; ni < 4; ++ni) {
                const f32x4 v = acc[mi][ni];
                const int c = n0 + ni * 16 + quad * 4;
                if (n0 < 512) {
                    const int g = c >> 4;
                    st_bf4(UH + ((size_t)((g * 16 + b) * 64 + (tt >> 5))) * 640 + (tt & 31) * 16 + (c & 15), v[0], v[1], v[2], v[3]);
                } else if (n0 < 1536) {
                    const float sc = 0.125f * LOG2E;
                    st_bf4(Qb + (size_t)t * 1024 + (c - 512), v[0] * sc, v[1] * sc, v[2] * sc, v[3] * sc);
                } else if (n0 < 2048) {
                    const int cc = c - 1536, z = cc >> 8, h = (cc >> 6) & 3, d = cc & 63;
                    st_bf4(KVC + ((size_t)(((b * 2 + z) * 4 + h) * 2048 + tt)) * 64 + d, v[0], v[1], v[2], v[3]);
                } else if (n0 < 3072) {
                    const int cc = (c - 2048) & 511, isw = (c - 2048) >> 9, h = (cc >> 6) & 3, d = cc & 63;
                    if (cc < 256) st_bf4((isw ? KW : KS) + ((size_t)((b * 4 + h) * 2048 + tt)) * 64 + d, v[0], v[1], v[2], v[3]);
                    else { bf16_t* o = (isw ? VWT : VST) + ((size_t)((b * 4 + h) * 64 + d)) * 2048 + tt;
#pragma unroll
                        for (int i = 0; i < 4; ++i) o[(size_t)i * 2048] = f2bf(v[i]); }
                } else if (n0 < 5120) {
                    st_bf4(GM + (size_t)t * 2048 + (c - 3072), sigmoidf_(v[0]), sigmoidf_(v[1]), sigmoidf_(v[2]), sigmoidf_(v[3]));
                } else {
                    const int cc = c - 5120;
                    if (cc < 48) *(f32x4*)(GN + (size_t)t * 48 + cc) = (f32x4){sigmoidf_(v[0]), sigmoidf_(v[1]), sigmoidf_(v[2]), sigmoidf_(v[3])};
                }
            }
        }
    }
};
struct EpiXkv {
    bf16_t *XK, *XVT;
    DEV void operator()(EPI_ARGS) const {
#pragma unroll
        for (int mi = 0; mi < 4; ++mi) {
            const int r = m0 + mi * 16 + l15, b = r >> 8, m = r & 255;
#pragma unroll
            for (int ni = 0; ni < 4; ++ni) {
                const f32x4 v = acc[mi][ni]; const int c = n0 + ni * 16 + quad * 4;
                if (n0 < 1024) st_bf4(XK + (size_t)r * 1024 + c, v[0], v[1], v[2], v[3]);
                else { const int cc = c - 1024, h = cc >> 8, d = cc & 255; bf16_t* o = XVT + ((size_t)((b * 4 + h) * 256 + d)) * 256 + m;
#pragma unroll
                    for (int i = 0; i < 4; ++i) o[i * 256] = f2bf(v[i]); }
            }
        }
    }
};
struct EpiSsmA { float* SS;
    DEV void operator()(EPI_ARGS) const {
        if (n0 >= 128) return;
#pragma unroll
        for (int mi = 0; mi < 4; ++mi)
#pragma unroll
            for (int ni = 0; ni < 4; ++ni) *(f32x4*)(SS + ((size_t)batch * 1024 + m0 + mi * 16 + l15) * 128 + n0 + ni * 16 + quad * 4) = acc[mi][ni];
    }
};
struct EpiCmp1 { bf16_t* HID; const float* bias2;
    DEV void operator()(EPI_ARGS) const {
        const int z = (batch >> 2) & 1;
#pragma unroll
        for (int ni = 0; ni < 4; ++ni) {
            const int c = n0 + ni * 16 + quad * 4; const f32x4 bv = *(const f32x4*)(bias2 + z * 256 + c);
#pragma unroll
            for (int mi = 0; mi < 4; ++mi) { const f32x4 v = acc[mi][ni] + bv;
                st_bf4(HID + ((size_t)batch * 128 + m0 + mi * 16 + l15) * 256 + c, gelu_tanh(v[0]), gelu_tanh(v[1]), gelu_tanh(v[2]), gelu_tanh(v[3])); }
        }
    }
};
struct EpiCmp2 { bf16_t *KC, *VCT;
    DEV void operator()(EPI_ARGS) const {
        if (n0 >= 64) return;
        const int z = (batch >> 2) & 1, bh = (batch >> 3) * 4 + (batch & 3);
#pragma unroll
        for (int mi = 0; mi < 4; ++mi) { const int r = m0 + mi * 16 + l15;
#pragma unroll
            for (int ni = 0; ni < 4; ++ni) { const f32x4 v = acc[mi][ni]; const int c = n0 + ni * 16 + quad * 4;
                if (z == 0) st_bf4(KC + ((size_t)bh * 128 + r) * 64 + c, v[0], v[1], v[2], v[3]);
                else {
#pragma unroll
                    for (int i = 0; i < 4; ++i) VCT[((size_t)bh * 64 + c + i) * 128 + r] = f2bf(v[i]); } } }
    }
};
struct EpiSsmB { const bf16_t* UH; const float* dskip; bf16_t* GB;
    DEV void operator()(EPI_ARGS) const {
#pragma unroll
        for (int mi = 0; mi < 4; ++mi) { const int r = m0 + mi * 16 + l15, b = r >> 6, k = r & 63;
#pragma unroll
            for (int ni = 0; ni < 4; ++ni) { const int col = n0 + ni * 16 + quad * 4, tau = col >> 4, c = col & 15;
                const f32x4 u = ld_bf4(UH + ((size_t)batch * 1024 + r) * 640 + col);
                const f32x4 dv = *(const f32x4*)(dskip + batch * 16 + c);
                const f32x4 y = acc[mi][ni] + dv * u;
                st_bf4(GB + ((size_t)(b * 2048 + k * 32 + tau)) * 512 + batch * 16 + c, gelu_tanh(y[0]), gelu_tanh(y[1]), gelu_tanh(y[2]), gelu_tanh(y[3])); } }
    }
};
struct EpiGlu { const bf16_t* GB; const float* bglu; bf16_t* YS;
    DEV void operator()(EPI_ARGS) const {
#pragma unroll
        for (int ni = 0; ni < 4; ++ni) { const int c = n0 + ni * 16 + quad * 4; const f32x4 bv = *(const f32x4*)(bglu + c);
#pragma unroll
            for (int mi = 0; mi < 4; ++mi) { const size_t o = (size_t)(m0 + mi * 16 + l15) * 512 + c; const f32x4 g = ld_bf4(GB + o); const f32x4 v = acc[mi][ni] + bv;
                st_bf4(YS + o, g[0] * sigmoidf_(v[0]), g[1] * sigmoidf_(v[1]), g[2] * sigmoidf_(v[2]), g[3] * sigmoidf_(v[3])); } }
    }
};
struct EpiSout { const bf16_t* GM; bf16_t* P1;
    DEV void operator()(EPI_ARGS) const {
#pragma unroll
        for (int mi = 0; mi < 4; ++mi) { const size_t t = m0 + mi * 16 + l15;
#pragma unroll
            for (int ni = 0; ni < 4; ++ni) { const int c = n0 + ni * 16 + quad * 4; const f32x4 g = ld_bf4(GM + t * 2048 + c); const f32x4 v = acc[mi][ni] * g;
                st_bf4(P1 + t * 1024 + c, v[0], v[1], v[2], v[3]); } }
    }
};
struct EpiNout { const bf16_t* GM; const bf16_t* P1; bf16_t* MIX;
    DEV void operator()(EPI_ARGS) const {
#pragma unroll
        for (int mi = 0; mi < 4; ++mi) { const size_t t = m0 + mi * 16 + l15;
#pragma unroll
            for (int ni = 0; ni < 4; ++ni) { const int c = n0 + ni * 16 + quad * 4; const f32x4 g = ld_bf4(GM + t * 2048 + 1024 + c); const f32x4 v = acc[mi][ni] * g + ld_bf4(P1 + t * 1024 + c);
                st_bf4(MIX + t * 1024 + c, v[0], v[1], v[2], v[3]); } }
    }
};
struct EpiRes { const float* src; const float* stats; const float* g; const float* b; float* dst;
    DEV void operator()(EPI_ARGS) const {
#pragma unroll
        for (int mi = 0; mi < 4; ++mi) { const size_t t = m0 + mi * 16 + l15; const float mu = stats[t * 2], rs = stats[t * 2 + 1];
#pragma unroll
            for (int ni = 0; ni < 4; ++ni) { const int c = n0 + ni * 16 + quad * 4;
                const f32x4 xv = *(const f32x4*)(src + t * 1024 + c), gg = *(const f32x4*)(g + c), bb = *(const f32x4*)(b + c);
                *(f32x4*)(dst + t * 1024 + c) = ((xv - mu) * rs * gg + bb) * ALPHA + acc[mi][ni]; } }
    }
};
struct EpiScaleBf { bf16_t* O; int ldc; float sc;
    DEV void operator()(EPI_ARGS) const {
#pragma unroll
        for (int mi = 0; mi < 4; ++mi)
#pragma unroll
            for (int ni = 0; ni < 4; ++ni) { const f32x4 v = acc[mi][ni] * sc; st_bf4(O + (size_t)(m0 + mi * 16 + l15) * ldc + n0 + ni * 16 + quad * 4, v[0], v[1], v[2], v[3]); }
    }
};
struct EpiFfnIn { bf16_t* FB;
    DEV void operator()(EPI_ARGS) const {
#pragma unroll
        for (int mi = 0; mi < 4; ++mi) { const size_t t = m0 + mi * 16 + l15;
#pragma unroll
            for (int pp = 0; pp < 2; ++pp) { const f32x4 ga = acc[mi][2 * pp], up = acc[mi][2 * pp + 1]; const int j = (n0 + pp * 32) / 2 + quad * 4;
                st_bf4(FB + t * 2816 + j, ga[0] * sigmoidf_(ga[0]) * up[0], ga[1] * sigmoidf_(ga[1]) * up[1], ga[2] * sigmoidf_(ga[2]) * up[2], ga[3] * sigmoidf_(ga[3]) * up[3]); } }
    }
};

DEV float qmax(float v) { auto a = __builtin_amdgcn_permlane16_swap(__float_as_uint(v), __float_as_uint(v), false, false); v = fmaxf(__uint_as_float(a[0]), __uint_as_float(a[1]));
    auto b = __builtin_amdgcn_permlane32_swap(__float_as_uint(v), __float_as_uint(v), false, false); return fmaxf(__uint_as_float(b[0]), __uint_as_float(b[1])); }
DEV float qsum(float v) { auto a = __builtin_amdgcn_permlane16_swap(__float_as_uint(v), __float_as_uint(v), false, false); v = __uint_as_float(a[0]) + __uint_as_float(a[1]);
    auto b = __builtin_amdgcn_permlane32_swap(__float_as_uint(v), __float_as_uint(v), false, false); return __uint_as_float(b[0]) + __uint_as_float(b[1]); }
DEV bf16x8 pack_p(const f32x4& a, const f32x4& b) { u32x4 w; w.x = cvt_pk_bf16(a[0], a[1]); w.y = cvt_pk_bf16(a[2], a[3]); w.z = cvt_pk_bf16(b[0], b[1]); w.w = cvt_pk_bf16(b[2], b[3]); return __builtin_bit_cast(bf16x8, w); }
DEV void st_vt(unsigned char* rowbase, int e, const u32x4& v) {
    const int grp = e >> 2, ep = e & 3, a = ep >> 1, qp = (ep & 1) * 2;
    unsigned char* o = rowbase + grp * 64 + (qp * 8 + a * 4) * 2;
    *(u32x2*)o = (u32x2){v.x, v.y}; *(u32x2*)(o + 16) = (u32x2){v.z, v.w};
}

struct NsaCtx { const bf16_t *Qb, *KC, *VCT, *KS, *VST, *KW, *VWT; const float* GN; bf16_t* ON; };
constexpr float MINIT = -1e20f;

template <int MODE, bool BOUND>
DEV void nsa_tile(const unsigned char* Kl, const unsigned char* Vl, const bf16x8 (&Qf)[2][2], f32x4 (&O)[2][4], float (&m)[2], float (&l)[2],
                  const float (&slope)[2], int dist0, bool sel, int l15, int quad) {
    const float d0f = (float)dist0;
#pragma unroll
    for (int g = 0; g < 2; ++g) {
        f32x4 S[4];
#pragma unroll
        for (int kt = 0; kt < 4; ++kt) { S[kt] = (f32x4){0.f, 0.f, 0.f, 0.f};
#pragma unroll
            for (int ks = 0; ks < 2; ++ks) { const bf16x8 kf = *(const bf16x8*)(Kl + (kt * 16 + l15) * 144 + ks * 64 + quad * 16); S[kt] = __builtin_amdgcn_mfma_f32_16x16x32_bf16(kf, Qf[g][ks], S[kt], 0, 0, 0); } }
        float base = -slope[g] * d0f;
        if (MODE == 0) base = sel ? base : NEG;
        typedef float f2 __attribute__((ext_vector_type(2)));
        const f2 sl_lo = {0.f, slope[g]}, sl_hi = {2.f * slope[g], 3.f * slope[g]};
        float tmax = NEG;
        f2 Slo[4], Shi[4];
#pragma unroll
        for (int kt = 0; kt < 4; ++kt) {
            const float bk = fmaf(slope[g], (float)(16 * kt), base);
            f2 lo = (f2){S[kt][0], S[kt][1]} + (sl_lo + bk), hi = (f2){S[kt][2], S[kt][3]} + (sl_hi + bk);
            if (BOUND) {
#pragma unroll
                for (int i = 0; i < 4; ++i) { const int cc = 16 * kt + i; bool v = cc <= dist0; if (MODE == 1) v = v && (cc > dist0 - 512);
                    if (i < 2) lo[i] = v ? lo[i] : NEG; else hi[i - 2] = v ? hi[i - 2] : NEG; }
            }
            Slo[kt] = lo; Shi[kt] = hi;
            tmax = fmaxf(fmaxf(tmax, lo[0]), lo[1]); tmax = fmaxf(fmaxf(tmax, hi[0]), hi[1]);
        }
        tmax = qmax(tmax);
        const float mnew = fmaxf(m[g], tmax), alpha = fexp2(m[g] - mnew);
        f2 rs2 = {0.f, 0.f};
#pragma unroll
        for (int kt = 0; kt < 4; ++kt) {
            const f2 a = Slo[kt] - mnew, b = Shi[kt] - mnew;
            const f2 pa = {fexp2(a[0]), fexp2(a[1])}, pb = {fexp2(b[0]), fexp2(b[1])};
            rs2 += pa; rs2 += pb;
            S[kt] = (f32x4){pa[0], pa[1], pb[0], pb[1]};
        }
        l[g] = l[g] * alpha + (rs2[0] + rs2[1]); m[g] = mnew;
        const bf16x8 P0 = pack_p(S[0], S[1]), P1 = pack_p(S[2], S[3]);
#pragma unroll
        for (int dt = 0; dt < 4; ++dt) { O[g][dt] = O[g][dt] * alpha;
            const bf16x8 v0 = *(const bf16x8*)(Vl + (dt * 16 + l15) * 144 + quad * 16), v1 = *(const bf16x8*)(Vl + (dt * 16 + l15) * 144 + 64 + quad * 16);
            O[g][dt] = __builtin_amdgcn_mfma_f32_16x16x32_bf16(v0, P0, O[g][dt], 0, 0, 0);
            O[g][dt] = __builtin_amdgcn_mfma_f32_16x16x32_bf16(v1, P1, O[g][dt], 0, 0, 0); }
    }
}

template <int MODE>
DEV void nsa_tiles(unsigned char* lds, const bf16_t* Kg, const bf16_t* VTg, unsigned tilemask, unsigned wmask, unsigned qmask, int jb0, int jb1,
                   const bf16x8 (&Qf)[2][2], f32x4 (&O)[2][4], float (&m)[2], float (&l)[2], const float (&slope)[2], int tq, int l15, int quad) {
    const int tid = get_tid();
    const int prow = tid >> 3, pe = tid & 7;
    unsigned rem = tilemask;
    int j = __builtin_ctz(rem); rem &= rem - 1;
    u32x4 rk, rv;
    rk = *(const u32x4*)(Kg + (size_t)(64 * j + prow) * 64 + pe * 8); rv = *(const u32x4*)(VTg + (size_t)prow * 2048 + 64 * j + pe * 8);
    int cur = 0;
    *(u32x4*)(lds + prow * 144 + pe * 16) = rk; st_vt(lds + 9216 + prow * 144, pe, rv);
    __syncthreads();
    for (;;) {
        int jn = -1;
        if (rem) { jn = __builtin_ctz(rem); rem &= rem - 1;
            rk = *(const u32x4*)(Kg + (size_t)(64 * jn + prow) * 64 + pe * 8); rv = *(const u32x4*)(VTg + (size_t)prow * 2048 + 64 * jn + pe * 8); }
        __builtin_amdgcn_sched_barrier(0);
        const unsigned char* st = lds + cur * 18432;
        if (MODE == 1 || ((wmask >> j) & 1u)) {
            const int dist0 = tq - 64 * j - 4 * quad; const bool sel = (qmask >> j) & 1u;
            if (j == jb0 || j == jb1) nsa_tile<MODE, true>(st, st + 9216, Qf, O, m, l, slope, dist0, sel, l15, quad);
            else nsa_tile<MODE, false>(st, st + 9216, Qf, O, m, l, slope, dist0, sel, l15, quad);
        }
        if (jn >= 0) { unsigned char* sn = lds + (cur ^ 1) * 18432; *(u32x4*)(sn + prow * 144 + pe * 16) = rk; st_vt(sn + 9216 + prow * 144, pe, rv); }
        __syncthreads();
        if (jn < 0) break;
        j = jn; cur ^= 1;
    }
}

DEV void nsa_unit(const NsaCtx& c, int b, int hkv, int qb, unsigned char* lds) {
    const int tid = get_tid(), lane = tid & 63, wid = tid >> 6, l15 = lane & 15, quad = lane >> 4;
    const int qs = wid & 3, hp = wid >> 2;
    const int tq = qb * 64 + qs * 16 + l15, cur = qb;
    const size_t trow = (size_t)b * 2048 + tq;
    const int head0 = hkv * 4 + hp * 2;
    const float* gnp = c.GN + trow * 48 + head0 * 3;
    unsigned char* stash = lds + 36864 + wid * 4096;
    float* xch = (float*)(lds + 69632);
    unsigned* smask = (unsigned*)(lds + 102400);
    const int bh = b * 4 + hkv;
    {
        const bf16_t* Kg = c.KC + (size_t)bh * 128 * 64; const bf16_t* Vg = c.VCT + (size_t)bh * 64 * 128;
#pragma unroll
        for (int i = 0; i < 2; ++i) { const int pc = tid + 512 * i;
            *(u32x4*)(lds + (pc >> 3) * 144 + (pc & 7) * 16) = *(const u32x4*)(Kg + pc * 8);
            st_vt(lds + 18432 + (pc >> 4) * 272, pc & 15, *(const u32x4*)(Vg + pc * 8)); }
    }
    __syncthreads();
    const int nkt = (4 * qb + 2) / 16 + 1;
    float Mx[8], Sm[8];
#pragma unroll
    for (int kt = 0; kt < 8; ++kt) { Mx[kt] = NEG; Sm[kt] = 0.f; }
#ifdef NSA_NO_CMP
    for (int g = 0; g < 0; ++g) {
#else
#pragma unroll 1
    for (int g = 0; g < 2; ++g) {
#endif
        bf16x8 Qg[2];
#pragma unroll
        for (int ks = 0; ks < 2; ++ks) Qg[ks] = *(const bf16x8*)(c.Qb + trow * 1024 + (head0 + g) * 64 + ks * 32 + quad * 8);
        const float slope_g = exp2f(-0.5f * (float)(head0 + g + 1)) * LOG2E;
        f32x4 S[8];
#pragma unroll
        for (int kt = 0; kt < 8; ++kt) { S[kt] = (f32x4){0.f, 0.f, 0.f, 0.f};
            if (kt < nkt) {
#pragma unroll
                for (int ks = 0; ks < 2; ++ks) { const bf16x8 kf = *(const bf16x8*)(lds + (kt * 16 + l15) * 144 + ks * 64 + quad * 16); S[kt] = __builtin_amdgcn_mfma_f32_16x16x32_bf16(kf, Qg[ks], S[kt], 0, 0, 0); } } }
        float mx = NEG;
        const int d0 = tq - 31 - 64 * quad; const float base = -slope_g * (float)d0;
#pragma unroll
        for (int kt = 0; kt < 8; ++kt)
#pragma unroll
            for (int i = 0; i < 4; ++i) { const int cc = 256 * kt + 16 * i; const float s = (kt < nkt && cc <= d0) ? fmaf(slope_g, (float)cc, S[kt][i] + base) : NEG; S[kt][i] = s; mx = fmaxf(mx, s); }
        mx = qmax(mx);
        float ls = 0.f;
#pragma unroll
        for (int kt = 0; kt < 8; ++kt)
#pragma unroll
            for (int i = 0; i < 4; ++i) ls += S[kt][i] > -1e29f ? fexp2(S[kt][i] - mx) : 0.f;
        ls = qsum(ls);
        const float lcl = fmaxf(ls, 1e-30f), lg = __log2f(lcl) + mx;
        float x3[8];
#pragma unroll
        for (int kt = 0; kt < 8; ++kt) {
#pragma unroll
            for (int i = 0; i < 4; ++i) S[kt][i] = S[kt][i] > -1e29f ? S[kt][i] - lg : NEG;
            x3[kt] = __shfl(S[kt][3], (lane + 48) & 63);
        }
#pragma unroll
        for (int kt = 0; kt < 8; ++kt) {
            const float nb = quad >= 1 ? x3[kt] : (kt >= 1 ? x3[kt >= 1 ? kt - 1 : 0] : NEG);
            const float tm = fmaxf(fmaxf(fmaxf(S[kt][0], S[kt][1]), fmaxf(S[kt][2], S[kt][3])), nb);
            const float nm = fmaxf(Mx[kt], tm);
            Sm[kt] = Sm[kt] * fexp2(Mx[kt] - nm) + fexp2(S[kt][0] - nm) + fexp2(S[kt][1] - nm) + fexp2(S[kt][2] - nm) + fexp2(S[kt][3] - nm) + fexp2(nb - nm);
            Mx[kt] = nm;
        }
        const float gate0 = gnp[g * 3];
        f32x4 Oc[4];
#pragma unroll
        for (int dt = 0; dt < 4; ++dt) Oc[dt] = (f32x4){0.f, 0.f, 0.f, 0.f};
#pragma unroll
        for (int k2 = 0; k2 < 4; ++k2) {
            if (2 * k2 < nkt) {
                f32x4 pa, pb;
#pragma unroll
                for (int i = 0; i < 4; ++i) { pa[i] = fexp2(S[2 * k2][i]); pb[i] = fexp2(S[2 * k2 + 1][i]); }
                const bf16x8 pf = pack_p(pa, pb);
#pragma unroll
                for (int dt = 0; dt < 4; ++dt) { const bf16x8 vf = *(const bf16x8*)(lds + 18432 + (dt * 16 + l15) * 272 + k2 * 64 + quad * 16); Oc[dt] = __builtin_amdgcn_mfma_f32_16x16x32_bf16(vf, pf, Oc[dt], 0, 0, 0); }
            }
        }
#pragma unroll
        for (int dt = 0; dt < 4; ++dt) { const f32x4 v = Oc[dt] * gate0; u32x2 w; w.x = cvt_pk_bf16(v[0], v[1]); w.y = cvt_pk_bf16(v[2], v[3]); *(u32x2*)(stash + ((g * 4 + dt) * 64 + lane) * 8) = w; }
    }
    unsigned qmask;
    if (cur < 8) qmask = (2u << cur) - 1u;
    if (cur >= 8) {
#pragma unroll
        for (int kt = 0; kt < 8; ++kt) { xch[(wid * 16 + kt) * 64 + lane] = Mx[kt]; xch[(wid * 16 + 8 + kt) * 64 + lane] = Sm[kt]; }
    }
    __syncthreads();
    if (cur >= 8) {
        float v[8];
#pragma unroll
        for (int kt = 0; kt < 8; ++kt) {
            const float m2 = xch[((wid ^ 4) * 16 + kt) * 64 + lane], s2 = xch[((wid ^ 4) * 16 + 8 + kt) * 64 + lane];
            const float mm = fmaxf(Mx[kt], m2), ss = Sm[kt] * fexp2(Mx[kt] - mm) + s2 * fexp2(m2 - mm);
            const int jb = 4 * kt + quad; v[kt] = (jb >= 1 && jb <= cur - 2) ? mm + __log2f(ss) : -3e38f; }
        qmask = 1u | (1u << cur) | (1u << (cur - 1));
        for (int r = 0; r < 5; ++r) {
            float bv = v[0]; int bj = quad;
#pragma unroll
            for (int kt = 1; kt < 8; ++kt) if (v[kt] > bv) { bv = v[kt]; bj = 4 * kt + quad; }
#pragma unroll
            for (int o = 16; o <= 32; o <<= 1) { const float ov = __shfl_xor(bv, o); const int oj = __shfl_xor(bj, o); if (ov > bv || (ov == bv && oj < bj)) { bv = ov; bj = oj; } }
            qmask |= 1u << bj;
#pragma unroll
            for (int kt = 0; kt < 8; ++kt) if (4 * kt + quad == bj) v[kt] = -3.2e38f;
        }
    }
    unsigned wmask = qmask;
#pragma unroll
    for (int o = 1; o <= 8; o <<= 1) wmask |= __shfl_xor(wmask, o);
    if (lane == 0) smask[wid] = wmask;
    __syncthreads();
    const unsigned umask = (smask[0] | smask[1] | smask[2] | smask[3]) | (smask[4] | smask[5] | smask[6] | smask[7]);
    bf16x8 Qf[2][2]; float slope[2];
#pragma unroll
    for (int g = 0; g < 2; ++g) {
#pragma unroll
        for (int ks = 0; ks < 2; ++ks) Qf[g][ks] = *(const bf16x8*)(c.Qb + trow * 1024 + (head0 + g) * 64 + ks * 32 + quad * 8);
        slope[g] = exp2f(-0.5f * (float)(head0 + g + 1)) * LOG2E;
    }
    f32x4 O[2][4]; float m[2], l[2];
#pragma unroll
    for (int g = 0; g < 2; ++g) { m[g] = MINIT; l[g] = 0.f;
#pragma unroll
        for (int dt = 0; dt < 4; ++dt) O[g][dt] = (f32x4){0.f, 0.f, 0.f, 0.f}; }
#ifndef NSA_NO_SLC
    nsa_tiles<0>(lds, c.KS + (size_t)bh * 2048 * 64, c.VST + (size_t)bh * 64 * 2048, umask, wmask, qmask, cur, cur, Qf, O, m, l, slope, tq, l15, quad);
#endif
#pragma unroll
    for (int g = 0; g < 2; ++g) { const float sc = gnp[g * 3 + 1] / fmaxf(qsum(l[g]), 1e-30f);
#pragma unroll
        for (int dt = 0; dt < 4; ++dt) { u32x2* sp = (u32x2*)(stash + ((g * 4 + dt) * 64 + lane) * 8); const u32x2 w = *sp;
            const f32x4 v = O[g][dt] * sc + (f32x4){bflo(w.x), bfhi(w.x), bflo(w.y), bfhi(w.y)};
            u32x2 w2; w2.x = cvt_pk_bf16(v[0], v[1]); w2.y = cvt_pk_bf16(v[2], v[3]); *sp = w2;
            O[g][dt] = (f32x4){0.f, 0.f, 0.f, 0.f}; }
        m[g] = MINIT; l[g] = 0.f; }
    const int jlo = qb >= 8 ? qb - 8 : 0;
    const unsigned winmask = ((2u << cur) - 1u) & ~((1u << jlo) - 1u);
#ifndef NSA_NO_WIN
    nsa_tiles<1>(lds, c.KW + (size_t)bh * 2048 * 64, c.VWT + (size_t)bh * 64 * 2048, winmask, 0u, 0u, cur, jlo, Qf, O, m, l, slope, tq, l15, quad);
#endif
#pragma unroll
    for (int g = 0; g < 2; ++g) { const float sc = gnp[g * 3 + 2] / fmaxf(qsum(l[g]), 1e-30f);
#pragma unroll
        for (int dt = 0; dt < 4; ++dt) { const u32x2 w = *(const u32x2*)(stash + ((g * 4 + dt) * 64 + lane) * 8);
            const f32x4 v = O[g][dt] * sc + (f32x4){bflo(w.x), bfhi(w.x), bflo(w.y), bfhi(w.y)};
            st_bf4(c.ON + trow * 1024 + (head0 + g) * 64 + dt * 16 + quad * 4, v[0], v[1], v[2], v[3]); } }
}

DEV void xattn_unit(const bf16_t* Qx, const bf16_t* XK, const bf16_t* XVT, bf16_t* OX, int b, int h, int qblk  , unsigned char* lds) {
    const int tid = get_tid(), lane = tid & 63, wid = tid >> 6, l15 = lane & 15, quad = lane >> 4;
    const size_t trow = (size_t)b * 2048 + qblk * 128 + wid * 16 + l15;
    bf16x8 Qf[8];
#pragma unroll
    for (int ks = 0; ks < 8; ++ks) Qf[ks] = *(const bf16x8*)(Qx + trow * 1024 + h * 256 + ks * 32 + quad * 8);
    f32x4 O[16];
#pragma unroll
    for (int dt = 0; dt < 16; ++dt) O[dt] = (f32x4){0.f, 0.f, 0.f, 0.f};
    float m = NEG, l = 0.f;
    const bf16_t* Kg = XK + (size_t)b * 256 * 1024 + h * 256;
    const bf16_t* Vg = XVT + (size_t)(b * 4 + h) * 256 * 256;
    u32x4 rk[2], rv[2];
#pragma unroll
    for (int i = 0; i < 2; ++i) { const int pc = tid + 512 * i; rk[i] = *(const u32x4*)(Kg + (size_t)(pc >> 5) * 1024 + (pc & 31) * 8); rv[i] = *(const u32x4*)(Vg + (size_t)(pc >> 2) * 256 + (pc & 3) * 8); }
#pragma unroll
    for (int i = 0; i < 2; ++i) { const int pc = tid + 512 * i; *(u32x4*)(lds + (pc >> 5) * 528 + (pc & 31) * 16) = rk[i]; st_vt(lds + 16896 + (pc >> 2) * 80, pc & 3, rv[i]); }
    __syncthreads();
    for (int j = 0; j < 8; ++j) {
        const bool more = j + 1 < 8;
        if (more) {
#pragma unroll
            for (int i = 0; i < 2; ++i) { const int pc = tid + 512 * i; rk[i] = *(const u32x4*)(Kg + (size_t)(32 * (j + 1) + (pc >> 5)) * 1024 + (pc & 31) * 8); rv[i] = *(const u32x4*)(Vg + (size_t)(pc >> 2) * 256 + 32 * (j + 1) + (pc & 3) * 8); } }
        __builtin_amdgcn_sched_barrier(0);
        const unsigned char* st = lds + (j & 1) * 37376;
        f32x4 S[2];
#pragma unroll
        for (int kt = 0; kt < 2; ++kt) { S[kt] = (f32x4){0.f, 0.f, 0.f, 0.f};
#pragma unroll
            for (int ks = 0; ks < 8; ++ks) { const bf16x8 kf = *(const bf16x8*)(st + (kt * 16 + l15) * 528 + ks * 64 + quad * 16); S[kt] = __builtin_amdgcn_mfma_f32_16x16x32_bf16(kf, Qf[ks], S[kt], 0, 0, 0); } }
        float tmax = fmaxf(fmaxf(fmaxf(S[0][0], S[0][1]), fmaxf(S[0][2], S[0][3])), fmaxf(fmaxf(S[1][0], S[1][1]), fmaxf(S[1][2], S[1][3])));
        tmax = qmax(tmax);
        const float mnew = fmaxf(m, tmax), alpha = fexp2(m - mnew);
        float rs = 0.f;
#pragma unroll
        for (int kt = 0; kt < 2; ++kt)
#pragma unroll
            for (int i = 0; i < 4; ++i) { const float pv = fexp2(S[kt][i] - mnew); S[kt][i] = pv; rs += pv; }
        l = l * alpha + rs; m = mnew;
        const bf16x8 pf = pack_p(S[0], S[1]);
#pragma unroll
        for (int dt = 0; dt < 16; ++dt) { O[dt] = O[dt] * alpha; const bf16x8 vf = *(const bf16x8*)(st + 16896 + (dt * 16 + l15) * 80 + quad * 16); O[dt] = __builtin_amdgcn_mfma_f32_16x16x32_bf16(vf, pf, O[dt], 0, 0, 0); }
        if (more) { unsigned char* sn = lds + ((j + 1) & 1) * 37376;
#pragma unroll
            for (int i = 0; i < 2; ++i) { const int pc = tid + 512 * i; *(u32x4*)(sn + (pc >> 5) * 528 + (pc & 31) * 16) = rk[i]; st_vt(sn + 16896 + (pc >> 2) * 80, pc & 3, rv[i]); } }
        __syncthreads();
    }
    const float inv = 1.0f / qsum(l);
#pragma unroll
    for (int dt = 0; dt < 16; ++dt) { const f32x4 v = O[dt] * inv; st_bf4(OX + trow * 1024 + h * 256 + dt * 16 + quad * 4, v[0], v[1], v[2], v[3]); }
}


#define XB_TMO      128
#define XB_XCNT(j)  (256  + 64 * (j))
#define XB_XSUB(j)  (1280 + 64 * (j))
#define XB_XGEN(j)  (2304 + 64 * (j))
#define XB_TOP      3328
#define XB_TOPGEN   3392
#define XCD_BAR_WORDS 3456
#define XB_SPIN_CAP (1u << 18)
#define LAS __attribute__((address_space(3)))
DEV unsigned xb_ld(unsigned* p)              { return __hip_atomic_load(p, __ATOMIC_RELAXED, __HIP_MEMORY_SCOPE_AGENT); }
DEV unsigned xb_add(unsigned* p, unsigned v) { return __hip_atomic_fetch_add(p, v, __ATOMIC_RELAXED, __HIP_MEMORY_SCOPE_AGENT); }
DEV unsigned xb_xcc_id() { return (unsigned)__builtin_amdgcn_s_getreg((3 << 11) | 20) & 0xFu; }
#define XB_SPIN(cond, bar) do { unsigned _sp = 0; while (cond) { __builtin_amdgcn_s_sleep(1); \
    if ((++_sp & 255u) == 0u) { if (xb_ld(&(bar)[XB_TMO])) break; if (_sp > XB_SPIN_CAP) { atomicAdd(&(bar)[XB_TMO], 1u); break; } } } } while (0)
struct XcdBarrier { unsigned* bar; unsigned x; volatile LAS unsigned* st; };
DEV XcdBarrier xcd_barrier_post(unsigned* bar, volatile LAS unsigned* st) {
    XcdBarrier b; b.bar = bar; b.x = xb_xcc_id(); b.st = st;
    if (threadIdx.x == 0) { st[2] = xb_add(&bar[XB_XCNT(b.x)], 1u); st[3] = b.x; }
    return b;
}
DEV void xcd_barrier_complete(unsigned* bar, unsigned x, unsigned& nloc, unsigned& nx) {
    const unsigned G = gridDim.x * gridDim.y * gridDim.z;
    unsigned sum, cnt, mine, sp = 0u;
    for (;;) {
        sum = 0u; cnt = 0u; mine = 0u;
#pragma unroll
        for (unsigned j = 0; j < 16; ++j) { const unsigned c = xb_ld(&bar[XB_XCNT(j)]); sum += c; cnt += (c > 0u) ? 1u : 0u; mine = (j == x) ? c : mine; }
        if (sum == G) break;
        __builtin_amdgcn_s_sleep(1);
        if ((++sp & 255u) == 0u) { if (xb_ld(&bar[XB_TMO])) break; if (sp > XB_SPIN_CAP) { atomicAdd(&bar[XB_TMO], 1u); break; } }
    }
    nloc = mine > 0u ? mine : 1u; nx = cnt > 0u ? cnt : 1u;
}
DEV void xcd_barrier(const XcdBarrier& b) {
    asm volatile("s_waitcnt vmcnt(0)" ::: "memory");
    __syncthreads();
    if (threadIdx.x == 0) {
        unsigned* bar = b.bar;
        __builtin_amdgcn_s_waitcnt(0);
        unsigned nloc = b.st[0], nx = b.st[1];
        if (nloc == 0u) { xcd_barrier_complete(bar, b.x, nloc, nx); b.st[0] = nloc; b.st[1] = nx; }
        const unsigned old = xb_add(&bar[XB_XSUB(b.x)], 1u);
        const unsigned gen = old / nloc;
        if (old + 1u == (gen + 1u) * nloc) {
            __builtin_amdgcn_fence(__ATOMIC_RELEASE, "agent");
            asm volatile("s_waitcnt vmcnt(0)" ::: "memory");
            const unsigned og = xb_add(&bar[XB_TOP], 1u);
            const unsigned tg = og / nx;
            if (og + 1u == (tg + 1u) * nx) xb_add(&bar[XB_TOPGEN], 1u);
            else XB_SPIN(xb_ld(&bar[XB_TOPGEN]) == tg, bar);
            __builtin_amdgcn_fence(__ATOMIC_ACQUIRE, "agent");
            xb_add(&bar[XB_XGEN(b.x)], 1u);
            asm volatile("s_waitcnt vmcnt(0)" ::: "memory");
        } else {
            XB_SPIN(xb_ld(&bar[XB_XGEN(b.x)]) == gen, bar);
            __builtin_amdgcn_fence(__ATOMIC_ACQUIRE, "agent");
            asm volatile("s_waitcnt vmcnt(0)" ::: "memory");
        }
    }
    __syncthreads();
}

constexpr int NPHASE = 17;
__global__ void __launch_bounds__(512, 2) fwd_kernel(P p) {
    extern __shared__ __attribute__((aligned(16))) unsigned char lds[];
#define WSB(off) ((bf16_t*)(ws + (off)))
#define WSF(off) ((float*)(ws + (off)))
    volatile LAS unsigned* bst = (volatile LAS unsigned*)(LAS unsigned char*)(lds + LDS_BYTES - 16);
    if (threadIdx.x == 0) { bst[0] = 0u; bst[1] = 0u; bst[2] = 0u; bst[3] = 0u; }
    __syncthreads();
    XcdBarrier gbar; gbar.bar = (unsigned*)(p.ws + O_BAR); gbar.x = 0; gbar.st = bst;
    if (p.coop) gbar = xcd_barrier_post((unsigned*)(p.ws + O_BAR), bst);
    const SsmIn sin_{p.in[5], p.in[6], p.in[7], p.in[8], p.in[9], p.in[10], p.in[12]};
    for (int ph = p.ph_lo; ph < p.ph_hi; ++ph) {
        size_t zoff = 0; asm volatile("" : "+s"(zoff)); unsigned char* ws = p.ws + zoff;
        switch (ph) {
#ifdef ONLY_PHASE
        default: break;
#define CASE(k) case (k): if ((k) != ONLY_PHASE) break; else
#else
#define CASE(k) case (k):
#endif
        CASE(0) {
            const int tid = get_tid();
            ln_pass(p.in[0], p.in[2], p.in[3], WSB(O_B), WSF(O_ST0), nullptr);
            int cur = 0;
            conv_job(p.in[4], 5168, 1024, 5376, WSB(O_WIN_T), 1, lds, cur);
            conv_job(p.in[13], 512, 512, 512, WSB(O_WGLU_T), 0, lds, cur);
            conv_job(p.in[15], 1024, 512, 1024, WSB(O_WSOUT_T), 0, lds, cur);
            conv_job(p.in[17], 256, 2048, 256, WSB(O_W1_T), 0, lds, cur);
            conv_job(p.in[17] + 2048 * 256, 256, 2048, 256, WSB(O_W1_T) + 256 * 2048, 0, lds, cur);
            conv_job(p.in[19], 64, 256, 256, WSB(O_W2_T), 3, lds, cur);
            conv_job(p.in[19] + 256 * 64, 64, 256, 256, WSB(O_W2_T) + 256 * 256, 3, lds, cur);
            conv_job(p.in[20], 1024, 1024, 1024, WSB(O_WNOUT_T), 0, lds, cur);
            conv_job(p.in[21], 1024, 1024, 1024, WSB(O_WOUT_T), 0, lds, cur);
            conv_job(p.in[24], 1024, 1024, 1024, WSB(O_WXQ_T), 0, lds, cur);
            conv_job(p.in[25], 2048, 1024, 2048, WSB(O_WXKV_T), 0, lds, cur);
            conv_job(p.in[26], 1024, 1024, 1024, WSB(O_WXO_T), 0, lds, cur);
            conv_job(p.in[29], 5632, 1024, 5632, WSB(O_WFIN_T), 2, lds, cur);
            conv_job(p.in[30], 1024, 2816, 1024, WSB(O_WFOUT_T), 0, lds, cur);
            for (int it = get_bid(); it < 128; it += gridDim.x) {
                const int z = it >> 6, ec = (it >> 4) & 3, fc = it & 15, e = ec * 64 + (tid & 63), fg = tid >> 6;
                float a = 0.f;
#pragma unroll 8
                for (int f = fc * 128 + fg * 16; f < fc * 128 + fg * 16 + 16; ++f) a += p.in[16][z * 2048 + f] * p.in[17][((size_t)z * 2048 + f) * 256 + e];
                float* red = (float*)lds;
                __syncthreads(); red[tid] = a; __syncthreads();
                if (tid < 64) { float t = 0.f; for (int k = 0; k < 8; ++k) t += red[tid + 64 * k]; WSF(O_BPART)[(z * 16 + fc) * 256 + e] = t; }
                __syncthreads();
            }
            ssm_prep(sin_, WSB(O_BT1), WSB(O_MTW), lds);
        } break;
        CASE(1) {
            if (get_bid() == 0) { for (int e = get_tid(); e < 512; e += NTHR) { float a = p.in[18][e]; for (int fc = 0; fc < 16; ++fc) a += WSF(O_BPART)[((e >> 8) * 16 + fc) * 256 + (e & 255)]; WSF(O_BIAS2)[e] = a; } }
            { const GemmP g{WSB(O_B), WSB(O_WIN_T), 1024, 1024, 256, 42, 16, 1};
              const EpiIn e{WSB(O_UH), WSB(O_QB), WSB(O_KVC), WSB(O_KS), WSB(O_VST), WSB(O_KW), WSB(O_VWT), WSB(O_GM), WSF(O_GN)};
              gemm_run<8>(g, AddrNone{}, e, lds); }
        } break;
        CASE(2) {
            { const GemmP g{WSB(O_KVC), WSB(O_W1_T), 1024, 2048, 1, 2, 32, 128};
              const EpiCmp1 e{WSB(O_HID), WSF(O_BIAS2)};
              gemm_run<4>(g, AddrCmp1{}, e, lds); }
            { const GemmP g{WSB(O_UH), WSB(O_BT1), 640, 512, 8, 2, 8, 32};
              const EpiSsmA e{WSF(O_SS)};
              gemm_run<8>(g, AddrStride{1024ull * 640, 256ull * 512}, e, lds, 16); }
        } break;
        CASE(3) {
            ssm_scan(sin_, WSF(O_SS), WSB(O_UH));
            { const GemmP g{WSB(O_HID), WSB(O_W2_T), 256, 256, 1, 2, 4, 128};
              const EpiCmp2 e{WSB(O_KC), WSB(O_VCT)};
              gemm_run<4>(g, AddrCmp2{}, e, lds, 16); }
        } break;
        CASE(4) {
            const NsaCtx c{WSB(O_QB), WSB(O_KC), WSB(O_VCT), WSB(O_KS), WSB(O_VST), WSB(O_KW), WSB(O_VWT), WSF(O_GN), WSB(O_B)};
            const int G = gridDim.x;
            for (int i = 0;; ++i) {
                const int u = (i & 1) ? i * G + (G - 1 - get_bid()) : i * G + get_bid();
                if (i * G >= 2048) break;
                if (u < 2048) { const int qb = 31 - (u >> 6), bh = u & 63; nsa_unit(c, bh >> 2, bh & 3, qb, lds); }
                __syncthreads();
            }
            { const GemmP g{WSB(O_UH), WSB(O_MTW), 640, 640, 8, 4, 10, 32};
              const EpiSsmB e{WSB(O_UH), p.in[11], WSB(O_GB)};
              gemm_run<8>(g, AddrStride{1024ull * 640, 512ull * 640}, e, lds); }
        } break;
        CASE(5) { const GemmP g{WSB(O_GB), WSB(O_WGLU_T), 512, 512, 256, 4, 8, 1}; const EpiGlu e{WSB(O_GB), p.in[14], WSB(O_YS)}; gemm_run<8>(g, AddrNone{}, e, lds); } break;
        CASE(6) { const GemmP g{WSB(O_YS), WSB(O_WSOUT_T), 512, 512, 256, 8, 8, 1}; const EpiSout e{WSB(O_GM), WSB(O_QB)}; gemm_run<8>(g, AddrNone{}, e, lds); } break;
        CASE(7) { const GemmP g{WSB(O_B), WSB(O_WNOUT_T), 1024, 1024, 256, 8, 16, 1}; const EpiNout e{WSB(O_GM), WSB(O_QB), WSB(O_MIXIN)}; gemm_run<8>(g, AddrNone{}, e, lds); } break;
        CASE(8) { const GemmP g{WSB(O_MIXIN), WSB(O_WOUT_T), 1024, 1024, 256, 8, 16, 1}; const EpiRes e{p.in[0], WSF(O_ST0), p.in[2], p.in[3], WSF(O_V1)}; gemm_run<8>(g, AddrNone{}, e, lds); } break;
        CASE(9) { ln_pass(WSF(O_V1), p.in[22], p.in[23], WSB(O_B), WSF(O_ST1), nullptr);
            for (size_t i = (size_t)get_bid() * NTHR + get_tid(); i < 4096ull * 1024 / 4; i += (size_t)gridDim.x * NTHR) { const f32x4 v = ((const f32x4*)p.in[1])[i]; st_bf4(WSB(O_MEMB) + i * 4, v[0], v[1], v[2], v[3]); }
        } break;
        CASE(10) { { const GemmP g{WSB(O_B), WSB(O_WXQ_T), 1024, 1024, 256, 8, 16, 1}; const EpiScaleBf e{WSB(O_QB), 1024, 0.0625f * LOG2E}; gemm_run<8>(g, AddrNone{}, e, lds); }
            { const GemmP g{WSB(O_MEMB), WSB(O_WXKV_T), 1024, 1024, 32, 16, 16, 1};
              const EpiXkv e{WSB(O_XK), WSB(O_XVT)};
              gemm_run<4>(g, AddrNone{}, e, lds); }
        } break;
        CASE(11) {
            for (int u = get_bid(); u < 1024; u += gridDim.x) { const int qblk = u >> 6, bh = u & 63; xattn_unit(WSB(O_QB), WSB(O_XK), WSB(O_XVT), WSB(O_B), bh >> 2, bh & 3, qblk, lds); }
        } break;
        CASE(12) { const GemmP g{WSB(O_B), WSB(O_WXO_T), 1024, 1024, 256, 8, 16, 1}; const EpiRes e{WSF(O_V1), WSF(O_ST1), p.in[22], p.in[23], WSF(O_V2)}; gemm_run<8>(g, AddrNone{}, e, lds); } break;
        CASE(13) ln_pass(WSF(O_V2), p.in[27], p.in[28], WSB(O_B), WSF(O_ST2), nullptr); break;
        CASE(14) { const GemmP g{WSB(O_B), WSB(O_WFIN_T), 1024, 1024, 256, 44, 16, 1}; const EpiFfnIn e{WSB(O_FB)}; gemm_run<8>(g, AddrNone{}, e, lds); } break;
        CASE(15) { const GemmP g{WSB(O_FB), WSB(O_WFOUT_T), 2816, 2816, 256, 8, 44, 1}; const EpiRes e{WSF(O_V2), WSF(O_ST2), p.in[27], p.in[28], WSF(O_V2)}; gemm_run<8>(g, AddrNone{}, e, lds); } break;
        CASE(16) ln_pass(WSF(O_V2), p.in[31], p.in[32], nullptr, nullptr, p.out); break;
        }
        if (ph + 1 < p.ph_hi) { if (p.coop) xcd_barrier(gbar); if (p.pad == 0x5eed) cg::this_grid().sync(); }
    }
}

#ifndef ONE_LAUNCH
#define ONE_LAUNCH 1
#endif
extern "C" void kernel_launch(void* const* d_in, const int* in_sizes, int n_in, void* d_out, int out_size, void* d_ws, size_t ws_size, hipStream_t stream) {
    static int grid = 0;
    if (grid == 0) {
        if (n_in != 33 || out_size != T_ * 1024 || ws_size < WS_NEED) { fprintf(stderr, "kernel_launch: unexpected shapes (n_in %d out %d ws %zu need %zu)\n", n_in, out_size, ws_size, (size_t)WS_NEED); grid = -1; return; }
        int dev = 0, cus = 0, per_cu = 0;
        hipGetDevice(&dev);
        hipDeviceGetAttribute(&cus, hipDeviceAttributeMultiprocessorCount, dev);
        if (hipFuncSetAttribute((const void*)fwd_kernel, hipFuncAttributeMaxDynamicSharedMemorySize, LDS_BYTES) != hipSuccess) { fprintf(stderr, "kernel_launch: hipFuncSetAttribute failed\n"); grid = -1; return; }
        if (hipOccupancyMaxActiveBlocksPerMultiprocessor(&per_cu, (const void*)fwd_kernel, NTHR, LDS_BYTES) != hipSuccess || per_cu < 1) { fprintf(stderr, "kernel_launch: occupancy query failed (%d)\n", per_cu); per_cu = 1; (void)hipGetLastError(); }
        if (per_cu > 1) per_cu = 1;
        grid = cus * per_cu;
    }
    if (grid < 0) return;
    P p{};
    for (int i = 0; i < 33; ++i) p.in[i] = (const float*)d_in[i];
    p.out = (float*)d_out; p.ws = (unsigned char*)d_ws;
#if ONE_LAUNCH
    p.ph_lo = 0; p.ph_hi = NPHASE; p.coop = 1;
    if (hipMemsetAsync((unsigned char*)d_ws + O_BAR, 0, XCD_BAR_WORDS * 4, stream) != hipSuccess) { fprintf(stderr, "kernel_launch: memset of barrier words failed\n"); return; }
    void* args[] = {&p};
    hipError_t e = hipLaunchCooperativeKernel((const void*)fwd_kernel, dim3(grid), dim3(NTHR), args, LDS_BYTES, stream);
    if (e != hipSuccess) fprintf(stderr, "cooperative launch failed: %s (grid %d)\n", hipGetErrorString(e), grid);
#else
#ifdef STOP_AFTER
    const int nrun = STOP_AFTER + 1;
#else
    const int nrun = NPHASE;
#endif
    for (int ph = 0; ph < nrun; ++ph) {
        p.ph_lo = ph; p.ph_hi = ph + 1; p.coop = 0;
        hipLaunchKernelGGL(fwd_kernel, dim3(grid), dim3(NTHR), LDS_BYTES, stream, p);
    }
#endif
}
```

```cpp
#include <hip/hip_runtime.h>
#include <hip/hip_cooperative_groups.h>
#include <cstdio>
#include <cstdint>
namespace cg = cooperative_groups;

typedef unsigned short bf16_t;
typedef short bf16x8 __attribute__((ext_vector_type(8)));
typedef float f32x4 __attribute__((ext_vector_type(4)));
typedef unsigned u32x4 __attribute__((ext_vector_type(4)));
typedef unsigned u32x2 __attribute__((ext_vector_type(2)));
#define DEV __device__ __forceinline__

constexpr int T_ = 32768, L_ = 2048;
constexpr float LOG2E = 1.4426950408889634f;
constexpr float ALPHA = 1.189207115002721f;
constexpr float LN_EPS = 1e-5f;
constexpr float NEG = -1e30f;
constexpr int LDS_BYTES = 147456;
constexpr int NTHR = 512, NWAVE = 8;
constexpr size_t MiB = 1048576;

constexpr size_t O_WIN_T = 0;
constexpr size_t O_WGLU_T = O_WIN_T + 5376ull * 1024 * 2;
constexpr size_t O_WSOUT_T = O_WGLU_T + 512ull * 512 * 2;
constexpr size_t O_W1_T = O_WSOUT_T + 1024ull * 512 * 2;
constexpr size_t O_W2_T = O_W1_T + 2ull * 256 * 2048 * 2;
constexpr size_t O_WNOUT_T = O_W2_T + 2ull * 256 * 256 * 2;
constexpr size_t O_WOUT_T = O_WNOUT_T + 2 * MiB;
constexpr size_t O_WXQ_T = O_WOUT_T + 2 * MiB;
constexpr size_t O_WXKV_T = O_WXQ_T + 2 * MiB;
constexpr size_t O_WXO_T = O_WXKV_T + 4 * MiB;
constexpr size_t O_WFIN_T = O_WXO_T + 2 * MiB;
constexpr size_t O_WFOUT_T = O_WFIN_T + 5632ull * 1024 * 2;
constexpr size_t O_BT1 = O_WFOUT_T + 1024ull * 2816 * 2;
constexpr size_t O_MTW = O_BT1 + 8 * MiB;
constexpr size_t O_KC = O_MTW + 20 * MiB;
constexpr size_t O_VCT = O_KC + 1 * MiB;
constexpr size_t O_GN = O_VCT + 1 * MiB;
constexpr size_t O_ST0 = O_GN + 6 * MiB;
constexpr size_t O_ST1 = O_ST0 + 262144;
constexpr size_t O_ST2 = O_ST1 + 262144;
constexpr size_t O_BIAS2 = O_ST2 + 262144;
constexpr size_t O_BPART = O_BIAS2 + 4096;
constexpr size_t O_BAR = O_BPART + 32768;
constexpr size_t O_A = 81 * MiB;
constexpr size_t O_KVC = O_A;
constexpr size_t O_KS = O_A + 32 * MiB;
constexpr size_t O_VST = O_A + 48 * MiB;
constexpr size_t O_KW = O_A + 64 * MiB;
constexpr size_t O_VWT = O_A + 80 * MiB;
constexpr size_t O_GB = O_A + 96 * MiB;
constexpr size_t O_MIXIN = O_A;
constexpr size_t O_MEMB = O_A + 64 * MiB;
constexpr size_t O_XK = O_A + 72 * MiB;
constexpr size_t O_XVT = O_A + 80 * MiB;
constexpr size_t O_V2 = O_A;
constexpr size_t O_B = O_A + 128 * MiB;
constexpr size_t O_SS = O_B;
constexpr size_t O_HID = O_B + 16 * MiB;
constexpr size_t O_Y = O_B + 64 * MiB;
constexpr size_t O_GM = O_Y;
constexpr size_t O_V1 = O_Y;
constexpr size_t O_X = O_Y + 128 * MiB;
constexpr size_t O_QB = O_X;
constexpr size_t O_UH = O_X + 64 * MiB;
constexpr size_t O_YS = O_X + 64 * MiB;
constexpr size_t O_FB = O_Y;
constexpr size_t WS_NEED = O_X + 104 * MiB;
static_assert(O_BAR + 16384 <= O_A, "F region overflow");

struct P {
    const float* in[33];
    float* out;
    unsigned char* ws;
    int ph_lo, ph_hi, coop, pad;
};

DEV int get_tid() { int t = threadIdx.x; asm volatile("" : "+v"(t)); return t; }
DEV int get_bid() { int t = blockIdx.x; asm volatile("" : "+s"(t)); return t; }
typedef __bf16 bf2_t __attribute__((ext_vector_type(2)));
typedef float f32x2_t __attribute__((ext_vector_type(2)));
DEV unsigned cvt_pk_bf16(float lo, float hi) { const f32x2_t f = {lo, hi}; const bf2_t r = __builtin_convertvector(f, bf2_t); return __builtin_bit_cast(unsigned, r); }
DEV bf16_t f2bf(float v) { return (bf16_t)(cvt_pk_bf16(v, 0.f) & 0xffffu); }
DEV float bf2f(unsigned v) { return __uint_as_float(v << 16); }
DEV float bflo(unsigned w) { return __uint_as_float(w << 16); }
DEV float bfhi(unsigned w) { return __uint_as_float(w & 0xffff0000u); }
DEV float fexp2(float x) { return __builtin_amdgcn_exp2f(x); }
DEV float frcp(float x) { return __builtin_amdgcn_rcpf(x); }
DEV float sigmoidf_(float x) { return frcp(1.f + fexp2(-x * LOG2E)); }
DEV float gelu_tanh(float x) { const float u = 0.7978845608028654f * (x + 0.044715f * x * x * x); return x * frcp(1.f + fexp2(-2.f * LOG2E * u)); }
DEV void st_bf4(bf16_t* p, float a, float b, float c, float d) { u32x2 w; w.x = cvt_pk_bf16(a, b); w.y = cvt_pk_bf16(c, d); *(u32x2*)p = w; }
DEV f32x4 ld_bf4(const bf16_t* p) { const u32x2 w = *(const u32x2*)p; return (f32x4){bflo(w.x), bfhi(w.x), bflo(w.y), bfhi(w.y)}; }
DEV float wred_sum(float v) {
#pragma unroll
    for (int o = 32; o >= 1; o >>= 1) v += __shfl_xor(v, o);
    return v;
}

template <bool SRCBF>
DEV void ln_pass(const void* src_, const float* g, const float* b, bf16_t* dstb, float* stats, float* dstf) {
    constexpr int CH = SRCBF ? 8 : 4, NCH = 16 / CH;
    const int lane = get_tid() & 63, wid = get_tid() >> 6;
    const int nw = gridDim.x * NWAVE;
    for (int row = get_bid() * NWAVE + wid; row < T_; row += nw) {
        float e[16];
        if (SRCBF) {
            const u32x4* p = (const u32x4*)((const bf16_t*)src_ + (size_t)row * 1024);
#pragma unroll
            for (int i = 0; i < 2; ++i) { const u32x4 w = p[lane + 64 * i];
                e[8 * i + 0] = bflo(w.x); e[8 * i + 1] = bfhi(w.x); e[8 * i + 2] = bflo(w.y); e[8 * i + 3] = bfhi(w.y);
                e[8 * i + 4] = bflo(w.z); e[8 * i + 5] = bfhi(w.z); e[8 * i + 6] = bflo(w.w); e[8 * i + 7] = bfhi(w.w); }
        } else {
            const f32x4* p = (const f32x4*)((const float*)src_ + (size_t)row * 1024);
#pragma unroll
            for (int i = 0; i < 4; ++i) { const f32x4 v = p[lane + 64 * i]; e[4 * i] = v[0]; e[4 * i + 1] = v[1]; e[4 * i + 2] = v[2]; e[4 * i + 3] = v[3]; }
        }
        float s = 0.f;
#pragma unroll
        for (int k = 0; k < 16; ++k) s += e[k];
        s = wred_sum(s);
        const float mu = s * (1.f / 1024.f);
        float q = 0.f;
#pragma unroll
        for (int k = 0; k < 16; ++k) { const float d = e[k] - mu; q += d * d; }
        q = wred_sum(q);
        const float rstd = 1.0f / sqrtf(q * (1.f / 1024.f) + LN_EPS);
        if (stats && lane == 0) { stats[row * 2] = mu; stats[row * 2 + 1] = rstd; }
#pragma unroll
        for (int i = 0; i < NCH; ++i) {
            const int col = (lane + 64 * i) * CH;
            float y[CH];
#pragma unroll
            for (int k = 0; k < CH; k += 4) { const f32x4 gg = *(const f32x4*)(g + col + k), bb = *(const f32x4*)(b + col + k);
#pragma unroll
                for (int t = 0; t < 4; ++t) y[k + t] = (e[CH * i + k + t] - mu) * rstd * gg[t] + bb[t]; }
#pragma unroll
            for (int k = 0; k < CH; k += 4) {
                if (dstb) st_bf4(dstb + (size_t)row * 1024 + col + k, y[k], y[k + 1], y[k + 2], y[k + 3]);
                if (dstf) *(f32x4*)(dstf + (size_t)row * 1024 + col + k) = (f32x4){y[k], y[k + 1], y[k + 2], y[k + 3]};
            }
        }
    }
}

DEV int colmap(int mode, int n) {
    if (mode == 0) return n;
    if (mode == 1) return n < 3072 ? n : (n < 5120 ? n + 48 : (n < 5168 ? n - 5120 + 3072 : -1));
    if (mode == 2) { const int blk = n >> 5, r = n & 31; return r < 16 ? blk * 16 + r : 2816 + blk * 16 + (r - 16); }
    return n < 64 ? n : -1;
}
DEV void conv_job(const float* src, int ldsrc, int K, int N, bf16_t* dst, int mode, unsigned char* lds, int& cursor) {
    const int tid = get_tid(), lane = tid & 63, gw = get_bid() * NWAVE + (tid >> 6), nw = gridDim.x * NWAVE;
    const int kb = K / 32, nitem = (N / 64) * kb;
    for (int t = (gw + nw - (cursor % nw)) % nw; t < nitem; t += nw) {
        const int k0 = (t % kb) * 32, n = (t / kb) * 64 + lane;
        const int sc = colmap(mode, n);
        float e[32];
#pragma unroll
        for (int r = 0; r < 32; ++r) e[r] = sc >= 0 ? src[(size_t)(k0 + r) * ldsrc + sc] : 0.f;
#pragma unroll
        for (int q = 0; q < 4; ++q) { u32x4 w; w.x = cvt_pk_bf16(e[8 * q], e[8 * q + 1]); w.y = cvt_pk_bf16(e[8 * q + 2], e[8 * q + 3]); w.z = cvt_pk_bf16(e[8 * q + 4], e[8 * q + 5]); w.w = cvt_pk_bf16(e[8 * q + 6], e[8 * q + 7]);
            *(u32x4*)(dst + (size_t)n * K + k0 + 8 * q) = w; }
    }
    cursor += nitem;
}

struct SsmIn { const float *a_re, *a_im, *b_re, *b_im, *c_re, *c_im, *log_dt; };
DEV void lb_pow(const SsmIn& s, int g, int n, float p, float& re, float& im) {
    const float lre = fminf(s.a_re[g * 64 + n], -1e-4f), lim = s.a_im[g * 64 + n], dt = expf(s.log_dt[g]);
    const float mag = expf(lre * dt * p); float sn, cs; sincosf(lim * dt * p, &sn, &cs);
    re = mag * cs; im = mag * sn;
}
DEV void bbar(const SsmIn& s, int g, int n, int c, float& re, float& im) {
    const float lre = fminf(s.a_re[g * 64 + n], -1e-4f), lim = s.a_im[g * 64 + n], dt = expf(s.log_dt[g]);
    const float mag = expf(lre * dt); float sn, cs; sincosf(lim * dt, &sn, &cs);
    const float sh = sinf(0.5f * lim * dt);
    const float nr = expm1f(lre * dt) - mag * 2.f * sh * sh, lbi = mag * sn;
    const float den = lre * lre + lim * lim;
    const float fre = (nr * lre + lbi * lim) / den, fim = (lbi * lre - nr * lim) / den;
    const float br = s.b_re[(g * 64 + n) * 16 + c], bi = s.b_im[(g * 64 + n) * 16 + c];
    re = fre * br - fim * bi; im = fre * bi + fim * br;
}
DEV void ssm_prep(const SsmIn& s, bf16_t* BT1, bf16_t* MTW, unsigned char* lds) {
    const int tid = get_tid();
    float* pw = (float*)lds;
    float* bb = pw + 33 * 128;
    float* cc = bb + 2048;
    float* fn = cc + 2048;
    float* km = fn + 128;
    for (int job = get_bid(); job < 512; job += gridDim.x) {
        const int g = job >> 4, pt = job & 15;
        __syncthreads();
        for (int e = tid; e < 33 * 64; e += NTHR) { float pr, pi; lb_pow(s, g, e & 63, (float)(e >> 6), pr, pi); pw[e * 2] = pr; pw[e * 2 + 1] = pi; }
        if (tid < 64) {
            const int n = tid;
            const float lre = fminf(s.a_re[g * 64 + n], -1e-4f), lim = s.a_im[g * 64 + n], dt = expf(s.log_dt[g]);
            const float mag = expf(lre * dt); float sn, cs; sincosf(lim * dt, &sn, &cs);
            const float sh = sinf(0.5f * lim * dt);
            const float nr = expm1f(lre * dt) - mag * 2.f * sh * sh, lbi = mag * sn;
            const float den = lre * lre + lim * lim;
            fn[n * 2] = (nr * lre + lbi * lim) / den; fn[n * 2 + 1] = (lbi * lre - nr * lim) / den;
        }
        for (int e = tid; e < 1024; e += NTHR) { const int c = e >> 6, n = e & 63; cc[e * 2] = s.c_re[(g * 16 + c) * 64 + n]; cc[e * 2 + 1] = s.c_im[(g * 16 + c) * 64 + n]; }
        __syncthreads();
        for (int e = tid; e < 1024; e += NTHR) { const int n = e >> 4; const float fre = fn[n * 2], fim = fn[n * 2 + 1];
            const float br = s.b_re[(g * 64) * 16 + e], bi = s.b_im[(g * 64) * 16 + e];
            bb[e * 2] = fre * br - fim * bi; bb[e * 2 + 1] = fre * bi + fim * br; }
        __syncthreads();
        for (int i = tid; i < 4096; i += NTHR) { const int e = pt * 4096 + i, nn = e >> 9, kk = e & 511, n = nn & 63, sidx = kk >> 4, c = kk & 15;
            const float pr = pw[((31 - sidx) * 64 + n) * 2], pi = pw[((31 - sidx) * 64 + n) * 2 + 1], br = bb[(n * 16 + c) * 2], bi = bb[(n * 16 + c) * 2 + 1];
            BT1[(size_t)g * 131072 + e] = f2bf((nn >> 6) ? (pr * bi + pi * br) : (pr * br - pi * bi)); }
        for (int i = tid; i < 4096; i += NTHR) BT1[(size_t)g * 131072 + 65536 + pt * 4096 + i] = 0;
        for (int i = tid; i < 4096; i += NTHR) { const int e = pt * 4096 + i, nn = e & 127, r = e >> 7, n = nn & 63, tau = r >> 4, c = r & 15;
            const float pr = pw[((tau + 1) * 64 + n) * 2], pi = pw[((tau + 1) * 64 + n) * 2 + 1], cr = cc[(c * 64 + n) * 2], ci = cc[(c * 64 + n) * 2 + 1];
            MTW[((size_t)g * 512 + r) * 640 + 512 + nn] = f2bf((nn >> 6) ? -(cr * pi + ci * pr) : (cr * pr - ci * pi)); }
        for (int i = tid; i < 32 * 512; i += NTHR) { const int r = pt * 32 + (i >> 9), kk = i & 511; if ((kk >> 4) > (r >> 4)) MTW[((size_t)g * 512 + r) * 640 + kk] = 0; }
        if (tid < 256) for (int dd = 0; dd < 2; ++dd) { const int d = 2 * pt + dd, c = tid >> 4, c2 = tid & 15; float acc = 0.f;
            for (int n = 0; n < 64; ++n) { const float cr = cc[(c * 64 + n) * 2], ci = cc[(c * 64 + n) * 2 + 1], pr = pw[(d * 64 + n) * 2], pi = pw[(d * 64 + n) * 2 + 1];
                const float xr = cr * pr - ci * pi, xi = cr * pi + ci * pr; acc += xr * bb[(n * 16 + c2) * 2] - xi * bb[(n * 16 + c2) * 2 + 1]; }
            km[dd * 256 + tid] = acc; }
        __syncthreads();
        if (tid < 256) for (int dd = 0; dd < 2; ++dd) { const int d = 2 * pt + dd; const bf16_t v = f2bf(km[dd * 256 + tid]); const int c = tid >> 4, c2 = tid & 15;
            for (int sidx = 0; sidx + d < 32; ++sidx) MTW[((size_t)g * 512 + (sidx + d) * 16 + c) * 640 + sidx * 16 + c2] = v; }
    }
    __syncthreads();
}
DEV void ssm_scan(const SsmIn& s, const float* SS, bf16_t* UH) {
    for (int idx = get_bid() * NTHR + get_tid(); idx < 32768; idx += gridDim.x * NTHR) {
        const int n = idx & 63, b = (idx >> 6) & 15, g = idx >> 10;
        float ar, ai; lb_pow(s, g, n, 32.f, ar, ai);
        float hr = 0.f, hi = 0.f;
        const size_t row0 = (size_t)(g * 16 + b) * 64;
#pragma unroll 8
        for (int k = 0; k < 64; ++k) {
            UH[(row0 + k) * 640 + 512 + n] = f2bf(hr); UH[(row0 + k) * 640 + 576 + n] = f2bf(hi);
            const float sr = SS[(row0 + k) * 128 + n], si = SS[(row0 + k) * 128 + 64 + n];
            const float nr = ar * hr - ai * hi + sr, ni = ar * hi + ai * hr + si;
            hr = nr; hi = ni;
        }
    }
}

struct GemmP { const bf16_t* A; const bf16_t* Bt; int lda, ldb, MT, NT, KT, nbatch; };
#define GLAS __attribute__((address_space(3)))
template <int WM, class Addr, class Epi>
DEV void gemm_run(const GemmP p, const Addr ad, const Epi epi, unsigned char* lds_, int rshift = 0) {
    constexpr int TM = 32 * WM, ABYTES = TM * 128, STAGE = ABYTES + 32768, NLA = WM / 2;
    GLAS unsigned char* lds = (GLAS unsigned char*)lds_;
    const int tid = get_tid(), lane = tid & 63, wid = __builtin_amdgcn_readfirstlane(tid >> 6), wr = wid >> 2, wc = wid & 3, l15 = lane & 15, quad = lane >> 4;
    int nx, x, jx, stride;
    { volatile GLAS unsigned* cw = (volatile GLAS unsigned*)(lds + LDS_BYTES - 16);
      const int nloc = (int)cw[0], nxc = (int)cw[1], rank = (int)cw[2], xcc = (int)cw[3];
      if (nloc > 0 && xcc < nxc && rank < nloc) { nx = nxc; x = xcc; jx = (rank + rshift) % nloc; stride = nloc; }
      else { nx = 1; x = 0; jx = get_bid(); stride = gridDim.x; } }
    nx = __builtin_amdgcn_readfirstlane(nx); x = __builtin_amdgcn_readfirstlane(x); jx = __builtin_amdgcn_readfirstlane(jx); stride = __builtin_amdgcn_readfirstlane(stride);
    const int MTT = p.MT / (WM / 4), NTT = p.NT / 2;
    const int SRtot = (p.nbatch * MTT) / 8, per = 8 * NTT, KT = p.KT;
    if (SRtot < nx) { nx = 1; x = 0; jx = get_bid(); stride = gridDim.x; }
    int offA[NLA], offB[4];
#pragma unroll
    for (int i = 0; i < NLA; ++i) { const int row = (wid + 8 * i) * 8 + (lane >> 3), c = (lane & 7) ^ ((row >> 1) & 7); offA[i] = row * p.lda + c * 8; }
#pragma unroll
    for (int i = 0; i < 4; ++i) { const int row = (wid + 8 * i) * 8 + (lane >> 3), c = (lane & 7) ^ ((row >> 1) & 7); offB[i] = row * p.ldb + c * 8; }
    const int sw = (l15 >> 1) & 7;
    int aoff[2], boff[2];
#pragma unroll
    for (int ks = 0; ks < 2; ++ks) { const int c = ((ks * 4 + quad) ^ sw) * 16; aoff[ks] = (wr * (WM * 16) + l15) * 128 + c; boff[ks] = ABYTES + (wc * 64 + l15) * 128 + c; }
    int ls = jx, lkt = 0; const bf16_t* lA = nullptr; const bf16_t* lB = nullptr; bool lvalid;
#define GEMM_DECODE_L() do { const int q_ = ls / per, rem_ = ls % per, sr_ = x + nx * q_; lvalid = sr_ < SRtot; if (lvalid) { const int R_ = sr_ * 8 + (rem_ & 7), b_ = R_ / MTT; \
        lA = p.A + ad.a_off(b_) + (size_t)((R_ % MTT) * TM) * p.lda; lB = p.Bt + ad.b_off(b_) + (size_t)((rem_ >> 3) * 256) * p.ldb; } } while (0)
#define GEMM_ISSUE(stg) do { _Pragma("unroll") for (int i_ = 0; i_ < NLA; ++i_) \
        __builtin_amdgcn_global_load_lds((const unsigned*)(lA + offA[i_] + lkt * 64), (GLAS unsigned*)(lds + (stg) * STAGE + (wid + 8 * i_) * 1024), 16, 0, 0); \
        _Pragma("unroll") for (int i_ = 0; i_ < 4; ++i_) \
        __builtin_amdgcn_global_load_lds((const unsigned*)(lB + offB[i_] + lkt * 64), (GLAS unsigned*)(lds + (stg) * STAGE + ABYTES + (wid + 8 * i_) * 1024), 16, 0, 0); \
        ++issued; if (++lkt == KT) { lkt = 0; ls += stride; GEMM_DECODE_L(); } } while (0)
    GEMM_DECODE_L();
    int issued = 0;
    asm volatile("s_waitcnt vmcnt(0)" ::: "memory");
    __syncthreads();
    if (lvalid) GEMM_ISSUE(0);
    if (lvalid) GEMM_ISSUE(1);
    f32x4 acc[WM][4];
#pragma unroll
    for (int i = 0; i < WM; ++i)
#pragma unroll
        for (int j = 0; j < 4; ++j) acc[i][j] = (f32x4){0.f, 0.f, 0.f, 0.f};
    int cs = jx, ckt = 0; bool drain = false;
#pragma unroll 1
    for (int it = 0; it < issued; ++it) {
        if (drain || issued - it - 1 == 0) asm volatile("s_waitcnt vmcnt(0)" ::: "memory");
        else asm volatile("s_waitcnt vmcnt(%0)" :: "n"(NLA + 4) : "memory");
        drain = false;
        __builtin_amdgcn_s_barrier();
        asm volatile("" ::: "memory");
        const GLAS unsigned char* st = lds + (it & 1) * STAGE;
        bf16x8 af[WM], bfr[4];
#pragma unroll
        for (int i = 0; i < 4; ++i) bfr[i] = *(const GLAS bf16x8*)(st + boff[0] + i * 2048);
#pragma unroll
        for (int i = 0; i < WM; ++i) af[i] = *(const GLAS bf16x8*)(st + aoff[0] + i * 2048);
#pragma unroll
        for (int mi = 0; mi < WM; ++mi)
#pragma unroll
            for (int ni = 0; ni < 4; ++ni) acc[mi][ni] = __builtin_amdgcn_mfma_f32_16x16x32_bf16(bfr[ni], af[mi], acc[mi][ni], 0, 0, 0);
#pragma unroll
        for (int i = 0; i < 4; ++i) bfr[i] = *(const GLAS bf16x8*)(st + boff[1] + i * 2048);
#pragma unroll
        for (int i = 0; i < WM; ++i) af[i] = *(const GLAS bf16x8*)(st + aoff[1] + i * 2048);
        asm volatile("s_waitcnt lgkmcnt(0)" ::: "memory");
        __builtin_amdgcn_s_barrier();
        asm volatile("" ::: "memory");
        if (lvalid) GEMM_ISSUE(it & 1);
        asm volatile("" ::: "memory");
#pragma unroll
        for (int mi = 0; mi < WM; ++mi)
#pragma unroll
            for (int ni = 0; ni < 4; ++ni) acc[mi][ni] = __builtin_amdgcn_mfma_f32_16x16x32_bf16(bfr[ni], af[mi], acc[mi][ni], 0, 0, 0);
        if (++ckt == KT) {
            const int q_ = cs / per, rem_ = cs % per, R_ = (x + nx * q_) * 8 + (rem_ & 7);
#pragma unroll
            for (int h = 0; h < WM / 4; ++h)
                epi(reinterpret_cast<const f32x4 (&)[4][4]>(acc[4 * h]), R_ / MTT, (R_ % MTT) * TM + wr * (WM * 16) + h * 64, (rem_ >> 3) * 256 + wc * 64, l15, quad);
#pragma unroll
            for (int i = 0; i < WM; ++i)
#pragma unroll
                for (int j = 0; j < 4; ++j) acc[i][j] = (f32x4){0.f, 0.f, 0.f, 0.f};
            ckt = 0; cs += stride; drain = true;
        }
    }
    asm volatile("s_waitcnt vmcnt(0) lgkmcnt(0)" ::: "memory");
    __syncthreads();
#undef GEMM_DECODE_L
#undef GEMM_ISSUE
}
struct AddrNone { DEV size_t a_off(int) const { return 0; } DEV size_t b_off(int) const { return 0; } };
struct AddrStride { size_t as, bs; DEV size_t a_off(int b) const { return as * b; } DEV size_t b_off(int b) const { return bs * b; } };
struct AddrCmp1 { DEV size_t a_off(int b) const { return (size_t)b * 2048 * 64; } DEV size_t b_off(int b) const { return (size_t)((b >> 2) & 1) * 256 * 2048; } };
struct AddrCmp2 { DEV size_t a_off(int b) const { return (size_t)b * 128 * 256; } DEV size_t b_off(int b) const { return (size_t)((b >> 2) & 1) * 256 * 256; } };

#define EPI_ARGS const f32x4 (&acc)[4][4], int batch, int m0, int n0, int l15, int quad
struct EpiIn {
    bf16_t *UH, *Qb, *KVC, *KS, *VST, *KW, *VWT, *GM; float* GN;
    DEV void operator()(EPI_ARGS) const {
#pragma unroll
        for (int mi = 0; mi < 4; ++mi) {
            const int t = m0 + mi * 16 + l15, b = t >> 11, tt = t & 2047;
#pragma unroll
            for (int ni = 0; ni < 4; ++ni) {
                const f32x4 v = acc[mi][ni];
                const int c = n0 + ni * 16 + quad * 4;
                if (n0 < 512) {
                    const int g = c >> 4;
                    st_bf4(UH + ((size_t)((g * 16 + b) * 64 + (tt >> 5))) * 640 + (tt & 31) * 16 + (c & 15), v[0], v[1], v[2], v[3]);
                } else if (n0 < 1536) {
                    const float sc = 0.125f * LOG2E;
                    st_bf4(Qb + (size_t)t * 1024 + (c - 512), v[0] * sc, v[1] * sc, v[2] * sc, v[3] * sc);
                } else if (n0 < 2048) {
                    const int cc = c - 1536, z = cc >> 8, h = (cc >> 6) & 3, d = cc & 63;
                    st_bf4(KVC + ((size_t)(((b * 2 + z) * 4 + h) * 2048 + tt)) * 64 + d, v[0], v[1], v[2], v[3]);
                } else if (n0 < 3072) {
                    const int cc = (c - 2048) & 511, isw = (c - 2048) >> 9, h = (cc >> 6) & 3, d = cc & 63;
                    if (cc < 256) st_bf4((isw ? KW : KS) + ((size_t)((b * 4 + h) * 2048 + tt)) * 64 + d, v[0], v[1], v[2], v[3]);
                    else { bf16_t* o = (isw ? VWT : VST) + ((size_t)((b * 4 + h) * 64 + d)) * 2048 + tt;
#pragma unroll
                        for (int i = 0; i < 4; ++i) o[(size_t)i * 2048] = f2bf(v[i]); }
                } else if (n0 < 5120) {
                    st_bf4(GM + (size_t)t * 2048 + (c - 3072), sigmoidf_(v[0]), sigmoidf_(v[1]), sigmoidf_(v[2]), sigmoidf_(v[3]));
                } else {
                    const int cc = c - 5120;
                    if (cc < 48) *(f32x4*)(GN + (size_t)t * 48 + cc) = (f32x4){sigmoidf_(v[0]), sigmoidf_(v[1]), sigmoidf_(v[2]), sigmoidf_(v[3])};
                }
            }
        }
    }
};
struct EpiXkv {
    bf16_t *XK, *XVT;
    DEV void operator()(EPI_ARGS) const {
#pragma unroll
        for (int mi = 0; mi < 4; ++mi) {
            const int r = m0 + mi * 16 + l15, b = r >> 8, m = r & 255;
#pragma unroll
            for (int ni = 0; ni < 4; ++ni) {
                const f32x4 v = acc[mi][ni]; const int c = n0 + ni * 16 + quad * 4;
                if (n0 < 1024) st_bf4(XK + (size_t)r * 1024 + c, v[0], v[1], v[2], v[3]);
                else { const int cc = c - 1024, h = cc >> 8, d = cc & 255; bf16_t* o = XVT + ((size_t)((b * 4 + h) * 256 + d)) * 256 + m;
#pragma unroll
                    for (int i = 0; i < 4; ++i) o[i * 256] = f2bf(v[i]); }
            }
        }
    }
};
struct EpiSsmA { float* SS;
    DEV void operator()(EPI_ARGS) const {
        if (n0 >= 128) return;
#pragma unroll
        for (int mi = 0; mi < 4; ++mi)
#pragma unroll
            for (int ni = 0; ni < 4; ++ni) *(f32x4*)(SS + ((size_t)batch * 1024 + m0 + mi * 16 + l15) * 128 + n0 + ni * 16 + quad * 4) = acc[mi][ni];
    }
};
struct EpiCmp1 { bf16_t* HID; const float* bias2;
    DEV void operator()(EPI_ARGS) const {
        const int z = (batch >> 2) & 1;
#pragma unroll
        for (int ni = 0; ni < 4; ++ni) {
            const int c = n0 + ni * 16 + quad * 4; const f32x4 bv = *(const f32x4*)(bias2 + z * 256 + c);
#pragma unroll
            for (int mi = 0; mi < 4; ++mi) { const f32x4 v = acc[mi][ni] + bv;
                st_bf4(HID + ((size_t)batch * 128 + m0 + mi * 16 + l15) * 256 + c, gelu_tanh(v[0]), gelu_tanh(v[1]), gelu_tanh(v[2]), gelu_tanh(v[3])); }
        }
    }
};
struct EpiCmp2 { bf16_t *KC, *VCT;
    DEV void operator()(EPI_ARGS) const {
        if (n0 >= 64) return;
        const int z = (batch >> 2) & 1, bh = (batch >> 3) * 4 + (batch & 3);
#pragma unroll
        for (int mi = 0; mi < 4; ++mi) { const int r = m0 + mi * 16 + l15;
#pragma unroll
            for (int ni = 0; ni < 4; ++ni) { const f32x4 v = acc[mi][ni]; const int c = n0 + ni * 16 + quad * 4;
                if (z == 0) st_bf4(KC + ((size_t)bh * 128 + r) * 64 + c, v[0], v[1], v[2], v[3]);
                else {
#pragma unroll
                    for (int i = 0; i < 4; ++i) VCT[((size_t)bh * 64 + c + i) * 128 + r] = f2bf(v[i]); } } }
    }
};
struct EpiSsmB { const bf16_t* UH; const float* dskip; bf16_t* GB;
    DEV void operator()(EPI_ARGS) const {
#pragma unroll
        for (int mi = 0; mi < 4; ++mi) { const int r = m0 + mi * 16 + l15, b = r >> 6, k = r & 63;
#pragma unroll
            for (int ni = 0; ni < 4; ++ni) { const int col = n0 + ni * 16 + quad * 4, tau = col >> 4, c = col & 15;
                const f32x4 u = ld_bf4(UH + ((size_t)batch * 1024 + r) * 640 + col);
                const f32x4 dv = *(const f32x4*)(dskip + batch * 16 + c);
                const f32x4 y = acc[mi][ni] + dv * u;
                st_bf4(GB + ((size_t)(b * 2048 + k * 32 + tau)) * 512 + batch * 16 + c, gelu_tanh(y[0]), gelu_tanh(y[1]), gelu_tanh(y[2]), gelu_tanh(y[3])); } }
    }
};
struct EpiGlu { const bf16_t* GB; const float* bglu; bf16_t* YS;
    DEV void operator()(EPI_ARGS) const {
#pragma unroll
        for (int ni = 0; ni < 4; ++ni) { const int c = n0 + ni * 16 + quad * 4; const f32x4 bv = *(const f32x4*)(bglu + c);
#pragma unroll
            for (int mi = 0; mi < 4; ++mi) { const size_t o = (size_t)(m0 + mi * 16 + l15) * 512 + c; const f32x4 g = ld_bf4(GB + o); const f32x4 v = acc[mi][ni] + bv;
                st_bf4(YS + o, g[0] * sigmoidf_(v[0]), g[1] * sigmoidf_(v[1]), g[2] * sigmoidf_(v[2]), g[3] * sigmoidf_(v[3])); } }
    }
};
struct EpiSout { const bf16_t* GM; bf16_t* P1;
    DEV void operator()(EPI_ARGS) const {
#pragma unroll
        for (int mi = 0; mi < 4; ++mi) { const size_t t = m0 + mi * 16 + l15;
#pragma unroll
            for (int ni = 0; ni < 4; ++ni) { const int c = n0 + ni * 16 + quad * 4; const f32x4 g = ld_bf4(GM + t * 2048 + c); const f32x4 v = acc[mi][ni] * g;
                st_bf4(P1 + t * 1024 + c, v[0], v[1], v[2], v[3]); } }
    }
};
struct EpiNout { const bf16_t* GM; const bf16_t* P1; bf16_t* MIX;
    DEV void operator()(EPI_ARGS) const {
#pragma unroll
        for (int mi = 0; mi < 4; ++mi) { const size_t t = m0 + mi * 16 + l15;
#pragma unroll
            for (int ni = 0; ni < 4; ++ni) { const int c = n0 + ni * 16 + quad * 4; const f32x4 g = ld_bf4(GM + t * 2048 + 1024 + c); const f32x4 v = acc[mi][ni] * g + ld_bf4(P1 + t * 1024 + c);
                st_bf4(MIX + t * 1024 + c, v[0], v[1], v[2], v[3]); } }
    }
};
template <bool SRCBF> struct EpiRes { const void* src; const float* stats; const float* g; const float* b; bf16_t* dst;
    DEV void operator()(EPI_ARGS) const {
#pragma unroll
        for (int mi = 0; mi < 4; ++mi) { const size_t t = m0 + mi * 16 + l15; const float mu = stats[t * 2], rs = stats[t * 2 + 1];
#pragma unroll
            for (int ni = 0; ni < 4; ++ni) { const int c = n0 + ni * 16 + quad * 4;
                const f32x4 xv = SRCBF ? ld_bf4((const bf16_t*)src + t * 1024 + c) : *(const f32x4*)((const float*)src + t * 1024 + c);
                const f32x4 gg = *(const f32x4*)(g + c), bb = *(const f32x4*)(b + c);
                const f32x4 o = ((xv - mu) * rs * gg + bb) * ALPHA + acc[mi][ni];
                st_bf4(dst + t * 1024 + c, o[0], o[1], o[2], o[3]); } }
    }
};
struct EpiScaleBf { bf16_t* O; int ldc; float sc;
    DEV void operator()(EPI_ARGS) const {
#pragma unroll
        for (int mi = 0; mi < 4; ++mi)
#pragma unroll
            for (int ni = 0; ni < 4; ++ni) { const f32x4 v = acc[mi][ni] * sc; st_bf4(O + (size_t)(m0 + mi * 16 + l15) * ldc + n0 + ni * 16 + quad * 4, v[0], v[1], v[2], v[3]); }
    }
};
struct EpiFfnIn { bf16_t* FB;
    DEV void operator()(EPI_ARGS) const {
#pragma unroll
        for (int mi = 0; mi < 4; ++mi) { const size_t t = m0 + mi * 16 + l15;
#pragma unroll
            for (int pp = 0; pp < 2; ++pp) { const f32x4 ga = acc[mi][2 * pp], up = acc[mi][2 * pp + 1]; const int j = (n0 + pp * 32) / 2 + quad * 4;
                st_bf4(FB + t * 2816 + j, ga[0] * sigmoidf_(ga[0]) * up[0], ga[1] * sigmoidf_(ga[1]) * up[1], ga[2] * sigmoidf_(ga[2]) * up[2], ga[3] * sigmoidf_(ga[3]) * up[3]); } }
    }
};

DEV float qmax(float v) { auto a = __builtin_amdgcn_permlane16_swap(__float_as_uint(v), __float_as_uint(v), false, false); v = fmaxf(__uint_as_float(a[0]), __uint_as_float(a[1]));
    auto b = __builtin_amdgcn_permlane32_swap(__float_as_uint(v), __float_as_uint(v), false, false); return fmaxf(__uint_as_float(b[0]), __uint_as_float(b[1])); }
DEV float qsum(float v) { auto a = __builtin_amdgcn_permlane16_swap(__float_as_uint(v), __float_as_uint(v), false, false); v = __uint_as_float(a[0]) + __uint_as_float(a[1]);
    auto b = __builtin_amdgcn_permlane32_swap(__float_as_uint(v), __float_as_uint(v), false, false); return __uint_as_float(b[0]) + __uint_as_float(b[1]); }
DEV bf16x8 pack_p(const f32x4& a, const f32x4& b) { u32x4 w; w.x = cvt_pk_bf16(a[0], a[1]); w.y = cvt_pk_bf16(a[2], a[3]); w.z = cvt_pk_bf16(b[0], b[1]); w.w = cvt_pk_bf16(b[2], b[3]); return __builtin_bit_cast(bf16x8, w); }
DEV void st_vt(unsigned char* rowbase, int e, const u32x4& v) {
    const int grp = e >> 2, ep = e & 3, a = ep >> 1, qp = (ep & 1) * 2;
    unsigned char* o = rowbase + grp * 64 + (qp * 8 + a * 4) * 2;
    *(u32x2*)o = (u32x2){v.x, v.y}; *(u32x2*)(o + 16) = (u32x2){v.z, v.w};
}

struct NsaCtx { const bf16_t *Qb, *KC, *VCT, *KS, *VST, *KW, *VWT; const float* GN; bf16_t* ON; };
constexpr float MINIT = -1e20f;

template <int MODE, bool BOUND>
DEV void nsa_tile(const unsigned char* Kl, const unsigned char* Vl, const bf16x8 (&Qf)[2][2], f32x4 (&O)[2][4], float (&m)[2], float (&l)[2],
                  const float (&slope)[2], int dist0, bool sel, int l15, int quad) {
    const float d0f = (float)dist0;
#pragma unroll
    for (int g = 0; g < 2; ++g) {
        f32x4 S[4];
#pragma unroll
        for (int kt = 0; kt < 4; ++kt) { S[kt] = (f32x4){0.f, 0.f, 0.f, 0.f};
#pragma unroll
            for (int ks = 0; ks < 2; ++ks) { const bf16x8 kf = *(const bf16x8*)(Kl + (kt * 16 + l15) * 144 + ks * 64 + quad * 16); S[kt] = __builtin_amdgcn_mfma_f32_16x16x32_bf16(kf, Qf[g][ks], S[kt], 0, 0, 0); } }
        float base = -slope[g] * d0f;
        if (MODE == 0) base = sel ? base : NEG;
        typedef float f2 __attribute__((ext_vector_type(2)));
        const f2 sl_lo = {0.f, slope[g]}, sl_hi = {2.f * slope[g], 3.f * slope[g]};
        float tmax = NEG;
        f2 Slo[4], Shi[4];
#pragma unroll
        for (int kt = 0; kt < 4; ++kt) {
            const float bk = fmaf(slope[g], (float)(16 * kt), base);
            f2 lo = (f2){S[kt][0], S[kt][1]} + (sl_lo + bk), hi = (f2){S[kt][2], S[kt][3]} + (sl_hi + bk);
            if (BOUND) {
#pragma unroll
                for (int i = 0; i < 4; ++i) { const int cc = 16 * kt + i; bool v = cc <= dist0; if (MODE == 1) v = v && (cc > dist0 - 512);
                    if (i < 2) lo[i] = v ? lo[i] : NEG; else hi[i - 2] = v ? hi[i - 2] : NEG; }
            }
            Slo[kt] = lo; Shi[kt] = hi;
            tmax = fmaxf(fmaxf(tmax, lo[0]), lo[1]); tmax = fmaxf(fmaxf(tmax, hi[0]), hi[1]);
        }
        tmax = qmax(tmax);
        const float mnew = fmaxf(m[g], tmax), alpha = fexp2(m[g] - mnew);
        f2 rs2 = {0.f, 0.f};
#pragma unroll
        for (int kt = 0; kt < 4; ++kt) {
            const f2 a = Slo[kt] - mnew, b = Shi[kt] - mnew;
            const f2 pa = {fexp2(a[0]), fexp2(a[1])}, pb = {fexp2(b[0]), fexp2(b[1])};
            rs2 += pa; rs2 += pb;
            S[kt] = (f32x4){pa[0], pa[1], pb[0], pb[1]};
        }
        l[g] = l[g] * alpha + (rs2[0] + rs2[1]); m[g] = mnew;
        const bf16x8 P0 = pack_p(S[0], S[1]), P1 = pack_p(S[2], S[3]);
#pragma unroll
        for (int dt = 0; dt < 4; ++dt) { O[g][dt] = O[g][dt] * alpha;
            const bf16x8 v0 = *(const bf16x8*)(Vl + (dt * 16 + l15) * 144 + quad * 16), v1 = *(const bf16x8*)(Vl + (dt * 16 + l15) * 144 + 64 + quad * 16);
            O[g][dt] = __builtin_amdgcn_mfma_f32_16x16x32_bf16(v0, P0, O[g][dt], 0, 0, 0);
            O[g][dt] = __builtin_amdgcn_mfma_f32_16x16x32_bf16(v1, P1, O[g][dt], 0, 0, 0); }
    }
}

template <int MODE>
DEV void nsa_tiles(unsigned char* lds, const bf16_t* Kg, const bf16_t* VTg, unsigned tilemask, unsigned wmask, unsigned qmask, int jb0, int jb1,
                   const bf16x8 (&Qf)[2][2], f32x4 (&O)[2][4], float (&m)[2], float (&l)[2], const float (&slope)[2], int tq, int l15, int quad) {
    const int tid = get_tid();
    const int prow = tid >> 3, pe = tid & 7;
    unsigned rem = tilemask;
    int j = __builtin_ctz(rem); rem &= rem - 1;
    u32x4 rk, rv;
    rk = *(const u32x4*)(Kg + (size_t)(64 * j + prow) * 64 + pe * 8); rv = *(const u32x4*)(VTg + (size_t)prow * 2048 + 64 * j + pe * 8);
    int cur = 0;
    *(u32x4*)(lds + prow * 144 + pe * 16) = rk; st_vt(lds + 9216 + prow * 144, pe, rv);
    __syncthreads();
    for (;;) {
        int jn = -1;
        if (rem) { jn = __builtin_ctz(rem); rem &= rem - 1;
            rk = *(const u32x4*)(Kg + (size_t)(64 * jn + prow) * 64 + pe * 8); rv = *(const u32x4*)(VTg + (size_t)prow * 2048 + 64 * jn + pe * 8); }
        __builtin_amdgcn_sched_barrier(0);
        const unsigned char* st = lds + cur * 18432;
        if (MODE == 1 || ((wmask >> j) & 1u)) {
            const int dist0 = tq - 64 * j - 4 * quad; const bool sel = (qmask >> j) & 1u;
            if (j == jb0 || j == jb1) nsa_tile<MODE, true>(st, st + 9216, Qf, O, m, l, slope, dist0, sel, l15, quad);
            else nsa_tile<MODE, false>(st, st + 9216, Qf, O, m, l, slope, dist0, sel, l15, quad);
        }
        if (jn >= 0) { unsigned char* sn = lds + (cur ^ 1) * 18432; *(u32x4*)(sn + prow * 144 + pe * 16) = rk; st_vt(sn + 9216 + prow * 144, pe, rv); }
        __syncthreads();
        if (jn < 0) break;
        j = jn; cur ^= 1;
    }
}

DEV void nsa_unit(const NsaCtx& c, int b, int hkv, int qb, unsigned char* lds) {
    const int tid = get_tid(), lane = tid & 63, wid = tid >> 6, l15 = lane & 15, quad = lane >> 4;
    const int qs = wid & 3, hp = wid >> 2;
    const int tq = qb * 64 + qs * 16 + l15, cur = qb;
    const size_t trow = (size_t)b * 2048 + tq;
    const int head0 = hkv * 4 + hp * 2;
    const float* gnp = c.GN + trow * 48 + head0 * 3;
    unsigned char* stash = lds + 36864 + wid * 4096;
    float* xch = (float*)(lds + 69632);
    unsigned* smask = (unsigned*)(lds + 102400);
    const int bh = b * 4 + hkv;
    {
        const bf16_t* Kg = c.KC + (size_t)bh * 128 * 64; const bf16_t* Vg = c.VCT + (size_t)bh * 64 * 128;
#pragma unroll
        for (int i = 0; i < 2; ++i) { const int pc = tid + 512 * i;
            *(u32x4*)(lds + (pc >> 3) * 144 + (pc & 7) * 16) = *(const u32x4*)(Kg + pc * 8);
            st_vt(lds + 18432 + (pc >> 4) * 272, pc & 15, *(const u32x4*)(Vg + pc * 8)); }
    }
    __syncthreads();
    const int nkt = (4 * qb + 2) / 16 + 1;
    float Mx[8], Sm[8];
#pragma unroll
    for (int kt = 0; kt < 8; ++kt) { Mx[kt] = NEG; Sm[kt] = 0.f; }
#ifdef NSA_NO_CMP
    for (int g = 0; g < 0; ++g) {
#else
#pragma unroll 1
    for (int g = 0; g < 2; ++g) {
#endif
        bf16x8 Qg[2];
#pragma unroll
        for (int ks = 0; ks < 2; ++ks) Qg[ks] = *(const bf16x8*)(c.Qb + trow * 1024 + (head0 + g) * 64 + ks * 32 + quad * 8);
        const float slope_g = exp2f(-0.5f * (float)(head0 + g + 1)) * LOG2E;
        f32x4 S[8];
#pragma unroll
        for (int kt = 0; kt < 8; ++kt) { S[kt] = (f32x4){0.f, 0.f, 0.f, 0.f};
            if (kt < nkt) {
#pragma unroll
                for (int ks = 0; ks < 2; ++ks) { const bf16x8 kf = *(const bf16x8*)(lds + (kt * 16 + l15) * 144 + ks * 64 + quad * 16); S[kt] = __builtin_amdgcn_mfma_f32_16x16x32_bf16(kf, Qg[ks], S[kt], 0, 0, 0); } } }
        float mx = NEG;
        const int d0 = tq - 31 - 64 * quad; const float base = -slope_g * (float)d0;
#pragma unroll
        for (int kt = 0; kt < 8; ++kt)
#pragma unroll
            for (int i = 0; i < 4; ++i) { const int cc = 256 * kt + 16 * i; const float s = (kt < nkt && cc <= d0) ? fmaf(slope_g, (float)cc, S[kt][i] + base) : NEG; S[kt][i] = s; mx = fmaxf(mx, s); }
        mx = qmax(mx);
        float ls = 0.f;
#pragma unroll
        for (int kt = 0; kt < 8; ++kt)
#pragma unroll
            for (int i = 0; i < 4; ++i) ls += S[kt][i] > -1e29f ? fexp2(S[kt][i] - mx) : 0.f;
        ls = qsum(ls);
        const float lcl = fmaxf(ls, 1e-30f), lg = __log2f(lcl) + mx;
        float x3[8];
#pragma unroll
        for (int kt = 0; kt < 8; ++kt) {
#pragma unroll
            for (int i = 0; i < 4; ++i) S[kt][i] = S[kt][i] > -1e29f ? S[kt][i] - lg : NEG;
            x3[kt] = __shfl(S[kt][3], (lane + 48) & 63);
        }
#pragma unroll
        for (int kt = 0; kt < 8; ++kt) {
            const float nb = quad >= 1 ? x3[kt] : (kt >= 1 ? x3[kt >= 1 ? kt - 1 : 0] : NEG);
            const float tm = fmaxf(fmaxf(fmaxf(S[kt][0], S[kt][1]), fmaxf(S[kt][2], S[kt][3])), nb);
            const float nm = fmaxf(Mx[kt], tm);
            Sm[kt] = Sm[kt] * fexp2(Mx[kt] - nm) + fexp2(S[kt][0] - nm) + fexp2(S[kt][1] - nm) + fexp2(S[kt][2] - nm) + fexp2(S[kt][3] - nm) + fexp2(nb - nm);
            Mx[kt] = nm;
        }
        const float gate0 = gnp[g * 3];
        f32x4 Oc[4];
#pragma unroll
        for (int dt = 0; dt < 4; ++dt) Oc[dt] = (f32x4){0.f, 0.f, 0.f, 0.f};
#pragma unroll
        for (int k2 = 0; k2 < 4; ++k2) {
            if (2 * k2 < nkt) {
                f32x4 pa, pb;
#pragma unroll
                for (int i = 0; i < 4; ++i) { pa[i] = fexp2(S[2 * k2][i]); pb[i] = fexp2(S[2 * k2 + 1][i]); }
                const bf16x8 pf = pack_p(pa, pb);
#pragma unroll
                for (int dt = 0; dt < 4; ++dt) { const bf16x8 vf = *(const bf16x8*)(lds + 18432 + (dt * 16 + l15) * 272 + k2 * 64 + quad * 16); Oc[dt] = __builtin_amdgcn_mfma_f32_16x16x32_bf16(vf, pf, Oc[dt], 0, 0, 0); }
            }
        }
#pragma unroll
        for (int dt = 0; dt < 4; ++dt) { const f32x4 v = Oc[dt] * gate0; u32x2 w; w.x = cvt_pk_bf16(v[0], v[1]); w.y = cvt_pk_bf16(v[2], v[3]); *(u32x2*)(stash + ((g * 4 + dt) * 64 + lane) * 8) = w; }
    }
    unsigned qmask;
    if (cur < 8) qmask = (2u << cur) - 1u;
    if (cur >= 8) {
#pragma unroll
        for (int kt = 0; kt < 8; ++kt) { xch[(wid * 16 + kt) * 64 + lane] = Mx[kt]; xch[(wid * 16 + 8 + kt) * 64 + lane] = Sm[kt]; }
    }
    __syncthreads();
    if (cur >= 8) {
        float v[8];
#pragma unroll
        for (int kt = 0; kt < 8; ++kt) {
            const float m2 = xch[((wid ^ 4) * 16 + kt) * 64 + lane], s2 = xch[((wid ^ 4) * 16 + 8 + kt) * 64 + lane];
            const float mm = fmaxf(Mx[kt], m2), ss = Sm[kt] * fexp2(Mx[kt] - mm) + s2 * fexp2(m2 - mm);
            const int jb = 4 * kt + quad; v[kt] = (jb >= 1 && jb <= cur - 2) ? mm + __log2f(ss) : -3e38f; }
        qmask = 1u | (1u << cur) | (1u << (cur - 1));
        for (int r = 0; r < 5; ++r) {
            float bv = v[0]; int bj = quad;
#pragma unroll
            for (int kt = 1; kt < 8; ++kt) if (v[kt] > bv) { bv = v[kt]; bj = 4 * kt + quad; }
#pragma unroll
            for (int o = 16; o <= 32; o <<= 1) { const float ov = __shfl_xor(bv, o); const int oj = __shfl_xor(bj, o); if (ov > bv || (ov == bv && oj < bj)) { bv = ov; bj = oj; } }
            qmask |= 1u << bj;
#pragma unroll
            for (int kt = 0; kt < 8; ++kt) if (4 * kt + quad == bj) v[kt] = -3.2e38f;
        }
    }
    unsigned wmask = qmask;
#pragma unroll
    for (int o = 1; o <= 8; o <<= 1) wmask |= __shfl_xor(wmask, o);
    if (lane == 0) smask[wid] = wmask;
    __syncthreads();
    const unsigned umask = (smask[0] | smask[1] | smask[2] | smask[3]) | (smask[4] | smask[5] | smask[6] | smask[7]);
    bf16x8 Qf[2][2]; float slope[2];
#pragma unroll
    for (int g = 0; g < 2; ++g) {
#pragma unroll
        for (int ks = 0; ks < 2; ++ks) Qf[g][ks] = *(const bf16x8*)(c.Qb + trow * 1024 + (head0 + g) * 64 + ks * 32 + quad * 8);
        slope[g] = exp2f(-0.5f * (float)(head0 + g + 1)) * LOG2E;
    }
    f32x4 O[2][4]; float m[2], l[2];
#pragma unroll
    for (int g = 0; g < 2; ++g) { m[g] = MINIT; l[g] = 0.f;
#pragma unroll
        for (int dt = 0; dt < 4; ++dt) O[g][dt] = (f32x4){0.f, 0.f, 0.f, 0.f}; }
#ifndef NSA_NO_SLC
    nsa_tiles<0>(lds, c.KS + (size_t)bh * 2048 * 64, c.VST + (size_t)bh * 64 * 2048, umask, wmask, qmask, cur, cur, Qf, O, m, l, slope, tq, l15, quad);
#endif
#pragma unroll
    for (int g = 0; g < 2; ++g) { const float sc = gnp[g * 3 + 1] / fmaxf(qsum(l[g]), 1e-30f);
#pragma unroll
        for (int dt = 0; dt < 4; ++dt) { u32x2* sp = (u32x2*)(stash + ((g * 4 + dt) * 64 + lane) * 8); const u32x2 w = *sp;
            const f32x4 v = O[g][dt] * sc + (f32x4){bflo(w.x), bfhi(w.x), bflo(w.y), bfhi(w.y)};
            u32x2 w2; w2.x = cvt_pk_bf16(v[0], v[1]); w2.y = cvt_pk_bf16(v[2], v[3]); *sp = w2;
            O[g][dt] = (f32x4){0.f, 0.f, 0.f, 0.f}; }
        m[g] = MINIT; l[g] = 0.f; }
    const int jlo = qb >= 8 ? qb - 8 : 0;
    const unsigned winmask = ((2u << cur) - 1u) & ~((1u << jlo) - 1u);
#ifndef NSA_NO_WIN
    nsa_tiles<1>(lds, c.KW + (size_t)bh * 2048 * 64, c.VWT + (size_t)bh * 64 * 2048, winmask, 0u, 0u, cur, jlo, Qf, O, m, l, slope, tq, l15, quad);
#endif
#pragma unroll
    for (int g = 0; g < 2; ++g) { const float sc = gnp[g * 3 + 2] / fmaxf(qsum(l[g]), 1e-30f);
#pragma unroll
        for (int dt = 0; dt < 4; ++dt) { const u32x2 w = *(const u32x2*)(stash + ((g * 4 + dt) * 64 + lane) * 8);
            const f32x4 v = O[g][dt] * sc + (f32x4){bflo(w.x), bfhi(w.x), bflo(w.y), bfhi(w.y)};
            st_bf4(c.ON + trow * 1024 + (head0 + g) * 64 + dt * 16 + quad * 4, v[0], v[1], v[2], v[3]); } }
}

DEV void xattn_unit(const bf16_t* Qx, const bf16_t* XK, const bf16_t* XVT, bf16_t* OX, int b, int h, int qblk  , unsigned char* lds) {
    const int tid = get_tid(), lane = tid & 63, wid = tid >> 6, l15 = lane & 15, quad = lane >> 4;
    const size_t trow = (size_t)b * 2048 + qblk * 128 + wid * 16 + l15;
    bf16x8 Qf[8];
#pragma unroll
    for (int ks = 0; ks < 8; ++ks) Qf[ks] = *(const bf16x8*)(Qx + trow * 1024 + h * 256 + ks * 32 + quad * 8);
    f32x4 O[16];
#pragma unroll
    for (int dt = 0; dt < 16; ++dt) O[dt] = (f32x4){0.f, 0.f, 0.f, 0.f};
    float m = NEG, l = 0.f;
    const bf16_t* Kg = XK + (size_t)b * 256 * 1024 + h * 256;
    const bf16_t* Vg = XVT + (size_t)(b * 4 + h) * 256 * 256;
    u32x4 rk[2], rv[2];
#pragma unroll
    for (int i = 0; i < 2; ++i) { const int pc = tid + 512 * i; rk[i] = *(const u32x4*)(Kg + (size_t)(pc >> 5) * 1024 + (pc & 31) * 8); rv[i] = *(const u32x4*)(Vg + (size_t)(pc >> 2) * 256 + (pc & 3) * 8); }
#pragma unroll
    for (int i = 0; i < 2; ++i) { const int pc = tid + 512 * i; *(u32x4*)(lds + (pc >> 5) * 528 + (pc & 31) * 16) = rk[i]; st_vt(lds + 16896 + (pc >> 2) * 80, pc & 3, rv[i]); }
    __syncthreads();
    for (int j = 0; j < 8; ++j) {
        const bool more = j + 1 < 8;
        if (more) {
#pragma unroll
            for (int i = 0; i < 2; ++i) { const int pc = tid + 512 * i; rk[i] = *(const u32x4*)(Kg + (size_t)(32 * (j + 1) + (pc >> 5)) * 1024 + (pc & 31) * 8); rv[i] = *(const u32x4*)(Vg + (size_t)(pc >> 2) * 256 + 32 * (j + 1) + (pc & 3) * 8); } }
        __builtin_amdgcn_sched_barrier(0);
        const unsigned char* st = lds + (j & 1) * 37376;
        f32x4 S[2];
#pragma unroll
        for (int kt = 0; kt < 2; ++kt) { S[kt] = (f32x4){0.f, 0.f, 0.f, 0.f};
#pragma unroll
            for (int ks = 0; ks < 8; ++ks) { const bf16x8 kf = *(const bf16x8*)(st + (kt * 16 + l15) * 528 + ks * 64 + quad * 16); S[kt] = __builtin_amdgcn_mfma_f32_16x16x32_bf16(kf, Qf[ks], S[kt], 0, 0, 0); } }
        float tmax = fmaxf(fmaxf(fmaxf(S[0][0], S[0][1]), fmaxf(S[0][2], S[0][3])), fmaxf(fmaxf(S[1][0], S[1][1]), fmaxf(S[1][2], S[1][3])));
        tmax = qmax(tmax);
        const float mnew = fmaxf(m, tmax), alpha = fexp2(m - mnew);
        float rs = 0.f;
#pragma unroll
        for (int kt = 0; kt < 2; ++kt)
#pragma unroll
            for (int i = 0; i < 4; ++i) { const float pv = fexp2(S[kt][i] - mnew); S[kt][i] = pv; rs += pv; }
        l = l * alpha + rs; m = mnew;
        const bf16x8 pf = pack_p(S[0], S[1]);
#pragma unroll
        for (int dt = 0; dt < 16; ++dt) { O[dt] = O[dt] * alpha; const bf16x8 vf = *(const bf16x8*)(st + 16896 + (dt * 16 + l15) * 80 + quad * 16); O[dt] = __builtin_amdgcn_mfma_f32_16x16x32_bf16(vf, pf, O[dt], 0, 0, 0); }
        if (more) { unsigned char* sn = lds + ((j + 1) & 1) * 37376;
#pragma unroll
            for (int i = 0; i < 2; ++i) { const int pc = tid + 512 * i; *(u32x4*)(sn + (pc >> 5) * 528 + (pc & 31) * 16) = rk[i]; st_vt(sn + 16896 + (pc >> 2) * 80, pc & 3, rv[i]); } }
        __syncthreads();
    }
    const float inv = 1.0f / qsum(l);
#pragma unroll
    for (int dt = 0; dt < 16; ++dt) { const f32x4 v = O[dt] * inv; st_bf4(OX + trow * 1024 + h * 256 + dt * 16 + quad * 4, v[0], v[1], v[2], v[3]); }
}


#define XB_TMO      128
#define XB_XCNT(j)  (256  + 64 * (j))
#define XB_XSUB(j)  (1280 + 64 * (j))
#define XB_XGEN(j)  (2304 + 64 * (j))
#define XB_TOP      3328
#define XB_TOPGEN   3392
#define XCD_BAR_WORDS 3456
#define XB_SPIN_CAP (1u << 18)
#define LAS __attribute__((address_space(3)))
DEV unsigned xb_ld(unsigned* p)              { return __hip_atomic_load(p, __ATOMIC_RELAXED, __HIP_MEMORY_SCOPE_AGENT); }
DEV unsigned xb_add(unsigned* p, unsigned v) { return __hip_atomic_fetch_add(p, v, __ATOMIC_RELAXED, __HIP_MEMORY_SCOPE_AGENT); }
DEV unsigned xb_xcc_id() { return (unsigned)__builtin_amdgcn_s_getreg((3 << 11) | 20) & 0xFu; }
#define XB_SPIN(cond, bar) do { unsigned _sp = 0; while (cond) { __builtin_amdgcn_s_sleep(1); \
    if ((++_sp & 255u) == 0u) { if (xb_ld(&(bar)[XB_TMO])) break; if (_sp > XB_SPIN_CAP) { atomicAdd(&(bar)[XB_TMO], 1u); break; } } } } while (0)
struct XcdBarrier { unsigned* bar; unsigned x; volatile LAS unsigned* st; };
DEV XcdBarrier xcd_barrier_post(unsigned* bar, volatile LAS unsigned* st) {
    XcdBarrier b; b.bar = bar; b.x = xb_xcc_id(); b.st = st;
    if (threadIdx.x == 0) { st[2] = xb_add(&bar[XB_XCNT(b.x)], 1u); st[3] = b.x; }
    return b;
}
DEV void xcd_barrier_complete(unsigned* bar, unsigned x, unsigned& nloc, unsigned& nx) {
    const unsigned G = gridDim.x * gridDim.y * gridDim.z;
    unsigned sum, cnt, mine, sp = 0u;
    for (;;) {
        sum = 0u; cnt = 0u; mine = 0u;
#pragma unroll
        for (unsigned j = 0; j < 16; ++j) { const unsigned c = xb_ld(&bar[XB_XCNT(j)]); sum += c; cnt += (c > 0u) ? 1u : 0u; mine = (j == x) ? c : mine; }
        if (sum == G) break;
        __builtin_amdgcn_s_sleep(1);
        if ((++sp & 255u) == 0u) { if (xb_ld(&bar[XB_TMO])) break; if (sp > XB_SPIN_CAP) { atomicAdd(&bar[XB_TMO], 1u); break; } }
    }
    nloc = mine > 0u ? mine : 1u; nx = cnt > 0u ? cnt : 1u;
}
DEV void xcd_barrier(const XcdBarrier& b) {
    asm volatile("s_waitcnt vmcnt(0)" ::: "memory");
    __syncthreads();
    if (threadIdx.x == 0) {
        unsigned* bar = b.bar;
        __builtin_amdgcn_s_waitcnt(0);
        unsigned nloc = b.st[0], nx = b.st[1];
        if (nloc == 0u) { xcd_barrier_complete(bar, b.x, nloc, nx); b.st[0] = nloc; b.st[1] = nx; }
        const unsigned old = xb_add(&bar[XB_XSUB(b.x)], 1u);
        const unsigned gen = old / nloc;
        if (old + 1u == (gen + 1u) * nloc) {
            __builtin_amdgcn_fence(__ATOMIC_RELEASE, "agent");
            asm volatile("s_waitcnt vmcnt(0)" ::: "memory");
            const unsigned og = xb_add(&bar[XB_TOP], 1u);
            const unsigned tg = og / nx;
            if (og + 1u == (tg + 1u) * nx) xb_add(&bar[XB_TOPGEN], 1u);
            else XB_SPIN(xb_ld(&bar[XB_TOPGEN]) == tg, bar);
            __builtin_amdgcn_fence(__ATOMIC_ACQUIRE, "agent");
            xb_add(&bar[XB_XGEN(b.x)], 1u);
            asm volatile("s_waitcnt vmcnt(0)" ::: "memory");
        } else {
            XB_SPIN(xb_ld(&bar[XB_XGEN(b.x)]) == gen, bar);
            __builtin_amdgcn_fence(__ATOMIC_ACQUIRE, "agent");
            asm volatile("s_waitcnt vmcnt(0)" ::: "memory");
        }
    }
    __syncthreads();
}

constexpr int NPHASE = 17;
__global__ void __launch_bounds__(512, 2) fwd_kernel(P p) {
    extern __shared__ __attribute__((aligned(16))) unsigned char lds[];
#define WSB(off) ((bf16_t*)(ws + (off)))
#define WSF(off) ((float*)(ws + (off)))
    volatile LAS unsigned* bst = (volatile LAS unsigned*)(LAS unsigned char*)(lds + LDS_BYTES - 16);
    if (threadIdx.x == 0) { bst[0] = 0u; bst[1] = 0u; bst[2] = 0u; bst[3] = 0u; }
    __syncthreads();
    XcdBarrier gbar; gbar.bar = (unsigned*)(p.ws + O_BAR); gbar.x = 0; gbar.st = bst;
    if (p.coop) gbar = xcd_barrier_post((unsigned*)(p.ws + O_BAR), bst);
    const SsmIn sin_{p.in[5], p.in[6], p.in[7], p.in[8], p.in[9], p.in[10], p.in[12]};
    for (int ph = p.ph_lo; ph < p.ph_hi; ++ph) {
        size_t zoff = 0; asm volatile("" : "+s"(zoff)); unsigned char* ws = p.ws + zoff;
        switch (ph) {
#ifdef ONLY_PHASE
        default: break;
#define CASE(k) case (k): if ((k) != ONLY_PHASE) break; else
#else
#define CASE(k) case (k):
#endif
        CASE(0) {
            const int tid = get_tid();
            ln_pass<false>(p.in[0], p.in[2], p.in[3], WSB(O_B), WSF(O_ST0), nullptr);
            int cur = 0;
            conv_job(p.in[4], 5168, 1024, 5376, WSB(O_WIN_T), 1, lds, cur);
            conv_job(p.in[13], 512, 512, 512, WSB(O_WGLU_T), 0, lds, cur);
            conv_job(p.in[15], 1024, 512, 1024, WSB(O_WSOUT_T), 0, lds, cur);
            conv_job(p.in[17], 256, 2048, 256, WSB(O_W1_T), 0, lds, cur);
            conv_job(p.in[17] + 2048 * 256, 256, 2048, 256, WSB(O_W1_T) + 256 * 2048, 0, lds, cur);
            conv_job(p.in[19], 64, 256, 256, WSB(O_W2_T), 3, lds, cur);
            conv_job(p.in[19] + 256 * 64, 64, 256, 256, WSB(O_W2_T) + 256 * 256, 3, lds, cur);
            conv_job(p.in[20], 1024, 1024, 1024, WSB(O_WNOUT_T), 0, lds, cur);
            conv_job(p.in[21], 1024, 1024, 1024, WSB(O_WOUT_T), 0, lds, cur);
            conv_job(p.in[24], 1024, 1024, 1024, WSB(O_WXQ_T), 0, lds, cur);
            conv_job(p.in[25], 2048, 1024, 2048, WSB(O_WXKV_T), 0, lds, cur);
            conv_job(p.in[26], 1024, 1024, 1024, WSB(O_WXO_T), 0, lds, cur);
            conv_job(p.in[29], 5632, 1024, 5632, WSB(O_WFIN_T), 2, lds, cur);
            conv_job(p.in[30], 1024, 2816, 1024, WSB(O_WFOUT_T), 0, lds, cur);
            for (int it = get_bid(); it < 128; it += gridDim.x) {
                const int z = it >> 6, ec = (it >> 4) & 3, fc = it & 15, e = ec * 64 + (tid & 63), fg = tid >> 6;
                float a = 0.f;
#pragma unroll 8
                for (int f = fc * 128 + fg * 16; f < fc * 128 + fg * 16 + 16; ++f) a += p.in[16][z * 2048 + f] * p.in[17][((size_t)z * 2048 + f) * 256 + e];
                float* red = (float*)lds;
                __syncthreads(); red[tid] = a; __syncthreads();
                if (tid < 64) { float t = 0.f; for (int k = 0; k < 8; ++k) t += red[tid + 64 * k]; WSF(O_BPART)[(z * 16 + fc) * 256 + e] = t; }
                __syncthreads();
            }
            ssm_prep(sin_, WSB(O_BT1), WSB(O_MTW), lds);
        } break;
        CASE(1) {
            if (get_bid() == 0) { for (int e = get_tid(); e < 512; e += NTHR) { float a = p.in[18][e]; for (int fc = 0; fc < 16; ++fc) a += WSF(O_BPART)[((e >> 8) * 16 + fc) * 256 + (e & 255)]; WSF(O_BIAS2)[e] = a; } }
            { const GemmP g{WSB(O_B), WSB(O_WIN_T), 1024, 1024, 256, 42, 16, 1};
              const EpiIn e{WSB(O_UH), WSB(O_QB), WSB(O_KVC), WSB(O_KS), WSB(O_VST), WSB(O_KW), WSB(O_VWT), WSB(O_GM), WSF(O_GN)};
              gemm_run<8>(g, AddrNone{}, e, lds); }
        } break;
        CASE(2) {
            { const GemmP g{WSB(O_KVC), WSB(O_W1_T), 1024, 2048, 1, 2, 32, 128};
              const EpiCmp1 e{WSB(O_HID), WSF(O_BIAS2)};
              gemm_run<4>(g, AddrCmp1{}, e, lds); }
            { const GemmP g{WSB(O_UH), WSB(O_BT1), 640, 512, 8, 2, 8, 32};
              const EpiSsmA e{WSF(O_SS)};
              gemm_run<8>(g, AddrStride{1024ull * 640, 256ull * 512}, e, lds, 16); }
        } break;
        CASE(3) {
            ssm_scan(sin_, WSF(O_SS), WSB(O_UH));
            { const GemmP g{WSB(O_HID), WSB(O_W2_T), 256, 256, 1, 2, 4, 128};
              const EpiCmp2 e{WSB(O_KC), WSB(O_VCT)};
              gemm_run<4>(g, AddrCmp2{}, e, lds, 16); }
        } break;
        CASE(4) {
            const NsaCtx c{WSB(O_QB), WSB(O_KC), WSB(O_VCT), WSB(O_KS), WSB(O_VST), WSB(O_KW), WSB(O_VWT), WSF(O_GN), WSB(O_B)};
            const int G = gridDim.x;
            for (int i = 0;; ++i) {
                const int u = (i & 1) ? i * G + (G - 1 - get_bid()) : i * G + get_bid();
                if (i * G >= 2048) break;
                if (u < 2048) { const int qb = 31 - (u >> 6), bh = u & 63; nsa_unit(c, bh >> 2, bh & 3, qb, lds); }
                __syncthreads();
            }
            { const GemmP g{WSB(O_UH), WSB(O_MTW), 640, 640, 8, 4, 10, 32};
              const EpiSsmB e{WSB(O_UH), p.in[11], WSB(O_GB)};
              gemm_run<8>(g, AddrStride{1024ull * 640, 512ull * 640}, e, lds); }
        } break;
        CASE(5) { const GemmP g{WSB(O_GB), WSB(O_WGLU_T), 512, 512, 256, 4, 8, 1}; const EpiGlu e{WSB(O_GB), p.in[14], WSB(O_YS)}; gemm_run<8>(g, AddrNone{}, e, lds); } break;
        CASE(6) { const GemmP g{WSB(O_YS), WSB(O_WSOUT_T), 512, 512, 256, 8, 8, 1}; const EpiSout e{WSB(O_GM), WSB(O_QB)}; gemm_run<8>(g, AddrNone{}, e, lds); } break;
        CASE(7) { const GemmP g{WSB(O_B), WSB(O_WNOUT_T), 1024, 1024, 256, 8, 16, 1}; const EpiNout e{WSB(O_GM), WSB(O_QB), WSB(O_MIXIN)}; gemm_run<8>(g, AddrNone{}, e, lds); } break;
        CASE(8) { const GemmP g{WSB(O_MIXIN), WSB(O_WOUT_T), 1024, 1024, 256, 8, 16, 1}; const EpiRes<false> e{p.in[0], WSF(O_ST0), p.in[2], p.in[3], WSB(O_V1)}; gemm_run<8>(g, AddrNone{}, e, lds); } break;
        CASE(9) { ln_pass<true>(WSB(O_V1), p.in[22], p.in[23], WSB(O_B), WSF(O_ST1), nullptr);
            for (size_t i = (size_t)get_bid() * NTHR + get_tid(); i < 4096ull * 1024 / 4; i += (size_t)gridDim.x * NTHR) { const f32x4 v = ((const f32x4*)p.in[1])[i]; st_bf4(WSB(O_MEMB) + i * 4, v[0], v[1], v[2], v[3]); }
        } break;
        CASE(10) { { const GemmP g{WSB(O_B), WSB(O_WXQ_T), 1024, 1024, 256, 8, 16, 1}; const EpiScaleBf e{WSB(O_QB), 1024, 0.0625f * LOG2E}; gemm_run<8>(g, AddrNone{}, e, lds); }
            { const GemmP g{WSB(O_MEMB), WSB(O_WXKV_T), 1024, 1024, 32, 16, 16, 1};
              const EpiXkv e{WSB(O_XK), WSB(O_XVT)};
              gemm_run<4>(g, AddrNone{}, e, lds); }
        } break;
        CASE(11) {
            for (int u = get_bid(); u < 1024; u += gridDim.x) { const int qblk = u >> 6, bh = u & 63; xattn_unit(WSB(O_QB), WSB(O_XK), WSB(O_XVT), WSB(O_B), bh >> 2, bh & 3, qblk, lds); }
        } break;
        CASE(12) { const GemmP g{WSB(O_B), WSB(O_WXO_T), 1024, 1024, 256, 8, 16, 1}; const EpiRes<true> e{WSB(O_V1), WSF(O_ST1), p.in[22], p.in[23], WSB(O_V2)}; gemm_run<8>(g, AddrNone{}, e, lds); } break;
        CASE(13) ln_pass<true>(WSB(O_V2), p.in[27], p.in[28], WSB(O_B), WSF(O_ST2), nullptr); break;
        CASE(14) { const GemmP g{WSB(O_B), WSB(O_WFIN_T), 1024, 1024, 256, 44, 16, 1}; const EpiFfnIn e{WSB(O_FB)}; gemm_run<8>(g, AddrNone{}, e, lds); } break;
        CASE(15) { const GemmP g{WSB(O_FB), WSB(O_WFOUT_T), 2816, 2816, 256, 8, 44, 1}; const EpiRes<true> e{WSB(O_V2), WSF(O_ST2), p.in[27], p.in[28], WSB(O_V2)}; gemm_run<8>(g, AddrNone{}, e, lds); } break;
        CASE(16) ln_pass<true>(WSB(O_V2), p.in[31], p.in[32], nullptr, nullptr, p.out); break;
        }
        if (ph + 1 < p.ph_hi) { if (p.coop) xcd_barrier(gbar); if (p.pad == 0x5eed) cg::this_grid().sync(); }
    }
}

#ifndef ONE_LAUNCH
#define ONE_LAUNCH 1
#endif
extern "C" void kernel_launch(void* const* d_in, const int* in_sizes, int n_in, void* d_out, int out_size, void* d_ws, size_t ws_size, hipStream_t stream) {
    static int grid = 0;
    if (grid == 0) {
        if (n_in != 33 || out_size != T_ * 1024 || ws_size < WS_NEED) { fprintf(stderr, "kernel_launch: unexpected shapes (n_in %d out %d ws %zu need %zu)\n", n_in, out_size, ws_size, (size_t)WS_NEED); grid = -1; return; }
        int dev = 0, cus = 0, per_cu = 0;
        hipGetDevice(&dev);
        hipDeviceGetAttribute(&cus, hipDeviceAttributeMultiprocessorCount, dev);
        if (hipFuncSetAttribute((const void*)fwd_kernel, hipFuncAttributeMaxDynamicSharedMemorySize, LDS_BYTES) != hipSuccess) { fprintf(stderr, "kernel_launch: hipFuncSetAttribute failed\n"); grid = -1; return; }
        if (hipOccupancyMaxActiveBlocksPerMultiprocessor(&per_cu, (const void*)fwd_kernel, NTHR, LDS_BYTES) != hipSuccess || per_cu < 1) { fprintf(stderr, "kernel_launch: occupancy query failed (%d)\n", per_cu); per_cu = 1; (void)hipGetLastError(); }
        if (per_cu > 1) per_cu = 1;
        grid = cus * per_cu;
    }
    if (grid < 0) return;
    P p{};
    for (int i = 0; i < 33; ++i) p.in[i] = (const float*)d_in[i];
    p.out = (float*)d_out; p.ws = (unsigned char*)d_ws;
#if ONE_LAUNCH
    p.ph_lo = 0; p.ph_hi = NPHASE; p.coop = 1;
    if (hipMemsetAsync((unsigned char*)d_ws + O_BAR, 0, XCD_BAR_WORDS * 4, stream) != hipSuccess) { fprintf(stderr, "kernel_launch: memset of barrier words failed\n"); return; }
    void* args[] = {&p};
    hipError_t e = hipLaunchCooperativeKernel((const void*)fwd_kernel, dim3(grid), dim3(NTHR), args, LDS_BYTES, stream);
    if (e != hipSuccess) fprintf(stderr, "cooperative launch failed: %s (grid %d)\n", hipGetErrorString(e), grid);
#else
#ifdef STOP_AFTER
    const int nrun = STOP_AFTER + 1;
#else
    const int nrun = NPHASE;
#endif
    for (int ph = 0; ph < nrun; ++ph) {
        p.ph_lo = ph; p.ph_hi = ph + 1; p.coop = 0;
        hipLaunchKernelGGL(fwd_kernel, dim3(grid), dim3(NTHR), LDS_BYTES, stream, p);
    }
#endif
}
```

```cpp
#include <hip/hip_runtime.h>
#include <hip/hip_cooperative_groups.h>
#include <cstdio>
#include <cstdint>
namespace cg = cooperative_groups;

typedef unsigned short bf16_t;
typedef short bf16x8 __attribute__((ext_vector_type(8)));
typedef float f32x4 __attribute__((ext_vector_type(4)));
typedef unsigned u32x4 __attribute__((ext_vector_type(4)));
typedef unsigned u32x2 __attribute__((ext_vector_type(2)));
#define DEV __device__ __forceinline__

constexpr int T_ = 32768, L_ = 2048;
constexpr float LOG2E = 1.4426950408889634f;
constexpr float ALPHA = 1.189207115002721f;
constexpr float LN_EPS = 1e-5f;
constexpr float NEG = -1e30f;
constexpr int LDS_BYTES = 147456;
constexpr int NTHR = 512, NWAVE = 8;
constexpr size_t MiB = 1048576;

constexpr size_t O_WIN_T = 0;
constexpr size_t O_WGLU_T = O_WIN_T + 5376ull * 1024 * 2;
constexpr size_t O_WSOUT_T = O_WGLU_T + 512ull * 512 * 2;
constexpr size_t O_W1_T = O_WSOUT_T + 1024ull * 512 * 2;
constexpr size_t O_W2_T = O_W1_T + 2ull * 256 * 2048 * 2;
constexpr size_t O_WNOUT_T = O_W2_T + 2ull * 256 * 256 * 2;
constexpr size_t O_WOUT_T = O_WNOUT_T + 2 * MiB;
constexpr size_t O_WXQ_T = O_WOUT_T + 2 * MiB;
constexpr size_t O_WXKV_T = O_WXQ_T + 2 * MiB;
constexpr size_t O_WXO_T = O_WXKV_T + 4 * MiB;
constexpr size_t O_WFIN_T = O_WXO_T + 2 * MiB;
constexpr size_t O_WFOUT_T = O_WFIN_T + 5632ull * 1024 * 2;
constexpr size_t O_BT1 = O_WFOUT_T + 1024ull * 2816 * 2;
constexpr size_t O_MTW = O_BT1 + 8 * MiB;
constexpr size_t O_KC = O_MTW + 20 * MiB;
constexpr size_t O_VCT = O_KC + 1 * MiB;
constexpr size_t O_GN = O_VCT + 1 * MiB;
constexpr size_t O_ST0 = O_GN + 6 * MiB;
constexpr size_t O_ST1 = O_ST0 + 262144;
constexpr size_t O_ST2 = O_ST1 + 262144;
constexpr size_t O_BIAS2 = O_ST2 + 262144;
constexpr size_t O_BPART = O_BIAS2 + 4096;
constexpr size_t O_BAR = O_BPART + 32768;
constexpr size_t O_A = 81 * MiB;
constexpr size_t O_KVC = O_A;
constexpr size_t O_KS = O_A + 32 * MiB;
constexpr size_t O_VST = O_A + 48 * MiB;
constexpr size_t O_KW = O_A + 64 * MiB;
constexpr size_t O_VWT = O_A + 80 * MiB;
constexpr size_t O_GB = O_A + 96 * MiB;
constexpr size_t O_MIXIN = O_A;
constexpr size_t O_MEMB = O_A + 64 * MiB;
constexpr size_t O_XK = O_A + 72 * MiB;
constexpr size_t O_XVT = O_A + 80 * MiB;
constexpr size_t O_V2 = O_A;
constexpr size_t O_B = O_A + 128 * MiB;
constexpr size_t O_SS = O_B;
constexpr size_t O_HID = O_B + 16 * MiB;
constexpr size_t O_Y = O_B + 64 * MiB;
constexpr size_t O_GM = O_Y;
constexpr size_t O_V1 = O_Y;
constexpr size_t O_X = O_Y + 128 * MiB;
constexpr size_t O_QB = O_X;
constexpr size_t O_UH = O_X + 64 * MiB;
constexpr size_t O_YS = O_X + 64 * MiB;
constexpr size_t O_FB = O_Y;
constexpr size_t WS_NEED = O_X + 104 * MiB;
static_assert(O_BAR + 16384 <= O_A, "F region overflow");

struct P {
    const float* in[33];
    float* out;
    unsigned char* ws;
    int ph_lo, ph_hi, coop, pad;
};

DEV int get_tid() { int t = threadIdx.x; asm volatile("" : "+v"(t)); return t; }
DEV int get_bid() { int t = blockIdx.x; asm volatile("" : "+s"(t)); return t; }
typedef __bf16 bf2_t __attribute__((ext_vector_type(2)));
typedef float f32x2_t __attribute__((ext_vector_type(2)));
DEV unsigned cvt_pk_bf16(float lo, float hi) { const f32x2_t f = {lo, hi}; const bf2_t r = __builtin_convertvector(f, bf2_t); return __builtin_bit_cast(unsigned, r); }
DEV bf16_t f2bf(float v) { return (bf16_t)(cvt_pk_bf16(v, 0.f) & 0xffffu); }
DEV float bf2f(unsigned v) { return __uint_as_float(v << 16); }
DEV float bflo(unsigned w) { return __uint_as_float(w << 16); }
DEV float bfhi(unsigned w) { return __uint_as_float(w & 0xffff0000u); }
DEV float fexp2(float x) { return __builtin_amdgcn_exp2f(x); }
DEV float frcp(float x) { return __builtin_amdgcn_rcpf(x); }
DEV float sigmoidf_(float x) { return frcp(1.f + fexp2(-x * LOG2E)); }
DEV float gelu_tanh(float x) { const float u = 0.7978845608028654f * (x + 0.044715f * x * x * x); return x * frcp(1.f + fexp2(-2.f * LOG2E * u)); }
DEV void st_bf4(bf16_t* p, float a, float b, float c, float d) { u32x2 w; w.x = cvt_pk_bf16(a, b); w.y = cvt_pk_bf16(c, d); *(u32x2*)p = w; }
DEV f32x4 ld_bf4(const bf16_t* p) { const u32x2 w = *(const u32x2*)p; return (f32x4){bflo(w.x), bfhi(w.x), bflo(w.y), bfhi(w.y)}; }
DEV float wred_sum(float v) {
#pragma unroll
    for (int o = 32; o >= 1; o >>= 1) v += __shfl_xor(v, o);
    return v;
}

template <bool SRCBF>
DEV void ln_pass(const void* src_, const float* g, const float* b, bf16_t* dstb, float* stats, float* dstf) {
    constexpr int CH = SRCBF ? 8 : 4, NCH = 16 / CH;
    const int lane = get_tid() & 63, wid = get_tid() >> 6;
    const int nw = gridDim.x * NWAVE;
    for (int row = get_bid() * NWAVE + wid; row < T_; row += nw) {
        float e[16];
        if (SRCBF) {
            const u32x4* p = (const u32x4*)((const bf16_t*)src_ + (size_t)row * 1024);
#pragma unroll
            for (int i = 0; i < 2; ++i) { const u32x4 w = p[lane + 64 * i];
                e[8 * i + 0] = bflo(w.x); e[8 * i + 1] = bfhi(w.x); e[8 * i + 2] = bflo(w.y); e[8 * i + 3] = bfhi(w.y);
                e[8 * i + 4] = bflo(w.z); e[8 * i + 5] = bfhi(w.z); e[8 * i + 6] = bflo(w.w); e[8 * i + 7] = bfhi(w.w); }
        } else {
            const f32x4* p = (const f32x4*)((const float*)src_ + (size_t)row * 1024);
#pragma unroll
            for (int i = 0; i < 4; ++i) { const f32x4 v = p[lane + 64 * i]; e[4 * i] = v[0]; e[4 * i + 1] = v[1]; e[4 * i + 2] = v[2]; e[4 * i + 3] = v[3]; }
        }
        float s = 0.f;
#pragma unroll
        for (int k = 0; k < 16; ++k) s += e[k];
        s = wred_sum(s);
        const float mu = s * (1.f / 1024.f);
        float q = 0.f;
#pragma unroll
        for (int k = 0; k < 16; ++k) { const float d = e[k] - mu; q += d * d; }
        q = wred_sum(q);
        const float rstd = 1.0f / sqrtf(q * (1.f / 1024.f) + LN_EPS);
        if (stats && lane == 0) { stats[row * 2] = mu; stats[row * 2 + 1] = rstd; }
#pragma unroll
        for (int i = 0; i < NCH; ++i) {
            const int col = (lane + 64 * i) * CH;
            float y[CH];
#pragma unroll
            for (int k = 0; k < CH; k += 4) { const f32x4 gg = *(const f32x4*)(g + col + k), bb = *(const f32x4*)(b + col + k);
#pragma unroll
                for (int t = 0; t < 4; ++t) y[k + t] = (e[CH * i + k + t] - mu) * rstd * gg[t] + bb[t]; }
#pragma unroll
            for (int k = 0; k < CH; k += 4) {
                if (dstb) st_bf4(dstb + (size_t)row * 1024 + col + k, y[k], y[k + 1], y[k + 2], y[k + 3]);
                if (dstf) *(f32x4*)(dstf + (size_t)row * 1024 + col + k) = (f32x4){y[k], y[k + 1], y[k + 2], y[k + 3]};
            }
        }
    }
}

DEV int colmap(int mode, int n) {
    if (mode == 0) return n;
    if (mode == 1) return n < 3072 ? n : (n < 5120 ? n + 48 : (n < 5168 ? n - 5120 + 3072 : -1));
    if (mode == 2) { const int blk = n >> 5, r = n & 31; return r < 16 ? blk * 16 + r : 2816 + blk * 16 + (r - 16); }
    return n < 64 ? n : -1;
}
DEV void conv_job(const float* src, int ldsrc, int K, int N, bf16_t* dst, int mode, unsigned char* lds, int& cursor) {
    const int tid = get_tid(), lane = tid & 63, gw = get_bid() * NWAVE + (tid >> 6), nw = gridDim.x * NWAVE;
    const int kb = K / 32, nitem = (N / 64) * kb;
    for (int t = (gw + nw - (cursor % nw)) % nw; t < nitem; t += nw) {
        const int k0 = (t % kb) * 32, n = (t / kb) * 64 + lane;
        const int sc = colmap(mode, n);
        float e[32];
#pragma unroll
        for (int r = 0; r < 32; ++r) e[r] = sc >= 0 ? src[(size_t)(k0 + r) * ldsrc + sc] : 0.f;
#pragma unroll
        for (int q = 0; q < 4; ++q) { u32x4 w; w.x = cvt_pk_bf16(e[8 * q], e[8 * q + 1]); w.y = cvt_pk_bf16(e[8 * q + 2], e[8 * q + 3]); w.z = cvt_pk_bf16(e[8 * q + 4], e[8 * q + 5]); w.w = cvt_pk_bf16(e[8 * q + 6], e[8 * q + 7]);
            *(u32x4*)(dst + (size_t)n * K + k0 + 8 * q) = w; }
    }
    cursor += nitem;
}

struct SsmIn { const float *a_re, *a_im, *b_re, *b_im, *c_re, *c_im, *log_dt; };
DEV void lb_pow(const SsmIn& s, int g, int n, float p, float& re, float& im) {
    const float lre = fminf(s.a_re[g * 64 + n], -1e-4f), lim = s.a_im[g * 64 + n], dt = expf(s.log_dt[g]);
    const float mag = expf(lre * dt * p); float sn, cs; sincosf(lim * dt * p, &sn, &cs);
    re = mag * cs; im = mag * sn;
}
DEV void bbar(const SsmIn& s, int g, int n, int c, float& re, float& im) {
    const float lre = fminf(s.a_re[g * 64 + n], -1e-4f), lim = s.a_im[g * 64 + n], dt = expf(s.log_dt[g]);
    const float mag = expf(lre * dt); float sn, cs; sincosf(lim * dt, &sn, &cs);
    const float sh = sinf(0.5f * lim * dt);
    const float nr = expm1f(lre * dt) - mag * 2.f * sh * sh, lbi = mag * sn;
    const float den = lre * lre + lim * lim;
    const float fre = (nr * lre + lbi * lim) / den, fim = (lbi * lre - nr * lim) / den;
    const float br = s.b_re[(g * 64 + n) * 16 + c], bi = s.b_im[(g * 64 + n) * 16 + c];
    re = fre * br - fim * bi; im = fre * bi + fim * br;
}
DEV void ssm_prep(const SsmIn& s, bf16_t* BT1, bf16_t* MTW, unsigned char* lds) {
    const int tid = get_tid();
    float* pw = (float*)lds;
    float* bb = pw + 33 * 128;
    float* cc = bb + 2048;
    float* fn = cc + 2048;
    float* km = fn + 128;
    for (int job = get_bid(); job < 512; job += gridDim.x) {
        const int g = job >> 4, pt = job & 15;
        __syncthreads();
        for (int e = tid; e < 33 * 64; e += NTHR) { float pr, pi; lb_pow(s, g, e & 63, (float)(e >> 6), pr, pi); pw[e * 2] = pr; pw[e * 2 + 1] = pi; }
        if (tid < 64) {
            const int n = tid;
            const float lre = fminf(s.a_re[g * 64 + n], -1e-4f), lim = s.a_im[g * 64 + n], dt = expf(s.log_dt[g]);
            const float mag = expf(lre * dt); float sn, cs; sincosf(lim * dt, &sn, &cs);
            const float sh = sinf(0.5f * lim * dt);
            const float nr = expm1f(lre * dt) - mag * 2.f * sh * sh, lbi = mag * sn;
            const float den = lre * lre + lim * lim;
            fn[n * 2] = (nr * lre + lbi * lim) / den; fn[n * 2 + 1] = (lbi * lre - nr * lim) / den;
        }
        for (int e = tid; e < 1024; e += NTHR) { const int c = e >> 6, n = e & 63; cc[e * 2] = s.c_re[(g * 16 + c) * 64 + n]; cc[e * 2 + 1] = s.c_im[(g * 16 + c) * 64 + n]; }
        __syncthreads();
        for (int e = tid; e < 1024; e += NTHR) { const int n = e >> 4; const float fre = fn[n * 2], fim = fn[n * 2 + 1];
            const float br = s.b_re[(g * 64) * 16 + e], bi = s.b_im[(g * 64) * 16 + e];
            bb[e * 2] = fre * br - fim * bi; bb[e * 2 + 1] = fre * bi + fim * br; }
        __syncthreads();
        for (int i = tid; i < 4096; i += NTHR) { const int e = pt * 4096 + i, nn = e >> 9, kk = e & 511, n = nn & 63, sidx = kk >> 4, c = kk & 15;
            const float pr = pw[((31 - sidx) * 64 + n) * 2], pi = pw[((31 - sidx) * 64 + n) * 2 + 1], br = bb[(n * 16 + c) * 2], bi = bb[(n * 16 + c) * 2 + 1];
            BT1[(size_t)g * 131072 + e] = f2bf((nn >> 6) ? (pr * bi + pi * br) : (pr * br - pi * bi)); }
        for (int i = tid; i < 4096; i += NTHR) BT1[(size_t)g * 131072 + 65536 + pt * 4096 + i] = 0;
        for (int i = tid; i < 4096; i += NTHR) { const int e = pt * 4096 + i, nn = e & 127, r = e >> 7, n = nn & 63, tau = r >> 4, c = r & 15;
            const float pr = pw[((tau + 1) * 64 + n) * 2], pi = pw[((tau + 1) * 64 + n) * 2 + 1], cr = cc[(c * 64 + n) * 2], ci = cc[(c * 64 + n) * 2 + 1];
            MTW[((size_t)g * 512 + r) * 640 + 512 + nn] = f2bf((nn >> 6) ? -(cr * pi + ci * pr) : (cr * pr - ci * pi)); }
        for (int i = tid; i < 32 * 512; i += NTHR) { const int r = pt * 32 + (i >> 9), kk = i & 511; if ((kk >> 4) > (r >> 4)) MTW[((size_t)g * 512 + r) * 640 + kk] = 0; }
        if (tid < 256) for (int dd = 0; dd < 2; ++dd) { const int d = 2 * pt + dd, c = tid >> 4, c2 = tid & 15; float acc = 0.f;
            for (int n = 0; n < 64; ++n) { const float cr = cc[(c * 64 + n) * 2], ci = cc[(c * 64 + n) * 2 + 1], pr = pw[(d * 64 + n) * 2], pi = pw[(d * 64 + n) * 2 + 1];
                const float xr = cr * pr - ci * pi, xi = cr * pi + ci * pr; acc += xr * bb[(n * 16 + c2) * 2] - xi * bb[(n * 16 + c2) * 2 + 1]; }
            km[dd * 256 + tid] = acc; }
        __syncthreads();
        if (tid < 256) for (int dd = 0; dd < 2; ++dd) { const int d = 2 * pt + dd; const bf16_t v = f2bf(km[dd * 256 + tid]); const int c = tid >> 4, c2 = tid & 15;
            for (int sidx = 0; sidx + d < 32; ++sidx) MTW[((size_t)g * 512 + (sidx + d) * 16 + c) * 640 + sidx * 16 + c2] = v; }
    }
    __syncthreads();
}
DEV void ssm_scan(const SsmIn& s, const float* SS, bf16_t* UH) {
    for (int idx = get_bid() * NTHR + get_tid(); idx < 32768; idx += gridDim.x * NTHR) {
        const int n = idx & 63, b = (idx >> 6) & 15, g = idx >> 10;
        float ar, ai; lb_pow(s, g, n, 32.f, ar, ai);
        float hr = 0.f, hi = 0.f;
        const size_t row0 = (size_t)(g * 16 + b) * 64;
#pragma unroll 8
        for (int k = 0; k < 64; ++k) {
            UH[(row0 + k) * 640 + 512 + n] = f2bf(hr); UH[(row0 + k) * 640 + 576 + n] = f2bf(hi);
            const float sr = SS[(row0 + k) * 128 + n], si = SS[(row0 + k) * 128 + 64 + n];
            const float nr = ar * hr - ai * hi + sr, ni = ar * hi + ai * hr + si;
            hr = nr; hi = ni;
        }
    }
}

struct GemmP { const bf16_t* A; const bf16_t* Bt; int lda, ldb, MT, NT, KT, nbatch; };
#define GLAS __attribute__((address_space(3)))
template <int WM, class Addr, class Epi>
DEV void gemm_run(const GemmP p, const Addr ad, const Epi epi, unsigned char* lds_, int rshift = 0) {
    constexpr int TM = 32 * WM, ABYTES = TM * 128, STAGE = ABYTES + 32768, NLA = WM / 2;
    GLAS unsigned char* lds = (GLAS unsigned char*)lds_;
    const int tid = get_tid(), lane = tid & 63, wid = __builtin_amdgcn_readfirstlane(tid >> 6), wr = wid >> 2, wc = wid & 3, l15 = lane & 15, quad = lane >> 4;
    int nx, x, jx, stride;
    { volatile GLAS unsigned* cw = (volatile GLAS unsigned*)(lds + LDS_BYTES - 16);
      const int nloc = (int)cw[0], nxc = (int)cw[1], rank = (int)cw[2], xcc = (int)cw[3];
      if (nloc > 0 && xcc < nxc && rank < nloc) { nx = nxc; x = xcc; jx = (rank + rshift) % nloc; stride = nloc; }
      else { nx = 1; x = 0; jx = get_bid(); stride = gridDim.x; } }
    nx = __builtin_amdgcn_readfirstlane(nx); x = __builtin_amdgcn_readfirstlane(x); jx = __builtin_amdgcn_readfirstlane(jx); stride = __builtin_amdgcn_readfirstlane(stride);
    const int MTT = p.MT / (WM / 4), NTT = p.NT / 2;
    const int SRtot = (p.nbatch * MTT) / 8, per = 8 * NTT, KT = p.KT;
    if (SRtot < nx) { nx = 1; x = 0; jx = get_bid(); stride = gridDim.x; }
    int offA[NLA], offB[4];
#pragma unroll
    for (int i = 0; i < NLA; ++i) { const int row = (wid + 8 * i) * 8 + (lane >> 3), c = (lane & 7) ^ ((row >> 1) & 7); offA[i] = row * p.lda + c * 8; }
#pragma unroll
    for (int i = 0; i < 4; ++i) { const int row = (wid + 8 * i) * 8 + (lane >> 3), c = (lane & 7) ^ ((row >> 1) & 7); offB[i] = row * p.ldb + c * 8; }
    const int sw = (l15 >> 1) & 7;
    int aoff[2], boff[2];
#pragma unroll
    for (int ks = 0; ks < 2; ++ks) { const int c = ((ks * 4 + quad) ^ sw) * 16; aoff[ks] = (wr * (WM * 16) + l15) * 128 + c; boff[ks] = ABYTES + (wc * 64 + l15) * 128 + c; }
    int ls = jx, lkt = 0; const bf16_t* lA = nullptr; const bf16_t* lB = nullptr; bool lvalid;
#define GEMM_DECODE_L() do { const int q_ = ls / per, rem_ = ls % per, sr_ = x + nx * q_; lvalid = sr_ < SRtot; if (lvalid) { const int R_ = sr_ * 8 + (rem_ & 7), b_ = R_ / MTT; \
        lA = p.A + ad.a_off(b_) + (size_t)((R_ % MTT) * TM) * p.lda; lB = p.Bt + ad.b_off(b_) + (size_t)((rem_ >> 3) * 256) * p.ldb; } } while (0)
#define GEMM_ISSUE(stg) do { _Pragma("unroll") for (int i_ = 0; i_ < NLA; ++i_) \
        __builtin_amdgcn_global_load_lds((const unsigned*)(lA + offA[i_] + lkt * 64), (GLAS unsigned*)(lds + (stg) * STAGE + (wid + 8 * i_) * 1024), 16, 0, 0); \
        _Pragma("unroll") for (int i_ = 0; i_ < 4; ++i_) \
        __builtin_amdgcn_global_load_lds((const unsigned*)(lB + offB[i_] + lkt * 64), (GLAS unsigned*)(lds + (stg) * STAGE + ABYTES + (wid + 8 * i_) * 1024), 16, 0, 0); \
        ++issued; if (++lkt == KT) { lkt = 0; ls += stride; GEMM_DECODE_L(); } } while (0)
    GEMM_DECODE_L();
    int issued = 0;
    asm volatile("s_waitcnt vmcnt(0)" ::: "memory");
    __syncthreads();
    if (lvalid) GEMM_ISSUE(0);
    if (lvalid) GEMM_ISSUE(1);
    f32x4 acc[WM][4];
#pragma unroll
    for (int i = 0; i < WM; ++i)
#pragma unroll
        for (int j = 0; j < 4; ++j) acc[i][j] = (f32x4){0.f, 0.f, 0.f, 0.f};
    int cs = jx, ckt = 0; bool drain = false;
#pragma unroll 1
    for (int it = 0; it < issued; ++it) {
        if (drain || issued - it - 1 == 0) asm volatile("s_waitcnt vmcnt(0)" ::: "memory");
        else asm volatile("s_waitcnt vmcnt(%0)" :: "n"(NLA + 4) : "memory");
        drain = false;
        __builtin_amdgcn_s_barrier();
        asm volatile("" ::: "memory");
        const GLAS unsigned char* st = lds + (it & 1) * STAGE;
        bf16x8 af[WM], bfr[4];
#pragma unroll
        for (int i = 0; i < 4; ++i) bfr[i] = *(const GLAS bf16x8*)(st + boff[0] + i * 2048);
#pragma unroll
        for (int i = 0; i < WM; ++i) af[i] = *(const GLAS bf16x8*)(st + aoff[0] + i * 2048);
#pragma unroll
        for (int mi = 0; mi < WM; ++mi)
#pragma unroll
            for (int ni = 0; ni < 4; ++ni) acc[mi][ni] = __builtin_amdgcn_mfma_f32_16x16x32_bf16(bfr[ni], af[mi], acc[mi][ni], 0, 0, 0);
#pragma unroll
        for (int i = 0; i < 4; ++i) bfr[i] = *(const GLAS bf16x8*)(st + boff[1] + i * 2048);
#pragma unroll
        for (int i = 0; i < WM; ++i) af[i] = *(const GLAS bf16x8*)(st + aoff[1] + i * 2048);
        asm volatile("s_waitcnt lgkmcnt(0)" ::: "memory");
        __builtin_amdgcn_s_barrier();
        asm volatile("" ::: "memory");
        if (lvalid) GEMM_ISSUE(it & 1);
        asm volatile("" ::: "memory");
#pragma unroll
        for (int mi = 0; mi < WM; ++mi)
#pragma unroll
            for (int ni = 0; ni < 4; ++ni) acc[mi][ni] = __builtin_amdgcn_mfma_f32_16x16x32_bf16(bfr[ni], af[mi], acc[mi][ni], 0, 0, 0);
        if (++ckt == KT) {
            const int q_ = cs / per, rem_ = cs % per, R_ = (x + nx * q_) * 8 + (rem_ & 7);
#pragma unroll
            for (int h = 0; h < WM / 4; ++h)
                epi(reinterpret_cast<const f32x4 (&)[4][4]>(acc[4 * h]), R_ / MTT, (R_ % MTT) * TM + wr * (WM * 16) + h * 64, (rem_ >> 3) * 256 + wc * 64, l15, quad);
#pragma unroll
            for (int i = 0; i < WM; ++i)
#pragma unroll
                for (int j = 0; j < 4; ++j) acc[i][j] = (f32x4){0.f, 0.f, 0.f, 0.f};
            ckt = 0; cs += stride; drain = true;
        }
    }
    asm volatile("s_waitcnt vmcnt(0) lgkmcnt(0)" ::: "memory");
    __syncthreads();
#undef GEMM_DECODE_L
#undef GEMM_ISSUE
}
struct AddrNone { DEV size_t a_off(int) const { return 0; } DEV size_t b_off(int) const { return 0; } };
struct AddrStride { size_t as, bs; DEV size_t a_off(int b) const { return as * b; } DEV size_t b_off(int b) const { return bs * b; } };
struct AddrCmp1 { DEV size_t a_off(int b) const { return (size_t)b * 2048 * 64; } DEV size_t b_off(int b) const { return (size_t)((b >> 2) & 1) * 256 * 2048; } };
struct AddrCmp2 { DEV size_t a_off(int b) const { return (size_t)b * 128 * 256; } DEV size_t b_off(int b) const { return (size_t)((b >> 2) & 1) * 256 * 256; } };

#define EPI_ARGS const f32x4 (&acc)[4][4], int batch, int m0, int n0, int l15, int quad
struct EpiIn {
    bf16_t *UH, *Qb, *KVC, *KS, *VST, *KW, *VWT, *GM; float* GN;
    DEV void operator()(EPI_ARGS) const {
#pragma unroll
        for (int mi = 0; mi < 4; ++mi) {
            const int t = m0 + mi * 16 + l15, b = t >> 11, tt = t & 2047;
#pragma unroll
            for (int ni = 0; ni < 4; ++ni) {
                const f32x4 v = acc[mi][ni];
                const int c = n0 + ni * 16 + quad * 4;
                if (n0 < 512) {
                    const int g = c >> 4;
                    st_bf4(UH + ((size_t)((g * 16 + b) * 64 + (tt >> 5))) * 640 + (tt & 31) * 16 + (c & 15), v[0], v[1], v[2], v[3]);
                } else if (n0 < 1536) {
                    const float sc = 0.125f * LOG2E;
                    st_bf4(Qb + (size_t)t * 1024 + (c - 512), v[0] * sc, v[1] * sc, v[2] * sc, v[3] * sc);
                } else if (n0 < 2048) {
                    const int cc = c - 1536, z = cc >> 8, h = (cc >> 6) & 3, d = cc & 63;
                    st_bf4(KVC + ((size_t)(((b * 2 + z) * 4 + h) * 2048 + tt)) * 64 + d, v[0], v[1], v[2], v[3]);
                } else if (n0 < 3072) {
                    const int cc = (c - 2048) & 511, isw = (c - 2048) >> 9, h = (cc >> 6) & 3, d = cc & 63;
                    if (cc < 256) st_bf4((isw ? KW : KS) + ((size_t)((b * 4 + h) * 2048 + tt)) * 64 + d, v[0], v[1], v[2], v[3]);
                    else { bf16_t* o = (isw ? VWT : VST) + ((size_t)((b * 4 + h) * 64 + d)) * 2048 + tt;
#pragma unroll
                        for (int i = 0; i < 4; ++i) o[(size_t)i * 2048] = f2bf(v[i]); }
                } else if (n0 < 5120) {
                    st_bf4(GM + (size_t)t * 2048 + (c - 3072), sigmoidf_(v[0]), sigmoidf_(v[1]), sigmoidf_(v[2]), sigmoidf_(v[3]));
                } else {
                    const int cc = c - 5120;
                    if (cc < 48) *(f32x4*)(GN + (size_t)t * 48 + cc) = (f32x4){sigmoidf_(v[0]), sigmoidf_(v[1]), sigmoidf_(v[2]), sigmoidf_(v[3])};
                }
            }
        }
    }
};
struct EpiXkv {
    bf16_t *XK, *XVT;
    DEV void operator()(EPI_ARGS) const {
#pragma unroll
        for (int mi = 0; mi < 4; ++mi) {
            const int r = m0 + mi * 16 + l15, b = r >> 8, m = r & 255;
#pragma unroll
            for (int ni = 0; ni < 4; ++ni) {
                const f32x4 v = acc[mi][ni]; const int c = n0 + ni * 16 + quad * 4;
                if (n0 < 1024) st_bf4(XK + (size_t)r * 1024 + c, v[0], v[1], v[2], v[3]);
                else { const int cc = c - 1024, h = cc >> 8, d = cc & 255; bf16_t* o = XVT + ((size_t)((b * 4 + h) * 256 + d)) * 256 + m;
#pragma unroll
                    for (int i = 0; i < 4; ++i) o[i * 256] = f2bf(v[i]); }
            }
        }
    }
};
struct EpiSsmA { float* SS;
    DEV void operator()(EPI_ARGS) const {
        if (n0 >= 128) return;
#pragma unroll
        for (int mi = 0; mi < 4; ++mi)
#pragma unroll
            for (int ni = 0; ni < 4; ++ni) *(f32x4*)(SS + ((size_t)batch * 1024 + m0 + mi * 16 + l15) * 128 + n0 + ni * 16 + quad * 4) = acc[mi][ni];
    }
};
struct EpiCmp1 { bf16_t* HID; const float* bias2;
    DEV void operator()(EPI_ARGS) const {
        const int z = (batch >> 2) & 1;
#pragma unroll
        for (int ni = 0; ni < 4; ++ni) {
            const int c = n0 + ni * 16 + quad * 4; const f32x4 bv = *(const f32x4*)(bias2 + z * 256 + c);
#pragma unroll
            for (int mi = 0; mi < 4; ++mi) { const f32x4 v = acc[mi][ni] + bv;
                st_bf4(HID + ((size_t)batch * 128 + m0 + mi * 16 + l15) * 256 + c, gelu_tanh(v[0]), gelu_tanh(v[1]), gelu_tanh(v[2]), gelu_tanh(v[3])); }
        }
    }
};
struct EpiCmp2 { bf16_t *KC, *VCT;
    DEV void operator()(EPI_ARGS) const {
        if (n0 >= 64) return;
        const int z = (batch >> 2) & 1, bh = (batch >> 3) * 4 + (batch & 3);
#pragma unroll
        for (int mi = 0; mi < 4; ++mi) { const int r = m0 + mi * 16 + l15;
#pragma unroll
            for (int ni = 0; ni < 4; ++ni) { const f32x4 v = acc[mi][ni]; const int c = n0 + ni * 16 + quad * 4;
                if (z == 0) st_bf4(KC + ((size_t)bh * 128 + r) * 64 + c, v[0], v[1], v[2], v[3]);
                else {
#pragma unroll
                    for (int i = 0; i < 4; ++i) VCT[((size_t)bh * 64 + c + i) * 128 + r] = f2bf(v[i]); } } }
    }
};
struct EpiSsmB { const bf16_t* UH; const float* dskip; bf16_t* GB;
    DEV void operator()(EPI_ARGS) const {
#pragma unroll
        for (int mi = 0; mi < 4; ++mi) { const int r = m0 + mi * 16 + l15, b = r >> 6, k = r & 63;
#pragma unroll
            for (int ni = 0; ni < 4; ++ni) { const int col = n0 + ni * 16 + quad * 4, tau = col >> 4, c = col & 15;
                const f32x4 u = ld_bf4(UH + ((size_t)batch * 1024 + r) * 640 + col);
                const f32x4 dv = *(const f32x4*)(dskip + batch * 16 + c);
                const f32x4 y = acc[mi][ni] + dv * u;
                st_bf4(GB + ((size_t)(b * 2048 + k * 32 + tau)) * 512 + batch * 16 + c, gelu_tanh(y[0]), gelu_tanh(y[1]), gelu_tanh(y[2]), gelu_tanh(y[3])); } }
    }
};
struct EpiGlu { const bf16_t* GB; const float* bglu; bf16_t* YS;
    DEV void operator()(EPI_ARGS) const {
#pragma unroll
        for (int ni = 0; ni < 4; ++ni) { const int c = n0 + ni * 16 + quad * 4; const f32x4 bv = *(const f32x4*)(bglu + c);
#pragma unroll
            for (int mi = 0; mi < 4; ++mi) { const size_t o = (size_t)(m0 + mi * 16 + l15) * 512 + c; const f32x4 g = ld_bf4(GB + o); const f32x4 v = acc[mi][ni] + bv;
                st_bf4(YS + o, g[0] * sigmoidf_(v[0]), g[1] * sigmoidf_(v[1]), g[2] * sigmoidf_(v[2]), g[3] * sigmoidf_(v[3])); } }
    }
};
struct EpiSout { const bf16_t* GM; bf16_t* P1;
    DEV void operator()(EPI_ARGS) const {
#pragma unroll
        for (int mi = 0; mi < 4; ++mi) { const size_t t = m0 + mi * 16 + l15;
#pragma unroll
            for (int ni = 0; ni < 4; ++ni) { const int c = n0 + ni * 16 + quad * 4; const f32x4 g = ld_bf4(GM + t * 2048 + c); const f32x4 v = acc[mi][ni] * g;
                st_bf4(P1 + t * 1024 + c, v[0], v[1], v[2], v[3]); } }
    }
};
struct EpiNout { const bf16_t* GM; const bf16_t* P1; bf16_t* MIX;
    DEV void operator()(EPI_ARGS) const {
#pragma unroll
        for (int mi = 0; mi < 4; ++mi) { const size_t t = m0 + mi * 16 + l15;
#pragma unroll
            for (int ni = 0; ni < 4; ++ni) { const int c = n0 + ni * 16 + quad * 4; const f32x4 g = ld_bf4(GM + t * 2048 + 1024 + c); const f32x4 v = acc[mi][ni] * g + ld_bf4(P1 + t * 1024 + c);
                st_bf4(MIX + t * 1024 + c, v[0], v[1], v[2], v[3]); } }
    }
};
template <bool SRCBF> struct EpiRes { const void* src; const float* stats; const float* g; const float* b; bf16_t* dst;
    DEV void operator()(EPI_ARGS) const {
#pragma unroll
        for (int mi = 0; mi < 4; ++mi) { const size_t t = m0 + mi * 16 + l15; const float mu = stats[t * 2], rs = stats[t * 2 + 1];
#pragma unroll
            for (int ni = 0; ni < 4; ++ni) { const int c = n0 + ni * 16 + quad * 4;
                const f32x4 xv = SRCBF ? ld_bf4((const bf16_t*)src + t * 1024 + c) : *(const f32x4*)((const float*)src + t * 1024 + c);
                const f32x4 gg = *(const f32x4*)(g + c), bb = *(const f32x4*)(b + c);
                const f32x4 o = ((xv - mu) * rs * gg + bb) * ALPHA + acc[mi][ni];
                st_bf4(dst + t * 1024 + c, o[0], o[1], o[2], o[3]); } }
    }
};
struct EpiScaleBf { bf16_t* O; int ldc; float sc;
    DEV void operator()(EPI_ARGS) const {
#pragma unroll
        for (int mi = 0; mi < 4; ++mi)
#pragma unroll
            for (int ni = 0; ni < 4; ++ni) { const f32x4 v = acc[mi][ni] * sc; st_bf4(O + (size_t)(m0 + mi * 16 + l15) * ldc + n0 + ni * 16 + quad * 4, v[0], v[1], v[2], v[3]); }
    }
};
struct EpiFfnIn { bf16_t* FB;
    DEV void operator()(EPI_ARGS) const {
#pragma unroll
        for (int mi = 0; mi < 4; ++mi) { const size_t t = m0 + mi * 16 + l15;
#pragma unroll
            for (int pp = 0; pp < 2; ++pp) { const f32x4 ga = acc[mi][2 * pp], up = acc[mi][2 * pp + 1]; const int j = (n0 + pp * 32) / 2 + quad * 4;
                st_bf4(FB + t * 2816 + j, ga[0] * sigmoidf_(ga[0]) * up[0], ga[1] * sigmoidf_(ga[1]) * up[1], ga[2] * sigmoidf_(ga[2]) * up[2], ga[3] * sigmoidf_(ga[3]) * up[3]); } }
    }
};

DEV float qmax(float v) { auto a = __builtin_amdgcn_permlane16_swap(__float_as_uint(v), __float_as_uint(v), false, false); v = fmaxf(__uint_as_float(a[0]), __uint_as_float(a[1]));
    auto b = __builtin_amdgcn_permlane32_swap(__float_as_uint(v), __float_as_uint(v), false, false); return fmaxf(__uint_as_float(b[0]), __uint_as_float(b[1])); }
DEV float qsum(float v) { auto a = __builtin_amdgcn_permlane16_swap(__float_as_uint(v), __float_as_uint(v), false, false); v = __uint_as_float(a[0]) + __uint_as_float(a[1]);
    auto b = __builtin_amdgcn_permlane32_swap(__float_as_uint(v), __float_as_uint(v), false, false); return __uint_as_float(b[0]) + __uint_as_float(b[1]); }
DEV bf16x8 pack_p(const f32x4& a, const f32x4& b) { u32x4 w; w.x = cvt_pk_bf16(a[0], a[1]); w.y = cvt_pk_bf16(a[2], a[3]); w.z = cvt_pk_bf16(b[0], b[1]); w.w = cvt_pk_bf16(b[2], b[3]); return __builtin_bit_cast(bf16x8, w); }
DEV void st_vt(unsigned char* rowbase, int e, const u32x4& v) {
    const int grp = e >> 2, ep = e & 3, a = ep >> 1, qp = (ep & 1) * 2;
    unsigned char* o = rowbase + grp * 64 + (qp * 8 + a * 4) * 2;
    *(u32x2*)o = (u32x2){v.x, v.y}; *(u32x2*)(o + 16) = (u32x2){v.z, v.w};
}

struct NsaCtx { const bf16_t *Qb, *KC, *VCT, *KS, *VST, *KW, *VWT; const float* GN; bf16_t* ON; };
constexpr float MINIT = -1e20f;

template <int MODE, bool BOUND>
DEV void nsa_tile(const unsigned char* Kl, const unsigned char* Vl, const bf16x8 (&Qf)[2][2], f32x4 (&O)[2][4], float (&m)[2], float (&l)[2],
                  const float (&slope)[2], int dist0, bool sel, int l15, int quad) {
    const float d0f = (float)dist0;
#pragma unroll
    for (int g = 0; g < 2; ++g) {
        f32x4 S[4];
#pragma unroll
        for (int kt = 0; kt < 4; ++kt) { S[kt] = (f32x4){0.f, 0.f, 0.f, 0.f};
#pragma unroll
            for (int ks = 0; ks < 2; ++ks) { const bf16x8 kf = *(const bf16x8*)(Kl + (kt * 16 + l15) * 144 + ks * 64 + quad * 16); S[kt] = __builtin_amdgcn_mfma_f32_16x16x32_bf16(kf, Qf[g][ks], S[kt], 0, 0, 0); } }
        float base = -slope[g] * d0f;
        if (MODE == 0) base = sel ? base : NEG;
        typedef float f2 __attribute__((ext_vector_type(2)));
        const f2 sl_lo = {0.f, slope[g]}, sl_hi = {2.f * slope[g], 3.f * slope[g]};
        float tmax = NEG;
        f2 Slo[4], Shi[4];
#pragma unroll
        for (int kt = 0; kt < 4; ++kt) {
            const float bk = fmaf(slope[g], (float)(16 * kt), base);
            f2 lo = (f2){S[kt][0], S[kt][1]} + (sl_lo + bk), hi = (f2){S[kt][2], S[kt][3]} + (sl_hi + bk);
            if (BOUND) {
#pragma unroll
                for (int i = 0; i < 4; ++i) { const int cc = 16 * kt + i; bool v = cc <= dist0; if (MODE == 1) v = v && (cc > dist0 - 512);
                    if (i < 2) lo[i] = v ? lo[i] : NEG; else hi[i - 2] = v ? hi[i - 2] : NEG; }
            }
            Slo[kt] = lo; Shi[kt] = hi;
            tmax = fmaxf(fmaxf(tmax, lo[0]), lo[1]); tmax = fmaxf(fmaxf(tmax, hi[0]), hi[1]);
        }
        tmax = qmax(tmax);
        const float mnew = fmaxf(m[g], tmax), alpha = fexp2(m[g] - mnew);
        f2 rs2 = {0.f, 0.f};
#pragma unroll
        for (int kt = 0; kt < 4; ++kt) {
            const f2 a = Slo[kt] - mnew, b = Shi[kt] - mnew;
            const f2 pa = {fexp2(a[0]), fexp2(a[1])}, pb = {fexp2(b[0]), fexp2(b[1])};
            rs2 += pa; rs2 += pb;
            S[kt] = (f32x4){pa[0], pa[1], pb[0], pb[1]};
        }
        l[g] = l[g] * alpha + (rs2[0] + rs2[1]); m[g] = mnew;
        const bf16x8 P0 = pack_p(S[0], S[1]), P1 = pack_p(S[2], S[3]);
#pragma unroll
        for (int dt = 0; dt < 4; ++dt) { O[g][dt] = O[g][dt] * alpha;
            const bf16x8 v0 = *(const bf16x8*)(Vl + (dt * 16 + l15) * 144 + quad * 16), v1 = *(const bf16x8*)(Vl + (dt * 16 + l15) * 144 + 64 + quad * 16);
            O[g][dt] = __builtin_amdgcn_mfma_f32_16x16x32_bf16(v0, P0, O[g][dt], 0, 0, 0);
            O[g][dt] = __builtin_amdgcn_mfma_f32_16x16x32_bf16(v1, P1, O[g][dt], 0, 0, 0); }
    }
}

template <int MODE>
DEV void nsa_tiles(unsigned char* lds, const bf16_t* Kg, const bf16_t* VTg, unsigned tilemask, unsigned wmask, unsigned qmask, int jb0, int jb1,
                   const bf16x8 (&Qf)[2][2], f32x4 (&O)[2][4], float (&m)[2], float (&l)[2], const float (&slope)[2], int tq, int l15, int quad) {
    const int tid = get_tid();
    const int prow = tid >> 3, pe = tid & 7;
    unsigned rem = tilemask;
    int j = __builtin_ctz(rem); rem &= rem - 1;
    u32x4 rk, rv;
    rk = *(const u32x4*)(Kg + (size_t)(64 * j + prow) * 64 + pe * 8); rv = *(const u32x4*)(VTg + (size_t)prow * 2048 + 64 * j + pe * 8);
    int cur = 0;
    *(u32x4*)(lds + prow * 144 + pe * 16) = rk; st_vt(lds + 9216 + prow * 144, pe, rv);
    __syncthreads();
    for (;;) {
        int jn = -1;
        if (rem) { jn = __builtin_ctz(rem); rem &= rem - 1;
            rk = *(const u32x4*)(Kg + (size_t)(64 * jn + prow) * 64 + pe * 8); rv = *(const u32x4*)(VTg + (size_t)prow * 2048 + 64 * jn + pe * 8); }
        __builtin_amdgcn_sched_barrier(0);
        const unsigned char* st = lds + cur * 18432;
        if (MODE == 1 || ((wmask >> j) & 1u)) {
            const int dist0 = tq - 64 * j - 4 * quad; const bool sel = (qmask >> j) & 1u;
            if (j == jb0 || j == jb1) nsa_tile<MODE, true>(st, st + 9216, Qf, O, m, l, slope, dist0, sel, l15, quad);
            else nsa_tile<MODE, false>(st, st + 9216, Qf, O, m, l, slope, dist0, sel, l15, quad);
        }
        if (jn >= 0) { unsigned char* sn = lds + (cur ^ 1) * 18432; *(u32x4*)(sn + prow * 144 + pe * 16) = rk; st_vt(sn + 9216 + prow * 144, pe, rv); }
        __syncthreads();
        if (jn < 0) break;
        j = jn; cur ^= 1;
    }
}

DEV void nsa_unit(const NsaCtx& c, int b, int hkv, int qb, unsigned char* lds) {
    const int tid = get_tid(), lane = tid & 63, wid = tid >> 6, l15 = lane & 15, quad = lane >> 4;
    const int qs = wid & 3, hp = wid >> 2;
    const int tq = qb * 64 + qs * 16 + l15, cur = qb;
    const size_t trow = (size_t)b * 2048 + tq;
    const int head0 = hkv * 4 + hp * 2;
    const float* gnp = c.GN + trow * 48 + head0 * 3;
    unsigned char* stash = lds + 36864 + wid * 4096;
    float* xch = (float*)(lds + 69632);
    unsigned* smask = (unsigned*)(lds + 102400);
    const int bh = b * 4 + hkv;
    {
        const bf16_t* Kg = c.KC + (size_t)bh * 128 * 64; const bf16_t* Vg = c.VCT + (size_t)bh * 64 * 128;
#pragma unroll
        for (int i = 0; i < 2; ++i) { const int pc = tid + 512 * i;
            *(u32x4*)(lds + (pc >> 3) * 144 + (pc & 7) * 16) = *(const u32x4*)(Kg + pc * 8);
            st_vt(lds + 18432 + (pc >> 4) * 272, pc & 15, *(const u32x4*)(Vg + pc * 8)); }
    }
    __syncthreads();
    const int nkt = (4 * qb + 2) / 16 + 1;
    float Mx[8], Sm[8];
#pragma unroll
    for (int kt = 0; kt < 8; ++kt) { Mx[kt] = NEG; Sm[kt] = 0.f; }
#ifdef NSA_NO_CMP
    for (int g = 0; g < 0; ++g) {
#else
#pragma unroll
    for (int g = 0; g < 2; ++g) {
#endif
        bf16x8 Qg[2];
#pragma unroll
        for (int ks = 0; ks < 2; ++ks) Qg[ks] = *(const bf16x8*)(c.Qb + trow * 1024 + (head0 + g) * 64 + ks * 32 + quad * 8);
        const float slope_g = exp2f(-0.5f * (float)(head0 + g + 1)) * LOG2E;
        f32x4 S[8];
#pragma unroll
        for (int kt = 0; kt < 8; ++kt) { S[kt] = (f32x4){0.f, 0.f, 0.f, 0.f};
            if (kt < nkt) {
#pragma unroll
                for (int ks = 0; ks < 2; ++ks) { const bf16x8 kf = *(const bf16x8*)(lds + (kt * 16 + l15) * 144 + ks * 64 + quad * 16); S[kt] = __builtin_amdgcn_mfma_f32_16x16x32_bf16(kf, Qg[ks], S[kt], 0, 0, 0); } } }
        float mx = NEG;
        const int d0 = tq - 31 - 64 * quad; const float base = -slope_g * (float)d0;
#pragma unroll
        for (int kt = 0; kt < 8; ++kt)
#pragma unroll
            for (int i = 0; i < 4; ++i) { const int cc = 256 * kt + 16 * i; const float s = (kt < nkt && cc <= d0) ? fmaf(slope_g, (float)cc, S[kt][i] + base) : NEG; S[kt][i] = s; mx = fmaxf(mx, s); }
        mx = qmax(mx);
        float ls = 0.f;
#pragma unroll
        for (int kt = 0; kt < 8; ++kt)
#pragma unroll
            for (int i = 0; i < 4; ++i) ls += S[kt][i] > -1e29f ? fexp2(S[kt][i] - mx) : 0.f;
        ls = qsum(ls);
        const float lcl = fmaxf(ls, 1e-30f), lg = __log2f(lcl) + mx;
        float x3[8];
#pragma unroll
        for (int kt = 0; kt < 8; ++kt) {
#pragma unroll
            for (int i = 0; i < 4; ++i) S[kt][i] = S[kt][i] > -1e29f ? S[kt][i] - lg : NEG;
            x3[kt] = __shfl(S[kt][3], (lane + 48) & 63);
        }
#pragma unroll
        for (int kt = 0; kt < 8; ++kt) {
            const float nb = quad >= 1 ? x3[kt] : (kt >= 1 ? x3[kt >= 1 ? kt - 1 : 0] : NEG);
            const float tm = fmaxf(fmaxf(fmaxf(S[kt][0], S[kt][1]), fmaxf(S[kt][2], S[kt][3])), nb);
            const float nm = fmaxf(Mx[kt], tm);
            Sm[kt] = Sm[kt] * fexp2(Mx[kt] - nm) + fexp2(S[kt][0] - nm) + fexp2(S[kt][1] - nm) + fexp2(S[kt][2] - nm) + fexp2(S[kt][3] - nm) + fexp2(nb - nm);
            Mx[kt] = nm;
        }
        const float gate0 = gnp[g * 3];
        f32x4 Oc[4];
#pragma unroll
        for (int dt = 0; dt < 4; ++dt) Oc[dt] = (f32x4){0.f, 0.f, 0.f, 0.f};
#pragma unroll
        for (int k2 = 0; k2 < 4; ++k2) {
            if (2 * k2 < nkt) {
                f32x4 pa, pb;
#pragma unroll
                for (int i = 0; i < 4; ++i) { pa[i] = fexp2(S[2 * k2][i]); pb[i] = fexp2(S[2 * k2 + 1][i]); }
                const bf16x8 pf = pack_p(pa, pb);
#pragma unroll
                for (int dt = 0; dt < 4; ++dt) { const bf16x8 vf = *(const bf16x8*)(lds + 18432 + (dt * 16 + l15) * 272 + k2 * 64 + quad * 16); Oc[dt] = __builtin_amdgcn_mfma_f32_16x16x32_bf16(vf, pf, Oc[dt], 0, 0, 0); }
            }
        }
#pragma unroll
        for (int dt = 0; dt < 4; ++dt) { const f32x4 v = Oc[dt] * gate0; u32x2 w; w.x = cvt_pk_bf16(v[0], v[1]); w.y = cvt_pk_bf16(v[2], v[3]); *(u32x2*)(stash + ((g * 4 + dt) * 64 + lane) * 8) = w; }
    }
    unsigned qmask;
    if (cur < 8) qmask = (2u << cur) - 1u;
    if (cur >= 8) {
#pragma unroll
        for (int kt = 0; kt < 8; ++kt) { xch[(wid * 16 + kt) * 64 + lane] = Mx[kt]; xch[(wid * 16 + 8 + kt) * 64 + lane] = Sm[kt]; }
    }
    __syncthreads();
    if (cur >= 8) {
        float v[8];
#pragma unroll
        for (int kt = 0; kt < 8; ++kt) {
            const float m2 = xch[((wid ^ 4) * 16 + kt) * 64 + lane], s2 = xch[((wid ^ 4) * 16 + 8 + kt) * 64 + lane];
            const float mm = fmaxf(Mx[kt], m2), ss = Sm[kt] * fexp2(Mx[kt] - mm) + s2 * fexp2(m2 - mm);
            const int jb = 4 * kt + quad; v[kt] = (jb >= 1 && jb <= cur - 2) ? mm + __log2f(ss) : -3e38f; }
        qmask = 1u | (1u << cur) | (1u << (cur - 1));
        for (int r = 0; r < 5; ++r) {
            float bv = v[0]; int bj = quad;
#pragma unroll
            for (int kt = 1; kt < 8; ++kt) if (v[kt] > bv) { bv = v[kt]; bj = 4 * kt + quad; }
#pragma unroll
            for (int o = 16; o <= 32; o <<= 1) { const float ov = __shfl_xor(bv, o); const int oj = __shfl_xor(bj, o); if (ov > bv || (ov == bv && oj < bj)) { bv = ov; bj = oj; } }
            qmask |= 1u << bj;
#pragma unroll
            for (int kt = 0; kt < 8; ++kt) if (4 * kt + quad == bj) v[kt] = -3.2e38f;
        }
    }
    unsigned wmask = qmask;
#pragma unroll
    for (int o = 1; o <= 8; o <<= 1) wmask |= __shfl_xor(wmask, o);
    if (lane == 0) smask[wid] = wmask;
    __syncthreads();
    const unsigned umask = (smask[0] | smask[1] | smask[2] | smask[3]) | (smask[4] | smask[5] | smask[6] | smask[7]);
    bf16x8 Qf[2][2]; float slope[2];
#pragma unroll
    for (int g = 0; g < 2; ++g) {
#pragma unroll
        for (int ks = 0; ks < 2; ++ks) Qf[g][ks] = *(const bf16x8*)(c.Qb + trow * 1024 + (head0 + g) * 64 + ks * 32 + quad * 8);
        slope[g] = exp2f(-0.5f * (float)(head0 + g + 1)) * LOG2E;
    }
    f32x4 O[2][4]; float m[2], l[2];
#pragma unroll
    for (int g = 0; g < 2; ++g) { m[g] = MINIT; l[g] = 0.f;
#pragma unroll
        for (int dt = 0; dt < 4; ++dt) O[g][dt] = (f32x4){0.f, 0.f, 0.f, 0.f}; }
#ifndef NSA_NO_SLC
    nsa_tiles<0>(lds, c.KS + (size_t)bh * 2048 * 64, c.VST + (size_t)bh * 64 * 2048, umask, wmask, qmask, cur, cur, Qf, O, m, l, slope, tq, l15, quad);
#endif
#pragma unroll
    for (int g = 0; g < 2; ++g) { const float sc = gnp[g * 3 + 1] / fmaxf(qsum(l[g]), 1e-30f);
#pragma unroll
        for (int dt = 0; dt < 4; ++dt) { u32x2* sp = (u32x2*)(stash + ((g * 4 + dt) * 64 + lane) * 8); const u32x2 w = *sp;
            const f32x4 v = O[g][dt] * sc + (f32x4){bflo(w.x), bfhi(w.x), bflo(w.y), bfhi(w.y)};
            u32x2 w2; w2.x = cvt_pk_bf16(v[0], v[1]); w2.y = cvt_pk_bf16(v[2], v[3]); *sp = w2;
            O[g][dt] = (f32x4){0.f, 0.f, 0.f, 0.f}; }
        m[g] = MINIT; l[g] = 0.f; }
    const int jlo = qb >= 8 ? qb - 8 : 0;
    const unsigned winmask = ((2u << cur) - 1u) & ~((1u << jlo) - 1u);
#ifndef NSA_NO_WIN
    nsa_tiles<1>(lds, c.KW + (size_t)bh * 2048 * 64, c.VWT + (size_t)bh * 64 * 2048, winmask, 0u, 0u, cur, jlo, Qf, O, m, l, slope, tq, l15, quad);
#endif
#pragma unroll
    for (int g = 0; g < 2; ++g) { const float sc = gnp[g * 3 + 2] / fmaxf(qsum(l[g]), 1e-30f);
#pragma unroll
        for (int dt = 0; dt < 4; ++dt) { const u32x2 w = *(const u32x2*)(stash + ((g * 4 + dt) * 64 + lane) * 8);
            const f32x4 v = O[g][dt] * sc + (f32x4){bflo(w.x), bfhi(w.x), bflo(w.y), bfhi(w.y)};
            st_bf4(c.ON + trow * 1024 + (head0 + g) * 64 + dt * 16 + quad * 4, v[0], v[1], v[2], v[3]); } }
}

DEV void xattn_unit(const bf16_t* Qx, const bf16_t* XK, const bf16_t* XVT, bf16_t* OX, int b, int h, int qblk  , unsigned char* lds) {
    const int tid = get_tid(), lane = tid & 63, wid = tid >> 6, l15 = lane & 15, quad = lane >> 4;
    const size_t trow = (size_t)b * 2048 + qblk * 128 + wid * 16 + l15;
    bf16x8 Qf[8];
#pragma unroll
    for (int ks = 0; ks < 8; ++ks) Qf[ks] = *(const bf16x8*)(Qx + trow * 1024 + h * 256 + ks * 32 + quad * 8);
    f32x4 O[16];
#pragma unroll
    for (int dt = 0; dt < 16; ++dt) O[dt] = (f32x4){0.f, 0.f, 0.f, 0.f};
    float m = NEG, l = 0.f;
    const bf16_t* Kg = XK + (size_t)b * 256 * 1024 + h * 256;
    const bf16_t* Vg = XVT + (size_t)(b * 4 + h) * 256 * 256;
    u32x4 rk[2], rv[2];
#pragma unroll
    for (int i = 0; i < 2; ++i) { const int pc = tid + 512 * i; rk[i] = *(const u32x4*)(Kg + (size_t)(pc >> 5) * 1024 + (pc & 31) * 8); rv[i] = *(const u32x4*)(Vg + (size_t)(pc >> 2) * 256 + (pc & 3) * 8); }
#pragma unroll
    for (int i = 0; i < 2; ++i) { const int pc = tid + 512 * i; *(u32x4*)(lds + (pc >> 5) * 528 + (pc & 31) * 16) = rk[i]; st_vt(lds + 16896 + (pc >> 2) * 80, pc & 3, rv[i]); }
    __syncthreads();
    for (int j = 0; j < 8; ++j) {
        const bool more = j + 1 < 8;
        if (more) {
#pragma unroll
            for (int i = 0; i < 2; ++i) { const int pc = tid + 512 * i; rk[i] = *(const u32x4*)(Kg + (size_t)(32 * (j + 1) + (pc >> 5)) * 1024 + (pc & 31) * 8); rv[i] = *(const u32x4*)(Vg + (size_t)(pc >> 2) * 256 + 32 * (j + 1) + (pc & 3) * 8); } }
        __builtin_amdgcn_sched_barrier(0);
        const unsigned char* st = lds + (j & 1) * 37376;
        f32x4 S[2];
#pragma unroll
        for (int kt = 0; kt < 2; ++kt) { S[kt] = (f32x4){0.f, 0.f, 0.f, 0.f};
#pragma unroll
            for (int ks = 0; ks < 8; ++ks) { const bf16x8 kf = *(const bf16x8*)(st + (kt * 16 + l15) * 528 + ks * 64 + quad * 16); S[kt] = __builtin_amdgcn_mfma_f32_16x16x32_bf16(kf, Qf[ks], S[kt], 0, 0, 0); } }
        float tmax = fmaxf(fmaxf(fmaxf(S[0][0], S[0][1]), fmaxf(S[0][2], S[0][3])), fmaxf(fmaxf(S[1][0], S[1][1]), fmaxf(S[1][2], S[1][3])));
        tmax = qmax(tmax);
        const float mnew = fmaxf(m, tmax), alpha = fexp2(m - mnew);
        float rs = 0.f;
#pragma unroll
        for (int kt = 0; kt < 2; ++kt)
#pragma unroll
            for (int i = 0; i < 4; ++i) { const float pv = fexp2(S[kt][i] - mnew); S[kt][i] = pv; rs += pv; }
        l = l * alpha + rs; m = mnew;
        const bf16x8 pf = pack_p(S[0], S[1]);
#pragma unroll
        for (int dt = 0; dt < 16; ++dt) { O[dt] = O[dt] * alpha; const bf16x8 vf = *(const bf16x8*)(st + 16896 + (dt * 16 + l15) * 80 + quad * 16); O[dt] = __builtin_amdgcn_mfma_f32_16x16x32_bf16(vf, pf, O[dt], 0, 0, 0); }
        if (more) { unsigned char* sn = lds + ((j + 1) & 1) * 37376;
#pragma unroll
            for (int i = 0; i < 2; ++i) { const int pc = tid + 512 * i; *(u32x4*)(sn + (pc >> 5) * 528 + (pc & 31) * 16) = rk[i]; st_vt(sn + 16896 + (pc >> 2) * 80, pc & 3, rv[i]); } }
        __syncthreads();
    }
    const float inv = 1.0f / qsum(l);
#pragma unroll
    for (int dt = 0; dt < 16; ++dt) { const f32x4 v = O[dt] * inv; st_bf4(OX + trow * 1024 + h * 256 + dt * 16 + quad * 4, v[0], v[1], v[2], v[3]); }
}


#define XB_TMO      128
#define XB_XCNT(j)  (256  + 64 * (j))
#define XB_XSUB(j)  (1280 + 64 * (j))
#define XB_XGEN(j)  (2304 + 64 * (j))
#define XB_TOP      3328
#define XB_TOPGEN   3392
#define XCD_BAR_WORDS 3456
#define XB_SPIN_CAP (1u << 18)
#define LAS __attribute__((address_space(3)))
DEV unsigned xb_ld(unsigned* p)              { return __hip_atomic_load(p, __ATOMIC_RELAXED, __HIP_MEMORY_SCOPE_AGENT); }
DEV unsigned xb_add(unsigned* p, unsigned v) { return __hip_atomic_fetch_add(p, v, __ATOMIC_RELAXED, __HIP_MEMORY_SCOPE_AGENT); }
DEV unsigned xb_xcc_id() { return (unsigned)__builtin_amdgcn_s_getreg((3 << 11) | 20) & 0xFu; }
#define XB_SPIN(cond, bar) do { unsigned _sp = 0; while (cond) { __builtin_amdgcn_s_sleep(1); \
    if ((++_sp & 255u) == 0u) { if (xb_ld(&(bar)[XB_TMO])) break; if (_sp > XB_SPIN_CAP) { atomicAdd(&(bar)[XB_TMO], 1u); break; } } } } while (0)
struct XcdBarrier { unsigned* bar; unsigned x; volatile LAS unsigned* st; };
DEV XcdBarrier xcd_barrier_post(unsigned* bar, volatile LAS unsigned* st) {
    XcdBarrier b; b.bar = bar; b.x = xb_xcc_id(); b.st = st;
    if (threadIdx.x == 0) { st[2] = xb_add(&bar[XB_XCNT(b.x)], 1u); st[3] = b.x; }
    return b;
}
DEV void xcd_barrier_complete(unsigned* bar, unsigned x, unsigned& nloc, unsigned& nx) {
    const unsigned G = gridDim.x * gridDim.y * gridDim.z;
    unsigned sum, cnt, mine, sp = 0u;
    for (;;) {
        sum = 0u; cnt = 0u; mine = 0u;
#pragma unroll
        for (unsigned j = 0; j < 16; ++j) { const unsigned c = xb_ld(&bar[XB_XCNT(j)]); sum += c; cnt += (c > 0u) ? 1u : 0u; mine = (j == x) ? c : mine; }
        if (sum == G) break;
        __builtin_amdgcn_s_sleep(1);
        if ((++sp & 255u) == 0u) { if (xb_ld(&bar[XB_TMO])) break; if (sp > XB_SPIN_CAP) { atomicAdd(&bar[XB_TMO], 1u); break; } }
    }
    nloc = mine > 0u ? mine : 1u; nx = cnt > 0u ? cnt : 1u;
}
DEV void xcd_barrier(const XcdBarrier& b) {
    asm volatile("s_waitcnt vmcnt(0)" ::: "memory");
    __syncthreads();
    if (threadIdx.x == 0) {
        unsigned* bar = b.bar;
        __builtin_amdgcn_s_waitcnt(0);
        unsigned nloc = b.st[0], nx = b.st[1];
        if (nloc == 0u) { xcd_barrier_complete(bar, b.x, nloc, nx); b.st[0] = nloc; b.st[1] = nx; }
        const unsigned old = xb_add(&bar[XB_XSUB(b.x)], 1u);
        const unsigned gen = old / nloc;
        if (old + 1u == (gen + 1u) * nloc) {
            __builtin_amdgcn_fence(__ATOMIC_RELEASE, "agent");
            asm volatile("s_waitcnt vmcnt(0)" ::: "memory");
            const unsigned og = xb_add(&bar[XB_TOP], 1u);
            const unsigned tg = og / nx;
            if (og + 1u == (tg + 1u) * nx) xb_add(&bar[XB_TOPGEN], 1u);
            else XB_SPIN(xb_ld(&bar[XB_TOPGEN]) == tg, bar);
            __builtin_amdgcn_fence(__ATOMIC_ACQUIRE, "agent");
            xb_add(&bar[XB_XGEN(b.x)], 1u);
            asm volatile("s_waitcnt vmcnt(0)" ::: "memory");
        } else {
            XB_SPIN(xb_ld(&bar[XB_XGEN(b.x)]) == gen, bar);
            __builtin_amdgcn_fence(__ATOMIC_ACQUIRE, "agent");
            asm volatile("s_waitcnt vmcnt(0)" ::: "memory");
        }
    }
    __syncthreads();
}

constexpr int NPHASE = 17;
__global__ void __launch_bounds__(512, 2) fwd_kernel(P p) {
    extern __shared__ __attribute__((aligned(16))) unsigned char lds[];
#define WSB(off) ((bf16_t*)(ws + (off)))
#define WSF(off) ((float*)(ws + (off)))
    volatile LAS unsigned* bst = (volatile LAS unsigned*)(LAS unsigned char*)(lds + LDS_BYTES - 16);
    if (threadIdx.x == 0) { bst[0] = 0u; bst[1] = 0u; bst[2] = 0u; bst[3] = 0u; }
    __syncthreads();
    XcdBarrier gbar; gbar.bar = (unsigned*)(p.ws + O_BAR); gbar.x = 0; gbar.st = bst;
    if (p.coop) gbar = xcd_barrier_post((unsigned*)(p.ws + O_BAR), bst);
    const SsmIn sin_{p.in[5], p.in[6], p.in[7], p.in[8], p.in[9], p.in[10], p.in[12]};
    for (int ph = p.ph_lo; ph < p.ph_hi; ++ph) {
        size_t zoff = 0; asm volatile("" : "+s"(zoff)); unsigned char* ws = p.ws + zoff;
        switch (ph) {
#ifdef ONLY_PHASE
        default: break;
#define CASE(k) case (k): if ((k) != ONLY_PHASE) break; else
#else
#define CASE(k) case (k):
#endif
        CASE(0) {
            const int tid = get_tid();
            ln_pass<false>(p.in[0], p.in[2], p.in[3], WSB(O_B), WSF(O_ST0), nullptr);
            int cur = 0;
            conv_job(p.in[4], 5168, 1024, 5376, WSB(O_WIN_T), 1, lds, cur);
            conv_job(p.in[13], 512, 512, 512, WSB(O_WGLU_T), 0, lds, cur);
            conv_job(p.in[15], 1024, 512, 1024, WSB(O_WSOUT_T), 0, lds, cur);
            conv_job(p.in[17], 256, 2048, 256, WSB(O_W1_T), 0, lds, cur);
            conv_job(p.in[17] + 2048 * 256, 256, 2048, 256, WSB(O_W1_T) + 256 * 2048, 0, lds, cur);
            conv_job(p.in[19], 64, 256, 256, WSB(O_W2_T), 3, lds, cur);
            conv_job(p.in[19] + 256 * 64, 64, 256, 256, WSB(O_W2_T) + 256 * 256, 3, lds, cur);
            conv_job(p.in[20], 1024, 1024, 1024, WSB(O_WNOUT_T), 0, lds, cur);
            conv_job(p.in[21], 1024, 1024, 1024, WSB(O_WOUT_T), 0, lds, cur);
            conv_job(p.in[24], 1024, 1024, 1024, WSB(O_WXQ_T), 0, lds, cur);
            conv_job(p.in[25], 2048, 1024, 2048, WSB(O_WXKV_T), 0, lds, cur);
            conv_job(p.in[26], 1024, 1024, 1024, WSB(O_WXO_T), 0, lds, cur);
            conv_job(p.in[29], 5632, 1024, 5632, WSB(O_WFIN_T), 2, lds, cur);
            conv_job(p.in[30], 1024, 2816, 1024, WSB(O_WFOUT_T), 0, lds, cur);
            for (int it = get_bid(); it < 128; it += gridDim.x) {
                const int z = it >> 6, ec = (it >> 4) & 3, fc = it & 15, e = ec * 64 + (tid & 63), fg = tid >> 6;
                float a = 0.f;
#pragma unroll 8
                for (int f = fc * 128 + fg * 16; f < fc * 128 + fg * 16 + 16; ++f) a += p.in[16][z * 2048 + f] * p.in[17][((size_t)z * 2048 + f) * 256 + e];
                float* red = (float*)lds;
                __syncthreads(); red[tid] = a; __syncthreads();
                if (tid < 64) { float t = 0.f; for (int k = 0; k < 8; ++k) t += red[tid + 64 * k]; WSF(O_BPART)[(z * 16 + fc) * 256 + e] = t; }
                __syncthreads();
            }
            ssm_prep(sin_, WSB(O_BT1), WSB(O_MTW), lds);
        } break;
        CASE(1) {
            if (get_bid() == 0) { for (int e = get_tid(); e < 512; e += NTHR) { float a = p.in[18][e]; for (int fc = 0; fc < 16; ++fc) a += WSF(O_BPART)[((e >> 8) * 16 + fc) * 256 + (e & 255)]; WSF(O_BIAS2)[e] = a; } }
            { const GemmP g{WSB(O_B), WSB(O_WIN_T), 1024, 1024, 256, 42, 16, 1};
              const EpiIn e{WSB(O_UH), WSB(O_QB), WSB(O_KVC), WSB(O_KS), WSB(O_VST), WSB(O_KW), WSB(O_VWT), WSB(O_GM), WSF(O_GN)};
              gemm_run<8>(g, AddrNone{}, e, lds); }
        } break;
        CASE(2) {
            { const GemmP g{WSB(O_KVC), WSB(O_W1_T), 1024, 2048, 1, 2, 32, 128};
              const EpiCmp1 e{WSB(O_HID), WSF(O_BIAS2)};
              gemm_run<4>(g, AddrCmp1{}, e, lds); }
            { const GemmP g{WSB(O_UH), WSB(O_BT1), 640, 512, 8, 2, 8, 32};
              const EpiSsmA e{WSF(O_SS)};
              gemm_run<8>(g, AddrStride{1024ull * 640, 256ull * 512}, e, lds, 16); }
        } break;
        CASE(3) {
            ssm_scan(sin_, WSF(O_SS), WSB(O_UH));
            { const GemmP g{WSB(O_HID), WSB(O_W2_T), 256, 256, 1, 2, 4, 128};
              const EpiCmp2 e{WSB(O_KC), WSB(O_VCT)};
              gemm_run<4>(g, AddrCmp2{}, e, lds, 16); }
        } break;
        CASE(4) {
            const NsaCtx c{WSB(O_QB), WSB(O_KC), WSB(O_VCT), WSB(O_KS), WSB(O_VST), WSB(O_KW), WSB(O_VWT), WSF(O_GN), WSB(O_B)};
            const int G = gridDim.x;
            for (int i = 0;; ++i) {
                const int u = (i & 1) ? i * G + (G - 1 - get_bid()) : i * G + get_bid();
                if (i * G >= 2048) break;
                if (u < 2048) { const int qb = 31 - (u >> 6), bh = u & 63; nsa_unit(c, bh >> 2, bh & 3, qb, lds); }
                __syncthreads();
            }
            { const GemmP g{WSB(O_UH), WSB(O_MTW), 640, 640, 8, 4, 10, 32};
              const EpiSsmB e{WSB(O_UH), p.in[11], WSB(O_GB)};
              gemm_run<8>(g, AddrStride{1024ull * 640, 512ull * 640}, e, lds); }
        } break;
        CASE(5) { const GemmP g{WSB(O_GB), WSB(O_WGLU_T), 512, 512, 256, 4, 8, 1}; const EpiGlu e{WSB(O_GB), p.in[14], WSB(O_YS)}; gemm_run<8>(g, AddrNone{}, e, lds); } break;
        CASE(6) { const GemmP g{WSB(O_YS), WSB(O_WSOUT_T), 512, 512, 256, 8, 8, 1}; const EpiSout e{WSB(O_GM), WSB(O_QB)}; gemm_run<8>(g, AddrNone{}, e, lds); } break;
        CASE(7) { const GemmP g{WSB(O_B), WSB(O_WNOUT_T), 1024, 1024, 256, 8, 16, 1}; const EpiNout e{WSB(O_GM), WSB(O_QB), WSB(O_MIXIN)}; gemm_run<8>(g, AddrNone{}, e, lds); } break;
        CASE(8) { const GemmP g{WSB(O_MIXIN), WSB(O_WOUT_T), 1024, 1024, 256, 8, 16, 1}; const EpiRes<false> e{p.in[0], WSF(O_ST0), p.in[2], p.in[3], WSB(O_V1)}; gemm_run<8>(g, AddrNone{}, e, lds); } break;
        CASE(9) { ln_pass<true>(WSB(O_V1), p.in[22], p.in[23], WSB(O_B), WSF(O_ST1), nullptr);
            for (size_t i = (size_t)get_bid() * NTHR + get_tid(); i < 4096ull * 1024 / 4; i += (size_t)gridDim.x * NTHR) { const f32x4 v = ((const f32x4*)p.in[1])[i]; st_bf4(WSB(O_MEMB) + i * 4, v[0], v[1], v[2], v[3]); }
        } break;
        CASE(10) { { const GemmP g{WSB(O_B), WSB(O_WXQ_T), 1024, 1024, 256, 8, 16, 1}; const EpiScaleBf e{WSB(O_QB), 1024, 0.0625f * LOG2E}; gemm_run<8>(g, AddrNone{}, e, lds); }
            { const GemmP g{WSB(O_MEMB), WSB(O_WXKV_T), 1024, 1024, 32, 16, 16, 1};
              const EpiXkv e{WSB(O_XK), WSB(O_XVT)};
              gemm_run<4>(g, AddrNone{}, e, lds); }
        } break;
        CASE(11) {
            for (int u = get_bid(); u < 1024; u += gridDim.x) { const int qblk = u >> 6, bh = u & 63; xattn_unit(WSB(O_QB), WSB(O_XK), WSB(O_XVT), WSB(O_B), bh >> 2, bh & 3, qblk, lds); }
        } break;
        CASE(12) { const GemmP g{WSB(O_B), WSB(O_WXO_T), 1024, 1024, 256, 8, 16, 1}; const EpiRes<true> e{WSB(O_V1), WSF(O_ST1), p.in[22], p.in[23], WSB(O_V2)}; gemm_run<8>(g, AddrNone{}, e, lds); } break;
        CASE(13) ln_pass<true>(WSB(O_V2), p.in[27], p.in[28], WSB(O_B), WSF(O_ST2), nullptr); break;
        CASE(14) { const GemmP g{WSB(O_B), WSB(O_WFIN_T), 1024, 1024, 256, 44, 16, 1}; const EpiFfnIn e{WSB(O_FB)}; gemm_run<8>(g, AddrNone{}, e, lds); } break;
        CASE(15) { const GemmP g{WSB(O_FB), WSB(O_WFOUT_T), 2816, 2816, 256, 8, 44, 1}; const EpiRes<true> e{WSB(O_V2), WSF(O_ST2), p.in[27], p.in[28], WSB(O_V2)}; gemm_run<8>(g, AddrNone{}, e, lds); } break;
        CASE(16) ln_pass<true>(WSB(O_V2), p.in[31], p.in[32], nullptr, nullptr, p.out); break;
        }
        if (ph + 1 < p.ph_hi) { if (p.coop) xcd_barrier(gbar); if (p.pad == 0x5eed) cg::this_grid().sync(); }
    }
}

#ifndef ONE_LAUNCH
#define ONE_LAUNCH 1
#endif
extern "C" void kernel_launch(void* const* d_in, const int* in_sizes, int n_in, void* d_out, int out_size, void* d_ws, size_t ws_size, hipStream_t stream) {
    static int grid = 0;
    if (grid == 0) {
        if (n_in != 33 || out_size != T_ * 1024 || ws_size < WS_NEED) { fprintf(stderr, "kernel_launch: unexpected shapes (n_in %d out %d ws %zu need %zu)\n", n_in, out_size, ws_size, (size_t)WS_NEED); grid = -1; return; }
        int dev = 0, cus = 0, per_cu = 0;
        hipGetDevice(&dev);
        hipDeviceGetAttribute(&cus, hipDeviceAttributeMultiprocessorCount, dev);
        if (hipFuncSetAttribute((const void*)fwd_kernel, hipFuncAttributeMaxDynamicSharedMemorySize, LDS_BYTES) != hipSuccess) { fprintf(stderr, "kernel_launch: hipFuncSetAttribute failed\n"); grid = -1; return; }
        if (hipOccupancyMaxActiveBlocksPerMultiprocessor(&per_cu, (const void*)fwd_kernel, NTHR, LDS_BYTES) != hipSuccess || per_cu < 1) { fprintf(stderr, "kernel_launch: occupancy query failed (%d)\n", per_cu); per_cu = 1; (void)hipGetLastError(); }
        if (per_cu > 1) per_cu = 1;
        grid = cus * per_cu;
    }
    if (grid < 0) return;
    P p{};
    for (int i = 0; i < 33; ++i) p.in[i] = (const float*)d_in[i];
    p.out = (float*)d_out; p.ws = (unsigned char*)d_ws;
#if ONE_LAUNCH
    p.ph_lo = 0; p.ph_hi = NPHASE; p.coop = 1;
    if (hipMemsetAsync((unsigned char*)d_ws + O_BAR, 0, XCD_BAR_WORDS * 4, stream) != hipSuccess) { fprintf(stderr, "kernel_launch: memset of barrier words failed\n"); return; }
    void* args[] = {&p};
    hipError_t e = hipLaunchCooperativeKernel((const void*)fwd_kernel, dim3(grid), dim3(NTHR), args, LDS_BYTES, stream);
    if (e != hipSuccess) fprintf(stderr, "cooperative launch failed: %s (grid %d)\n", hipGetErrorString(e), grid);
#else
#ifdef STOP_AFTER
    const int nrun = STOP_AFTER + 1;
#else
    const int nrun = NPHASE;
#endif
    for (int ph = 0; ph < nrun; ++ph) {
        p.ph_lo = ph; p.ph_hi = ph + 1; p.coop = 0;
        hipLaunchKernelGGL(fwd_kernel, dim3(grid), dim3(NTHR), LDS_BYTES, stream, p);
    }
#endif
}
```
